# Optimizing an MI355X kernel written in HIP

```python
import math
import jax, jax.numpy as jnp
from jax import lax
import numpy as np

D_MODEL = 1024
BATCH = 8
SEQ = 2048
DEPTH = 4
DEC_BATCH = 128
DEC_SEQ = 4
PAST_LEN = 8192
PAGE_SIZE = 128

W_A = D_MODEL // 2
POOL_WINDOWS = (2, 4, 8, 16)
POOL_GROUP = W_A // len(POOL_WINDOWS)
POOL_BUF = max(POOL_WINDOWS) - 1
HEAD_DIM = 64
N_HEADS = (D_MODEL // 2) // HEAD_DIM
KV_HEADS = 2
Q_PER_KV = N_HEADS // KV_HEADS
W_B = N_HEADS * HEAD_DIM
KV_W = KV_HEADS * HEAD_DIM
WINDOW = 128
BLOCK = WINDOW
ROT_DIM = HEAD_DIM // 4
ROPE_THETA = 500000.0
W_C = D_MODEL // 2
SSM_CH = 16
SSM_GROUPS = W_C // SSM_CH
SSM_STATE = 64
N_BRANCH = 3
D_FF = -(-(8 * D_MODEL // 3) // 256) * 256
EPS = 1e-6
IN_SPLITS = (W_A, W_A + W_B, W_A + W_B + KV_W, W_A + W_B + 2 * KV_W, W_A + W_B + 2 * KV_W + W_C)
IN_COLS = W_A + W_B + 2 * KV_W + W_C + N_BRANCH * D_MODEL

kernel_name = "gated_hybrid_pool_swa_s5_decoder_step"


def _rmsnorm(x, g):
    xf = x.astype(jnp.float32)
    r = lax.rsqrt(jnp.mean(xf * xf, axis=-1, keepdims=True) + EPS)
    return (xf * r).astype(x.dtype) * g


def _rope(x, pos):
    f32 = jnp.float32
    inv = ROPE_THETA ** (-jnp.arange(0, ROT_DIM, 2, dtype=f32) / ROT_DIM)
    ang = pos.astype(f32)[:, None] * inv[None, :]
    cos = jnp.cos(ang)[None, :, None, :]
    sin = jnp.sin(ang)[None, :, None, :]
    xr = x[..., :ROT_DIM].astype(f32)
    x1, x2 = xr[..., : ROT_DIM // 2], xr[..., ROT_DIM // 2:]
    rot = jnp.concatenate([x1 * cos - x2 * sin, x2 * cos + x1 * sin], axis=-1).astype(x.dtype)
    return jnp.concatenate([rot, x[..., ROT_DIM:]], axis=-1)


def _sink_attend(s, mask, sinks, v, eq_pv):
    s = jnp.where(mask, s, -jnp.inf)
    sk = sinks.astype(jnp.float32).reshape(KV_HEADS, Q_PER_KV, 1, 1)
    m = jnp.maximum(jnp.max(s, axis=-1, keepdims=True), sk)
    p = jnp.exp(s - m)
    den = jnp.sum(p, axis=-1, keepdims=True) + jnp.exp(sk - m)
    return jnp.einsum(eq_pv, (p / den).astype(v.dtype), v)


def _swa_prompt(q, k, v, sinks):
    bsz, seq = q.shape[:2]
    nb = seq // BLOCK
    qb = q.reshape(bsz, nb, BLOCK, KV_HEADS, Q_PER_KV, HEAD_DIM)

    def band(t):
        tb = t.reshape(bsz, nb, BLOCK, KV_HEADS, HEAD_DIM)
        prev = jnp.concatenate([jnp.zeros_like(tb[:, :1]), tb[:, :-1]], axis=1)
        return jnp.concatenate([prev, tb], axis=2)

    kb, vb = band(k), band(v)
    s = jnp.einsum("bnqgrd,bnkgd->bngrqk", qb, kb, preferred_element_type=jnp.float32) * (HEAD_DIM ** -0.5)
    qi = jnp.arange(BLOCK)[:, None]
    kj = jnp.arange(2 * BLOCK)[None, :]
    diff = BLOCK + qi - kj
    in_band = (diff >= 0) & (diff < WINDOW)
    blk = jnp.arange(nb)[:, None, None]
    mask = in_band[None] & ((blk > 0) | (kj >= BLOCK)[None])
    mask = mask[None, :, None, None]
    o = _sink_attend(s, mask, sinks, vb, "bngrqk,bnkgd->bnqgrd")
    return o.reshape(bsz, seq, W_B), k[:, -WINDOW:], v[:, -WINDOW:]


def _swa_sample(q, k, v, ck, cv, pos, sinks):
    bsz, t = q.shape[:2]
    wb = ck.shape[1]
    ke = jnp.concatenate([ck, k], axis=1)
    ve = jnp.concatenate([cv, v], axis=1)
    kpos = PAST_LEN - wb + jnp.arange(wb + t, dtype=jnp.int32)
    diff = pos[:, None] - kpos[None, :]
    mask = (diff >= 0) & (diff < WINDOW)
    qg = q.reshape(bsz, t, KV_HEADS, Q_PER_KV, HEAD_DIM)
    s = jnp.einsum("bqgrd,bkgd->bgrqk", qg, ke, preferred_element_type=jnp.float32) * (HEAD_DIM ** -0.5)
    o = _sink_attend(s, mask, sinks, ve, "bgrqk,bkgd->bqgrd")
    return o.reshape(bsz, t, W_B), ke[:, -wb:], ve[:, -wb:]


def _pool_mix(xa, prev, pos, pool_w, pool_scale):
    t = xa.shape[1]
    xe = jnp.concatenate([prev, xa], axis=1)
    cs = jnp.cumsum(xe.astype(jnp.float32), axis=1)
    cs = jnp.concatenate([jnp.zeros_like(cs[:, :1]), cs], axis=1)
    end = cs[:, POOL_BUF + 1:]
    outs = []
    for g, w in enumerate(POOL_WINDOWS):
        lo, hi = g * POOL_GROUP, (g + 1) * POOL_GROUP
        start = cs[:, POOL_BUF + 1 - w: POOL_BUF + 1 - w + t, lo:hi]
        cnt = jnp.minimum(pos + 1, w).astype(jnp.float32)[None, :, None]
        d = ((end[..., lo:hi] - start) / cnt - xa[..., lo:hi].astype(jnp.float32)).astype(xa.dtype)
        outs.append(d @ pool_w[g])
    y = jnp.concatenate(outs, axis=-1) * pool_scale
    return y, xe[:, -POOL_BUF:]


def _lin_combine(left, right):
    return (left[0] * right[0], right[0] * left[1] + right[1])


def _s5(u, h0_re, h0_im, a_re, a_im, log_dt, b_re, b_im, c_re, c_im, d, w_glu):
    f32 = jnp.float32
    bsz, t = u.shape[:2]
    uf = u.astype(f32).reshape(bsz, t, SSM_GROUPS, SSM_CH)
    a = lax.complex(a_re.astype(f32), a_im.astype(f32))
    dt = jnp.exp(log_dt.astype(f32))[:, None]
    a_bar = jnp.exp(a * dt)
    b = lax.complex(b_re.astype(f32), b_im.astype(f32))
    b_bar = ((a_bar - 1.0) / a)[..., None] * b
    drive = jnp.einsum("gpc,btgc->btgp", b_bar, uf.astype(jnp.complex64))
    h0 = lax.complex(h0_re.astype(f32), h0_im.astype(f32))
    drive = drive.at[:, 0].add(a_bar[None] * h0)
    decay = jnp.broadcast_to(a_bar, drive.shape)
    _, h = lax.associative_scan(_lin_combine, (decay, drive), axis=1)
    cm = lax.complex(c_re.astype(f32), c_im.astype(f32))
    y = jnp.einsum("gcp,btgp->btgc", cm, h).real + d.astype(f32).reshape(SSM_GROUPS, SSM_CH) * uf
    y = jax.nn.gelu(y.reshape(bsz, t, W_C)).astype(u.dtype)
    y = y * jax.nn.sigmoid(y @ w_glu)
    h_last = h[:, -1]
    return y, h_last.real.astype(h0_re.dtype), h_last.imag.astype(h0_re.dtype)


def _layer(x, c, pos, win_k, win_v, pool_prev, h0_re, h0_im, lp):
    bsz, t, _ = x.shape
    if pool_prev is None:
        pool_prev = jnp.zeros((bsz, POOL_BUF, W_A), x.dtype)
        h0_re = jnp.zeros((bsz, SSM_GROUPS, SSM_STATE), x.dtype)
        h0_im = jnp.zeros((bsz, SSM_GROUPS, SSM_STATE), x.dtype)
    mod = jax.nn.silu(c) @ lp["w_ada"] + lp["b_ada"]
    sh1, sc1, g1, sh2, sc2, g2 = [m[:, None, :] for m in jnp.split(mod, 6, axis=-1)]
    h = _rmsnorm(x, lp["norm1_g"]) * (1.0 + sc1) + sh1
    z = h @ lp["w_in"]
    xa, q, k, v, u, gates = jnp.split(z, list(IN_SPLITS), axis=-1)
    q = _rope(q.reshape(bsz, t, N_HEADS, HEAD_DIM), pos)
    k = _rope(k.reshape(bsz, t, KV_HEADS, HEAD_DIM), pos)
    v = v.reshape(bsz, t, KV_HEADS, HEAD_DIM)
    ya, pool_new = _pool_mix(xa, pool_prev, pos, lp["pool_w"], lp["pool_scale"])
    if win_k is None:
        yb, k_new, v_new = _swa_prompt(q, k, v, lp["attn_sinks"])
    else:
        yb, k_new, v_new = _swa_sample(q, k, v, win_k, win_v, pos, lp["attn_sinks"])
    yc, hre, him = _s5(u, h0_re, h0_im, lp["ssm_a_re"], lp["ssm_a_im"], lp["ssm_log_dt"], lp["ssm_b_re"],
                       lp["ssm_b_im"], lp["ssm_c_re"], lp["ssm_c_im"], lp["ssm_d"], lp["w_glu"])
    ga, gb, gc = jnp.split(jax.nn.sigmoid(gates), N_BRANCH, axis=-1)
    merged = ga * (ya @ lp["w_branch_a"]) + gb * (yb @ lp["w_branch_b"]) + gc * (yc @ lp["w_branch_c"])
    x = x + g1 * (merged @ lp["w_out"])
    h2 = _rmsnorm(x, lp["norm2_g"]) * (1.0 + sc2) + sh2
    a_up, b_up = jnp.split(h2 @ lp["w_ffn_in"], 2, axis=-1)
    x = x + g2 * ((jax.nn.silu(a_up) * b_up) @ lp["w_ffn_out"])
    return x, k_new, v_new, pool_new, hre, him


def setup_inputs(seed: int = 0) -> dict:
    key = jax.random.key(seed)
    ks = iter(jax.random.split(key, 48))
    f32 = jnp.float32

    def nrm(shape, s=1.0):
        return s * jax.random.normal(next(ks), shape, f32)

    L, D = DEPTH, D_MODEL
    win = min(WINDOW, PAST_LEN)
    n_idx = jnp.arange(SSM_STATE, dtype=f32)
    return {
        "x_prompt": nrm((BATCH, SEQ, D)),
        "x_sample": nrm((DEC_BATCH, DEC_SEQ, D)),
        "cache_win_k": nrm((L, DEC_BATCH, win, KV_HEADS, HEAD_DIM)),
        "cache_win_v": nrm((L, DEC_BATCH, win, KV_HEADS, HEAD_DIM)),
        "state_pool": nrm((L, DEC_BATCH, POOL_BUF, W_A)),
        "state_ssm_re": nrm((L, DEC_BATCH, SSM_GROUPS, SSM_STATE), 0.5),
        "state_ssm_im": nrm((L, DEC_BATCH, SSM_GROUPS, SSM_STATE), 0.5),
        "c_prompt": nrm((BATCH, D)),
        "c_sample": nrm((DEC_BATCH, D)),
        "norm1_g": 1.0 + nrm((L, D), 0.05),
        "norm2_g": 1.0 + nrm((L, D), 0.05),
        "w_ada": nrm((L, D, 6 * D), 0.5 * D ** -0.5),
        "b_ada": nrm((L, 6 * D), 0.02),
        "w_in": nrm((L, D, IN_COLS), D ** -0.5),
        "pool_w": nrm((L, len(POOL_WINDOWS), POOL_GROUP, POOL_GROUP), POOL_GROUP ** -0.5),
        "pool_scale": 1.0 + nrm((L, W_A), 0.1),
        "attn_sinks": nrm((L, N_HEADS), 0.5),
        "ssm_a_re": -0.5 * jnp.exp(nrm((L, SSM_GROUPS, SSM_STATE), 0.05)),
        "ssm_a_im": math.pi * n_idx + nrm((L, SSM_GROUPS, SSM_STATE), 0.05),
        "ssm_log_dt": jax.random.uniform(next(ks), (L, SSM_GROUPS), f32, math.log(1e-3), math.log(1e-1)),
        "ssm_b_re": nrm((L, SSM_GROUPS, SSM_STATE, SSM_CH), (2 * SSM_CH) ** -0.5),
        "ssm_b_im": nrm((L, SSM_GROUPS, SSM_STATE, SSM_CH), (2 * SSM_CH) ** -0.5),
        "ssm_c_re": nrm((L, SSM_GROUPS, SSM_CH, SSM_STATE), SSM_STATE ** -0.5),
        "ssm_c_im": nrm((L, SSM_GROUPS, SSM_CH, SSM_STATE), SSM_STATE ** -0.5),
        "ssm_d": nrm((L, W_C)),
        "w_glu": nrm((L, W_C, W_C), W_C ** -0.5),
        "w_branch_a": nrm((L, W_A, D), W_A ** -0.5),
        "w_branch_b": nrm((L, W_B, D), W_B ** -0.5),
        "w_branch_c": nrm((L, W_C, D), W_C ** -0.5),
        "w_out": nrm((L, D, D), D ** -0.5),
        "w_ffn_in": nrm((L, D, 2 * D_FF), D ** -0.5),
        "w_ffn_out": nrm((L, D_FF, D), D_FF ** -0.5),
        "final_norm_g": 1.0 + nrm((D,), 0.05),
    }


def reference(x_prompt, x_sample, cache_win_k, cache_win_v, state_pool, state_ssm_re, state_ssm_im,
              c_prompt, c_sample, norm1_g, norm2_g, w_ada, b_ada, w_in, pool_w, pool_scale, attn_sinks,
              ssm_a_re, ssm_a_im, ssm_log_dt, ssm_b_re, ssm_b_im, ssm_c_re, ssm_c_im, ssm_d, w_glu,
              w_branch_a, w_branch_b, w_branch_c, w_out, w_ffn_in, w_ffn_out, final_norm_g):
    pos_p = jnp.arange(x_prompt.shape[1], dtype=jnp.int32)
    pos_s = PAST_LEN + jnp.arange(x_sample.shape[1], dtype=jnp.int32)
    hp, hs = x_prompt, x_sample
    pk, pv, ppool, pre, pim = [], [], [], [], []
    sk, sv, spool, sre, sim = [], [], [], [], []
    for l in range(DEPTH):
        lp = dict(norm1_g=norm1_g[l], norm2_g=norm2_g[l], w_ada=w_ada[l], b_ada=b_ada[l], w_in=w_in[l],
                  pool_w=pool_w[l], pool_scale=pool_scale[l], attn_sinks=attn_sinks[l],
                  ssm_a_re=ssm_a_re[l], ssm_a_im=ssm_a_im[l], ssm_log_dt=ssm_log_dt[l],
                  ssm_b_re=ssm_b_re[l], ssm_b_im=ssm_b_im[l], ssm_c_re=ssm_c_re[l], ssm_c_im=ssm_c_im[l],
                  ssm_d=ssm_d[l], w_glu=w_glu[l], w_branch_a=w_branch_a[l], w_branch_b=w_branch_b[l],
                  w_branch_c=w_branch_c[l], w_out=w_out[l], w_ffn_in=w_ffn_in[l], w_ffn_out=w_ffn_out[l])
        hp, k1, v1, po1, r1, i1 = _layer(hp, c_prompt, pos_p, None, None, None, None, None, lp)
        pk.append(k1); pv.append(v1); ppool.append(po1); pre.append(r1); pim.append(i1)
        hs, k2, v2, po2, r2, i2 = _layer(hs, c_sample, pos_s, cache_win_k[l], cache_win_v[l], state_pool[l],
                                         state_ssm_re[l], state_ssm_im[l], lp)
        sk.append(k2); sv.append(v2); spool.append(po2); sre.append(r2); sim.append(i2)
    y_prompt = _rmsnorm(hp, final_norm_g)
    y_sample = _rmsnorm(hs, final_norm_g)
    return (y_prompt, y_sample,
            jnp.stack(pk), jnp.stack(pv), jnp.stack(ppool), jnp.stack(pre), jnp.stack(pim),
            jnp.stack(sk), jnp.stack(sv), jnp.stack(spool), jnp.stack(sre), jnp.stack(sim))
```

```cpp
#include <hip/hip_runtime.h>
#include <hip/hip_cooperative_groups.h>
#include <cstdio>
#include <cstdint>
#include <cmath>
namespace cg = cooperative_groups;

#ifndef MK_MULTI
#define MK_MULTI 0
#endif

__device__ __forceinline__ int lane_id_v() { int l; asm volatile("v_mbcnt_lo_u32_b32 %0, -1, 0\n\tv_mbcnt_hi_u32_b32 %0, -1, %0" : "=v"(l)); return l; }
__device__ __forceinline__ float shx(float v, int mask, int lane) { return __builtin_bit_cast(float, __builtin_amdgcn_ds_bpermute((lane ^ mask) << 2, __builtin_bit_cast(int, v))); }

__device__ __forceinline__ float shx32(float v, int upper  ) { const unsigned x = __builtin_bit_cast(unsigned, v); auto r = __builtin_amdgcn_permlane32_swap(x, x, false, false); return __builtin_bit_cast(float, upper ? r[0] : r[1]); }
__device__ __forceinline__ float shx16(float v, int odd  ) { const unsigned x = __builtin_bit_cast(unsigned, v); auto r = __builtin_amdgcn_permlane16_swap(x, x, false, false); return __builtin_bit_cast(float, odd ? r[0] : r[1]); }

namespace cfg {
constexpr int D = 1024, MP = 16384, MS = 512, M = MP + MS, SEQ = 2048, NBAT = 136, DEPTH = 4;
constexpr int IN_COLS = 4864, DFF = 2816, NMOD = 6 * D * DEPTH;
constexpr size_t OFF_Y = 0;
constexpr size_t OFF_KP = (size_t)M * D;
constexpr size_t OFF_VP = OFF_KP + (size_t)4 * 8 * 128 * 128;
constexpr size_t OFF_PP = OFF_VP + (size_t)4 * 8 * 128 * 128;
constexpr size_t OFF_SRP = OFF_PP + (size_t)4 * 8 * 15 * 512;
constexpr size_t OFF_SIP = OFF_SRP + (size_t)4 * 8 * 32 * 64;
constexpr size_t OFF_KS = OFF_SIP + (size_t)4 * 8 * 32 * 64;
constexpr size_t OFF_VS = OFF_KS + (size_t)4 * 128 * 128 * 128;
constexpr size_t OFF_PS = OFF_VS + (size_t)4 * 128 * 128 * 128;
constexpr size_t OFF_SRS = OFF_PS + (size_t)4 * 128 * 15 * 512;
constexpr size_t OFF_SIS = OFF_SRS + (size_t)4 * 128 * 32 * 64;
constexpr size_t OUT_TOTAL = OFF_SIS + (size_t)4 * 128 * 32 * 64;
static_assert(OUT_TOTAL == 41533440, "output size");
constexpr size_t MiB = 1u << 20;
constexpr size_t WS_WIN = 1 * MiB;
constexpr size_t WS_WGLU = WS_WIN + 38 * MiB;
constexpr size_t WS_WBR = WS_WGLU + 2 * MiB;
constexpr size_t WS_WOUT = WS_WBR + 12 * MiB;
constexpr size_t WS_WFI = WS_WOUT + 8 * MiB;
constexpr size_t WS_WFO = WS_WFI + 44 * MiB;
constexpr size_t WS_MOD = WS_WFO + 22 * MiB;
constexpr size_t WS_CA = WS_MOD + 13 * MiB;
constexpr size_t WS_TAB = WS_CA + 1 * MiB;
constexpr size_t WS_H = WS_TAB + 2 * MiB;
constexpr size_t WS_XA = WS_H + 33 * MiB;
constexpr size_t WS_U = WS_XA + 33 * MiB;
constexpr size_t WS_Q = WS_U + 33 * MiB;
constexpr size_t WS_K = WS_Q + 17 * MiB;
constexpr size_t WS_V = WS_K + 5 * MiB;
constexpr size_t WS_DYY = WS_V + 5 * MiB;
constexpr size_t WS_YC0 = WS_DYY + 50 * MiB;
constexpr size_t WS_GT = WS_YC0 + 17 * MiB;
constexpr size_t WS_END = WS_GT + 99 * MiB;
static_assert((size_t)M * 512 * 2 * 3 <= 50 * MiB && (size_t)M * 3072 * 2 <= 99 * MiB && (size_t)M * 1024 * 2 <= 33 * MiB, "ws map");
constexpr size_t TB_ROPEC = 0;
constexpr size_t TB_ROPES = 65664;
constexpr size_t TB_ABAR = 131328;
constexpr size_t TB_ABAR256 = TB_ABAR + 65536;
constexpr size_t TB_BBF = 262400;
constexpr size_t TB_CF = TB_BBF + 524288;
static_assert(TB_CF + 524288 <= 2 * MiB, "tables");
constexpr int LDS_BYTES = 147456;
constexpr int NPHASE = 2 + 9 * DEPTH + 1;
}

namespace pg8 {
#define PG8_LAS __attribute__((address_space(3)))
typedef unsigned short bf16_t;
typedef short bf16x8 __attribute__((ext_vector_type(8)));
typedef float f32x4 __attribute__((ext_vector_type(4)));
typedef unsigned u32x4 __attribute__((ext_vector_type(4)));
constexpr int BM = 256, BK = 64, HALF = 128, HTB = HALF * BK * 2  , STAGE_BYTES = 8 * HTB, NXCD = 8, WGM = 8;

__host__ __device__ __forceinline__ int lds_byte(int r, int c) { const int st = (r >> 4) * 2 + (c >> 5), rr = r & 15, cc = c & 31, ob = rr * 64 + cc * 2; return st * 1024 + (ob ^ (((ob >> 9) & 1) << 5)); }
__host__ __device__ __forceinline__ void stage_rc(int b, int& R, int& C) { const int st = b / 1024, sb = b % 1024, swz = sb ^ (((sb >> 9) & 1) << 5); R = (st >> 1) * 16 + swz / 64; C = (st & 1) * 32 + (swz % 64) / 2; }
__host__ __device__ __forceinline__ int perm32(int rho) { const int n = rho >> 4, i = rho & 15; return 8 * (i >> 2) + 4 * n + (i & 3); }

struct Unit { int pm, pn, k0; };
struct Gemm { const bf16_t* A; const bf16_t* Bt; int M, N, K, lda, ldb; };

struct StaticOrder {
    int nM, nN, nwg, G, c;
    __host__ __device__ void init(int M, int N, int G_, int c_) { nM = M / BM; nN = N / BM; nwg = nM * nN; G = G_; c = c_; }
    __host__ __device__ bool next(int i, Unit& u) const {
        const long L = (long)i * G + c; if (L >= nwg) return false;
        int wgid = (int)L; { const int q = nwg / NXCD, r = nwg % NXCD, xcd = wgid % NXCD, off = wgid / NXCD; wgid = (xcd < r ? xcd * (q + 1) : r * (q + 1) + (xcd - r) * q) + off; }
        const int nig = WGM * nN, gid = wgid / nig, fm = gid * WGM, gsz = (nM - fm) < WGM ? (nM - fm) : WGM;
        u.pm = fm + ((wgid % nig) % gsz); u.pn = (wgid % nig) / gsz; u.k0 = 0; return true;
    }
    __device__ __forceinline__ void a_ready(const Unit&) const {}
    __device__ __forceinline__ void done(const Unit&) const {}
};

__device__ __forceinline__ unsigned cvt_pk_bf16(float lo, float hi) { unsigned r; asm volatile("v_cvt_pk_bf16_f32 %0, %1, %2" : "=v"(r) : "v"(lo), "v"(hi)); return r; }
typedef unsigned u32x2 __attribute__((ext_vector_type(2)));
__device__ __forceinline__ float sigm(float x) { return __builtin_amdgcn_rcpf(1.f + __expf(-x)); }
__device__ __forceinline__ f32x4 ld_bf4(const bf16_t* p) { const u32x2 w = *(const u32x2*)p; f32x4 r; r[0] = __uint_as_float(w.x << 16); r[1] = __uint_as_float(w.x & 0xffff0000u); r[2] = __uint_as_float(w.y << 16); r[3] = __uint_as_float(w.y & 0xffff0000u); return r; }
__device__ __forceinline__ void st_bf4(bf16_t* p, const f32x4 v) { u32x2 w; w.x = cvt_pk_bf16(v[0], v[1]); w.y = cvt_pk_bf16(v[2], v[3]); *(u32x2*)p = w; }
__device__ __forceinline__ int batch_of(int row) { return row < cfg::MP ? (row >> 11) : 8 + ((row - cfg::MP) >> 2); }

struct EpiMod {
    static constexpr bool PERM = true, AFTER_DRAIN = false;
    float* MOD; const float* bada;
    __device__ __forceinline__ void operator()(const f32x4 (&acc)[2][2][4][2], const Unit& u, int wr, int wc, int fr, int fq) const {
#pragma unroll
        for (int ai = 0; ai < 2; ++ai)
#pragma unroll
            for (int m = 0; m < 4; ++m) { const int row = u.pm * 256 + ai * 128 + wr * 64 + m * 16 + fr;
                if (row < cfg::NBAT) {
#pragma unroll
                    for (int bj = 0; bj < 2; ++bj)
#pragma unroll
                        for (int n = 0; n < 2; ++n) { const int col = u.pn * 256 + bj * 128 + wc * 32 + 8 * fq + 4 * n;
                            *(f32x4*)(MOD + (size_t)row * cfg::NMOD + col) = acc[ai][bj][m][n] + *(const f32x4*)(bada + col); } } }
    }
};

struct EpiIn {
    static constexpr bool PERM = true, AFTER_DRAIN = false;
    float* XA; float* U; bf16_t* Q; bf16_t* KB; bf16_t* VB; bf16_t* GT; const float* ropec; const float* ropes; float* out; int layer;
    __device__ __forceinline__ void operator()(const f32x4 (&acc)[2][2][4][2], const Unit& u, int wr, int wc, int fr, int fq) const {
        const int pn = u.pn;
#pragma unroll
        for (int ai = 0; ai < 2; ++ai)
#pragma unroll
            for (int m = 0; m < 4; ++m) { const int row = u.pm * 256 + ai * 128 + wr * 64 + m * 16 + fr;
#pragma unroll
                for (int bj = 0; bj < 2; ++bj)
#pragma unroll
                    for (int n = 0; n < 2; ++n) { const int tc = bj * 128 + wc * 32 + 8 * fq + 4 * n; f32x4 v = acc[ai][bj][m][n];
                        if (pn < 2) { *(f32x4*)(XA + (size_t)row * 512 + pn * 256 + tc) = v; }
                        else if (pn <= 4) {
                            const bool isv = (pn == 4 && bj == 1);
                            if (!isv && (wc & 1) == 0) {
                                const int tix = row < cfg::MP ? (row & 2047) : 2048 + (row & 3);
                                const f32x4 cs = *(const f32x4*)(ropec + tix * 8 + 4 * n), sn = *(const f32x4*)(ropes + tix * 8 + 4 * n);
#pragma unroll
                                for (int i = 0; i < 4; ++i) { const float p = shx16(v[i], fq & 1); const float rv = v[i] * cs[i] + (fq == 0 ? -p : p) * sn[i]; v[i] = fq < 2 ? rv : v[i]; }
                            }
                            if (pn < 4) st_bf4(Q + (size_t)row * 512 + (pn - 2) * 256 + tc, v);
                            else { st_bf4((bj == 0 ? KB : VB) + (size_t)row * 128 + (tc & 127), v);
                                bool w = false; size_t o = 0;
                                if (row < cfg::MP) { const int t = row & 2047; if (t >= 1920) { w = true; o = (bj == 0 ? cfg::OFF_KP : cfg::OFF_VP) + ((size_t)(layer * 8 + (row >> 11)) * 128 + (t - 1920)) * 128 + (tc & 127); } }
                                else { const int rs = row - cfg::MP; w = true; o = (bj == 0 ? cfg::OFF_KS : cfg::OFF_VS) + ((size_t)(layer * 128 + (rs >> 2)) * 128 + 124 + (rs & 3)) * 128 + (tc & 127); }
                                if (w) *(f32x4*)(out + o) = v; }
                        }
                        else if (pn < 7) { *(f32x4*)(U + (size_t)row * 512 + (pn - 5) * 256 + tc) = v; }
                        else { f32x4 s; s[0] = sigm(v[0]); s[1] = sigm(v[1]); s[2] = sigm(v[2]); s[3] = sigm(v[3]); st_bf4(GT + (size_t)row * 3072 + (pn - 7) * 256 + tc, s); }
                    } }
    }
};

struct EpiGlu {
    static constexpr bool PERM = true, AFTER_DRAIN = false;
    const bf16_t* YC0; bf16_t* YC;
    __device__ __forceinline__ void operator()(const f32x4 (&acc)[2][2][4][2], const Unit& u, int wr, int wc, int fr, int fq) const {
#pragma unroll
        for (int ai = 0; ai < 2; ++ai)
#pragma unroll
            for (int m = 0; m < 4; ++m) { const int row = u.pm * 256 + ai * 128 + wr * 64 + m * 16 + fr;
#pragma unroll
                for (int bj = 0; bj < 2; ++bj)
#pragma unroll
                    for (int n = 0; n < 2; ++n) { const int col = u.pn * 256 + bj * 128 + wc * 32 + 8 * fq + 4 * n; const f32x4 v = acc[ai][bj][m][n];
                        const f32x4 y0 = ld_bf4(YC0 + (size_t)row * 512 + col); f32x4 o;
#pragma unroll
                        for (int i = 0; i < 4; ++i) o[i] = y0[i] * sigm(v[i]);
                        st_bf4(YC + (size_t)row * 512 + col, o); } }
    }
};

struct EpiMerge {
    static constexpr bool PERM = true, AFTER_DRAIN = false;
    const bf16_t* GT; float* M32; bf16_t* M16;
    __device__ __forceinline__ void operator()(const f32x4 (&acc)[2][2][4][2], const Unit& u, int wr, int wc, int fr, int fq) const {
        const int br = u.pm / 66, pm = u.pm - br * 66, pn = u.pn & 3;
        if (br > 0) asm volatile("s_waitcnt vmcnt(0)" ::: "memory");
#pragma unroll
        for (int ai = 0; ai < 2; ++ai)
#pragma unroll
            for (int m = 0; m < 4; ++m) { const int row = pm * 256 + ai * 128 + wr * 64 + m * 16 + fr;
#pragma unroll
                for (int bj = 0; bj < 2; ++bj)
#pragma unroll
                    for (int n = 0; n < 2; ++n) { const int col = pn * 256 + bj * 128 + wc * 32 + 8 * fq + 4 * n; const f32x4 v = acc[ai][bj][m][n];
                        const f32x4 g = ld_bf4(GT + (size_t)row * 3072 + br * 1024 + col);
                        float* mp = M32 + (size_t)row * 1024 + col;
                        if (br == 0) { *(f32x4*)mp = g * v; }
                        else if (br == 1) { *(f32x4*)mp = *(const f32x4*)mp + g * v; }
                        else { st_bf4(M16 + (size_t)row * 1024 + col, *(const f32x4*)mp + g * v); } } }
    }
};

struct EpiRes {
    static constexpr bool PERM = true, AFTER_DRAIN = false;
    const float* xin; float* X; const float* MODG;
    __device__ __forceinline__ void operator()(const f32x4 (&acc)[2][2][4][2], const Unit& u, int wr, int wc, int fr, int fq) const {
        const float* gp = MODG + (size_t)(u.pm >> 3) * cfg::NMOD + u.pn * 256 + wc * 32 + 8 * fq;
        f32x4 g[2][2];
#pragma unroll
        for (int bj = 0; bj < 2; ++bj)
#pragma unroll
            for (int n = 0; n < 2; ++n) g[bj][n] = *(const f32x4*)(gp + bj * 128 + n * 4);
#pragma unroll
        for (int ai = 0; ai < 2; ++ai)
#pragma unroll
            for (int m = 0; m < 4; ++m) { const int row = u.pm * 256 + ai * 128 + wr * 64 + m * 16 + fr;
#pragma unroll
                for (int bj = 0; bj < 2; ++bj)
#pragma unroll
                    for (int n = 0; n < 2; ++n) { const size_t o = (size_t)row * 1024 + u.pn * 256 + bj * 128 + wc * 32 + 8 * fq + 4 * n;
                        *(f32x4*)(X + o) = *(const f32x4*)(xin + o) + g[bj][n] * acc[ai][bj][m][n]; } }
    }
};

struct EpiPart {
    static constexpr bool PERM = true, AFTER_DRAIN = false;
    float* P; const bf16_t* GT; int nks;
    __device__ __forceinline__ void operator()(const f32x4 (&acc)[2][2][4][2], const Unit& u, int wr, int wc, int fr, int fq) const {
        const int br = u.pm / 66, pmr = u.pm - br * 66 - 64, pn = u.pn & 3, slice = br * nks + (u.k0 >> 7);
#pragma unroll
        for (int ai = 0; ai < 2; ++ai)
#pragma unroll
            for (int m = 0; m < 4; ++m) { const int rs = pmr * 256 + ai * 128 + wr * 64 + m * 16 + fr;
#pragma unroll
                for (int bj = 0; bj < 2; ++bj)
#pragma unroll
                    for (int n = 0; n < 2; ++n) { const int col = pn * 256 + bj * 128 + wc * 32 + 8 * fq + 4 * n; f32x4 v = acc[ai][bj][m][n];
                        if (GT) v = v * ld_bf4(GT + (size_t)(cfg::MP + rs) * 3072 + br * 1024 + col);
                        *(f32x4*)(P + ((size_t)slice * 512 + rs) * 1024 + col) = v; } }
    }
};

struct EpiFfn {
    static constexpr bool PERM = true, AFTER_DRAIN = false;
    bf16_t* ACT;
    __device__ __forceinline__ void operator()(const f32x4 (&acc)[2][2][4][2], const Unit& u, int wr, int wc, int fr, int fq) const {
#pragma unroll
        for (int ai = 0; ai < 2; ++ai)
#pragma unroll
            for (int m = 0; m < 4; ++m) { const int row = u.pm * 256 + ai * 128 + wr * 64 + m * 16 + fr;
#pragma unroll
                for (int n = 0; n < 2; ++n) { const int col = u.pn * 128 + wc * 32 + 8 * fq + 4 * n; const f32x4 a = acc[ai][0][m][n], b = acc[ai][1][m][n]; f32x4 o;
#pragma unroll
                    for (int i = 0; i < 4; ++i) o[i] = a[i] * sigm(a[i]) * b[i];
                    st_bf4(ACT + (size_t)row * cfg::DFF + col, o); } }
    }
};

struct BranchOrder {
    int G, c;
    __host__ __device__ bool next(int i, Unit& u) const { const int tile = c + (i / 3) * G; if (tile >= 256) return false; const int br = i % 3; u.pm = br * 66 + (tile >> 2); u.pn = br * 4 + (tile & 3); u.k0 = 0; return true; }
    __device__ __forceinline__ void a_ready(const Unit&) const {}
    __device__ __forceinline__ void done(const Unit&) const {}
};
struct SplitOrder {
    int G, c, nks, nbr;
    __host__ __device__ bool next(int i, Unit& u) const { const int j = c + i * G; if (j >= 8 * nbr * nks) return false; const int ks = j % nks, t = j / nks, br = t % nbr, tile = t / nbr;
        u.pm = br * 66 + 64 + (tile >> 2); u.pn = br * 4 + (tile & 3); u.k0 = ks * 128; return true; }
    __device__ __forceinline__ void a_ready(const Unit&) const {}
    __device__ __forceinline__ void done(const Unit&) const {}
};

template <class Epi, class Sched, bool ALIGN_EPI = false, bool SP2 = false>
__device__ __forceinline__ void gemm_phase(PG8_LAS unsigned char* lds, const Gemm g, const Sched& S, const Epi& E, const int tid_in) {
    int tid_l = tid_in; asm volatile("" : "+v"(tid_l));
    const int tid = tid_l, wid = __builtin_amdgcn_readfirstlane(tid >> 6), lane = tid & 63, wr = wid >> 2, wc = wid & 3, fr = lane & 15, fq = lane >> 4;
    const int K = g.K, nt = K / BK, lda = g.lda ? g.lda : K, ldb = lda;
    unsigned voffA[2], voffB[2];
#pragma unroll
    for (int i = 0; i < 2; ++i) { int R, C; stage_rc(tid * 16 + i * 8192, R, C); const int Rb = Epi::PERM ? ((R & ~31) + perm32(R & 31)) : R;
        voffA[i] = (unsigned)(R * lda + C) * 2u; voffB[i] = (unsigned)(Rb * ldb + C) * 2u; }
    const size_t kstep = (size_t)(BK * 2);
    const size_t hstepA = (size_t)HALF * lda * 2, hstepB = (size_t)HALF * ldb * 2;
    const size_t tstepA = 2 * hstepA, tstepB = 2 * hstepB;
    const unsigned ldsw = (unsigned)wid * 1024u;
    const int aoff = lds_byte(wr * 64 + fr, fq * 8), boff = lds_byte(wc * 32 + fr, fq * 8);
#define PG8_SA(b, h) (((b) * 2 + (h)) * HTB)
#define PG8_SB(b, h) ((4 + (b) * 2 + (h)) * HTB)
#define PG8_STAGE(bufoff, gbase, voff) do { _Pragma("unroll") for (int _i = 0; _i < 2; ++_i) \
        __builtin_amdgcn_global_load_lds((const unsigned*)((const char*)(gbase) + (voff)[_i]), (PG8_LAS unsigned*)(lds + (bufoff) + ldsw + _i * 8192), 16, 0, 0); } while (0)
#define PG8_LDA(dst, b, h) do { _Pragma("unroll") for (int m = 0; m < 4; ++m) _Pragma("unroll") for (int k = 0; k < 2; ++k) dst[m][k] = *(const PG8_LAS bf16x8*)(lds + PG8_SA(b, h) + aoff + m * 2048 + k * 1024); } while (0)
#define PG8_LDB(dst, b, h) do { _Pragma("unroll") for (int n = 0; n < 2; ++n) _Pragma("unroll") for (int k = 0; k < 2; ++k) dst[n][k] = *(const PG8_LAS bf16x8*)(lds + PG8_SB(b, h) + boff + n * 2048 + k * 1024); } while (0)
#define PG8_MMA(ai, bj, At, Bt) do { __builtin_amdgcn_s_setprio(1); _Pragma("unroll") for (int m = 0; m < 4; ++m) _Pragma("unroll") for (int n = 0; n < 2; ++n) _Pragma("unroll") for (int k = 0; k < 2; ++k) \
        acc[ai][bj][m][n] = __builtin_amdgcn_mfma_f32_16x16x32_bf16(Bt[n][k], At[m][k], acc[ai][bj][m][n], 0, 0, 0); __builtin_amdgcn_s_setprio(0); } while (0)
#define PG8_WAIT_V(n) asm volatile("s_waitcnt vmcnt(" #n ")" ::: "memory")
#define PG8_WAIT_L(n) asm volatile("s_waitcnt lgkmcnt(" #n ")" ::: "memory")
#define PG8_BAR __builtin_amdgcn_s_barrier()
#define PG8_SCHED __builtin_amdgcn_sched_barrier(0)
    Unit cur, nxt; int ui = 0;
    if (!S.next(0, cur)) return;
    f32x4 acc[2][2][4][2];
#pragma unroll
    for (int a = 0; a < 2; ++a)
#pragma unroll
        for (int b = 0; b < 2; ++b)
#pragma unroll
            for (int m = 0; m < 4; ++m)
#pragma unroll
                for (int n = 0; n < 2; ++n) acc[a][b][m][n] = (f32x4){0.f, 0.f, 0.f, 0.f};
    bf16x8 At[4][2], B0[2][2], B1[2][2];
    const char* cA = (const char*)g.A + (size_t)cur.pm * tstepA + (size_t)cur.k0 * 2; const char* cB = (const char*)g.Bt + (size_t)cur.pn * tstepB + (size_t)cur.k0 * 2;
    S.a_ready(cur);
    if constexpr (SP2) {
        PG8_STAGE(PG8_SB(0, 0), cB, voffB); PG8_STAGE(PG8_SB(0, 1), cB + hstepB, voffB); PG8_STAGE(PG8_SA(0, 0), cA, voffA); PG8_STAGE(PG8_SA(0, 1), cA + hstepA, voffA);
        if (wr == 1) PG8_BAR;
        PG8_WAIT_V(2); PG8_BAR;
        PG8_STAGE(PG8_SB(1, 0), cB + kstep, voffB); PG8_STAGE(PG8_SA(1, 0), cA + kstep, voffA); PG8_STAGE(PG8_SB(1, 1), cB + hstepB + kstep, voffB);
        PG8_WAIT_V(6); PG8_BAR;
    } else {
        PG8_STAGE(PG8_SB(0, 0), cB, voffB); PG8_STAGE(PG8_SA(0, 0), cA, voffA); PG8_STAGE(PG8_SB(0, 1), cB + hstepB, voffB); PG8_STAGE(PG8_SA(0, 1), cA + hstepA, voffA);
        if (wr == 1) PG8_BAR;
        PG8_WAIT_V(4); PG8_BAR;
        PG8_STAGE(PG8_SB(1, 0), cB + kstep, voffB); PG8_STAGE(PG8_SA(1, 0), cA + kstep, voffA); PG8_STAGE(PG8_SB(1, 1), cB + hstepB + kstep, voffB);
        PG8_WAIT_V(6); PG8_BAR;
    }
    for (;;) {
        const bool has_next = S.next(ui + 1, nxt);
        const char* nA = has_next ? (const char*)g.A + (size_t)nxt.pm * tstepA + (size_t)nxt.k0 * 2 : cA; const char* nB = has_next ? (const char*)g.Bt + (size_t)nxt.pn * tstepB + (size_t)nxt.k0 * 2 : cB;
        for (int t = 0; t < nt; t += 2) {
            const bool last = (t == nt - 2);
            const char* a1 = cA + (size_t)(t + 1) * kstep;
            const char* a2 = last ? nA : cA + (size_t)(t + 2) * kstep; const char* b2 = last ? nB : cB + (size_t)(t + 2) * kstep;
            const char* a3 = a2 + kstep; const char* b3 = b2 + kstep;
            if (last && has_next) S.a_ready(nxt);
            if constexpr (SP2) {
            PG8_LDB(B0, 0, 0); PG8_LDB(B1, 0, 1); PG8_SCHED; PG8_LDA(At, 0, 0); PG8_STAGE(PG8_SA(1, 1), a1 + hstepA, voffA);
            PG8_WAIT_V(8); PG8_WAIT_L(0); PG8_BAR; PG8_MMA(0, 0, At, B0); PG8_MMA(0, 1, At, B1); PG8_BAR; PG8_SCHED;
            PG8_LDA(At, 0, 1); PG8_STAGE(PG8_SB(0, 0), b2, voffB); PG8_STAGE(PG8_SB(0, 1), b2 + hstepB, voffB); PG8_STAGE(PG8_SA(0, 0), a2, voffA);
            PG8_WAIT_V(8); PG8_WAIT_L(0); PG8_BAR; PG8_MMA(1, 0, At, B0); PG8_MMA(1, 1, At, B1); PG8_BAR; PG8_SCHED;
            PG8_LDB(B0, 1, 0); PG8_LDB(B1, 1, 1); PG8_SCHED; PG8_LDA(At, 1, 0); PG8_STAGE(PG8_SA(0, 1), a2 + hstepA, voffA);
            PG8_WAIT_V(8); PG8_WAIT_L(0); PG8_BAR; PG8_MMA(0, 0, At, B0); PG8_MMA(0, 1, At, B1); PG8_BAR; PG8_SCHED;
            PG8_LDA(At, 1, 1); PG8_STAGE(PG8_SB(1, 0), b3, voffB); PG8_STAGE(PG8_SB(1, 1), b3 + hstepB, voffB); PG8_STAGE(PG8_SA(1, 0), a3, voffA);
            PG8_WAIT_V(8); PG8_WAIT_L(0); PG8_BAR; PG8_MMA(1, 0, At, B0); PG8_MMA(1, 1, At, B1); PG8_BAR; PG8_SCHED;
            } else {
            PG8_LDB(B0, 0, 0); PG8_SCHED; PG8_LDA(At, 0, 0); PG8_STAGE(PG8_SA(1, 1), a1 + hstepA, voffA);
            PG8_WAIT_L(8); PG8_BAR; PG8_WAIT_L(0); PG8_MMA(0, 0, At, B0); PG8_BAR; PG8_SCHED;
            PG8_LDB(B1, 0, 1); PG8_STAGE(PG8_SB(0, 0), b2, voffB);
            PG8_BAR; PG8_WAIT_L(0); PG8_MMA(0, 1, At, B1); PG8_BAR;
            PG8_LDA(At, 0, 1); PG8_STAGE(PG8_SA(0, 0), a2, voffA);
            PG8_BAR; PG8_WAIT_L(0); PG8_MMA(1, 0, At, B0); PG8_BAR; PG8_SCHED;
            PG8_STAGE(PG8_SB(0, 1), b2 + hstepB, voffB);
            PG8_WAIT_V(6); PG8_BAR; PG8_MMA(1, 1, At, B1); PG8_BAR;
            PG8_LDB(B0, 1, 0); PG8_SCHED; PG8_LDA(At, 1, 0); PG8_STAGE(PG8_SA(0, 1), a2 + hstepA, voffA);
            PG8_WAIT_L(8); PG8_BAR; PG8_WAIT_L(0); PG8_MMA(0, 0, At, B0); PG8_BAR; PG8_SCHED;
            PG8_LDB(B1, 1, 1); PG8_STAGE(PG8_SB(1, 0), b3, voffB);
            PG8_BAR; PG8_WAIT_L(0); PG8_MMA(0, 1, At, B1); PG8_BAR;
            PG8_LDA(At, 1, 1); PG8_STAGE(PG8_SA(1, 0), a3, voffA);
            PG8_BAR; PG8_WAIT_L(0); PG8_MMA(1, 0, At, B0); PG8_BAR; PG8_SCHED;
            PG8_STAGE(PG8_SB(1, 1), b3 + hstepB, voffB);
            PG8_WAIT_V(6); PG8_BAR; PG8_MMA(1, 1, At, B1); PG8_BAR;
            }
        }
        if constexpr (ALIGN_EPI) { if (wr == 0) PG8_BAR; }
        if constexpr (!Epi::AFTER_DRAIN) { E(acc, cur, wr, wc, fr, fq); S.done(cur); }
        if (!has_next) break;
#pragma unroll
        for (int a = 0; a < 2; ++a)
#pragma unroll
            for (int b = 0; b < 2; ++b)
#pragma unroll
                for (int m = 0; m < 4; ++m)
#pragma unroll
                    for (int n = 0; n < 2; ++n) acc[a][b][m][n] = (f32x4){0.f, 0.f, 0.f, 0.f};
        cur = nxt; cA = nA; cB = nB; ++ui;
        if constexpr (ALIGN_EPI) { if (wr == 1) PG8_BAR; }
    }
    PG8_WAIT_V(0);
    if constexpr (!ALIGN_EPI) { if (wr == 0) PG8_BAR; }
    PG8_BAR;
    if constexpr (Epi::AFTER_DRAIN) { E.fused(acc, cur, wr, wc, fr, fq, lds, wid, lane); S.done(cur); }
#undef PG8_SA
#undef PG8_SB
#undef PG8_STAGE
#undef PG8_LDA
#undef PG8_LDB
#undef PG8_MMA
#undef PG8_WAIT_V
#undef PG8_WAIT_L
#undef PG8_BAR
#undef PG8_SCHED
}
}

#define LAS __attribute__((address_space(3)))
#define DI __device__ __forceinline__
typedef unsigned short bf16_t;
typedef short bf16x8 __attribute__((ext_vector_type(8)));
typedef short s16x4 __attribute__((ext_vector_type(4)));
typedef float f32x4 __attribute__((ext_vector_type(4)));
typedef float f32x16 __attribute__((ext_vector_type(16)));
typedef unsigned u32x4 __attribute__((ext_vector_type(4)));
typedef unsigned u32x2 __attribute__((ext_vector_type(2)));
using pg8::cvt_pk_bf16; using pg8::sigm; using pg8::ld_bf4; using pg8::st_bf4; using pg8::batch_of;
using namespace cfg;

DI float bf2f(bf16_t b) { return __uint_as_float((unsigned)b << 16); }
DI unsigned f2bf(float f) { unsigned u = __float_as_uint(f); return (u + 0x7fffu + ((u >> 16) & 1u)) >> 16; }
DI float wave_sum(float v, int lane) {
#pragma unroll
    for (int o = 1; o < 64; o <<= 1) v += shx(v, o, lane);
    return v;
}
DI float wave_max(float v, int lane) {
#pragma unroll
    for (int o = 1; o < 64; o <<= 1) v = fmaxf(v, shx(v, o, lane));
    return v;
}
DI bf16x8 pack8(const f32x4 a, const f32x4 b) { u32x4 p; p.x = cvt_pk_bf16(a[0], a[1]); p.y = cvt_pk_bf16(a[2], a[3]); p.z = cvt_pk_bf16(b[0], b[1]); p.w = cvt_pk_bf16(b[2], b[3]); return __builtin_bit_cast(bf16x8, p); }
#define MFMA16(a, b, c) __builtin_amdgcn_mfma_f32_16x16x32_bf16((a), (b), (c), 0, 0, 0)
#define MFMA32(a, b, c) __builtin_amdgcn_mfma_f32_32x32x16_bf16((a), (b), (c), 0, 0, 0)

#define XB_TMO      128
#define XB_XCNT(j)  (256  + 64 * (j))
#define XB_XSUB(j)  (1280 + 64 * (j))
#define XB_XGEN(j)  (2304 + 64 * (j))
#define XB_TOP      3328
#define XB_TOPGEN   3392
#define XCD_BAR_WORDS 3456
#define XB_SPIN_CAP (1u << 18)

__device__ __forceinline__ unsigned xb_ld(unsigned* p)              { return __hip_atomic_load(p, __ATOMIC_RELAXED, __HIP_MEMORY_SCOPE_AGENT); }
__device__ __forceinline__ unsigned xb_add(unsigned* p, unsigned v) { return __hip_atomic_fetch_add(p, v, __ATOMIC_RELAXED, __HIP_MEMORY_SCOPE_AGENT); }
__device__ __forceinline__ unsigned xb_xcc_id() { return (unsigned)__builtin_amdgcn_s_getreg((3 << 11) | 20) & 0xFu; }
#define XB_SPIN(cond, bar) do { unsigned _sp = 0; while (cond) { __builtin_amdgcn_s_sleep(1); \
    if ((++_sp & 255u) == 0u) { if (xb_ld(&(bar)[XB_TMO])) break; if (_sp > XB_SPIN_CAP) { atomicAdd(&(bar)[XB_TMO], 1u); break; } } } } while (0)

struct XcdBarrier {
    unsigned* bar; unsigned x;
    volatile LAS unsigned* st;
};

__device__ __forceinline__ XcdBarrier xcd_barrier_post(unsigned* bar, volatile LAS unsigned* st) {
    XcdBarrier b; b.bar = bar; b.x = xb_xcc_id(); b.st = st;
    if (threadIdx.x == 0) (void)xb_add(&bar[XB_XCNT(b.x)], 1u);
    return b;
}
__device__ __forceinline__ void xcd_barrier_complete(unsigned* bar, unsigned x, unsigned& nloc, unsigned& nx) {
    const unsigned G = gridDim.x * gridDim.y * gridDim.z;
    unsigned sum, cnt, mine, sp = 0u;
    for (;;) {
        sum = 0u; cnt = 0u; mine = 0u;
#pragma unroll
        for (unsigned j = 0; j < 16; ++j) { const unsigned c = xb_ld(&bar[XB_XCNT(j)]); sum += c; cnt += (c > 0u) ? 1u : 0u; mine = (j == x) ? c : mine; }
        if (sum == G) break;
        __builtin_amdgcn_s_sleep(1);
        if ((++sp & 255u) == 0u) { if (xb_ld(&bar[XB_TMO])) break; if (sp > XB_SPIN_CAP) { atomicAdd(&bar[XB_TMO], 1u); break; } }
    }
    nloc = mine > 0u ? mine : 1u; nx = cnt > 0u ? cnt : 1u;
}

__device__ __forceinline__ void xcd_barrier(const XcdBarrier& b) {
    asm volatile("s_waitcnt vmcnt(0)" ::: "memory");
    __syncthreads();
    if (threadIdx.x == 0) {
        unsigned* bar = b.bar;
        __builtin_amdgcn_s_waitcnt(0);
        unsigned nloc = b.st[0], nx = b.st[1];
        if (nloc == 0u) { xcd_barrier_complete(bar, b.x, nloc, nx); b.st[0] = nloc; b.st[1] = nx; }
        const unsigned old = xb_add(&bar[XB_XSUB(b.x)], 1u);
        const unsigned gen = old / nloc;
        if (old + 1u == (gen + 1u) * nloc) {
            __builtin_amdgcn_fence(__ATOMIC_RELEASE, "agent");
            asm volatile("s_waitcnt vmcnt(0)" ::: "memory");
            const unsigned og = xb_add(&bar[XB_TOP], 1u);
            const unsigned tg = og / nx;
            if (og + 1u == (tg + 1u) * nx) xb_add(&bar[XB_TOPGEN], 1u);
            else XB_SPIN(xb_ld(&bar[XB_TOPGEN]) == tg, bar);
            __builtin_amdgcn_fence(__ATOMIC_ACQUIRE, "agent");
            xb_add(&bar[XB_XGEN(b.x)], 1u);
            asm volatile("s_waitcnt vmcnt(0)" ::: "memory");
        } else {
            XB_SPIN(xb_ld(&bar[XB_XGEN(b.x)]) == gen, bar);
            __builtin_amdgcn_fence(__ATOMIC_ACQUIRE, "agent");
            asm volatile("s_waitcnt vmcnt(0)" ::: "memory");
        }
    }
    __syncthreads();
}

#ifndef MIXM
#define MIXM 0
#endif
#ifndef SYNC2
#define SYNC2 0
#endif
#ifndef REPM
#define REPM 0
#endif
#ifndef GM
#define GM 0xff
#endif
#ifndef PHM
#define PHM 0xff
#endif
struct Args { const float* in[33]; float* out; unsigned char* ws; unsigned long long rfix[8]; int ph_lo, ph_hi; };
typedef const Args __attribute__((address_space(4)))* ArgsP;

DI void tr_item(const float* W, int K, int N, bf16_t* WT, int k0, int n0, int drow0, LAS float* scr, int lane) {
#pragma unroll 8
    for (int i = 0; i < 32; ++i) { const int kk = 2 * i + (lane >> 5); scr[kk * 33 + (lane & 31)] = W[(size_t)(k0 + kk) * N + n0 + (lane & 31)]; }
    asm volatile("s_waitcnt lgkmcnt(0)" ::: "memory");
    const int c = lane & 7;
#pragma unroll
    for (int j = 0; j < 4; ++j) { const int n = (lane >> 3) + 8 * j; const LAS float* s = scr + (8 * c) * 33 + n;
        u32x4 o; o.x = cvt_pk_bf16(s[0 * 33], s[1 * 33]); o.y = cvt_pk_bf16(s[2 * 33], s[3 * 33]); o.z = cvt_pk_bf16(s[4 * 33], s[5 * 33]); o.w = cvt_pk_bf16(s[6 * 33], s[7 * 33]);
        *(u32x4*)(WT + (size_t)(drow0 + n) * K + k0 + 8 * c) = o; }
    asm volatile("s_waitcnt lgkmcnt(0)" ::: "memory");
}
#define FOLD_LD(dst, ii) do { const float* pr_ = Pw + ((size_t)g * 128 + ((k0 & 127) + 2 * (ii) + hi)) * 128 + jc * 32; _Pragma("unroll") for (int j4 = 0; j4 < 8; ++j4) dst[j4] = *(const f32x4*)(pr_ + 4 * j4); } while (0)
#define FOLD_FMA(src, ii) do { float acc = 0.f; _Pragma("unroll") for (int j4 = 0; j4 < 8; ++j4) acc += src[j4][0] * w[4 * j4] + src[j4][1] * w[4 * j4 + 1] + src[j4][2] * w[4 * j4 + 2] + src[j4][3] * w[4 * j4 + 3]; \
        LAS float* sp = scr + (2 * (ii) + hi) * 33 + nn; if (jc == 0) *sp = acc; else *sp += acc; } while (0)
DI void fold_item(const float* Pw  , const float* Sc  , const float* Wa  , bf16_t* WT  , int k0, int n0, LAS float* scr, int lane) {
    const int g = k0 >> 7, nn = lane & 31, hi = lane >> 5;
    for (int jc = 0; jc < 4; ++jc) {
        float w[32];
#pragma unroll
        for (int jj = 0; jj < 32; ++jj) { const int j = g * 128 + jc * 32 + jj; w[jj] = Sc[j] * Wa[(size_t)j * 1024 + n0 + nn]; }
        f32x4 pa[8], pb[8];
        FOLD_LD(pa, 0);
#pragma unroll 1
        for (int i = 0; i < 16; i += 2) { FOLD_LD(pb, i + 1); FOLD_FMA(pa, i); if (i + 2 < 16) FOLD_LD(pa, i + 2); FOLD_FMA(pb, i + 1); }
    }
    asm volatile("s_waitcnt lgkmcnt(0)" ::: "memory");
    { const int c = lane & 3, n0l = lane >> 2;
#pragma unroll
      for (int j = 0; j < 2; ++j) { const int n = n0l + 16 * j; const LAS float* s = scr + (8 * c) * 33 + n;
          u32x4 o; o.x = cvt_pk_bf16(s[0 * 33], s[1 * 33]); o.y = cvt_pk_bf16(s[2 * 33], s[3 * 33]); o.z = cvt_pk_bf16(s[4 * 33], s[5 * 33]); o.w = cvt_pk_bf16(s[6 * 33], s[7 * 33]);
          *(u32x4*)(WT + (size_t)(n0 + n) * 512 + k0 + 8 * c) = o; } }
    asm volatile("s_waitcnt lgkmcnt(0)" ::: "memory");
}
DI void sincos_frac(float f  , float& c, float& s) { s = __builtin_amdgcn_sinf(f); c = __builtin_amdgcn_cosf(f); }

DI void convert_layer(ArgsP a, int l, LAS float* scr, int gw, int NGW, int lane) {
    unsigned char* ws = a->ws;
    constexpr int I_IN = 16 * 152, I_GLU = 8 * 16, I_BR = 8 * 32, I_OUT = 16 * 32, I_FI = 16 * 176, I_FO = 44 * 32, I_FOLD = 16 * 32;
    constexpr int PER_L = I_IN + I_GLU + 2 * I_BR + I_OUT + I_FI + I_FO + I_FOLD;
    for (int it = gw; it < PER_L; it += NGW) {
        int r = it;
        if (r < I_FOLD) { fold_item(a->in[14] + (size_t)l * 4 * 128 * 128, a->in[15] + l * 512, a->in[26] + (size_t)l * 512 * 1024, (bf16_t*)(ws + WS_WBR) + (size_t)l * 3072 * 512, (r >> 5) * 32, (r & 31) * 32, scr, lane); continue; } r -= I_FOLD;
        if (r < I_IN) { const int kb = r / 152, nb = r % 152; tr_item(a->in[13] + (size_t)l * 1024 * IN_COLS, 1024, IN_COLS, (bf16_t*)(ws + WS_WIN) + (size_t)l * IN_COLS * 1024, kb * 64, nb * 32, nb * 32, scr, lane); continue; } r -= I_IN;
        if (r < I_GLU) { const int kb = r / 16, nb = r % 16; tr_item(a->in[25] + (size_t)l * 512 * 512, 512, 512, (bf16_t*)(ws + WS_WGLU) + (size_t)l * 512 * 512, kb * 64, nb * 32, nb * 32, scr, lane); continue; } r -= I_GLU;
        if (r < I_BR) { const int kb = r / 32, nb = r % 32; tr_item(a->in[27] + (size_t)l * 512 * 1024, 512, 1024, (bf16_t*)(ws + WS_WBR) + (size_t)l * 3072 * 512, kb * 64, nb * 32, 1024 + nb * 32, scr, lane); continue; } r -= I_BR;
        if (r < I_BR) { const int kb = r / 32, nb = r % 32; tr_item(a->in[28] + (size_t)l * 512 * 1024, 512, 1024, (bf16_t*)(ws + WS_WBR) + (size_t)l * 3072 * 512, kb * 64, nb * 32, 2048 + nb * 32, scr, lane); continue; } r -= I_BR;
        if (r < I_OUT) { const int kb = r / 32, nb = r % 32; tr_item(a->in[29] + (size_t)l * 1024 * 1024, 1024, 1024, (bf16_t*)(ws + WS_WOUT) + (size_t)l * 1024 * 1024, kb * 64, nb * 32, nb * 32, scr, lane); continue; } r -= I_OUT;
        if (r < I_FI) { const int kb = r / 176, nb = r % 176; const int n0 = nb * 32, half = n0 / DFF, j = n0 - half * DFF;
            tr_item(a->in[30] + (size_t)l * 1024 * 2 * DFF, 1024, 2 * DFF, (bf16_t*)(ws + WS_WFI) + (size_t)l * 2 * DFF * 1024, kb * 64, n0, 256 * (j >> 7) + 128 * half + (j & 127), scr, lane); continue; } r -= I_FI;
        { const int kb = r / 32, nb = r % 32; tr_item(a->in[31] + (size_t)l * DFF * 1024, DFF, 1024, (bf16_t*)(ws + WS_WFO) + (size_t)l * 1024 * DFF, kb * 64, nb * 32, nb * 32, scr, lane); }
    }
}
DI void prologue(ArgsP a, LAS unsigned char* lds, int tid) {
    const int lane = tid & 63, wave = tid >> 6;
    const int gw = blockIdx.x * 8 + wave, NGW = gridDim.x * 8;
    const int gt = blockIdx.x * 512 + tid, NT = gridDim.x * 512;
    unsigned char* ws = a->ws;
    LAS float* scr = (LAS float*)(lds + wave * 16384);
    constexpr int I_ADA = 16 * 192;
    for (int it = gw; it < 4 * I_ADA; it += NGW) { const int l = it & 3, r = it >> 2, kb = r / 192, nb = r % 192;
        tr_item(a->in[11] + (size_t)l * 1024 * 6144, 1024, 6144, (bf16_t*)(ws + WS_GT), kb * 64, nb * 32, l * 6144 + nb * 32, scr, lane); }
    for (int l = 0; l < DEPTH; ++l) convert_layer(a, l, scr, (gw + l * (NGW / 4)) % NGW, NGW, lane);
    { bf16_t* CA = (bf16_t*)(ws + WS_CA);
      for (int i = gt; i < 256 * 1024; i += NT) { const int r = i >> 10, c = i & 1023; float v = 0.f;
          if (r < 8) v = a->in[7][r * 1024 + c]; else if (r < NBAT) v = a->in[8][(r - 8) * 1024 + c];
          CA[i] = (bf16_t)f2bf(v * sigm(v)); } }
    { float* rc = (float*)(ws + WS_TAB + TB_ROPEC); float* rs = (float*)(ws + WS_TAB + TB_ROPES);
      for (int i = gt; i < 2052 * 8; i += NT) { const int ti = i >> 3, j = i & 7; const int pos = ti < 2048 ? ti : 8192 + (ti - 2048);
          const unsigned long long fx = (unsigned long long)pos * a->rfix[j];
          float c, s; sincos_frac((float)(unsigned)(fx >> 40) * 5.9604644775390625e-08f, c, s); rc[i] = c; rs[i] = s; } }
    { float* AB = (float*)(ws + WS_TAB + TB_ABAR); float* AB256 = (float*)(ws + WS_TAB + TB_ABAR256); bf16_t* BBF = (bf16_t*)(ws + WS_TAB + TB_BBF);
      for (int i = gt; i < 4 * 32 * 64; i += NT) { const int lg = i >> 6, p = i & 63;
          const float dt = expf(a->in[19][lg]); const float ar = a->in[17][i], ai = a->in[18][i];
          const float x = ar * dt; const float yt = ai * dt * 0.15915494309189535f;
          float c, s; sincos_frac(yt, c, s); float ch, sh; sincos_frac(0.5f * yt, ch, sh);
          const float em1 = x * (1.f + x * (0.5f + x * (0.16666667f + x * (0.041666668f + x * 0.0083333338f))));
          const float ex = 1.f + em1;
          const float abr = ex * c, abi = ex * s;
          const float nr = em1 * c - (sh + sh) * sh, ni = abi;
          const float den = 1.f / (ar * ar + ai * ai);
          const float cr = (nr * ar + ni * ai) * den, ci = (ni * ar - nr * ai) * den;
          AB[2 * i] = abr; AB[2 * i + 1] = abi;
          float pr = abr, pi = abi;
#pragma unroll
          for (int k = 0; k < 8; ++k) { const float t = pr * pr - pi * pi; pi = (pr + pr) * pi; pr = t; }
          AB256[2 * i] = pr; AB256[2 * i + 1] = pi;
          const float* br = a->in[20] + (size_t)i * 16; const float* bi = a->in[21] + (size_t)i * 16;
          const int st = p >> 5;
#pragma unroll
          for (int half = 0; half < 2; ++half) { u32x4 ore, oim; unsigned* pre = (unsigned*)&ore; unsigned* pim = (unsigned*)&oim; (void)pre; (void)pim;
              float vr[8], vi[8];
#pragma unroll
              for (int j = 0; j < 8; ++j) { const float b_r = br[half * 8 + j], b_i = bi[half * 8 + j]; vr[j] = cr * b_r - ci * b_i; vi[j] = cr * b_i + ci * b_r; }
              ore.x = cvt_pk_bf16(vr[0], vr[1]); ore.y = cvt_pk_bf16(vr[2], vr[3]); ore.z = cvt_pk_bf16(vr[4], vr[5]); ore.w = cvt_pk_bf16(vr[6], vr[7]);
              oim.x = cvt_pk_bf16(vi[0], vi[1]); oim.y = cvt_pk_bf16(vi[2], vi[3]); oim.z = cvt_pk_bf16(vi[4], vi[5]); oim.w = cvt_pk_bf16(vi[6], vi[7]);
              *(u32x4*)(BBF + (((size_t)lg * 4 + 0 + st) * 64 + half * 32 + (p & 31)) * 8) = ore;
              *(u32x4*)(BBF + (((size_t)lg * 4 + 2 + st) * 64 + half * 32 + (p & 31)) * 8) = oim; } } }
    { bf16_t* CF = (bf16_t*)(ws + WS_TAB + TB_CF);
      for (int i = gt; i < 4 * 32 * 4 * 64; i += NT) { const int ln = i & 63, ks = (i >> 6) & 3, lg = i >> 8; const int c = ln & 15, quad = ln >> 4;
          float v[8];
#pragma unroll
          for (int j = 0; j < 8; ++j) { const int k = ks * 32 + quad * 8 + j; v[j] = k < 64 ? a->in[22][((size_t)lg * 16 + c) * 64 + k] : -a->in[23][((size_t)lg * 16 + c) * 64 + (k - 64)]; }
          u32x4 o; o.x = cvt_pk_bf16(v[0], v[1]); o.y = cvt_pk_bf16(v[2], v[3]); o.z = cvt_pk_bf16(v[4], v[5]); o.w = cvt_pk_bf16(v[6], v[7]);
          *(u32x4*)(CF + (size_t)i * 8) = o; } }
    { for (int i = gt; i < 4 * 128 * 124 * 32; i += NT) { const int c4 = i & 31, j = (i >> 5) % 124, lb = (i >> 5) / 124;
          *(f32x4*)(a->out + OFF_KS + ((size_t)lb * 128 + j) * 128 + c4 * 4) = *(const f32x4*)(a->in[2] + ((size_t)lb * 128 + j + 4) * 128 + c4 * 4);
          *(f32x4*)(a->out + OFF_VS + ((size_t)lb * 128 + j) * 128 + c4 * 4) = *(const f32x4*)(a->in[3] + ((size_t)lb * 128 + j + 4) * 128 + c4 * 4); }
      for (int i = gt; i < 4 * 128 * 11 * 128; i += NT) { const int c4 = i & 127, j = (i >> 7) % 11, lb = (i >> 7) / 11;
          *(f32x4*)(a->out + OFF_PS + ((size_t)lb * 15 + j) * 512 + c4 * 4) = *(const f32x4*)(a->in[4] + ((size_t)lb * 15 + j + 4) * 512 + c4 * 4); } }
}

DI void norm_phase(const float* xp, const float* xs, const float* gvec, const float* MODL  , int sc_off, bf16_t* H, int tid,
                   const float* P, int nparts, const float* pgate, float* X) {
    const int lane = tid & 63, gw = blockIdx.x * 8 + (tid >> 6), NGW = gridDim.x * 8;
    for (int it = gw; it < M; it += NGW) {
        const int row = it < MS ? MP + it : it - MS;
        const int bi = batch_of(row);
        const float* xr = (row < MP ? xp : xs) + (size_t)row * 1024; const float* mr = MODL + (size_t)bi * NMOD;
        f32x4 v[4]; float ss = 0.f;
#pragma unroll
        for (int j = 0; j < 4; ++j) v[j] = *(const f32x4*)(xr + 4 * lane + 256 * j);
        if (row >= MP && nparts > 0) {
            f32x4 s[4];
#pragma unroll
            for (int j = 0; j < 4; ++j) s[j] = (f32x4){0.f, 0.f, 0.f, 0.f};
            for (int p = 0; p < nparts; ++p) { const float* pr = P + ((size_t)p * 512 + (row - MP)) * 1024 + 4 * lane;
#pragma unroll
                for (int j = 0; j < 4; ++j) s[j] += *(const f32x4*)(pr + 256 * j); }
#pragma unroll
            for (int j = 0; j < 4; ++j) { v[j] += *(const f32x4*)(pgate + (size_t)bi * NMOD + 4 * lane + 256 * j) * s[j]; *(f32x4*)(X + (size_t)row * 1024 + 4 * lane + 256 * j) = v[j]; }
        }
#pragma unroll
        for (int j = 0; j < 4; ++j) ss += v[j][0] * v[j][0] + v[j][1] * v[j][1] + v[j][2] * v[j][2] + v[j][3] * v[j][3];
        const float r = rsqrtf(wave_sum(ss, lane) * (1.f / 1024.f) + 1e-6f);
        if (H) {
#pragma unroll
            for (int j = 0; j < 4; ++j) { const int c = 4 * lane + 256 * j; const f32x4 g = *(const f32x4*)(gvec + c), sh = *(const f32x4*)(mr + c), sc = *(const f32x4*)(mr + sc_off + c);
                st_bf4(H + (size_t)row * 1024 + c, v[j] * r * g * (1.f + sc) + sh); }
        } else {
#pragma unroll
            for (int j = 0; j < 4; ++j) { const int c = 4 * lane + 256 * j; *(f32x4*)(X + (size_t)row * 1024 + c) = v[j] * r * *(const f32x4*)(gvec + c); }
        }
    }
}

template <int W>
DI void pool_run(const float* XA, bf16_t* Dm, float* out, int l, int row0, int c4) {
    const int t0 = row0 & 2047;
    f32x4 x[W + 7];
#pragma unroll
    for (int i = 0; i < W + 7; ++i) { const int dt = i - (W - 1); x[i] = (t0 + dt >= 0) ? *(const f32x4*)(XA + (size_t)(row0 + dt) * 512 + c4) : (f32x4){0.f, 0.f, 0.f, 0.f}; }
    f32x4 s = x[0];
#pragma unroll
    for (int i = 1; i < W - 1; ++i) s += x[i];
#pragma unroll
    for (int k = 0; k < 8; ++k) { s += x[W - 1 + k]; const int t = t0 + k; const float cnt = (float)((t + 1 < W) ? t + 1 : W);
        st_bf4(Dm + (size_t)(row0 + k) * 512 + c4, s * (1.f / cnt) - x[W - 1 + k]);
        if (t >= 2033) *(f32x4*)(out + OFF_PP + ((size_t)(l * 8 + (row0 >> 11)) * 15 + (t - 2033)) * 512 + c4) = x[W - 1 + k];
        s -= x[k]; }
}
DI void pool_phase(ArgsP a, int l, const float* XA, bf16_t* Dm, int tid) {
    const int gt = blockIdx.x * 512 + tid, NT = gridDim.x * 512;
    constexpr int NRUN = MP / 8;
    for (int item = gt; item < 4 * NRUN * 32; item += NT) {
        const int c4l = item & 31, gr = item >> 5, g = gr / NRUN, run = gr - g * NRUN; const int c4 = g * 128 + c4l * 4, row0 = run * 8;
        if (g == 0) pool_run<2>(XA, Dm, a->out, l, row0, c4); else if (g == 1) pool_run<4>(XA, Dm, a->out, l, row0, c4);
        else if (g == 2) pool_run<8>(XA, Dm, a->out, l, row0, c4); else pool_run<16>(XA, Dm, a->out, l, row0, c4);
    }
    for (int idx = gt; idx < MS * 128; idx += NT) {
        const int row = MP + (idx >> 7), c4 = (idx & 127) * 4, w = 2 << (c4 >> 7);
        const f32x4 x = *(const f32x4*)(XA + (size_t)row * 512 + c4); f32x4 sum = x;
        const int rs = row - MP, bs = rs >> 2, t = rs & 3;
        for (int s = 1; s < w; ++s) { const int pos = t - s;
            sum += pos >= 0 ? *(const f32x4*)(XA + (size_t)(row - s) * 512 + c4) : *(const f32x4*)(a->in[4] + ((size_t)(l * 128 + bs) * 15 + 15 + pos) * 512 + c4); }
        *(f32x4*)(a->out + OFF_PS + ((size_t)(l * 128 + bs) * 15 + 11 + t) * 512 + c4) = x;
        st_bf4(Dm + (size_t)row * 512 + c4, sum * (1.f / (float)w) - x);
    }
}

DI void attn_prompt_unit(LAS unsigned char* lds, int unit, const bf16_t* Q, const bf16_t* KB, const bf16_t* VB, bf16_t* YB, const float* sinks, int tid) {
    const int b = unit >> 5, g = (unit >> 4) & 1, nb = unit & 15;
    LAS bf16_t* Ks = (LAS bf16_t*)lds;
    LAS bf16_t* Vt = (LAS bf16_t*)(lds + 36864);
    const int krow0 = b * 2048 + (nb - 1) * 128;
#pragma unroll
    for (int it = 0; it < 4; ++it) {
        const int chunk = tid + 512 * it, j = chunk >> 3, c8 = chunk & 7;
        u32x4 kv = {0u, 0u, 0u, 0u}, vv = {0u, 0u, 0u, 0u};
        if (nb > 0 || j >= 128) { const size_t off = (size_t)(krow0 + j) * 128 + g * 64 + c8 * 8; kv = *(const u32x4*)(KB + off); vv = *(const u32x4*)(VB + off); }
        *(LAS u32x4*)(Ks + j * 72 + c8 * 8) = kv;
        LAS bf16_t* vp = Vt + (c8 * 8) * 264 + j;
        vp[0 * 264] = (bf16_t)(vv.x & 0xffffu); vp[1 * 264] = (bf16_t)(vv.x >> 16); vp[2 * 264] = (bf16_t)(vv.y & 0xffffu); vp[3 * 264] = (bf16_t)(vv.y >> 16);
        vp[4 * 264] = (bf16_t)(vv.z & 0xffffu); vp[5 * 264] = (bf16_t)(vv.z >> 16); vp[6 * 264] = (bf16_t)(vv.w & 0xffffu); vp[7 * 264] = (bf16_t)(vv.w >> 16);
    }
    __syncthreads();
    const int wave = tid >> 6, lane = tid & 63, l15 = lane & 15, quad = lane >> 4;
    const int r = wave >> 1, hq = g * 4 + r;
    const float sc2 = 0.125f * 1.4426950408889634f;
    const float sk2 = sinks[hq] * 1.4426950408889634f;
    const int kt0 = wave & 1;
#pragma unroll 1
    for (int qh = 0; qh < 2; ++qh) {
        const int q0 = (wave & 1) * 64 + qh * 32;
        const int qrow0 = b * 2048 + nb * 128 + q0;
        bf16x8 qf[2][2];
#pragma unroll
        for (int qt = 0; qt < 2; ++qt)
#pragma unroll
            for (int ds = 0; ds < 2; ++ds) qf[qt][ds] = *(const bf16x8*)(Q + (size_t)(qrow0 + qt * 16 + l15) * 512 + hq * 64 + ds * 32 + quad * 8);
        float m2[2], ls[2]; f32x4 o[4][2];
#pragma unroll
        for (int qt = 0; qt < 2; ++qt) { m2[qt] = sk2; ls[qt] = quad == 0 ? 1.f : 0.f;
#pragma unroll
            for (int dt = 0; dt < 4; ++dt) o[dt][qt] = (f32x4){0.f, 0.f, 0.f, 0.f}; }
#pragma unroll 1
        for (int kk = 0; kk < 3; ++kk) {
            const int kt = kt0 + kk;
            if (nb == 0 && kt < 2) continue;
            f32x4 s[4][2];
#pragma unroll
            for (int sub = 0; sub < 4; ++sub) { const LAS bf16_t* kp = Ks + (kt * 64 + sub * 16 + l15) * 72 + quad * 8;
                const bf16x8 k0 = *(const LAS bf16x8*)kp, k1 = *(const LAS bf16x8*)(kp + 32);
#pragma unroll
                for (int qt = 0; qt < 2; ++qt) { s[sub][qt] = MFMA16(k0, qf[qt][0], ((f32x4){0.f, 0.f, 0.f, 0.f})); s[sub][qt] = MFMA16(k1, qf[qt][1], s[sub][qt]); } }
#pragma unroll
            for (int qt = 0; qt < 2; ++qt) { const int i = q0 + qt * 16 + l15; float mx = -INFINITY;
#pragma unroll
                for (int sub = 0; sub < 4; ++sub)
#pragma unroll
                    for (int jj = 0; jj < 4; ++jj) { const int j = kt * 64 + sub * 16 + quad * 4 + jj; const bool valid = (j > i) && (j <= i + 128) && (nb > 0 || j >= 128);
                        const float v = valid ? s[sub][qt][jj] * sc2 : -INFINITY; s[sub][qt][jj] = v; mx = fmaxf(mx, v); }
                mx = fmaxf(mx, shx16(mx, quad & 1)); mx = fmaxf(mx, shx32(mx, quad >> 1));
                const float mn = fmaxf(m2[qt], mx), alpha = __builtin_amdgcn_exp2f(m2[qt] - mn); m2[qt] = mn; float sum = 0.f;
#pragma unroll
                for (int sub = 0; sub < 4; ++sub)
#pragma unroll
                    for (int jj = 0; jj < 4; ++jj) { const float p = __builtin_amdgcn_exp2f(s[sub][qt][jj] - mn); s[sub][qt][jj] = p; sum += p; }
                ls[qt] = ls[qt] * alpha + sum;
#pragma unroll
                for (int dt = 0; dt < 4; ++dt) o[dt][qt] *= alpha; }
#pragma unroll
            for (int s2 = 0; s2 < 2; ++s2) { bf16x8 pf[2];
#pragma unroll
                for (int qt = 0; qt < 2; ++qt) pf[qt] = pack8(s[2 * s2][qt], s[2 * s2 + 1][qt]);
#pragma unroll
                for (int dt = 0; dt < 4; ++dt) { const LAS bf16_t* vp = Vt + (dt * 16 + l15) * 264 + kt * 64 + s2 * 32 + quad * 4;
                    const s16x4 v0 = *(const LAS s16x4*)vp, v1 = *(const LAS s16x4*)(vp + 16);
                    const bf16x8 vf = __builtin_shufflevector(v0, v1, 0, 1, 2, 3, 4, 5, 6, 7);
#pragma unroll
                    for (int qt = 0; qt < 2; ++qt) o[dt][qt] = MFMA16(vf, pf[qt], o[dt][qt]); } }
        }
#pragma unroll
        for (int qt = 0; qt < 2; ++qt) { float lt = ls[qt]; lt += shx16(lt, quad & 1); lt += shx32(lt, quad >> 1); const float inv = 1.f / lt;
            bf16_t* yp = YB + (size_t)(qrow0 + qt * 16 + l15) * 512 + hq * 64 + quad * 4;
#pragma unroll
            for (int dt = 0; dt < 4; ++dt) st_bf4(yp + dt * 16, o[dt][qt] * inv); }
    }
    __syncthreads();
}

DI void attn_sample_task(LAS unsigned char* wl, int task, int l, ArgsP a, const bf16_t* Q, bf16_t* YB, int lane) {
    const int b = task >> 3, h = task & 7, g = h >> 2;
    LAS float* qs = (LAS float*)wl;
    LAS float* ps = qs + 256;
#pragma unroll
    for (int t = 0; t < 4; ++t) qs[t * 64 + lane] = bf2f(Q[(size_t)(MP + b * 4 + t) * 512 + h * 64 + lane]);
    const float* ck = a->in[2] + (size_t)(l * 128 + b) * 128 * 128 + g * 64;
    const float* cv = a->in[3] + (size_t)(l * 128 + b) * 128 * 128 + g * 64;
    const float* nk = a->out + OFF_KS + ((size_t)(l * 128 + b) * 128 + 124) * 128 + g * 64;
    const float* nv = a->out + OFF_VS + ((size_t)(l * 128 + b) * 128 + 124) * 128 + g * 64;
    const float sink = a->in[16][l * 8 + h];
    float mx[4] = {sink, sink, sink, sink};
    for (int rr = 0; rr < 3; ++rr) { const int j = rr * 64 + lane; float s[4] = {0.f, 0.f, 0.f, 0.f};
        if (j < 132) { const float* kp = j < 128 ? ck + (size_t)j * 128 : nk + (size_t)(j - 128) * 128;
#pragma unroll 4
            for (int d4 = 0; d4 < 16; ++d4) { const f32x4 k4 = *(const f32x4*)(kp + 4 * d4);
#pragma unroll
                for (int t = 0; t < 4; ++t) { const f32x4 q4 = *(const LAS f32x4*)(qs + t * 64 + 4 * d4); s[t] += k4[0] * q4[0] + k4[1] * q4[1] + k4[2] * q4[2] + k4[3] * q4[3]; } } }
#pragma unroll
        for (int t = 0; t < 4; ++t) { const bool valid = (j < 132) && (j >= t + 1) && (j <= t + 128); const float v = valid ? s[t] * 0.125f : -INFINITY;
            if (j < 136) ps[t * 136 + j] = v; mx[t] = fmaxf(mx[t], v); } }
    float den[4];
#pragma unroll
    for (int t = 0; t < 4; ++t) { mx[t] = wave_max(mx[t], lane); float sum = 0.f;
        for (int rr = 0; rr < 3; ++rr) { const int j = rr * 64 + lane; if (j < 132) { const float p = __expf(ps[t * 136 + j] - mx[t]); ps[t * 136 + j] = p; sum += p; } }
        den[t] = wave_sum(sum, lane) + __expf(sink - mx[t]); }
    float o[4] = {0.f, 0.f, 0.f, 0.f};
    for (int j = 0; j < 132; ++j) { const float v = (j < 128 ? cv + (size_t)j * 128 : nv + (size_t)(j - 128) * 128)[lane];
#pragma unroll
        for (int t = 0; t < 4; ++t) o[t] += ps[t * 136 + j] * v; }
#pragma unroll
    for (int t = 0; t < 4; ++t) YB[(size_t)(MP + b * 4 + t) * 512 + h * 64 + lane] = (bf16_t)f2bf(o[t] / den[t]);
}

struct S5C { bf16x8 bbf[4]; bf16x8 cf[4]; float are[2], aim[2]; };
DI float gelu_tanh(float y) { const float z = 1.5957691216057308f * (y + 0.044715f * y * y * y); return y * sigm(z); }
template <bool OUT>
DI void s5_tile(const S5C& K, const float* U, int row0, int g, int nruns, int nvalid, float (&hre)[2], float (&him)[2], LAS bf16_t* Hs, const float* dvec, bf16_t* YC0, int lane) {
    const int tok = lane & 31, half = lane >> 5;
    bf16x8 af = {0, 0, 0, 0, 0, 0, 0, 0};
    if (tok < nvalid) { const float* up = U + (size_t)(row0 + tok) * 512 + g * 16 + half * 8; af = pack8(*(const f32x4*)up, *(const f32x4*)(up + 4)); }
    f32x16 z16;
#pragma unroll
    for (int i = 0; i < 16; ++i) z16[i] = 0.f;
    f32x16 dre[2], dim[2];
#pragma unroll
    for (int st = 0; st < 2; ++st) { dre[st] = MFMA32(af, K.bbf[st], z16); dim[st] = MFMA32(af, K.bbf[2 + st], z16); }
#pragma unroll
    for (int r = 0; r < 8; ++r) {
        if (r < nruns) {
            const int hf = r & 1, i0 = 4 * (r >> 1);
            if (half == hf) {
#pragma unroll
                for (int k = 0; k < 4; ++k)
#pragma unroll
                    for (int st = 0; st < 2; ++st) { const float nr = K.are[st] * hre[st] - K.aim[st] * him[st] + dre[st][i0 + k]; const float ni = K.are[st] * him[st] + K.aim[st] * hre[st] + dim[st][i0 + k];
                        hre[st] = nr; him[st] = ni; dre[st][i0 + k] = nr; dim[st][i0 + k] = ni; }
            }
#pragma unroll
            for (int st = 0; st < 2; ++st) { const float pr = __shfl_xor(hre[st], 32), pi = __shfl_xor(him[st], 32); if (half != hf) { hre[st] = pr; him[st] = pi; } }
        }
    }
    if (OUT) {
#pragma unroll
        for (int i = 0; i < 16; ++i) { const int tr = (i & 3) + 8 * (i >> 2) + 4 * half; LAS bf16_t* hp = Hs + tr * 136 + tok;
#pragma unroll
            for (int st = 0; st < 2; ++st) { hp[st * 32] = (bf16_t)f2bf(dre[st][i]); hp[64 + st * 32] = (bf16_t)f2bf(dim[st][i]); } }
        const int l15 = lane & 15, quad = lane >> 4;
#pragma unroll
        for (int tt = 0; tt < 2; ++tt) {
            if (tt * 16 < nvalid) {
                f32x4 acc = {0.f, 0.f, 0.f, 0.f};
#pragma unroll
                for (int ks = 0; ks < 4; ++ks) { const bf16x8 hf8 = *(const LAS bf16x8*)(Hs + (tt * 16 + l15) * 136 + ks * 32 + quad * 8); acc = MFMA16(K.cf[ks], hf8, acc); }
                const int tk = tt * 16 + l15;
                if (tk < nvalid) { const size_t ro = (size_t)(row0 + tk) * 512 + g * 16 + quad * 4;
                    const f32x4 u4 = *(const f32x4*)(U + ro), d4 = *(const f32x4*)(dvec + quad * 4); f32x4 y = acc + d4 * u4;
                    y[0] = gelu_tanh(y[0]); y[1] = gelu_tanh(y[1]); y[2] = gelu_tanh(y[2]); y[3] = gelu_tanh(y[3]);
                    st_bf4(YC0 + ro, y); }
            }
        }
    }
}
DI void s5_load_consts(S5C& K, const unsigned char* ws, int lg, int lane) {
    const bf16_t* BBF = (const bf16_t*)(ws + WS_TAB + TB_BBF); const bf16_t* CF = (const bf16_t*)(ws + WS_TAB + TB_CF); const float* AB = (const float*)(ws + WS_TAB + TB_ABAR);
#pragma unroll
    for (int t = 0; t < 4; ++t) { K.bbf[t] = *(const bf16x8*)(BBF + (((size_t)lg * 4 + t) * 64 + lane) * 8); K.cf[t] = *(const bf16x8*)(CF + (((size_t)lg * 4 + t) * 64 + lane) * 8); }
#pragma unroll
    for (int st = 0; st < 2; ++st) { const int p = st * 32 + (lane & 31); K.are[st] = AB[((size_t)lg * 64 + p) * 2]; K.aim[st] = AB[((size_t)lg * 64 + p) * 2 + 1]; }
}
DI void s5_prompt_task(LAS unsigned char* lds, int task, int l, ArgsP a, const float* U, bf16_t* YC0, int tid) {
    const int b = task >> 5, g = task & 31, lg = l * 32 + g, wave = tid >> 6, lane = tid & 63;
    LAS bf16_t* Hs = (LAS bf16_t*)(lds + wave * 8704);
    LAS float* Es = (LAS float*)(lds + 8 * 8704);
    S5C K; s5_load_consts(K, a->ws, lg, lane);
    const float* dvec = a->in[24] + l * 512 + g * 16;
    const int rowb = b * 2048 + wave * 256;
    float hre[2] = {0.f, 0.f}, him[2] = {0.f, 0.f};
    for (int tl = 0; tl < 8; ++tl) s5_tile<false>(K, U, rowb + tl * 32, g, 8, 32, hre, him, Hs, dvec, YC0, lane);
    if (lane < 32) { Es[(wave * 4 + 0) * 32 + lane] = hre[0]; Es[(wave * 4 + 1) * 32 + lane] = hre[1]; Es[(wave * 4 + 2) * 32 + lane] = him[0]; Es[(wave * 4 + 3) * 32 + lane] = him[1]; }
    __syncthreads();
    { const float* A256 = (const float*)(a->ws + WS_TAB + TB_ABAR256); float pr[2], pi[2];
#pragma unroll
      for (int st = 0; st < 2; ++st) { const int p = st * 32 + (lane & 31); pr[st] = A256[((size_t)lg * 64 + p) * 2]; pi[st] = A256[((size_t)lg * 64 + p) * 2 + 1]; hre[st] = 0.f; him[st] = 0.f; }
      for (int w = 0; w < wave; ++w) {
#pragma unroll
          for (int st = 0; st < 2; ++st) { const float er = Es[(w * 4 + st) * 32 + (lane & 31)], ei = Es[(w * 4 + 2 + st) * 32 + (lane & 31)];
              const float nr = pr[st] * hre[st] - pi[st] * him[st] + er, ni = pr[st] * him[st] + pi[st] * hre[st] + ei; hre[st] = nr; him[st] = ni; } } }
    for (int tl = 0; tl < 8; ++tl) s5_tile<true>(K, U, rowb + tl * 32, g, 8, 32, hre, him, Hs, dvec, YC0, lane);
    if (wave == 7 && lane < 32) {
#pragma unroll
        for (int st = 0; st < 2; ++st) { a->out[OFF_SRP + ((size_t)(l * 8 + b) * 32 + g) * 64 + st * 32 + lane] = hre[st]; a->out[OFF_SIP + ((size_t)(l * 8 + b) * 32 + g) * 64 + st * 32 + lane] = him[st]; } }
    __syncthreads();
}
DI void s5_sample_task(LAS unsigned char* lds, int task, int l, ArgsP a, const float* U, bf16_t* YC0, int tid) {
    const int bs = task >> 5, g = task & 31, lg = l * 32 + g, wave = tid >> 6, lane = tid & 63;
    LAS bf16_t* Hs = (LAS bf16_t*)(lds + wave * 8704);
    S5C K; s5_load_consts(K, a->ws, lg, lane);
    const size_t so = ((size_t)(l * 128 + bs) * 32 + g) * 64;
    float hre[2], him[2];
#pragma unroll
    for (int st = 0; st < 2; ++st) { hre[st] = a->in[5][so + st * 32 + (lane & 31)]; him[st] = a->in[6][so + st * 32 + (lane & 31)]; }
    s5_tile<true>(K, U, MP + bs * 4, g, 1, 4, hre, him, Hs, a->in[24] + l * 512 + g * 16, YC0, lane);
    if (lane < 32) {
#pragma unroll
        for (int st = 0; st < 2; ++st) { a->out[OFF_SRS + so + st * 32 + lane] = hre[st]; a->out[OFF_SIS + so + st * 32 + lane] = him[st]; } }
}

DI void mixers_phase(ArgsP a, LAS unsigned char* lds, int l, int tid) {
    unsigned char* ws = a->ws;
    const float* XA = (const float*)(ws + WS_XA); const float* U = (const float*)(ws + WS_U);
    const bf16_t* Q = (const bf16_t*)(ws + WS_Q); const bf16_t* KB = (const bf16_t*)(ws + WS_K); const bf16_t* VB = (const bf16_t*)(ws + WS_V);
    bf16_t* Dm = (bf16_t*)(ws + WS_DYY); bf16_t* YB = Dm + (size_t)M * 512; bf16_t* YC0 = (bf16_t*)(ws + WS_YC0);
    const int wave = tid >> 6, lane = tid & 63, gw = blockIdx.x * 8 + wave, NGW = gridDim.x * 8;
    for (int rp = 0; rp < 1 + ((MIXM >> 0) & 1); ++rp) for (int u = blockIdx.x; u < 256; u += gridDim.x) attn_prompt_unit(lds, u, Q, KB, VB, YB, a->in[16] + l * 8, tid);
    for (int rp = 0; rp < 1 + ((MIXM >> 1) & 1); ++rp) for (int t = blockIdx.x; t < 256; t += gridDim.x) s5_prompt_task(lds, t, l, a, U, YC0, tid);
    for (int rp = 0; rp < 1 + ((MIXM >> 2) & 1); ++rp) for (int t = gw; t < 4096; t += NGW) s5_sample_task(lds, t, l, a, U, YC0, tid);
    __syncthreads();
    for (int rp = 0; rp < 1 + ((MIXM >> 3) & 1); ++rp) for (int t = gw; t < 1024; t += NGW) attn_sample_task(lds + wave * 4096, t, l, a, Q, YB, lane);
    for (int rp = 0; rp < 1 + ((MIXM >> 4) & 1); ++rp) pool_phase(a, l, XA, Dm, tid);
}

__global__ void __launch_bounds__(512, 2) mega(Args a_unused) {
    extern __shared__ __attribute__((aligned(16))) unsigned char lds_raw[];
    LAS unsigned char* lds = (LAS unsigned char*)lds_raw;
    cg::grid_group grid = cg::this_grid();
    const int wave_s = __builtin_amdgcn_readfirstlane((int)threadIdx.x >> 6);
    volatile LAS unsigned* bst = (volatile LAS unsigned*)(lds + 135168);
    if (threadIdx.x < 2) bst[threadIdx.x] = 0u;
    __syncthreads();
    XcdBarrier xbar = xcd_barrier_post((unsigned*)(((ArgsP)__builtin_amdgcn_kernarg_segment_ptr())->ws), bst);
    const int ph_lo = ((ArgsP)__builtin_amdgcn_kernarg_segment_ptr())->ph_lo, ph_hi = ((ArgsP)__builtin_amdgcn_kernarg_segment_ptr())->ph_hi;
    for (int ph = ph_lo; ph < ph_hi; ++ph) {
        const int kk9 = (ph - 2) % 9;
        const int cls = ph == 0 ? 0 : ph == 1 ? 1 : ph == NPHASE - 1 ? 10 : (kk9 == 0 || kk9 == 6) ? 2 : kk9 == 1 ? 3 : kk9 == 2 ? 4 : kk9 == 3 ? 5 : kk9 == 4 ? 6 : kk9 == 5 ? 7 : kk9 == 7 ? 8 : 9;
        const int nrep = 1 + ((REPM >> cls) & 1);
        for (int rep = 0; rep < nrep; ++rep) {
        ArgsP a = (ArgsP)__builtin_amdgcn_kernarg_segment_ptr(); asm volatile("" : "+s"(a));
        int G = gridDim.x, c = blockIdx.x; asm volatile("" : "+s"(G), "+s"(c));
        unsigned char* ws = a->ws;
        float* X = a->out;
        float* MOD = (float*)(ws + WS_MOD);
        bf16_t* H = (bf16_t*)(ws + WS_H);
        if (ph == 0) { if (PHM & 1) prologue(a, lds, (wave_s * 64 + lane_id_v())); }
        else if (ph == 1) { if (PHM & 4) {
            pg8::Gemm g{(const bf16_t*)(ws + WS_CA), (const bf16_t*)(ws + WS_GT), 256, NMOD, 1024}; pg8::StaticOrder S; S.init(256, NMOD, G, c);
            pg8::EpiMod E{MOD, a->in[12]};
            pg8::gemm_phase<pg8::EpiMod, pg8::StaticOrder, true, true>(lds, g, S, E, wave_s * 64 + lane_id_v()); }
        } else if (ph == NPHASE - 1) norm_phase(X, X, a->in[32], MOD, 0, nullptr, (wave_s * 64 + lane_id_v()), (const float*)(ws + WS_DYY), 22, MOD + 3 * 6144 + 5120, X);
        else {
            const int l = (ph - 2) / 9, k = (ph - 2) % 9;
            const float* xp = l == 0 ? a->in[0] : X; const float* xs = l == 0 ? a->in[1] - (size_t)MP * 1024 : X;
            if (k == 0) norm_phase(xp, xs, a->in[9] + l * 1024, MOD + l * 6144, 1024, H, (wave_s * 64 + lane_id_v()), (const float*)(ws + WS_DYY), l == 0 ? 0 : 22, MOD + (l - 1) * 6144 + 5120, X);
            else if (k == 1) { if (GM & 1) {
                pg8::Gemm g{H, (const bf16_t*)(ws + WS_WIN) + (size_t)l * IN_COLS * 1024, M, IN_COLS, 1024}; pg8::StaticOrder S; S.init(M, IN_COLS, G, c);
                pg8::EpiIn E{(float*)(ws + WS_XA), (float*)(ws + WS_U), (bf16_t*)(ws + WS_Q), (bf16_t*)(ws + WS_K), (bf16_t*)(ws + WS_V), (bf16_t*)(ws + WS_GT),
                             (const float*)(ws + WS_TAB + TB_ROPEC), (const float*)(ws + WS_TAB + TB_ROPES), a->out, l};
                pg8::gemm_phase<pg8::EpiIn, pg8::StaticOrder, true, true>(lds, g, S, E, wave_s * 64 + lane_id_v()); }
            } else if (k == 2) { if (PHM & 2) mixers_phase(a, lds, l, (wave_s * 64 + lane_id_v())); }
            else if (k == 3) { if (GM & 2) {
                pg8::Gemm g{(const bf16_t*)(ws + WS_YC0), (const bf16_t*)(ws + WS_WGLU) + (size_t)l * 512 * 512, M, 512, 512}; pg8::StaticOrder S; S.init(M, 512, G, c);
                pg8::EpiGlu E{(const bf16_t*)(ws + WS_YC0), (bf16_t*)(ws + WS_DYY) + (size_t)2 * M * 512};
                pg8::gemm_phase<pg8::EpiGlu, pg8::StaticOrder, true, true>(lds, g, S, E, wave_s * 64 + lane_id_v()); }
            } else if (k == 4) { if (GM & 4) {
                { pg8::Gemm g{(const bf16_t*)(ws + WS_DYY), (const bf16_t*)(ws + WS_WBR) + (size_t)l * 3072 * 512, 3 * M, 3072, 512, 0, 0}; pg8::BranchOrder S{G, c};
                  pg8::EpiMerge E{(const bf16_t*)(ws + WS_GT), (float*)(ws + WS_XA), H};
                  pg8::gemm_phase<pg8::EpiMerge, pg8::BranchOrder, true, true>(lds, g, S, E, wave_s * 64 + lane_id_v()); }
                { pg8::Gemm g{(const bf16_t*)(ws + WS_DYY), (const bf16_t*)(ws + WS_WBR) + (size_t)l * 3072 * 512, 3 * M, 3072, 128, 512, 512}; pg8::SplitOrder S{G, c, 4, 3};
                  pg8::EpiPart E{(float*)(ws + WS_Q), (const bf16_t*)(ws + WS_GT), 4};
                  pg8::gemm_phase<pg8::EpiPart, pg8::SplitOrder, true, true>(lds, g, S, E, wave_s * 64 + lane_id_v()); } }
            } else if (k == 5) { if (GM & 8) {
                { pg8::Gemm g{H, (const bf16_t*)(ws + WS_WOUT) + (size_t)l * 1024 * 1024, MP, 1024, 1024, 0, 0}; pg8::StaticOrder S; S.init(MP, 1024, G, c);
                  pg8::EpiRes E{xp, rep ? (float*)(ws + WS_XA) : X, MOD + l * 6144 + 2048};
                  pg8::gemm_phase<pg8::EpiRes, pg8::StaticOrder, true, true>(lds, g, S, E, wave_s * 64 + lane_id_v()); }
                for (int j = c; j < 64; j += G) { const int ks = j & 7, pmr = j >> 5; const float* Pm = (const float*)(ws + WS_Q);
                    for (int e2 = wave_s * 64 + lane_id_v(); e2 < 256 * 32; e2 += 512) { const int rs = pmr * 256 + (e2 >> 5), c4 = ks * 128 + (e2 & 31) * 4; f32x4 s = {0.f, 0.f, 0.f, 0.f};
#pragma unroll
                        for (int p = 0; p < 12; ++p) s += *(const f32x4*)(Pm + ((size_t)p * 512 + rs) * 1024 + c4);
                        st_bf4(H + (size_t)(MP + rs) * 1024 + c4, s); } }
                asm volatile("s_waitcnt vmcnt(0)" ::: "memory"); __syncthreads();
                { pg8::Gemm g{H, (const bf16_t*)(ws + WS_WOUT) + (size_t)l * 1024 * 1024, M, 1024, 128, 1024, 1024}; pg8::SplitOrder S{G, c, 8, 1};
                  pg8::EpiPart E{(float*)(ws + WS_YC0), nullptr, 8};
                  pg8::gemm_phase<pg8::EpiPart, pg8::SplitOrder, true, true>(lds, g, S, E, wave_s * 64 + lane_id_v()); } }
            } else if (k == 6) norm_phase(X, xs, a->in[10] + l * 1024, MOD + l * 6144 + 3072, 1024, H, (wave_s * 64 + lane_id_v()), (const float*)(ws + WS_YC0), 8, MOD + l * 6144 + 2048, X);
            else if (k == 7) { if (GM & 16) {
                pg8::Gemm g{H, (const bf16_t*)(ws + WS_WFI) + (size_t)l * 2 * DFF * 1024, M, 2 * DFF, 1024}; pg8::StaticOrder S; S.init(M, 2 * DFF, G, c);
                pg8::EpiFfn E{(bf16_t*)(ws + WS_GT)};
                pg8::gemm_phase<pg8::EpiFfn, pg8::StaticOrder, true, true>(lds, g, S, E, wave_s * 64 + lane_id_v()); }
            } else if (GM & 32) {
                { pg8::Gemm g{(const bf16_t*)(ws + WS_GT), (const bf16_t*)(ws + WS_WFO) + (size_t)l * 1024 * DFF, MP, 1024, DFF, 0, 0}; pg8::StaticOrder S; S.init(MP, 1024, G, c);
                  pg8::EpiRes E{X, rep ? (float*)(ws + WS_XA) : X, MOD + l * 6144 + 5120};
                  pg8::gemm_phase<pg8::EpiRes, pg8::StaticOrder, true, true>(lds, g, S, E, wave_s * 64 + lane_id_v()); }
                { pg8::Gemm g{(const bf16_t*)(ws + WS_GT), (const bf16_t*)(ws + WS_WFO) + (size_t)l * 1024 * DFF, M, 1024, 128, DFF, DFF}; pg8::SplitOrder S{G, c, 22, 1};
                  pg8::EpiPart E{(float*)(ws + WS_DYY), nullptr, 22};
                  pg8::gemm_phase<pg8::EpiPart, pg8::SplitOrder, true, true>(lds, g, S, E, wave_s * 64 + lane_id_v()); }
            }
        }
        if (REPM && rep + 1 < nrep) __syncthreads();
        }
        if (ph + 1 < ph_hi) { if (SYNC2 == 1 || ph_hi > 1000) grid.sync(); else { XcdBarrier xb = xbar; asm volatile("" : "+s"(xb.x), "+s"(xb.bar));
            xcd_barrier(xb); if (SYNC2 == 2) xcd_barrier(xb); } }
    }
}

extern "C" void kernel_launch(void* const* d_in, const int* in_sizes, int n_in, void* d_out, int out_size, void* d_ws, size_t ws_size, hipStream_t stream) {
    static int grid = 0;
    if (grid == 0) {
        if (n_in != 33 || (size_t)out_size != OUT_TOTAL || ws_size < WS_END) { fprintf(stderr, "kernel_launch: unexpected shapes: n_in %d out %d ws %zu (need %zu)\n", n_in, out_size, ws_size, (size_t)WS_END); grid = -1; return; }
        int dev = 0, cus = 0, per_cu = 0;
        (void)hipGetDevice(&dev); (void)hipDeviceGetAttribute(&cus, hipDeviceAttributeMultiprocessorCount, dev);
        if (hipFuncSetAttribute((const void*)mega, hipFuncAttributeMaxDynamicSharedMemorySize, LDS_BYTES) != hipSuccess) { fprintf(stderr, "kernel_launch: hipFuncSetAttribute failed\n"); grid = -1; return; }
        if (hipOccupancyMaxActiveBlocksPerMultiprocessor(&per_cu, (const void*)mega, 512, LDS_BYTES) != hipSuccess || per_cu < 1) { fprintf(stderr, "kernel_launch: occupancy query says %d\n", per_cu); per_cu = 1; }
        (void)hipGetLastError();
        grid = cus * 1;
        if (grid <= 0) grid = 256;
    }
    if (grid < 0) return;
    Args a{};
    for (int i = 0; i < 33; ++i) a.in[i] = (const float*)d_in[i];
    a.out = (float*)d_out; a.ws = (unsigned char*)d_ws;
    for (int j = 0; j < 8; ++j) a.rfix[j] = (unsigned long long)ldexpl(powl(500000.0L, -(long double)j / 8.0L) / (2.0L * 3.14159265358979323846264338327950288L), 64);
#if MK_MULTI
    for (int ph = 0; ph < NPHASE; ++ph) { a.ph_lo = ph; a.ph_hi = ph + 1; hipLaunchKernelGGL(mega, dim3(grid), dim3(512), LDS_BYTES, stream, a); }
#else
    a.ph_lo = 0; a.ph_hi = NPHASE;
    if (hipMemsetAsync(d_ws, 0, 16384, stream) != hipSuccess) { fprintf(stderr, "kernel_launch: memset failed\n"); return; }
    void* args[] = {&a};
    hipError_t e = hipLaunchCooperativeKernel((const void*)mega, dim3(grid), dim3(512), args, LDS_BYTES, stream);
    if (e != hipSuccess) fprintf(stderr, "kernel_launch: cooperative launch failed: %s (grid %d)\n", hipGetErrorString(e), grid);
#endif
}
```

```cpp
#include <hip/hip_runtime.h>
#include <hip/hip_cooperative_groups.h>
#include <cstdio>
#include <cstdint>
#include <cmath>
namespace cg = cooperative_groups;

#ifndef MK_MULTI
#define MK_MULTI 0
#endif

__device__ __forceinline__ int lane_id_v() { int l; asm volatile("v_mbcnt_lo_u32_b32 %0, -1, 0\n\tv_mbcnt_hi_u32_b32 %0, -1, %0" : "=v"(l)); return l; }
__device__ __forceinline__ float shx(float v, int mask, int lane) { return __builtin_bit_cast(float, __builtin_amdgcn_ds_bpermute((lane ^ mask) << 2, __builtin_bit_cast(int, v))); }

__device__ __forceinline__ float shx32(float v, int upper  ) { const unsigned x = __builtin_bit_cast(unsigned, v); auto r = __builtin_amdgcn_permlane32_swap(x, x, false, false); return __builtin_bit_cast(float, upper ? r[0] : r[1]); }
__device__ __forceinline__ float shx16(float v, int odd  ) { const unsigned x = __builtin_bit_cast(unsigned, v); auto r = __builtin_amdgcn_permlane16_swap(x, x, false, false); return __builtin_bit_cast(float, odd ? r[0] : r[1]); }

namespace cfg {
constexpr int D = 1024, MP = 16384, MS = 512, M = MP + MS, SEQ = 2048, NBAT = 136, DEPTH = 4;
constexpr int IN_COLS = 4864, DFF = 2816, NMOD = 6 * D * DEPTH;
constexpr size_t OFF_Y = 0;
constexpr size_t OFF_KP = (size_t)M * D;
constexpr size_t OFF_VP = OFF_KP + (size_t)4 * 8 * 128 * 128;
constexpr size_t OFF_PP = OFF_VP + (size_t)4 * 8 * 128 * 128;
constexpr size_t OFF_SRP = OFF_PP + (size_t)4 * 8 * 15 * 512;
constexpr size_t OFF_SIP = OFF_SRP + (size_t)4 * 8 * 32 * 64;
constexpr size_t OFF_KS = OFF_SIP + (size_t)4 * 8 * 32 * 64;
constexpr size_t OFF_VS = OFF_KS + (size_t)4 * 128 * 128 * 128;
constexpr size_t OFF_PS = OFF_VS + (size_t)4 * 128 * 128 * 128;
constexpr size_t OFF_SRS = OFF_PS + (size_t)4 * 128 * 15 * 512;
constexpr size_t OFF_SIS = OFF_SRS + (size_t)4 * 128 * 32 * 64;
constexpr size_t OUT_TOTAL = OFF_SIS + (size_t)4 * 128 * 32 * 64;
static_assert(OUT_TOTAL == 41533440, "output size");
constexpr size_t MiB = 1u << 20;
constexpr size_t WS_WIN = 1 * MiB;
constexpr size_t WS_WGLU = WS_WIN + 38 * MiB;
constexpr size_t WS_WBR = WS_WGLU + 2 * MiB;
constexpr size_t WS_WOUT = WS_WBR + 12 * MiB;
constexpr size_t WS_WFI = WS_WOUT + 8 * MiB;
constexpr size_t WS_WFO = WS_WFI + 44 * MiB;
constexpr size_t WS_MOD = WS_WFO + 22 * MiB;
constexpr size_t WS_CA = WS_MOD + 13 * MiB;
constexpr size_t WS_TAB = WS_CA + 1 * MiB;
constexpr size_t WS_H = WS_TAB + 2 * MiB;
constexpr size_t WS_XA = WS_H + 33 * MiB;
constexpr size_t WS_U = WS_XA + 33 * MiB;
constexpr size_t WS_Q = WS_U + 33 * MiB;
constexpr size_t WS_K = WS_Q + 17 * MiB;
constexpr size_t WS_V = WS_K + 5 * MiB;
constexpr size_t WS_DYY = WS_V + 5 * MiB;
constexpr size_t WS_YC0 = WS_DYY + 50 * MiB;
constexpr size_t WS_GT = WS_YC0 + 17 * MiB;
constexpr size_t WS_END = WS_GT + 99 * MiB;
static_assert((size_t)M * 512 * 2 * 3 <= 50 * MiB && (size_t)M * 3072 * 2 <= 99 * MiB && (size_t)M * 1024 * 2 <= 33 * MiB, "ws map");
constexpr size_t TB_ROPEC = 0;
constexpr size_t TB_ROPES = 65664;
constexpr size_t TB_ABAR = 131328;
constexpr size_t TB_ABAR256 = TB_ABAR + 65536;
constexpr size_t TB_BBF = 262400;
constexpr size_t TB_CF = TB_BBF + 524288;
static_assert(TB_CF + 524288 <= 2 * MiB, "tables");
constexpr int LDS_BYTES = 147456;
constexpr int NPHASE = 2 + 9 * DEPTH + 1;
}

namespace pg8 {
#define PG8_LAS __attribute__((address_space(3)))
typedef unsigned short bf16_t;
typedef short bf16x8 __attribute__((ext_vector_type(8)));
typedef float f32x4 __attribute__((ext_vector_type(4)));
typedef unsigned u32x4 __attribute__((ext_vector_type(4)));
constexpr int BM = 256, BK = 64, HALF = 128, HTB = HALF * BK * 2  , STAGE_BYTES = 8 * HTB, NXCD = 8, WGM = 8;

__host__ __device__ __forceinline__ int lds_byte(int r, int c) { const int st = (r >> 4) * 2 + (c >> 5), rr = r & 15, cc = c & 31, ob = rr * 64 + cc * 2; return st * 1024 + (ob ^ (((ob >> 9) & 1) << 5)); }
__host__ __device__ __forceinline__ void stage_rc(int b, int& R, int& C) { const int st = b / 1024, sb = b % 1024, swz = sb ^ (((sb >> 9) & 1) << 5); R = (st >> 1) * 16 + swz / 64; C = (st & 1) * 32 + (swz % 64) / 2; }
__host__ __device__ __forceinline__ int perm32(int rho) { const int n = rho >> 4, i = rho & 15; return 8 * (i >> 2) + 4 * n + (i & 3); }

struct Unit { int pm, pn, k0; };
struct Gemm { const bf16_t* A; const bf16_t* Bt; int M, N, K, lda, ldb; };

struct StaticOrder {
    int nM, nN, nwg, G, c;
    __host__ __device__ __forceinline__ void init(int M, int N, int G_, int c_) { nM = M / BM; nN = N / BM; nwg = nM * nN; G = G_; c = c_; }
    __host__ __device__ __forceinline__ bool next(int i, Unit& u) const {
        const long L = (long)i * G + c; if (L >= nwg) return false;
        int wgid = (int)L; { const int q = nwg / NXCD, r = nwg % NXCD, xcd = wgid % NXCD, off = wgid / NXCD; wgid = (xcd < r ? xcd * (q + 1) : r * (q + 1) + (xcd - r) * q) + off; }
        const int nig = WGM * nN, gid = wgid / nig, fm = gid * WGM, gsz = (nM - fm) < WGM ? (nM - fm) : WGM;
        u.pm = fm + ((wgid % nig) % gsz); u.pn = (wgid % nig) / gsz; u.k0 = 0; return true;
    }
    __device__ __forceinline__ void a_ready(const Unit&) const {}
    __device__ __forceinline__ void done(const Unit&) const {}
};

__device__ __forceinline__ unsigned cvt_pk_bf16(float lo, float hi) { unsigned r; asm volatile("v_cvt_pk_bf16_f32 %0, %1, %2" : "=v"(r) : "v"(lo), "v"(hi)); return r; }
typedef unsigned u32x2 __attribute__((ext_vector_type(2)));
__device__ __forceinline__ float sigm(float x) { return __builtin_amdgcn_rcpf(1.f + __expf(-x)); }
__device__ __forceinline__ f32x4 ld_bf4(const bf16_t* p) { const u32x2 w = *(const u32x2*)p; f32x4 r; r[0] = __uint_as_float(w.x << 16); r[1] = __uint_as_float(w.x & 0xffff0000u); r[2] = __uint_as_float(w.y << 16); r[3] = __uint_as_float(w.y & 0xffff0000u); return r; }
__device__ __forceinline__ void st_bf4(bf16_t* p, const f32x4 v) { u32x2 w; w.x = cvt_pk_bf16(v[0], v[1]); w.y = cvt_pk_bf16(v[2], v[3]); *(u32x2*)p = w; }
__device__ __forceinline__ int batch_of(int row) { return row < cfg::MP ? (row >> 11) : 8 + ((row - cfg::MP) >> 2); }

struct EpiMod {
    static constexpr bool PERM = true, AFTER_DRAIN = false;
    float* MOD; const float* bada;
    __device__ __forceinline__ void operator()(const f32x4 (&acc)[2][2][4][2], const Unit& u, int wr, int wc, int fr, int fq) const {
#pragma unroll
        for (int ai = 0; ai < 2; ++ai)
#pragma unroll
            for (int m = 0; m < 4; ++m) { const int row = u.pm * 256 + ai * 128 + wr * 64 + m * 16 + fr;
                if (row < cfg::NBAT) {
#pragma unroll
                    for (int bj = 0; bj < 2; ++bj)
#pragma unroll
                        for (int n = 0; n < 2; ++n) { const int col = u.pn * 256 + bj * 128 + wc * 32 + 8 * fq + 4 * n;
                            *(f32x4*)(MOD + (size_t)row * cfg::NMOD + col) = acc[ai][bj][m][n] + *(const f32x4*)(bada + col); } } }
    }
};

struct EpiIn {
    static constexpr bool PERM = true, AFTER_DRAIN = false;
    float* XA; float* U; bf16_t* Q; bf16_t* KB; bf16_t* VB; bf16_t* GT; const float* ropec; const float* ropes; float* out; int layer;
    __device__ __forceinline__ void operator()(const f32x4 (&acc)[2][2][4][2], const Unit& u, int wr, int wc, int fr, int fq) const {
        const int pn = u.pn;
#pragma unroll
        for (int ai = 0; ai < 2; ++ai)
#pragma unroll
            for (int m = 0; m < 4; ++m) { const int row = u.pm * 256 + ai * 128 + wr * 64 + m * 16 + fr;
#pragma unroll
                for (int bj = 0; bj < 2; ++bj)
#pragma unroll
                    for (int n = 0; n < 2; ++n) { const int tc = bj * 128 + wc * 32 + 8 * fq + 4 * n; f32x4 v = acc[ai][bj][m][n];
                        if (pn < 2) { *(f32x4*)(XA + (size_t)row * 512 + pn * 256 + tc) = v; }
                        else if (pn <= 4) {
                            const bool isv = (pn == 4 && bj == 1);
                            if (!isv && (wc & 1) == 0) {
                                const int tix = row < cfg::MP ? (row & 2047) : 2048 + (row & 3);
                                const f32x4 cs = *(const f32x4*)(ropec + tix * 8 + 4 * n), sn = *(const f32x4*)(ropes + tix * 8 + 4 * n);
#pragma unroll
                                for (int i = 0; i < 4; ++i) { const float p = shx16(v[i], fq & 1); const float rv = v[i] * cs[i] + (fq == 0 ? -p : p) * sn[i]; v[i] = fq < 2 ? rv : v[i]; }
                            }
                            if (pn < 4) st_bf4(Q + (size_t)row * 512 + (pn - 2) * 256 + tc, v);
                            else { st_bf4((bj == 0 ? KB : VB) + (size_t)row * 128 + (tc & 127), v);
                                bool w = false; size_t o = 0;
                                if (row < cfg::MP) { const int t = row & 2047; if (t >= 1920) { w = true; o = (bj == 0 ? cfg::OFF_KP : cfg::OFF_VP) + ((size_t)(layer * 8 + (row >> 11)) * 128 + (t - 1920)) * 128 + (tc & 127); } }
                                else { const int rs = row - cfg::MP; w = true; o = (bj == 0 ? cfg::OFF_KS : cfg::OFF_VS) + ((size_t)(layer * 128 + (rs >> 2)) * 128 + 124 + (rs & 3)) * 128 + (tc & 127); }
                                if (w) *(f32x4*)(out + o) = v; }
                        }
                        else if (pn < 7) { *(f32x4*)(U + (size_t)row * 512 + (pn - 5) * 256 + tc) = v; }
                        else { f32x4 s; s[0] = sigm(v[0]); s[1] = sigm(v[1]); s[2] = sigm(v[2]); s[3] = sigm(v[3]); st_bf4(GT + (size_t)row * 3072 + (pn - 7) * 256 + tc, s); }
                    } }
    }
};

struct EpiGlu {
    static constexpr bool PERM = true, AFTER_DRAIN = false;
    const bf16_t* YC0; bf16_t* YC;
    __device__ __forceinline__ void operator()(const f32x4 (&acc)[2][2][4][2], const Unit& u, int wr, int wc, int fr, int fq) const {
#pragma unroll
        for (int ai = 0; ai < 2; ++ai)
#pragma unroll
            for (int m = 0; m < 4; ++m) { const int row = u.pm * 256 + ai * 128 + wr * 64 + m * 16 + fr;
#pragma unroll
                for (int bj = 0; bj < 2; ++bj)
#pragma unroll
                    for (int n = 0; n < 2; ++n) { const int col = u.pn * 256 + bj * 128 + wc * 32 + 8 * fq + 4 * n; const f32x4 v = acc[ai][bj][m][n];
                        const f32x4 y0 = ld_bf4(YC0 + (size_t)row * 512 + col); f32x4 o;
#pragma unroll
                        for (int i = 0; i < 4; ++i) o[i] = y0[i] * sigm(v[i]);
                        st_bf4(YC + (size_t)row * 512 + col, o); } }
    }
};

struct EpiMerge {
    static constexpr bool PERM = true, AFTER_DRAIN = false;
    const bf16_t* GT; float* M32; bf16_t* M16;
    __device__ __forceinline__ void operator()(const f32x4 (&acc)[2][2][4][2], const Unit& u, int wr, int wc, int fr, int fq) const {
        const int br = u.pm / 66, pm = u.pm - br * 66, pn = u.pn & 3;
        if (br > 0) asm volatile("s_waitcnt vmcnt(0)" ::: "memory");
#pragma unroll
        for (int ai = 0; ai < 2; ++ai)
#pragma unroll
            for (int m = 0; m < 4; ++m) { const int row = pm * 256 + ai * 128 + wr * 64 + m * 16 + fr;
#pragma unroll
                for (int bj = 0; bj < 2; ++bj)
#pragma unroll
                    for (int n = 0; n < 2; ++n) { const int col = pn * 256 + bj * 128 + wc * 32 + 8 * fq + 4 * n; const f32x4 v = acc[ai][bj][m][n];
                        const f32x4 g = ld_bf4(GT + (size_t)row * 3072 + br * 1024 + col);
                        float* mp = M32 + (size_t)row * 1024 + col;
                        if (br == 0) { *(f32x4*)mp = g * v; }
                        else if (br == 1) { *(f32x4*)mp = *(const f32x4*)mp + g * v; }
                        else { st_bf4(M16 + (size_t)row * 1024 + col, *(const f32x4*)mp + g * v); } } }
    }
};

struct EpiRes {
    static constexpr bool PERM = true, AFTER_DRAIN = false;
    const float* xin; float* X; const float* MODG;
    __device__ __forceinline__ void operator()(const f32x4 (&acc)[2][2][4][2], const Unit& u, int wr, int wc, int fr, int fq) const {
        const float* gp = MODG + (size_t)(u.pm >> 3) * cfg::NMOD + u.pn * 256 + wc * 32 + 8 * fq;
        f32x4 g[2][2];
#pragma unroll
        for (int bj = 0; bj < 2; ++bj)
#pragma unroll
            for (int n = 0; n < 2; ++n) g[bj][n] = *(const f32x4*)(gp + bj * 128 + n * 4);
#pragma unroll
        for (int ai = 0; ai < 2; ++ai)
#pragma unroll
            for (int m = 0; m < 4; ++m) { const int row = u.pm * 256 + ai * 128 + wr * 64 + m * 16 + fr;
#pragma unroll
                for (int bj = 0; bj < 2; ++bj)
#pragma unroll
                    for (int n = 0; n < 2; ++n) { const size_t o = (size_t)row * 1024 + u.pn * 256 + bj * 128 + wc * 32 + 8 * fq + 4 * n;
                        *(f32x4*)(X + o) = *(const f32x4*)(xin + o) + g[bj][n] * acc[ai][bj][m][n]; } }
    }
};

struct EpiPart {
    static constexpr bool PERM = true, AFTER_DRAIN = false;
    float* P; const bf16_t* GT; int nks;
    __device__ __forceinline__ void operator()(const f32x4 (&acc)[2][2][4][2], const Unit& u, int wr, int wc, int fr, int fq) const {
        const int br = u.pm / 66, pmr = u.pm - br * 66 - 64, pn = u.pn & 3, slice = br * nks + (u.k0 >> 7);
#pragma unroll
        for (int ai = 0; ai < 2; ++ai)
#pragma unroll
            for (int m = 0; m < 4; ++m) { const int rs = pmr * 256 + ai * 128 + wr * 64 + m * 16 + fr;
#pragma unroll
                for (int bj = 0; bj < 2; ++bj)
#pragma unroll
                    for (int n = 0; n < 2; ++n) { const int col = pn * 256 + bj * 128 + wc * 32 + 8 * fq + 4 * n; f32x4 v = acc[ai][bj][m][n];
                        if (GT) v = v * ld_bf4(GT + (size_t)(cfg::MP + rs) * 3072 + br * 1024 + col);
                        *(f32x4*)(P + ((size_t)slice * 512 + rs) * 1024 + col) = v; } }
    }
};

struct EpiFfn {
    static constexpr bool PERM = true, AFTER_DRAIN = false;
    bf16_t* ACT;
    __device__ __forceinline__ void operator()(const f32x4 (&acc)[2][2][4][2], const Unit& u, int wr, int wc, int fr, int fq) const {
#pragma unroll
        for (int ai = 0; ai < 2; ++ai)
#pragma unroll
            for (int m = 0; m < 4; ++m) { const int row = u.pm * 256 + ai * 128 + wr * 64 + m * 16 + fr;
#pragma unroll
                for (int n = 0; n < 2; ++n) { const int col = u.pn * 128 + wc * 32 + 8 * fq + 4 * n; const f32x4 a = acc[ai][0][m][n], b = acc[ai][1][m][n]; f32x4 o;
#pragma unroll
                    for (int i = 0; i < 4; ++i) o[i] = a[i] * sigm(a[i]) * b[i];
                    st_bf4(ACT + (size_t)row * cfg::DFF + col, o); } }
    }
};

struct BranchOrder {
    int G, c;
    __host__ __device__ __forceinline__ bool next(int i, Unit& u) const { const int tile = c + (i / 3) * G; if (tile >= 256) return false; const int br = i % 3; u.pm = br * 66 + (tile >> 2); u.pn = br * 4 + (tile & 3); u.k0 = 0; return true; }
    __device__ __forceinline__ void a_ready(const Unit&) const {}
    __device__ __forceinline__ void done(const Unit&) const {}
};
struct SplitOrder {
    int G, c, nks, nbr;
    __host__ __device__ __forceinline__ bool next(int i, Unit& u) const { const int j = c + i * G; if (j >= 8 * nbr * nks) return false; const int ks = j % nks, t = j / nks, br = t % nbr, tile = t / nbr;
        u.pm = br * 66 + 64 + (tile >> 2); u.pn = br * 4 + (tile & 3); u.k0 = ks * 128; return true; }
    __device__ __forceinline__ void a_ready(const Unit&) const {}
    __device__ __forceinline__ void done(const Unit&) const {}
};

template <class Epi, class Sched, bool ALIGN_EPI = false, bool SP2 = false>
__device__ __forceinline__ void gemm_phase(PG8_LAS unsigned char* lds, const Gemm g, const Sched& S, const Epi& E, const int tid_in) {
    int tid_l = tid_in; asm volatile("" : "+v"(tid_l));
    const int tid = tid_l, wid = __builtin_amdgcn_readfirstlane(tid >> 6), lane = tid & 63, wr = wid >> 2, wc = wid & 3, fr = lane & 15, fq = lane >> 4;
    const int K = g.K, nt = K / BK, lda = g.lda ? g.lda : K, ldb = lda;
    unsigned voffA[2], voffB[2];
#pragma unroll
    for (int i = 0; i < 2; ++i) { int R, C; stage_rc(tid * 16 + i * 8192, R, C); const int Rb = Epi::PERM ? ((R & ~31) + perm32(R & 31)) : R;
        voffA[i] = (unsigned)(R * lda + C) * 2u; voffB[i] = (unsigned)(Rb * ldb + C) * 2u; }
    const size_t kstep = (size_t)(BK * 2);
    const size_t hstepA = (size_t)HALF * lda * 2, hstepB = (size_t)HALF * ldb * 2;
    const size_t tstepA = 2 * hstepA, tstepB = 2 * hstepB;
    const unsigned ldsw = (unsigned)wid * 1024u;
    const int aoff = lds_byte(wr * 64 + fr, fq * 8), boff = lds_byte(wc * 32 + fr, fq * 8);
#define PG8_SA(b, h) (((b) * 2 + (h)) * HTB)
#define PG8_SB(b, h) ((4 + (b) * 2 + (h)) * HTB)
#define PG8_STAGE(bufoff, gbase, voff) do { _Pragma("unroll") for (int _i = 0; _i < 2; ++_i) \
        __builtin_amdgcn_global_load_lds((const unsigned*)((const char*)(gbase) + (voff)[_i]), (PG8_LAS unsigned*)(lds + (bufoff) + ldsw + _i * 8192), 16, 0, 0); } while (0)
#define PG8_LDA(dst, b, h) do { _Pragma("unroll") for (int m = 0; m < 4; ++m) _Pragma("unroll") for (int k = 0; k < 2; ++k) dst[m][k] = *(const PG8_LAS bf16x8*)(lds + PG8_SA(b, h) + aoff + m * 2048 + k * 1024); } while (0)
#define PG8_LDB(dst, b, h) do { _Pragma("unroll") for (int n = 0; n < 2; ++n) _Pragma("unroll") for (int k = 0; k < 2; ++k) dst[n][k] = *(const PG8_LAS bf16x8*)(lds + PG8_SB(b, h) + boff + n * 2048 + k * 1024); } while (0)
#define PG8_MMA(ai, bj, At, Bt) do { __builtin_amdgcn_s_setprio(1); _Pragma("unroll") for (int m = 0; m < 4; ++m) _Pragma("unroll") for (int n = 0; n < 2; ++n) _Pragma("unroll") for (int k = 0; k < 2; ++k) \
        acc[ai][bj][m][n] = __builtin_amdgcn_mfma_f32_16x16x32_bf16(Bt[n][k], At[m][k], acc[ai][bj][m][n], 0, 0, 0); __builtin_amdgcn_s_setprio(0); } while (0)
#define PG8_WAIT_V(n) asm volatile("s_waitcnt vmcnt(" #n ")" ::: "memory")
#define PG8_WAIT_L(n) asm volatile("s_waitcnt lgkmcnt(" #n ")" ::: "memory")
#define PG8_BAR __builtin_amdgcn_s_barrier()
#define PG8_SCHED __builtin_amdgcn_sched_barrier(0)
    Unit cur, nxt; int ui = 0;
    if (!S.next(0, cur)) return;
    f32x4 acc[2][2][4][2];
#pragma unroll
    for (int a = 0; a < 2; ++a)
#pragma unroll
        for (int b = 0; b < 2; ++b)
#pragma unroll
            for (int m = 0; m < 4; ++m)
#pragma unroll
                for (int n = 0; n < 2; ++n) acc[a][b][m][n] = (f32x4){0.f, 0.f, 0.f, 0.f};
    bf16x8 At[4][2], B0[2][2], B1[2][2];
    const char* cA = (const char*)g.A + (size_t)cur.pm * tstepA + (size_t)cur.k0 * 2; const char* cB = (const char*)g.Bt + (size_t)cur.pn * tstepB + (size_t)cur.k0 * 2;
    S.a_ready(cur);
    if constexpr (SP2) {
        PG8_STAGE(PG8_SB(0, 0), cB, voffB); PG8_STAGE(PG8_SB(0, 1), cB + hstepB, voffB); PG8_STAGE(PG8_SA(0, 0), cA, voffA); PG8_STAGE(PG8_SA(0, 1), cA + hstepA, voffA);
        if (wr == 1) PG8_BAR;
        PG8_WAIT_V(2); PG8_BAR;
        PG8_STAGE(PG8_SB(1, 0), cB + kstep, voffB); PG8_STAGE(PG8_SA(1, 0), cA + kstep, voffA); PG8_STAGE(PG8_SB(1, 1), cB + hstepB + kstep, voffB);
        PG8_WAIT_V(6); PG8_BAR;
    } else {
        PG8_STAGE(PG8_SB(0, 0), cB, voffB); PG8_STAGE(PG8_SA(0, 0), cA, voffA); PG8_STAGE(PG8_SB(0, 1), cB + hstepB, voffB); PG8_STAGE(PG8_SA(0, 1), cA + hstepA, voffA);
        if (wr == 1) PG8_BAR;
        PG8_WAIT_V(4); PG8_BAR;
        PG8_STAGE(PG8_SB(1, 0), cB + kstep, voffB); PG8_STAGE(PG8_SA(1, 0), cA + kstep, voffA); PG8_STAGE(PG8_SB(1, 1), cB + hstepB + kstep, voffB);
        PG8_WAIT_V(6); PG8_BAR;
    }
    for (;;) {
        const bool has_next = S.next(ui + 1, nxt);
        const char* nA = has_next ? (const char*)g.A + (size_t)nxt.pm * tstepA + (size_t)nxt.k0 * 2 : cA; const char* nB = has_next ? (const char*)g.Bt + (size_t)nxt.pn * tstepB + (size_t)nxt.k0 * 2 : cB;
        for (int t = 0; t < nt; t += 2) {
            const bool last = (t == nt - 2);
            const char* a1 = cA + (size_t)(t + 1) * kstep;
            const char* a2 = last ? nA : cA + (size_t)(t + 2) * kstep; const char* b2 = last ? nB : cB + (size_t)(t + 2) * kstep;
            const char* a3 = a2 + kstep; const char* b3 = b2 + kstep;
            if (last && has_next) S.a_ready(nxt);
            if constexpr (SP2) {
            PG8_LDB(B0, 0, 0); PG8_LDB(B1, 0, 1); PG8_SCHED; PG8_LDA(At, 0, 0); PG8_STAGE(PG8_SA(1, 1), a1 + hstepA, voffA);
            PG8_WAIT_V(8); PG8_WAIT_L(0); PG8_BAR; PG8_MMA(0, 0, At, B0); PG8_MMA(0, 1, At, B1); PG8_BAR; PG8_SCHED;
            PG8_LDA(At, 0, 1); PG8_STAGE(PG8_SB(0, 0), b2, voffB); PG8_STAGE(PG8_SB(0, 1), b2 + hstepB, voffB); PG8_STAGE(PG8_SA(0, 0), a2, voffA);
            PG8_WAIT_V(8); PG8_WAIT_L(0); PG8_BAR; PG8_MMA(1, 0, At, B0); PG8_MMA(1, 1, At, B1); PG8_BAR; PG8_SCHED;
            PG8_LDB(B0, 1, 0); PG8_LDB(B1, 1, 1); PG8_SCHED; PG8_LDA(At, 1, 0); PG8_STAGE(PG8_SA(0, 1), a2 + hstepA, voffA);
            PG8_WAIT_V(8); PG8_WAIT_L(0); PG8_BAR; PG8_MMA(0, 0, At, B0); PG8_MMA(0, 1, At, B1); PG8_BAR; PG8_SCHED;
            PG8_LDA(At, 1, 1); PG8_STAGE(PG8_SB(1, 0), b3, voffB); PG8_STAGE(PG8_SB(1, 1), b3 + hstepB, voffB); PG8_STAGE(PG8_SA(1, 0), a3, voffA);
            PG8_WAIT_V(8); PG8_WAIT_L(0); PG8_BAR; PG8_MMA(1, 0, At, B0); PG8_MMA(1, 1, At, B1); PG8_BAR; PG8_SCHED;
            } else {
            PG8_LDB(B0, 0, 0); PG8_SCHED; PG8_LDA(At, 0, 0); PG8_STAGE(PG8_SA(1, 1), a1 + hstepA, voffA);
            PG8_WAIT_L(8); PG8_BAR; PG8_WAIT_L(0); PG8_MMA(0, 0, At, B0); PG8_BAR; PG8_SCHED;
            PG8_LDB(B1, 0, 1); PG8_STAGE(PG8_SB(0, 0), b2, voffB);
            PG8_BAR; PG8_WAIT_L(0); PG8_MMA(0, 1, At, B1); PG8_BAR;
            PG8_LDA(At, 0, 1); PG8_STAGE(PG8_SA(0, 0), a2, voffA);
            PG8_BAR; PG8_WAIT_L(0); PG8_MMA(1, 0, At, B0); PG8_BAR; PG8_SCHED;
            PG8_STAGE(PG8_SB(0, 1), b2 + hstepB, voffB);
            PG8_WAIT_V(6); PG8_BAR; PG8_MMA(1, 1, At, B1); PG8_BAR;
            PG8_LDB(B0, 1, 0); PG8_SCHED; PG8_LDA(At, 1, 0); PG8_STAGE(PG8_SA(0, 1), a2 + hstepA, voffA);
            PG8_WAIT_L(8); PG8_BAR; PG8_WAIT_L(0); PG8_MMA(0, 0, At, B0); PG8_BAR; PG8_SCHED;
            PG8_LDB(B1, 1, 1); PG8_STAGE(PG8_SB(1, 0), b3, voffB);
            PG8_BAR; PG8_WAIT_L(0); PG8_MMA(0, 1, At, B1); PG8_BAR;
            PG8_LDA(At, 1, 1); PG8_STAGE(PG8_SA(1, 0), a3, voffA);
            PG8_BAR; PG8_WAIT_L(0); PG8_MMA(1, 0, At, B0); PG8_BAR; PG8_SCHED;
            PG8_STAGE(PG8_SB(1, 1), b3 + hstepB, voffB);
            PG8_WAIT_V(6); PG8_BAR; PG8_MMA(1, 1, At, B1); PG8_BAR;
            }
        }
        if constexpr (ALIGN_EPI) { if (wr == 0) PG8_BAR; }
        if constexpr (!Epi::AFTER_DRAIN) { int ao_ = aoff; asm volatile("" : "+v"(ao_));
            const int fr_e = (ao_ >> 6) & 15, fq_e = ((ao_ ^ ((fr_e >> 3) << 5)) >> 4) & 3; E(acc, cur, wr, wc, fr_e, fq_e); S.done(cur); }
        if (!has_next) break;
#pragma unroll
        for (int a = 0; a < 2; ++a)
#pragma unroll
            for (int b = 0; b < 2; ++b)
#pragma unroll
                for (int m = 0; m < 4; ++m)
#pragma unroll
                    for (int n = 0; n < 2; ++n) acc[a][b][m][n] = (f32x4){0.f, 0.f, 0.f, 0.f};
        cur = nxt; cA = nA; cB = nB; ++ui;
        if constexpr (ALIGN_EPI) { if (wr == 1) PG8_BAR; }
    }
    PG8_WAIT_V(0);
    if constexpr (!ALIGN_EPI) { if (wr == 0) PG8_BAR; }
    PG8_BAR;
    if constexpr (Epi::AFTER_DRAIN) { E.fused(acc, cur, wr, wc, fr, fq, lds, wid, lane); S.done(cur); }
#undef PG8_SA
#undef PG8_SB
#undef PG8_STAGE
#undef PG8_LDA
#undef PG8_LDB
#undef PG8_MMA
#undef PG8_WAIT_V
#undef PG8_WAIT_L
#undef PG8_BAR
#undef PG8_SCHED
}
}

#define LAS __attribute__((address_space(3)))
#define DI __device__ __forceinline__
typedef unsigned short bf16_t;
typedef short bf16x8 __attribute__((ext_vector_type(8)));
typedef short s16x4 __attribute__((ext_vector_type(4)));
typedef float f32x4 __attribute__((ext_vector_type(4)));
typedef float f32x16 __attribute__((ext_vector_type(16)));
typedef unsigned u32x4 __attribute__((ext_vector_type(4)));
typedef unsigned u32x2 __attribute__((ext_vector_type(2)));
using pg8::cvt_pk_bf16; using pg8::sigm; using pg8::ld_bf4; using pg8::st_bf4; using pg8::batch_of;
using namespace cfg;

DI float bf2f(bf16_t b) { return __uint_as_float((unsigned)b << 16); }
DI unsigned f2bf(float f) { unsigned u = __float_as_uint(f); return (u + 0x7fffu + ((u >> 16) & 1u)) >> 16; }
DI float wave_sum(float v, int lane) {
#pragma unroll
    for (int o = 1; o < 64; o <<= 1) v += shx(v, o, lane);
    return v;
}
DI float wave_max(float v, int lane) {
#pragma unroll
    for (int o = 1; o < 64; o <<= 1) v = fmaxf(v, shx(v, o, lane));
    return v;
}
DI bf16x8 pack8(const f32x4 a, const f32x4 b) { u32x4 p; p.x = cvt_pk_bf16(a[0], a[1]); p.y = cvt_pk_bf16(a[2], a[3]); p.z = cvt_pk_bf16(b[0], b[1]); p.w = cvt_pk_bf16(b[2], b[3]); return __builtin_bit_cast(bf16x8, p); }
#define MFMA16(a, b, c) __builtin_amdgcn_mfma_f32_16x16x32_bf16((a), (b), (c), 0, 0, 0)
#define MFMA32(a, b, c) __builtin_amdgcn_mfma_f32_32x32x16_bf16((a), (b), (c), 0, 0, 0)

#define XB_TMO      128
#define XB_XCNT(j)  (256  + 64 * (j))
#define XB_XSUB(j)  (1280 + 64 * (j))
#define XB_XGEN(j)  (2304 + 64 * (j))
#define XB_TOP      3328
#define XB_TOPGEN   3392
#define XCD_BAR_WORDS 3456
#define XB_SPIN_CAP (1u << 18)

__device__ __forceinline__ unsigned xb_ld(unsigned* p)              { return __hip_atomic_load(p, __ATOMIC_RELAXED, __HIP_MEMORY_SCOPE_AGENT); }
__device__ __forceinline__ unsigned xb_add(unsigned* p, unsigned v) { return __hip_atomic_fetch_add(p, v, __ATOMIC_RELAXED, __HIP_MEMORY_SCOPE_AGENT); }
__device__ __forceinline__ unsigned xb_xcc_id() { return (unsigned)__builtin_amdgcn_s_getreg((3 << 11) | 20) & 0xFu; }
#define XB_SPIN(cond, bar) do { unsigned _sp = 0; while (cond) { __builtin_amdgcn_s_sleep(1); \
    if ((++_sp & 255u) == 0u) { if (xb_ld(&(bar)[XB_TMO])) break; if (_sp > XB_SPIN_CAP) { atomicAdd(&(bar)[XB_TMO], 1u); break; } } } } while (0)

struct XcdBarrier {
    unsigned* bar; unsigned x;
    volatile LAS unsigned* st;
};

__device__ __forceinline__ XcdBarrier xcd_barrier_post(unsigned* bar, volatile LAS unsigned* st) {
    XcdBarrier b; b.bar = bar; b.x = xb_xcc_id(); b.st = st;
    if (threadIdx.x == 0) (void)xb_add(&bar[XB_XCNT(b.x)], 1u);
    return b;
}
__device__ __forceinline__ void xcd_barrier_complete(unsigned* bar, unsigned x, unsigned& nloc, unsigned& nx) {
    const unsigned G = gridDim.x * gridDim.y * gridDim.z;
    unsigned sum, cnt, mine, sp = 0u;
    for (;;) {
        sum = 0u; cnt = 0u; mine = 0u;
#pragma unroll
        for (unsigned j = 0; j < 16; ++j) { const unsigned c = xb_ld(&bar[XB_XCNT(j)]); sum += c; cnt += (c > 0u) ? 1u : 0u; mine = (j == x) ? c : mine; }
        if (sum == G) break;
        __builtin_amdgcn_s_sleep(1);
        if ((++sp & 255u) == 0u) { if (xb_ld(&bar[XB_TMO])) break; if (sp > XB_SPIN_CAP) { atomicAdd(&bar[XB_TMO], 1u); break; } }
    }
    nloc = mine > 0u ? mine : 1u; nx = cnt > 0u ? cnt : 1u;
}

__device__ __forceinline__ void xcd_barrier(const XcdBarrier& b) {
    asm volatile("s_waitcnt vmcnt(0)" ::: "memory");
    __syncthreads();
    if (threadIdx.x == 0) {
        unsigned* bar = b.bar;
        __builtin_amdgcn_s_waitcnt(0);
        unsigned nloc = b.st[0], nx = b.st[1];
        if (nloc == 0u) { xcd_barrier_complete(bar, b.x, nloc, nx); b.st[0] = nloc; b.st[1] = nx; }
        const unsigned old = xb_add(&bar[XB_XSUB(b.x)], 1u);
        const unsigned gen = old / nloc;
        if (old + 1u == (gen + 1u) * nloc) {
            __builtin_amdgcn_fence(__ATOMIC_RELEASE, "agent");
            asm volatile("s_waitcnt vmcnt(0)" ::: "memory");
            const unsigned og = xb_add(&bar[XB_TOP], 1u);
            const unsigned tg = og / nx;
            if (og + 1u == (tg + 1u) * nx) xb_add(&bar[XB_TOPGEN], 1u);
            else XB_SPIN(xb_ld(&bar[XB_TOPGEN]) == tg, bar);
            __builtin_amdgcn_fence(__ATOMIC_ACQUIRE, "agent");
            xb_add(&bar[XB_XGEN(b.x)], 1u);
            asm volatile("s_waitcnt vmcnt(0)" ::: "memory");
        } else {
            XB_SPIN(xb_ld(&bar[XB_XGEN(b.x)]) == gen, bar);
            __builtin_amdgcn_fence(__ATOMIC_ACQUIRE, "agent");
            asm volatile("s_waitcnt vmcnt(0)" ::: "memory");
        }
    }
    __syncthreads();
}

#ifndef FUSE
#define FUSE 0
#endif
#ifndef MIXM
#define MIXM 0
#endif
#ifndef SYNC2
#define SYNC2 0
#endif
#ifndef REPM
#define REPM 0
#endif
#ifndef GM
#define GM 0xff
#endif
#ifndef PHM
#define PHM 0xff
#endif
struct Args { const float* in[33]; float* out; unsigned char* ws; unsigned long long rfix[8]; int ph_lo, ph_hi; };
typedef const Args __attribute__((address_space(4)))* ArgsP;

DI void tr_item(const float* W, int K, int N, bf16_t* WT, int k0, int n0, int drow0, LAS float* scr, int lane) {
#pragma unroll 8
    for (int i = 0; i < 32; ++i) { const int kk = 2 * i + (lane >> 5); scr[kk * 33 + (lane & 31)] = W[(size_t)(k0 + kk) * N + n0 + (lane & 31)]; }
    asm volatile("s_waitcnt lgkmcnt(0)" ::: "memory");
    const int c = lane & 7;
#pragma unroll
    for (int j = 0; j < 4; ++j) { const int n = (lane >> 3) + 8 * j; const LAS float* s = scr + (8 * c) * 33 + n;
        u32x4 o; o.x = cvt_pk_bf16(s[0 * 33], s[1 * 33]); o.y = cvt_pk_bf16(s[2 * 33], s[3 * 33]); o.z = cvt_pk_bf16(s[4 * 33], s[5 * 33]); o.w = cvt_pk_bf16(s[6 * 33], s[7 * 33]);
        *(u32x4*)(WT + (size_t)(drow0 + n) * K + k0 + 8 * c) = o; }
    asm volatile("s_waitcnt lgkmcnt(0)" ::: "memory");
}
DI void fold_item(const float* Pw  , const float* Sc  , const float* Wa  , bf16_t* WT  , int k0, int n0, LAS float* scr, int lane) {
    const int g = k0 >> 7, nn = lane & 31, hi = lane >> 5;
    for (int jc = 0; jc < 4; ++jc) {
        float w[32];
#pragma unroll
        for (int jj = 0; jj < 32; ++jj) { const int j = g * 128 + jc * 32 + jj; w[jj] = Sc[j] * Wa[(size_t)j * 1024 + n0 + nn]; }
#pragma unroll 1
        for (int i = 0; i < 32; ++i) { const float* pr = Pw + ((size_t)g * 128 + ((k0 & 127) + 2 * i + hi)) * 128 + jc * 32; float acc = 0.f;
#pragma unroll
            for (int j4 = 0; j4 < 8; ++j4) { const f32x4 p = *(const f32x4*)(pr + 4 * j4);
                acc += p[0] * w[4 * j4] + p[1] * w[4 * j4 + 1] + p[2] * w[4 * j4 + 2] + p[3] * w[4 * j4 + 3]; }
            LAS float* sp = scr + (2 * i + hi) * 33 + nn; if (jc == 0) *sp = acc; else *sp += acc; }
    }
    asm volatile("s_waitcnt lgkmcnt(0)" ::: "memory");
    const int c = lane & 7;
#pragma unroll
    for (int j = 0; j < 4; ++j) { const int n = (lane >> 3) + 8 * j; const LAS float* s = scr + (8 * c) * 33 + n;
        u32x4 o; o.x = cvt_pk_bf16(s[0 * 33], s[1 * 33]); o.y = cvt_pk_bf16(s[2 * 33], s[3 * 33]); o.z = cvt_pk_bf16(s[4 * 33], s[5 * 33]); o.w = cvt_pk_bf16(s[6 * 33], s[7 * 33]);
        *(u32x4*)(WT + (size_t)(n0 + n) * 512 + k0 + 8 * c) = o; }
    asm volatile("s_waitcnt lgkmcnt(0)" ::: "memory");
}
DI void sincos_frac(float f  , float& c, float& s) { s = __builtin_amdgcn_sinf(f); c = __builtin_amdgcn_cosf(f); }

DI void prologue(ArgsP a, LAS unsigned char* lds, int tid) {
    const int lane = tid & 63, wave = tid >> 6;
    const int gw = blockIdx.x * 8 + wave, NGW = gridDim.x * 8;
    const int gt = blockIdx.x * 512 + tid, NT = gridDim.x * 512;
    unsigned char* ws = a->ws;
    LAS float* scr = (LAS float*)(lds + wave * 16384);
    constexpr int I_IN = 16 * 152, I_GLU = 8 * 16, I_BR = 8 * 32, I_OUT = 16 * 32, I_FI = 16 * 176, I_FO = 44 * 32, I_ADA = 16 * 192, I_FOLD = 8 * 32;
    constexpr int PER_L = I_IN + I_GLU + 2 * I_BR + I_OUT + I_FI + I_FO + I_ADA + I_FOLD;
    for (int it = gw; it < PER_L * 4; it += NGW) {
        const int l = it & 3; int r = it >> 2;
        if (r < I_FOLD) { fold_item(a->in[14] + (size_t)l * 4 * 128 * 128, a->in[15] + l * 512, a->in[26] + (size_t)l * 512 * 1024, (bf16_t*)(ws + WS_WBR) + (size_t)l * 3072 * 512, (r >> 5) * 64, (r & 31) * 32, scr, lane); continue; } r -= I_FOLD;
        if (r < I_IN) { const int kb = r / 152, nb = r % 152; tr_item(a->in[13] + (size_t)l * 1024 * IN_COLS, 1024, IN_COLS, (bf16_t*)(ws + WS_WIN) + (size_t)l * IN_COLS * 1024, kb * 64, nb * 32, nb * 32, scr, lane); continue; } r -= I_IN;
        if (r < I_GLU) { const int kb = r / 16, nb = r % 16; tr_item(a->in[25] + (size_t)l * 512 * 512, 512, 512, (bf16_t*)(ws + WS_WGLU) + (size_t)l * 512 * 512, kb * 64, nb * 32, nb * 32, scr, lane); continue; } r -= I_GLU;
        if (r < I_BR) { const int kb = r / 32, nb = r % 32; tr_item(a->in[27] + (size_t)l * 512 * 1024, 512, 1024, (bf16_t*)(ws + WS_WBR) + (size_t)l * 3072 * 512, kb * 64, nb * 32, 1024 + nb * 32, scr, lane); continue; } r -= I_BR;
        if (r < I_BR) { const int kb = r / 32, nb = r % 32; tr_item(a->in[28] + (size_t)l * 512 * 1024, 512, 1024, (bf16_t*)(ws + WS_WBR) + (size_t)l * 3072 * 512, kb * 64, nb * 32, 2048 + nb * 32, scr, lane); continue; } r -= I_BR;
        if (r < I_OUT) { const int kb = r / 32, nb = r % 32; tr_item(a->in[29] + (size_t)l * 1024 * 1024, 1024, 1024, (bf16_t*)(ws + WS_WOUT) + (size_t)l * 1024 * 1024, kb * 64, nb * 32, nb * 32, scr, lane); continue; } r -= I_OUT;
        if (r < I_FI) { const int kb = r / 176, nb = r % 176; const int n0 = nb * 32, half = n0 / DFF, j = n0 - half * DFF;
            tr_item(a->in[30] + (size_t)l * 1024 * 2 * DFF, 1024, 2 * DFF, (bf16_t*)(ws + WS_WFI) + (size_t)l * 2 * DFF * 1024, kb * 64, n0, 256 * (j >> 7) + 128 * half + (j & 127), scr, lane); continue; } r -= I_FI;
        if (r < I_FO) { const int kb = r / 32, nb = r % 32; tr_item(a->in[31] + (size_t)l * DFF * 1024, DFF, 1024, (bf16_t*)(ws + WS_WFO) + (size_t)l * 1024 * DFF, kb * 64, nb * 32, nb * 32, scr, lane); continue; } r -= I_FO;
        { const int kb = r / 192, nb = r % 192; tr_item(a->in[11] + (size_t)l * 1024 * 6144, 1024, 6144, (bf16_t*)(ws + WS_GT), kb * 64, nb * 32, l * 6144 + nb * 32, scr, lane); }
    }
    { bf16_t* CA = (bf16_t*)(ws + WS_CA);
      for (int i = gt; i < 256 * 1024; i += NT) { const int r = i >> 10, c = i & 1023; float v = 0.f;
          if (r < 8) v = a->in[7][r * 1024 + c]; else if (r < NBAT) v = a->in[8][(r - 8) * 1024 + c];
          CA[i] = (bf16_t)f2bf(v * sigm(v)); } }
    { float* rc = (float*)(ws + WS_TAB + TB_ROPEC); float* rs = (float*)(ws + WS_TAB + TB_ROPES);
      for (int i = gt; i < 2052 * 8; i += NT) { const int ti = i >> 3, j = i & 7; const int pos = ti < 2048 ? ti : 8192 + (ti - 2048);
          const unsigned long long fx = (unsigned long long)pos * a->rfix[j];
          float c, s; sincos_frac((float)(unsigned)(fx >> 40) * 5.9604644775390625e-08f, c, s); rc[i] = c; rs[i] = s; } }
    { float* AB = (float*)(ws + WS_TAB + TB_ABAR); float* AB256 = (float*)(ws + WS_TAB + TB_ABAR256); bf16_t* BBF = (bf16_t*)(ws + WS_TAB + TB_BBF);
      for (int i = gt; i < 4 * 32 * 64; i += NT) { const int lg = i >> 6, p = i & 63;
          const float dt = expf(a->in[19][lg]); const float ar = a->in[17][i], ai = a->in[18][i];
          const float x = ar * dt; const float yt = ai * dt * 0.15915494309189535f;
          float c, s; sincos_frac(yt, c, s); float ch, sh; sincos_frac(0.5f * yt, ch, sh);
          const float em1 = x * (1.f + x * (0.5f + x * (0.16666667f + x * (0.041666668f + x * 0.0083333338f))));
          const float ex = 1.f + em1;
          const float abr = ex * c, abi = ex * s;
          const float nr = em1 * c - (sh + sh) * sh, ni = abi;
          const float den = 1.f / (ar * ar + ai * ai);
          const float cr = (nr * ar + ni * ai) * den, ci = (ni * ar - nr * ai) * den;
          AB[2 * i] = abr; AB[2 * i + 1] = abi;
          float pr = abr, pi = abi;
#pragma unroll
          for (int k = 0; k < 8; ++k) { const float t = pr * pr - pi * pi; pi = (pr + pr) * pi; pr = t; }
          AB256[2 * i] = pr; AB256[2 * i + 1] = pi;
          const float* br = a->in[20] + (size_t)i * 16; const float* bi = a->in[21] + (size_t)i * 16;
          const int st = p >> 5;
#pragma unroll
          for (int half = 0; half < 2; ++half) { u32x4 ore, oim; unsigned* pre = (unsigned*)&ore; unsigned* pim = (unsigned*)&oim; (void)pre; (void)pim;
              float vr[8], vi[8];
#pragma unroll
              for (int j = 0; j < 8; ++j) { const float b_r = br[half * 8 + j], b_i = bi[half * 8 + j]; vr[j] = cr * b_r - ci * b_i; vi[j] = cr * b_i + ci * b_r; }
              ore.x = cvt_pk_bf16(vr[0], vr[1]); ore.y = cvt_pk_bf16(vr[2], vr[3]); ore.z = cvt_pk_bf16(vr[4], vr[5]); ore.w = cvt_pk_bf16(vr[6], vr[7]);
              oim.x = cvt_pk_bf16(vi[0], vi[1]); oim.y = cvt_pk_bf16(vi[2], vi[3]); oim.z = cvt_pk_bf16(vi[4], vi[5]); oim.w = cvt_pk_bf16(vi[6], vi[7]);
              *(u32x4*)(BBF + (((size_t)lg * 4 + 0 + st) * 64 + half * 32 + (p & 31)) * 8) = ore;
              *(u32x4*)(BBF + (((size_t)lg * 4 + 2 + st) * 64 + half * 32 + (p & 31)) * 8) = oim; } } }
    { bf16_t* CF = (bf16_t*)(ws + WS_TAB + TB_CF);
      for (int i = gt; i < 4 * 32 * 4 * 64; i += NT) { const int ln = i & 63, ks = (i >> 6) & 3, lg = i >> 8; const int c = ln & 15, quad = ln >> 4;
          float v[8];
#pragma unroll
          for (int j = 0; j < 8; ++j) { const int k = ks * 32 + quad * 8 + j; v[j] = k < 64 ? a->in[22][((size_t)lg * 16 + c) * 64 + k] : -a->in[23][((size_t)lg * 16 + c) * 64 + (k - 64)]; }
          u32x4 o; o.x = cvt_pk_bf16(v[0], v[1]); o.y = cvt_pk_bf16(v[2], v[3]); o.z = cvt_pk_bf16(v[4], v[5]); o.w = cvt_pk_bf16(v[6], v[7]);
          *(u32x4*)(CF + (size_t)i * 8) = o; } }
    { for (int i = gt; i < 4 * 128 * 124 * 32; i += NT) { const int c4 = i & 31, j = (i >> 5) % 124, lb = (i >> 5) / 124;
          *(f32x4*)(a->out + OFF_KS + ((size_t)lb * 128 + j) * 128 + c4 * 4) = *(const f32x4*)(a->in[2] + ((size_t)lb * 128 + j + 4) * 128 + c4 * 4);
          *(f32x4*)(a->out + OFF_VS + ((size_t)lb * 128 + j) * 128 + c4 * 4) = *(const f32x4*)(a->in[3] + ((size_t)lb * 128 + j + 4) * 128 + c4 * 4); }
      for (int i = gt; i < 4 * 128 * 11 * 128; i += NT) { const int c4 = i & 127, j = (i >> 7) % 11, lb = (i >> 7) / 11;
          *(f32x4*)(a->out + OFF_PS + ((size_t)lb * 15 + j) * 512 + c4 * 4) = *(const f32x4*)(a->in[4] + ((size_t)lb * 15 + j + 4) * 512 + c4 * 4); } }
}

#define NA_PARAMS const float* n_xp, const float* n_xs, const float* n_gvec, const float* n_MODL, int n_sc_off, bf16_t* n_H, const float* n_P, int n_nparts, const float* n_pgate, float* n_X
#define NA_ARGS n_xp, n_xs, n_gvec, n_MODL, n_sc_off, n_H, n_P, n_nparts, n_pgate, n_X
DI void norm_row(NA_PARAMS, int row, int lane) {
    const int bi = batch_of(row);
    const float* xr = (row < MP ? n_xp : n_xs) + (size_t)row * 1024; const float* mr = n_MODL + (size_t)bi * NMOD;
    f32x4 v[4]; float ss = 0.f;
#pragma unroll
    for (int j = 0; j < 4; ++j) v[j] = *(const f32x4*)(xr + 4 * lane + 256 * j);
    if (row >= MP && n_nparts > 0) {
        f32x4 s[4];
#pragma unroll
        for (int j = 0; j < 4; ++j) s[j] = (f32x4){0.f, 0.f, 0.f, 0.f};
#pragma unroll 2
        for (int p = 0; p < n_nparts; ++p) { const float* pr = n_P + ((size_t)p * 512 + (row - MP)) * 1024 + 4 * lane;
#pragma unroll
            for (int j = 0; j < 4; ++j) s[j] += *(const f32x4*)(pr + 256 * j); }
#pragma unroll
        for (int j = 0; j < 4; ++j) { v[j] += *(const f32x4*)(n_pgate + (size_t)bi * NMOD + 4 * lane + 256 * j) * s[j]; if (n_H) *(f32x4*)(n_X + (size_t)row * 1024 + 4 * lane + 256 * j) = v[j]; }
    }
#pragma unroll
    for (int j = 0; j < 4; ++j) ss += v[j][0] * v[j][0] + v[j][1] * v[j][1] + v[j][2] * v[j][2] + v[j][3] * v[j][3];
    const float r = rsqrtf(wave_sum(ss, lane) * (1.f / 1024.f) + 1e-6f);
    if (n_H) {
#pragma unroll
        for (int j = 0; j < 4; ++j) { const int c = 4 * lane + 256 * j; const f32x4 g = *(const f32x4*)(n_gvec + c), sh = *(const f32x4*)(mr + c), sc = *(const f32x4*)(mr + n_sc_off + c);
            st_bf4(n_H + (size_t)row * 1024 + c, v[j] * r * g * (1.f + sc) + sh); }
    } else {
#pragma unroll
        for (int j = 0; j < 4; ++j) { const int c = 4 * lane + 256 * j; *(f32x4*)(n_X + (size_t)row * 1024 + c) = v[j] * r * *(const f32x4*)(n_gvec + c); }
    }
}
DI void norm_phase(NA_PARAMS, int tid) {
    const int lane = tid & 63, gw = blockIdx.x * 8 + (tid >> 6), NGW = gridDim.x * 8;
    for (int it = gw; it < M; it += NGW) norm_row(NA_ARGS, it < MS ? MP + it : it - MS, lane);
}
DI bool panel_done(unsigned* cnt, unsigned expected, volatile LAS unsigned* flagw, int tid) {
    asm volatile("s_waitcnt vmcnt(0)" ::: "memory"); __syncthreads();
    if (tid == 0) { __builtin_amdgcn_fence(__ATOMIC_RELEASE, "agent"); asm volatile("s_waitcnt vmcnt(0)" ::: "memory");
        const unsigned old = __hip_atomic_fetch_add(cnt, 1u, __ATOMIC_RELAXED, __HIP_MEMORY_SCOPE_AGENT); const bool last = (old + 1u == expected);
        if (last) { __builtin_amdgcn_fence(__ATOMIC_ACQUIRE, "agent"); asm volatile("s_waitcnt vmcnt(0)" ::: "memory"); }
        flagw[0] = last ? 1u : 0u; }
    __syncthreads();
    const bool r = flagw[0] != 0u;
    __syncthreads();
    return r;
}
DI void norm_panel(NA_PARAMS, int pm, int tid) { const int lane = tid & 63, wave = tid >> 6; for (int r = wave; r < 256; r += 8) norm_row(NA_ARGS, pm * 256 + r, lane); }

template <int W>
DI void pool_run(const float* XA, bf16_t* Dm, float* out, int l, int row0, int c4) {
    const int t0 = row0 & 2047;
    f32x4 x[W + 7];
#pragma unroll
    for (int i = 0; i < W + 7; ++i) { const int dt = i - (W - 1); x[i] = (t0 + dt >= 0) ? *(const f32x4*)(XA + (size_t)(row0 + dt) * 512 + c4) : (f32x4){0.f, 0.f, 0.f, 0.f}; }
    f32x4 s = x[0];
#pragma unroll
    for (int i = 1; i < W - 1; ++i) s += x[i];
#pragma unroll
    for (int k = 0; k < 8; ++k) { s += x[W - 1 + k]; const int t = t0 + k; const float cnt = (float)((t + 1 < W) ? t + 1 : W);
        st_bf4(Dm + (size_t)(row0 + k) * 512 + c4, s * (1.f / cnt) - x[W - 1 + k]);
        if (t >= 2033) *(f32x4*)(out + OFF_PP + ((size_t)(l * 8 + (row0 >> 11)) * 15 + (t - 2033)) * 512 + c4) = x[W - 1 + k];
        s -= x[k]; }
}
DI void pool_phase(ArgsP a, int l, const float* XA, bf16_t* Dm, int tid) {
    const int gt = blockIdx.x * 512 + tid, NT = gridDim.x * 512;
    constexpr int NRUN = MP / 8;
    for (int item = gt; item < 4 * NRUN * 32; item += NT) {
        const int c4l = item & 31, gr = item >> 5, g = gr / NRUN, run = gr - g * NRUN; const int c4 = g * 128 + c4l * 4, row0 = run * 8;
        if (g == 0) pool_run<2>(XA, Dm, a->out, l, row0, c4); else if (g == 1) pool_run<4>(XA, Dm, a->out, l, row0, c4);
        else if (g == 2) pool_run<8>(XA, Dm, a->out, l, row0, c4); else pool_run<16>(XA, Dm, a->out, l, row0, c4);
    }
    for (int idx = gt; idx < MS * 128; idx += NT) {
        const int row = MP + (idx >> 7), c4 = (idx & 127) * 4, w = 2 << (c4 >> 7);
        const f32x4 x = *(const f32x4*)(XA + (size_t)row * 512 + c4); f32x4 sum = x;
        const int rs = row - MP, bs = rs >> 2, t = rs & 3;
        for (int s = 1; s < w; ++s) { const int pos = t - s;
            sum += pos >= 0 ? *(const f32x4*)(XA + (size_t)(row - s) * 512 + c4) : *(const f32x4*)(a->in[4] + ((size_t)(l * 128 + bs) * 15 + 15 + pos) * 512 + c4); }
        *(f32x4*)(a->out + OFF_PS + ((size_t)(l * 128 + bs) * 15 + 11 + t) * 512 + c4) = x;
        st_bf4(Dm + (size_t)row * 512 + c4, sum * (1.f / (float)w) - x);
    }
}

DI void attn_prompt_unit(LAS unsigned char* lds, int unit, const bf16_t* Q, const bf16_t* KB, const bf16_t* VB, bf16_t* YB, const float* sinks, int tid) {
    const int b = unit >> 5, g = (unit >> 4) & 1, nb = unit & 15;
    LAS bf16_t* Ks = (LAS bf16_t*)lds;
    LAS bf16_t* Vt = (LAS bf16_t*)(lds + 36864);
    const int krow0 = b * 2048 + (nb - 1) * 128;
#pragma unroll
    for (int it = 0; it < 4; ++it) {
        const int chunk = tid + 512 * it, j = chunk >> 3, c8 = chunk & 7;
        u32x4 kv = {0u, 0u, 0u, 0u}, vv = {0u, 0u, 0u, 0u};
        if (nb > 0 || j >= 128) { const size_t off = (size_t)(krow0 + j) * 128 + g * 64 + c8 * 8; kv = *(const u32x4*)(KB + off); vv = *(const u32x4*)(VB + off); }
        *(LAS u32x4*)(Ks + j * 72 + c8 * 8) = kv;
        LAS bf16_t* vp = Vt + (c8 * 8) * 264 + j;
        vp[0 * 264] = (bf16_t)(vv.x & 0xffffu); vp[1 * 264] = (bf16_t)(vv.x >> 16); vp[2 * 264] = (bf16_t)(vv.y & 0xffffu); vp[3 * 264] = (bf16_t)(vv.y >> 16);
        vp[4 * 264] = (bf16_t)(vv.z & 0xffffu); vp[5 * 264] = (bf16_t)(vv.z >> 16); vp[6 * 264] = (bf16_t)(vv.w & 0xffffu); vp[7 * 264] = (bf16_t)(vv.w >> 16);
    }
    __syncthreads();
    const int wave = tid >> 6, lane = tid & 63, l15 = lane & 15, quad = lane >> 4;
    const int r = wave >> 1, hq = g * 4 + r;
    const float sc2 = 0.125f * 1.4426950408889634f;
    const float sk2 = sinks[hq] * 1.4426950408889634f;
    const int kt0 = wave & 1;
#pragma unroll 1
    for (int qh = 0; qh < 2; ++qh) {
        const int q0 = (wave & 1) * 64 + qh * 32;
        const int qrow0 = b * 2048 + nb * 128 + q0;
        bf16x8 qf[2][2];
#pragma unroll
        for (int qt = 0; qt < 2; ++qt)
#pragma unroll
            for (int ds = 0; ds < 2; ++ds) qf[qt][ds] = *(const bf16x8*)(Q + (size_t)(qrow0 + qt * 16 + l15) * 512 + hq * 64 + ds * 32 + quad * 8);
        float m2[2], ls[2]; f32x4 o[4][2];
#pragma unroll
        for (int qt = 0; qt < 2; ++qt) { m2[qt] = sk2; ls[qt] = quad == 0 ? 1.f : 0.f;
#pragma unroll
            for (int dt = 0; dt < 4; ++dt) o[dt][qt] = (f32x4){0.f, 0.f, 0.f, 0.f}; }
#pragma unroll 1
        for (int kk = 0; kk < 3; ++kk) {
            const int kt = kt0 + kk;
            if (nb == 0 && kt < 2) continue;
            f32x4 s[4][2];
#pragma unroll
            for (int sub = 0; sub < 4; ++sub) { const LAS bf16_t* kp = Ks + (kt * 64 + sub * 16 + l15) * 72 + quad * 8;
                const bf16x8 k0 = *(const LAS bf16x8*)kp, k1 = *(const LAS bf16x8*)(kp + 32);
#pragma unroll
                for (int qt = 0; qt < 2; ++qt) { s[sub][qt] = MFMA16(k0, qf[qt][0], ((f32x4){0.f, 0.f, 0.f, 0.f})); s[sub][qt] = MFMA16(k1, qf[qt][1], s[sub][qt]); } }
#pragma unroll
            for (int qt = 0; qt < 2; ++qt) { const int i = q0 + qt * 16 + l15; float mx = -INFINITY;
#pragma unroll
                for (int sub = 0; sub < 4; ++sub)
#pragma unroll
                    for (int jj = 0; jj < 4; ++jj) { const int j = kt * 64 + sub * 16 + quad * 4 + jj; const bool valid = (j > i) && (j <= i + 128) && (nb > 0 || j >= 128);
                        const float v = valid ? s[sub][qt][jj] * sc2 : -INFINITY; s[sub][qt][jj] = v; mx = fmaxf(mx, v); }
                mx = fmaxf(mx, shx16(mx, quad & 1)); mx = fmaxf(mx, shx32(mx, quad >> 1));
                const float mn = fmaxf(m2[qt], mx), alpha = __builtin_amdgcn_exp2f(m2[qt] - mn); m2[qt] = mn; float sum = 0.f;
#pragma unroll
                for (int sub = 0; sub < 4; ++sub)
#pragma unroll
                    for (int jj = 0; jj < 4; ++jj) { const float p = __builtin_amdgcn_exp2f(s[sub][qt][jj] - mn); s[sub][qt][jj] = p; sum += p; }
                ls[qt] = ls[qt] * alpha + sum;
#pragma unroll
                for (int dt = 0; dt < 4; ++dt) o[dt][qt] *= alpha; }
#pragma unroll
            for (int s2 = 0; s2 < 2; ++s2) { bf16x8 pf[2];
#pragma unroll
                for (int qt = 0; qt < 2; ++qt) pf[qt] = pack8(s[2 * s2][qt], s[2 * s2 + 1][qt]);
#pragma unroll
                for (int dt = 0; dt < 4; ++dt) { const LAS bf16_t* vp = Vt + (dt * 16 + l15) * 264 + kt * 64 + s2 * 32 + quad * 4;
                    const s16x4 v0 = *(const LAS s16x4*)vp, v1 = *(const LAS s16x4*)(vp + 16);
                    const bf16x8 vf = __builtin_shufflevector(v0, v1, 0, 1, 2, 3, 4, 5, 6, 7);
#pragma unroll
                    for (int qt = 0; qt < 2; ++qt) o[dt][qt] = MFMA16(vf, pf[qt], o[dt][qt]); } }
        }
#pragma unroll
        for (int qt = 0; qt < 2; ++qt) { float lt = ls[qt]; lt += shx16(lt, quad & 1); lt += shx32(lt, quad >> 1); const float inv = 1.f / lt;
            bf16_t* yp = YB + (size_t)(qrow0 + qt * 16 + l15) * 512 + hq * 64 + quad * 4;
#pragma unroll
            for (int dt = 0; dt < 4; ++dt) st_bf4(yp + dt * 16, o[dt][qt] * inv); }
    }
    __syncthreads();
}

DI void attn_sample_task(LAS unsigned char* wl, int task, int l, ArgsP a, const bf16_t* Q, bf16_t* YB, int lane) {
    const int b = task >> 3, h = task & 7, g = h >> 2;
    LAS float* qs = (LAS float*)wl;
    LAS float* ps = qs + 256;
#pragma unroll
    for (int t = 0; t < 4; ++t) qs[t * 64 + lane] = bf2f(Q[(size_t)(MP + b * 4 + t) * 512 + h * 64 + lane]);
    const float* ck = a->in[2] + (size_t)(l * 128 + b) * 128 * 128 + g * 64;
    const float* cv = a->in[3] + (size_t)(l * 128 + b) * 128 * 128 + g * 64;
    const float* nk = a->out + OFF_KS + ((size_t)(l * 128 + b) * 128 + 124) * 128 + g * 64;
    const float* nv = a->out + OFF_VS + ((size_t)(l * 128 + b) * 128 + 124) * 128 + g * 64;
    const float sink = a->in[16][l * 8 + h];
    float mx[4] = {sink, sink, sink, sink};
    for (int rr = 0; rr < 3; ++rr) { const int j = rr * 64 + lane; float s[4] = {0.f, 0.f, 0.f, 0.f};
        if (j < 132) { const float* kp = j < 128 ? ck + (size_t)j * 128 : nk + (size_t)(j - 128) * 128;
#pragma unroll 4
            for (int d4 = 0; d4 < 16; ++d4) { const f32x4 k4 = *(const f32x4*)(kp + 4 * d4);
#pragma unroll
                for (int t = 0; t < 4; ++t) { const f32x4 q4 = *(const LAS f32x4*)(qs + t * 64 + 4 * d4); s[t] += k4[0] * q4[0] + k4[1] * q4[1] + k4[2] * q4[2] + k4[3] * q4[3]; } } }
#pragma unroll
        for (int t = 0; t < 4; ++t) { const bool valid = (j < 132) && (j >= t + 1) && (j <= t + 128); const float v = valid ? s[t] * 0.125f : -INFINITY;
            if (j < 136) ps[t * 136 + j] = v; mx[t] = fmaxf(mx[t], v); } }
    float den[4];
#pragma unroll
    for (int t = 0; t < 4; ++t) { mx[t] = wave_max(mx[t], lane); float sum = 0.f;
        for (int rr = 0; rr < 3; ++rr) { const int j = rr * 64 + lane; if (j < 132) { const float p = __expf(ps[t * 136 + j] - mx[t]); ps[t * 136 + j] = p; sum += p; } }
        den[t] = wave_sum(sum, lane) + __expf(sink - mx[t]); }
    float o[4] = {0.f, 0.f, 0.f, 0.f};
#pragma unroll 2
    for (int j = 0; j < 132; j += 4) {
        const float* vp = j < 128 ? cv + (size_t)j * 128 : nv + (size_t)(j - 128) * 128;
        const float v0 = vp[lane], v1 = vp[128 + lane], v2 = vp[256 + lane], v3 = vp[384 + lane];
#pragma unroll
        for (int t = 0; t < 4; ++t) { const f32x4 p4 = *(const LAS f32x4*)(ps + t * 136 + j); o[t] += p4[0] * v0 + p4[1] * v1 + p4[2] * v2 + p4[3] * v3; } }
#pragma unroll
    for (int t = 0; t < 4; ++t) YB[(size_t)(MP + b * 4 + t) * 512 + h * 64 + lane] = (bf16_t)f2bf(o[t] / den[t]);
}

struct S5C { bf16x8 bbf[4]; bf16x8 cf[4]; float are[2], aim[2]; };
DI float gelu_tanh(float y) { const float z = 1.5957691216057308f * (y + 0.044715f * y * y * y); return y * sigm(z); }
template <bool OUT>
DI void s5_tile(const S5C& K, const float* U, int row0, int g, int nruns, int nvalid, float (&hre)[2], float (&him)[2], LAS bf16_t* Hs, const float* dvec, bf16_t* YC0, int lane) {
    const int tok = lane & 31, half = lane >> 5;
    bf16x8 af = {0, 0, 0, 0, 0, 0, 0, 0};
    if (tok < nvalid) { const float* up = U + (size_t)(row0 + tok) * 512 + g * 16 + half * 8; af = pack8(*(const f32x4*)up, *(const f32x4*)(up + 4)); }
    f32x16 z16;
#pragma unroll
    for (int i = 0; i < 16; ++i) z16[i] = 0.f;
    f32x16 dre[2], dim[2];
#pragma unroll
    for (int st = 0; st < 2; ++st) { dre[st] = MFMA32(af, K.bbf[st], z16); dim[st] = MFMA32(af, K.bbf[2 + st], z16); }
#pragma unroll
    for (int r = 0; r < 8; ++r) {
        if (r < nruns) {
            const int hf = r & 1, i0 = 4 * (r >> 1); const bool sel = (half == hf);
#pragma unroll
            for (int k = 0; k < 4; ++k)
#pragma unroll
                for (int st = 0; st < 2; ++st) { const float nr = K.are[st] * hre[st] - K.aim[st] * him[st] + dre[st][i0 + k]; const float ni = K.are[st] * him[st] + K.aim[st] * hre[st] + dim[st][i0 + k];
                    hre[st] = sel ? nr : hre[st]; him[st] = sel ? ni : him[st]; dre[st][i0 + k] = sel ? nr : dre[st][i0 + k]; dim[st][i0 + k] = sel ? ni : dim[st][i0 + k]; }
#pragma unroll
            for (int st = 0; st < 2; ++st) { const float pr = shx(hre[st], 32, lane), pi = shx(him[st], 32, lane); hre[st] = sel ? hre[st] : pr; him[st] = sel ? him[st] : pi; }
        }
    }
    if (OUT) {
#pragma unroll
        for (int i = 0; i < 16; ++i) { const int tr = (i & 3) + 8 * (i >> 2) + 4 * half; LAS bf16_t* hp = Hs + tr * 136 + tok;
#pragma unroll
            for (int st = 0; st < 2; ++st) { hp[st * 32] = (bf16_t)f2bf(dre[st][i]); hp[64 + st * 32] = (bf16_t)f2bf(dim[st][i]); } }
        const int l15 = lane & 15, quad = lane >> 4;
#pragma unroll
        for (int tt = 0; tt < 2; ++tt) {
            if (tt * 16 < nvalid) {
                f32x4 acc = {0.f, 0.f, 0.f, 0.f};
#pragma unroll
                for (int ks = 0; ks < 4; ++ks) { const bf16x8 hf8 = *(const LAS bf16x8*)(Hs + (tt * 16 + l15) * 136 + ks * 32 + quad * 8); acc = MFMA16(K.cf[ks], hf8, acc); }
                const int tk = tt * 16 + l15;
                if (tk < nvalid) { const size_t ro = (size_t)(row0 + tk) * 512 + g * 16 + quad * 4;
                    const f32x4 u4 = *(const f32x4*)(U + ro), d4 = *(const f32x4*)(dvec + quad * 4); f32x4 y = acc + d4 * u4;
                    y[0] = gelu_tanh(y[0]); y[1] = gelu_tanh(y[1]); y[2] = gelu_tanh(y[2]); y[3] = gelu_tanh(y[3]);
                    st_bf4(YC0 + ro, y); }
            }
        }
    }
}
DI void s5_load_consts(S5C& K, const unsigned char* ws, int lg, int lane) {
    const bf16_t* BBF = (const bf16_t*)(ws + WS_TAB + TB_BBF); const bf16_t* CF = (const bf16_t*)(ws + WS_TAB + TB_CF); const float* AB = (const float*)(ws + WS_TAB + TB_ABAR);
#pragma unroll
    for (int t = 0; t < 4; ++t) { K.bbf[t] = *(const bf16x8*)(BBF + (((size_t)lg * 4 + t) * 64 + lane) * 8); K.cf[t] = *(const bf16x8*)(CF + (((size_t)lg * 4 + t) * 64 + lane) * 8); }
#pragma unroll
    for (int st = 0; st < 2; ++st) { const int p = st * 32 + (lane & 31); K.are[st] = AB[((size_t)lg * 64 + p) * 2]; K.aim[st] = AB[((size_t)lg * 64 + p) * 2 + 1]; }
}
DI void s5_prompt_task(LAS unsigned char* lds, int task, int l, ArgsP a, const float* U, bf16_t* YC0, int tid) {
    const int b = task >> 5, g = task & 31, lg = l * 32 + g, wave = tid >> 6, lane = tid & 63;
    LAS bf16_t* Hs = (LAS bf16_t*)(lds + wave * 8704);
    LAS float* Es = (LAS float*)(lds + 8 * 8704);
    S5C K; s5_load_consts(K, a->ws, lg, lane);
    const float* dvec = a->in[24] + l * 512 + g * 16;
    const int rowb = b * 2048 + wave * 256;
    float hre[2] = {0.f, 0.f}, him[2] = {0.f, 0.f};
    for (int tl = 0; tl < 8; ++tl) s5_tile<false>(K, U, rowb + tl * 32, g, 8, 32, hre, him, Hs, dvec, YC0, lane);
    if (lane < 32) { Es[(wave * 4 + 0) * 32 + lane] = hre[0]; Es[(wave * 4 + 1) * 32 + lane] = hre[1]; Es[(wave * 4 + 2) * 32 + lane] = him[0]; Es[(wave * 4 + 3) * 32 + lane] = him[1]; }
    __syncthreads();
    { const float* A256 = (const float*)(a->ws + WS_TAB + TB_ABAR256); float pr[2], pi[2];
#pragma unroll
      for (int st = 0; st < 2; ++st) { const int p = st * 32 + (lane & 31); pr[st] = A256[((size_t)lg * 64 + p) * 2]; pi[st] = A256[((size_t)lg * 64 + p) * 2 + 1]; hre[st] = 0.f; him[st] = 0.f; }
      for (int w = 0; w < wave; ++w) {
#pragma unroll
          for (int st = 0; st < 2; ++st) { const float er = Es[(w * 4 + st) * 32 + (lane & 31)], ei = Es[(w * 4 + 2 + st) * 32 + (lane & 31)];
              const float nr = pr[st] * hre[st] - pi[st] * him[st] + er, ni = pr[st] * him[st] + pi[st] * hre[st] + ei; hre[st] = nr; him[st] = ni; } } }
    for (int tl = 0; tl < 8; ++tl) s5_tile<true>(K, U, rowb + tl * 32, g, 8, 32, hre, him, Hs, dvec, YC0, lane);
    if (wave == 7 && lane < 32) {
#pragma unroll
        for (int st = 0; st < 2; ++st) { a->out[OFF_SRP + ((size_t)(l * 8 + b) * 32 + g) * 64 + st * 32 + lane] = hre[st]; a->out[OFF_SIP + ((size_t)(l * 8 + b) * 32 + g) * 64 + st * 32 + lane] = him[st]; } }
    __syncthreads();
}
DI void s5_sample_task(LAS unsigned char* lds, int task, int l, ArgsP a, const float* U, bf16_t* YC0, int tid) {
    const int bs = task >> 5, g = task & 31, lg = l * 32 + g, wave = tid >> 6, lane = tid & 63;
    LAS bf16_t* Hs = (LAS bf16_t*)(lds + wave * 8704);
    S5C K; s5_load_consts(K, a->ws, lg, lane);
    const size_t so = ((size_t)(l * 128 + bs) * 32 + g) * 64;
    float hre[2], him[2];
#pragma unroll
    for (int st = 0; st < 2; ++st) { hre[st] = a->in[5][so + st * 32 + (lane & 31)]; him[st] = a->in[6][so + st * 32 + (lane & 31)]; }
    s5_tile<true>(K, U, MP + bs * 4, g, 1, 4, hre, him, Hs, a->in[24] + l * 512 + g * 16, YC0, lane);
    if (lane < 32) {
#pragma unroll
        for (int st = 0; st < 2; ++st) { a->out[OFF_SRS + so + st * 32 + lane] = hre[st]; a->out[OFF_SIS + so + st * 32 + lane] = him[st]; } }
}

DI void mixers_phase(ArgsP a, LAS unsigned char* lds, int l, int tid) {
    unsigned char* ws = a->ws;
    const float* XA = (const float*)(ws + WS_XA); const float* U = (const float*)(ws + WS_U);
    const bf16_t* Q = (const bf16_t*)(ws + WS_Q); const bf16_t* KB = (const bf16_t*)(ws + WS_K); const bf16_t* VB = (const bf16_t*)(ws + WS_V);
    bf16_t* Dm = (bf16_t*)(ws + WS_DYY); bf16_t* YB = Dm + (size_t)M * 512; bf16_t* YC0 = (bf16_t*)(ws + WS_YC0);
    const int wave = tid >> 6, lane = tid & 63, gw = blockIdx.x * 8 + wave, NGW = gridDim.x * 8;
    for (int rp = 0; rp < 1 + ((MIXM >> 0) & 1); ++rp) for (int u = blockIdx.x; u < 256; u += gridDim.x) attn_prompt_unit(lds, u, Q, KB, VB, YB, a->in[16] + l * 8, tid);
    for (int rp = 0; rp < 1 + ((MIXM >> 1) & 1); ++rp) for (int t = blockIdx.x; t < 256; t += gridDim.x) s5_prompt_task(lds, t, l, a, U, YC0, tid);
    for (int rp = 0; rp < 1 + ((MIXM >> 2) & 1); ++rp) for (int t = gw; t < 4096; t += NGW) s5_sample_task(lds, t, l, a, U, YC0, tid);
    __syncthreads();
    for (int rp = 0; rp < 1 + ((MIXM >> 3) & 1); ++rp) for (int t = gw; t < 1024; t += NGW) attn_sample_task(lds + wave * 4096, t, l, a, Q, YB, lane);
    for (int rp = 0; rp < 1 + ((MIXM >> 4) & 1); ++rp) pool_phase(a, l, XA, Dm, tid);
}

DI void attn_sample_phase(ArgsP a, LAS unsigned char* lds, int l, int c, int G, int tid) {
    const int wave = tid >> 6, lane = tid & 63; const int first = G > 132 ? 132 : 0, nb = G - first;
    if (c < first) return;
    const bf16_t* Q = (const bf16_t*)(a->ws + WS_Q); bf16_t* YB = (bf16_t*)(a->ws + WS_DYY) + (size_t)M * 512;
    for (int t = (c - first) * 8 + wave; t < 1024; t += nb * 8) attn_sample_task(lds + wave * 4096, t, l, a, Q, YB, lane);
}

DI void fused_norm(int ph, int wave_s, LAS unsigned char* lds) {
    ArgsP a = (ArgsP)__builtin_amdgcn_kernarg_segment_ptr(); asm volatile("" : "+s"(a));
    int G = gridDim.x, c = blockIdx.x; asm volatile("" : "+s"(G), "+s"(c));
    unsigned char* ws = a->ws; float* X = a->out; float* MOD = (float*)(ws + WS_MOD); bf16_t* H = (bf16_t*)(ws + WS_H);
    const int l = (ph - 2) / 9, k = (ph - 2) % 9;
    unsigned* cnt = (unsigned*)(ws + 16384) + ph * 66; volatile LAS unsigned* flagw = (volatile LAS unsigned*)(lds + 135168 + 64); pg8::Unit u;
    if (k == 5) {
        const float* xs = l == 0 ? a->in[1] - (size_t)MP * 1024 : X;
#define NA2 X, xs, a->in[10] + l * 1024, MOD + l * 6144 + 3072, 1024, H, (const float*)(ws + WS_YC0), 8, MOD + l * 6144 + 2048, X
        { pg8::StaticOrder S; S.init(MP, 1024, G, c); for (int i = 0; S.next(i, u); ++i) if (panel_done(cnt + u.pm, 4u, flagw, (wave_s * 64 + lane_id_v()))) norm_panel(NA2, u.pm, (wave_s * 64 + lane_id_v())); }
        { pg8::SplitOrder S{G, c, 8, 1}; for (int i = 0; S.next(i, u); ++i) if (panel_done(cnt + u.pm, 32u, flagw, (wave_s * 64 + lane_id_v()))) norm_panel(NA2, u.pm, (wave_s * 64 + lane_id_v())); }
    } else {
        const bool fin = (l == DEPTH - 1); const int ln = fin ? 0 : l + 1;
#define NA1 X, X, fin ? a->in[32] : a->in[9] + ln * 1024, MOD + ln * 6144, 1024, fin ? (bf16_t*)nullptr : H, (const float*)(ws + WS_DYY), 22, MOD + l * 6144 + 5120, X
        { pg8::StaticOrder S; S.init(MP, 1024, G, c); for (int i = 0; S.next(i, u); ++i) if (panel_done(cnt + u.pm, 4u, flagw, (wave_s * 64 + lane_id_v()))) norm_panel(NA1, u.pm, (wave_s * 64 + lane_id_v())); }
        { pg8::SplitOrder S{G, c, 22, 1}; for (int i = 0; S.next(i, u); ++i) if (panel_done(cnt + u.pm, 88u, flagw, (wave_s * 64 + lane_id_v()))) norm_panel(NA1, u.pm, (wave_s * 64 + lane_id_v())); }
    }
}

__global__ void __launch_bounds__(512, 2) mega(Args a_unused) {
    extern __shared__ __attribute__((aligned(16))) unsigned char lds_raw[];
    LAS unsigned char* lds = (LAS unsigned char*)lds_raw;
    cg::grid_group grid = cg::this_grid();
    const int wave_s = __builtin_amdgcn_readfirstlane((int)threadIdx.x >> 6);
    volatile LAS unsigned* bst = (volatile LAS unsigned*)(lds + 135168);
    if (threadIdx.x < 2) bst[threadIdx.x] = 0u;
    __syncthreads();
    XcdBarrier xbar = xcd_barrier_post((unsigned*)(((ArgsP)__builtin_amdgcn_kernarg_segment_ptr())->ws), bst);
    const int ph_lo = ((ArgsP)__builtin_amdgcn_kernarg_segment_ptr())->ph_lo, ph_hi = ((ArgsP)__builtin_amdgcn_kernarg_segment_ptr())->ph_hi;
    for (int ph = ph_lo; ph < ph_hi; ++ph) {
        const int kk9 = (ph - 2) % 9;
        const int cls = ph == 0 ? 0 : ph == 1 ? 1 : ph == NPHASE - 1 ? 10 : (kk9 == 0 || kk9 == 6) ? 2 : kk9 == 1 ? 3 : kk9 == 2 ? 4 : kk9 == 3 ? 5 : kk9 == 4 ? 6 : kk9 == 5 ? 7 : kk9 == 7 ? 8 : 9;
        const int nrep = 1 + ((REPM >> cls) & 1);
        if (FUSE && ((ph >= 2 && ph < NPHASE - 1 && (kk9 == 6 || (kk9 == 0 && ph > 2))) || ph == NPHASE - 1)) continue;
        for (int rep = 0; rep < nrep; ++rep) {
        ArgsP a = (ArgsP)__builtin_amdgcn_kernarg_segment_ptr(); asm volatile("" : "+s"(a));
        int G = gridDim.x, c = blockIdx.x; asm volatile("" : "+s"(G), "+s"(c));
        unsigned char* ws = a->ws;
        float* X = a->out;
        float* MOD = (float*)(ws + WS_MOD);
        bf16_t* H = (bf16_t*)(ws + WS_H);
        if (ph == 0) { if (PHM & 1) prologue(a, lds, (wave_s * 64 + lane_id_v())); }
        else if (ph == 1) { if (PHM & 4) {
            pg8::Gemm g{(const bf16_t*)(ws + WS_CA), (const bf16_t*)(ws + WS_GT), 256, NMOD, 1024}; pg8::StaticOrder S; S.init(256, NMOD, G, c);
            pg8::EpiMod E{MOD, a->in[12]};
            pg8::gemm_phase<pg8::EpiMod, pg8::StaticOrder, true, true>(lds, g, S, E, wave_s * 64 + lane_id_v()); }
        } else if (ph == NPHASE - 1) { if (!FUSE) norm_phase(X, X, a->in[32], MOD, 0, nullptr, (const float*)(ws + WS_DYY), 22, MOD + 3 * 6144 + 5120, X, (wave_s * 64 + lane_id_v())); }
        else {
            const int l = (ph - 2) / 9, k = (ph - 2) % 9;
            const float* xp = l == 0 ? a->in[0] : X; const float* xs = l == 0 ? a->in[1] - (size_t)MP * 1024 : X;
            if (k == 0) { if (l == 0 || !FUSE) { norm_phase(xp, xs, a->in[9] + l * 1024, MOD + l * 6144, 1024, H, (const float*)(ws + WS_DYY), l == 0 ? 0 : 22, MOD + (l > 0 ? l - 1 : 0) * 6144 + 5120, X, (wave_s * 64 + lane_id_v())); } }
            else if (k == 1) { if (GM & 1) {
                pg8::Gemm g{H, (const bf16_t*)(ws + WS_WIN) + (size_t)l * IN_COLS * 1024, M, IN_COLS, 1024}; pg8::StaticOrder S; S.init(M, IN_COLS, G, c);
                pg8::EpiIn E{(float*)(ws + WS_XA), (float*)(ws + WS_U), (bf16_t*)(ws + WS_Q), (bf16_t*)(ws + WS_K), (bf16_t*)(ws + WS_V), (bf16_t*)(ws + WS_GT),
                             (const float*)(ws + WS_TAB + TB_ROPEC), (const float*)(ws + WS_TAB + TB_ROPES), a->out, l};
                pg8::gemm_phase<pg8::EpiIn, pg8::StaticOrder, true, true>(lds, g, S, E, wave_s * 64 + lane_id_v()); }
            } else if (k == 2) { if (PHM & 2) mixers_phase(a, lds, l, (wave_s * 64 + lane_id_v())); }
            else if (k == 3) { if (GM & 2) {
                pg8::Gemm g{(const bf16_t*)(ws + WS_YC0), (const bf16_t*)(ws + WS_WGLU) + (size_t)l * 512 * 512, M, 512, 512}; pg8::StaticOrder S; S.init(M, 512, G, c);
                pg8::EpiGlu E{(const bf16_t*)(ws + WS_YC0), (bf16_t*)(ws + WS_DYY) + (size_t)2 * M * 512};
                pg8::gemm_phase<pg8::EpiGlu, pg8::StaticOrder, true, true>(lds, g, S, E, wave_s * 64 + lane_id_v()); }
            } else if (k == 4) { if (GM & 4) {
                { pg8::Gemm g{(const bf16_t*)(ws + WS_DYY), (const bf16_t*)(ws + WS_WBR) + (size_t)l * 3072 * 512, 3 * M, 3072, 512, 0, 0}; pg8::BranchOrder S{G, c};
                  pg8::EpiMerge E{(const bf16_t*)(ws + WS_GT), (float*)(ws + WS_XA), H};
                  pg8::gemm_phase<pg8::EpiMerge, pg8::BranchOrder, true, true>(lds, g, S, E, wave_s * 64 + lane_id_v()); }
                { pg8::Gemm g{(const bf16_t*)(ws + WS_DYY), (const bf16_t*)(ws + WS_WBR) + (size_t)l * 3072 * 512, 3 * M, 3072, 128, 512, 512}; pg8::SplitOrder S{G, c, 4, 3};
                  pg8::EpiPart E{(float*)(ws + WS_Q), (const bf16_t*)(ws + WS_GT), 4};
                  pg8::gemm_phase<pg8::EpiPart, pg8::SplitOrder, true, true>(lds, g, S, E, wave_s * 64 + lane_id_v()); } }
            } else if (k == 5) { if (GM & 8) {
                { pg8::Gemm g{H, (const bf16_t*)(ws + WS_WOUT) + (size_t)l * 1024 * 1024, MP, 1024, 1024, 0, 0}; pg8::StaticOrder S; S.init(MP, 1024, G, c);
                  pg8::EpiRes E{xp, rep ? (float*)(ws + WS_XA) : X, MOD + l * 6144 + 2048};
                  pg8::gemm_phase<pg8::EpiRes, pg8::StaticOrder, true, true>(lds, g, S, E, wave_s * 64 + lane_id_v()); }
                for (int j = c; j < 64; j += G) { const int ks = j & 7, pmr = j >> 5; const float* Pm = (const float*)(ws + WS_Q);
                    for (int e2 = wave_s * 64 + lane_id_v(); e2 < 256 * 32; e2 += 512) { const int rs = pmr * 256 + (e2 >> 5), c4 = ks * 128 + (e2 & 31) * 4; f32x4 s = {0.f, 0.f, 0.f, 0.f};
#pragma unroll
                        for (int p = 0; p < 12; ++p) s += *(const f32x4*)(Pm + ((size_t)p * 512 + rs) * 1024 + c4);
                        st_bf4(H + (size_t)(MP + rs) * 1024 + c4, s); } }
                asm volatile("s_waitcnt vmcnt(0)" ::: "memory"); __syncthreads();
                { pg8::Gemm g{H, (const bf16_t*)(ws + WS_WOUT) + (size_t)l * 1024 * 1024, M, 1024, 128, 1024, 1024}; pg8::SplitOrder S{G, c, 8, 1};
                  pg8::EpiPart E{(float*)(ws + WS_YC0), nullptr, 8};
                  pg8::gemm_phase<pg8::EpiPart, pg8::SplitOrder, true, true>(lds, g, S, E, wave_s * 64 + lane_id_v()); }
                if (FUSE) fused_norm(ph, wave_s, lds); }
            } else if (k == 6) { if (!FUSE) norm_phase(X, xs, a->in[10] + l * 1024, MOD + l * 6144 + 3072, 1024, H, (const float*)(ws + WS_YC0), 8, MOD + l * 6144 + 2048, X, (wave_s * 64 + lane_id_v())); }
            else if (k == 7) { if (GM & 16) {
                pg8::Gemm g{H, (const bf16_t*)(ws + WS_WFI) + (size_t)l * 2 * DFF * 1024, M, 2 * DFF, 1024}; pg8::StaticOrder S; S.init(M, 2 * DFF, G, c);
                pg8::EpiFfn E{(bf16_t*)(ws + WS_GT)};
                pg8::gemm_phase<pg8::EpiFfn, pg8::StaticOrder, true, true>(lds, g, S, E, wave_s * 64 + lane_id_v()); }
            } else if (GM & 32) {
                { pg8::Gemm g{(const bf16_t*)(ws + WS_GT), (const bf16_t*)(ws + WS_WFO) + (size_t)l * 1024 * DFF, MP, 1024, DFF, 0, 0}; pg8::StaticOrder S; S.init(MP, 1024, G, c);
                  pg8::EpiRes E{X, rep ? (float*)(ws + WS_XA) : X, MOD + l * 6144 + 5120};
                  pg8::gemm_phase<pg8::EpiRes, pg8::StaticOrder, true, true>(lds, g, S, E, wave_s * 64 + lane_id_v()); }
                { pg8::Gemm g{(const bf16_t*)(ws + WS_GT), (const bf16_t*)(ws + WS_WFO) + (size_t)l * 1024 * DFF, M, 1024, 128, DFF, DFF}; pg8::SplitOrder S{G, c, 22, 1};
                  pg8::EpiPart E{(float*)(ws + WS_DYY), nullptr, 22};
                  pg8::gemm_phase<pg8::EpiPart, pg8::SplitOrder, true, true>(lds, g, S, E, wave_s * 64 + lane_id_v()); }
                if (FUSE) fused_norm(ph, wave_s, lds);
            }
        }
        if (REPM && rep + 1 < nrep) __syncthreads();
        }
        if (ph + 1 < ph_hi && !(FUSE && ph == NPHASE - 2)) { if (SYNC2 == 1 || ph_hi > 1000) grid.sync(); else { XcdBarrier xb = xbar; asm volatile("" : "+s"(xb.x), "+s"(xb.bar));
            xcd_barrier(xb); if (SYNC2 == 2) xcd_barrier(xb); } }
    }
}

extern "C" void kernel_launch(void* const* d_in, const int* in_sizes, int n_in, void* d_out, int out_size, void* d_ws, size_t ws_size, hipStream_t stream) {
    static int grid = 0;
    if (grid == 0) {
        if (n_in != 33 || (size_t)out_size != OUT_TOTAL || ws_size < WS_END) { fprintf(stderr, "kernel_launch: unexpected shapes: n_in %d out %d ws %zu (need %zu)\n", n_in, out_size, ws_size, (size_t)WS_END); grid = -1; return; }
        int dev = 0, cus = 0, per_cu = 0;
        (void)hipGetDevice(&dev); (void)hipDeviceGetAttribute(&cus, hipDeviceAttributeMultiprocessorCount, dev);
        if (hipFuncSetAttribute((const void*)mega, hipFuncAttributeMaxDynamicSharedMemorySize, LDS_BYTES) != hipSuccess) { fprintf(stderr, "kernel_launch: hipFuncSetAttribute failed\n"); grid = -1; return; }
        if (hipOccupancyMaxActiveBlocksPerMultiprocessor(&per_cu, (const void*)mega, 512, LDS_BYTES) != hipSuccess || per_cu < 1) { fprintf(stderr, "kernel_launch: occupancy query says %d\n", per_cu); per_cu = 1; }
        (void)hipGetLastError();
        grid = cus * 1;
        if (grid <= 0) grid = 256;
    }
    if (grid < 0) return;
    Args a{};
    for (int i = 0; i < 33; ++i) a.in[i] = (const float*)d_in[i];
    a.out = (float*)d_out; a.ws = (unsigned char*)d_ws;
    for (int j = 0; j < 8; ++j) a.rfix[j] = (unsigned long long)ldexpl(powl(500000.0L, -(long double)j / 8.0L) / (2.0L * 3.14159265358979323846264338327950288L), 64);
#if MK_MULTI
    for (int ph = 0; ph < NPHASE; ++ph) { a.ph_lo = ph; a.ph_hi = ph + 1; hipLaunchKernelGGL(mega, dim3(grid), dim3(512), LDS_BYTES, stream, a); }
#else
    a.ph_lo = 0; a.ph_hi = NPHASE;
    if (hipMemsetAsync(d_ws, 0, 65536, stream) != hipSuccess) { fprintf(stderr, "kernel_launch: memset failed\n"); return; }
    void* args[] = {&a};
    hipError_t e = hipLaunchCooperativeKernel((const void*)mega, dim3(grid), dim3(512), args, LDS_BYTES, stream);
    if (e != hipSuccess) fprintf(stderr, "kernel_launch: cooperative launch failed: %s (grid %d)\n", hipGetErrorString(e), grid);
#endif
}
```

```cpp
#include <hip/hip_runtime.h>
#include <hip/hip_cooperative_groups.h>
#include <cstdio>
#include <cstdint>
#include <cmath>
namespace cg = cooperative_groups;

#ifndef MK_MULTI
#define MK_MULTI 0
#endif

__device__ __forceinline__ int lane_id_v() { int l; asm volatile("v_mbcnt_lo_u32_b32 %0, -1, 0\n\tv_mbcnt_hi_u32_b32 %0, -1, %0" : "=v"(l)); return l; }
__device__ __forceinline__ float shx(float v, int mask, int lane) { return __builtin_bit_cast(float, __builtin_amdgcn_ds_bpermute((lane ^ mask) << 2, __builtin_bit_cast(int, v))); }

__device__ __forceinline__ float shx32(float v, int upper  ) { const unsigned x = __builtin_bit_cast(unsigned, v); auto r = __builtin_amdgcn_permlane32_swap(x, x, false, false); return __builtin_bit_cast(float, upper ? r[0] : r[1]); }
__device__ __forceinline__ float shx16(float v, int odd  ) { const unsigned x = __builtin_bit_cast(unsigned, v); auto r = __builtin_amdgcn_permlane16_swap(x, x, false, false); return __builtin_bit_cast(float, odd ? r[0] : r[1]); }

namespace cfg {
constexpr int D = 1024, MP = 16384, MS = 512, M = MP + MS, SEQ = 2048, NBAT = 136, DEPTH = 4;
constexpr int IN_COLS = 4864, DFF = 2816, NMOD = 6 * D * DEPTH;
constexpr size_t OFF_Y = 0;
constexpr size_t OFF_KP = (size_t)M * D;
constexpr size_t OFF_VP = OFF_KP + (size_t)4 * 8 * 128 * 128;
constexpr size_t OFF_PP = OFF_VP + (size_t)4 * 8 * 128 * 128;
constexpr size_t OFF_SRP = OFF_PP + (size_t)4 * 8 * 15 * 512;
constexpr size_t OFF_SIP = OFF_SRP + (size_t)4 * 8 * 32 * 64;
constexpr size_t OFF_KS = OFF_SIP + (size_t)4 * 8 * 32 * 64;
constexpr size_t OFF_VS = OFF_KS + (size_t)4 * 128 * 128 * 128;
constexpr size_t OFF_PS = OFF_VS + (size_t)4 * 128 * 128 * 128;
constexpr size_t OFF_SRS = OFF_PS + (size_t)4 * 128 * 15 * 512;
constexpr size_t OFF_SIS = OFF_SRS + (size_t)4 * 128 * 32 * 64;
constexpr size_t OUT_TOTAL = OFF_SIS + (size_t)4 * 128 * 32 * 64;
static_assert(OUT_TOTAL == 41533440, "output size");
constexpr size_t MiB = 1u << 20;
constexpr size_t WS_WIN = 1 * MiB;
constexpr size_t WS_WGLU = WS_WIN + 38 * MiB;
constexpr size_t WS_WBR = WS_WGLU + 2 * MiB;
constexpr size_t WS_WOUT = WS_WBR + 12 * MiB;
constexpr size_t WS_WFI = WS_WOUT + 8 * MiB;
constexpr size_t WS_WFO = WS_WFI + 44 * MiB;
constexpr size_t WS_MOD = WS_WFO + 22 * MiB;
constexpr size_t WS_CA = WS_MOD + 13 * MiB;
constexpr size_t WS_TAB = WS_CA + 1 * MiB;
constexpr size_t WS_H = WS_TAB + 2 * MiB;
constexpr size_t WS_XA = WS_H + 33 * MiB;
constexpr size_t WS_U = WS_XA + 33 * MiB;
constexpr size_t WS_Q = WS_U + 33 * MiB;
constexpr size_t WS_K = WS_Q + 17 * MiB;
constexpr size_t WS_V = WS_K + 5 * MiB;
constexpr size_t WS_DYY = WS_V + 5 * MiB;
constexpr size_t WS_YC0 = WS_DYY + 50 * MiB;
constexpr size_t WS_GT = WS_YC0 + 17 * MiB;
constexpr size_t WS_END = WS_GT + 99 * MiB;
static_assert((size_t)M * 512 * 2 * 3 <= 50 * MiB && (size_t)M * 3072 * 2 <= 99 * MiB && (size_t)M * 1024 * 2 <= 33 * MiB, "ws map");
constexpr size_t TB_ROPEC = 0;
constexpr size_t TB_ROPES = 65664;
constexpr size_t TB_ABAR = 131328;
constexpr size_t TB_ABAR256 = TB_ABAR + 65536;
constexpr size_t TB_BBF = 262400;
constexpr size_t TB_CF = TB_BBF + 524288;
static_assert(TB_CF + 524288 <= 2 * MiB, "tables");
constexpr int LDS_BYTES = 147456;
constexpr int NPHASE = 2 + 9 * DEPTH + 1;
}

namespace pg8 {
#define PG8_LAS __attribute__((address_space(3)))
typedef unsigned short bf16_t;
typedef short bf16x8 __attribute__((ext_vector_type(8)));
typedef float f32x4 __attribute__((ext_vector_type(4)));
typedef unsigned u32x4 __attribute__((ext_vector_type(4)));
constexpr int BM = 256, BK = 64, HALF = 128, HTB = HALF * BK * 2  , STAGE_BYTES = 8 * HTB, NXCD = 8, WGM = 8;

__host__ __device__ __forceinline__ int lds_byte(int r, int c) { const int st = (r >> 4) * 2 + (c >> 5), rr = r & 15, cc = c & 31, ob = rr * 64 + cc * 2; return st * 1024 + (ob ^ (((ob >> 9) & 1) << 5)); }
__host__ __device__ __forceinline__ void stage_rc(int b, int& R, int& C) { const int st = b / 1024, sb = b % 1024, swz = sb ^ (((sb >> 9) & 1) << 5); R = (st >> 1) * 16 + swz / 64; C = (st & 1) * 32 + (swz % 64) / 2; }
__host__ __device__ __forceinline__ int perm32(int rho) { const int n = rho >> 4, i = rho & 15; return 8 * (i >> 2) + 4 * n + (i & 3); }

struct Unit { int pm, pn, k0; };
struct Gemm { const bf16_t* A; const bf16_t* Bt; int M, N, K, lda, ldb; };

struct StaticOrder {
    int nM, nN, nwg, G, c;
    __host__ __device__ void init(int M, int N, int G_, int c_) { nM = M / BM; nN = N / BM; nwg = nM * nN; G = G_; c = c_; }
    __host__ __device__ bool next(int i, Unit& u) const {
        const long L = (long)i * G + c; if (L >= nwg) return false;
        int wgid = (int)L; { const int q = nwg / NXCD, r = nwg % NXCD, xcd = wgid % NXCD, off = wgid / NXCD; wgid = (xcd < r ? xcd * (q + 1) : r * (q + 1) + (xcd - r) * q) + off; }
        const int nig = WGM * nN, gid = wgid / nig, fm = gid * WGM, gsz = (nM - fm) < WGM ? (nM - fm) : WGM;
        u.pm = fm + ((wgid % nig) % gsz); u.pn = (wgid % nig) / gsz; u.k0 = 0; return true;
    }
    __device__ __forceinline__ void a_ready(const Unit&) const {}
    __device__ __forceinline__ void done(const Unit&) const {}
};

__device__ __forceinline__ unsigned cvt_pk_bf16(float lo, float hi) { unsigned r; asm volatile("v_cvt_pk_bf16_f32 %0, %1, %2" : "=v"(r) : "v"(lo), "v"(hi)); return r; }
typedef unsigned u32x2 __attribute__((ext_vector_type(2)));
__device__ __forceinline__ float sigm(float x) { return __builtin_amdgcn_rcpf(1.f + __expf(-x)); }
__device__ __forceinline__ f32x4 ld_bf4(const bf16_t* p) { const u32x2 w = *(const u32x2*)p; f32x4 r; r[0] = __uint_as_float(w.x << 16); r[1] = __uint_as_float(w.x & 0xffff0000u); r[2] = __uint_as_float(w.y << 16); r[3] = __uint_as_float(w.y & 0xffff0000u); return r; }
__device__ __forceinline__ void st_bf4(bf16_t* p, const f32x4 v) { u32x2 w; w.x = cvt_pk_bf16(v[0], v[1]); w.y = cvt_pk_bf16(v[2], v[3]); *(u32x2*)p = w; }
__device__ __forceinline__ int batch_of(int row) { return row < cfg::MP ? (row >> 11) : 8 + ((row - cfg::MP) >> 2); }

struct EpiMod {
    static constexpr bool PERM = true, AFTER_DRAIN = false;
    float* MOD; const float* bada;
    __device__ __forceinline__ void operator()(const f32x4 (&acc)[2][2][4][2], const Unit& u, int wr, int wc, int fr, int fq) const {
#pragma unroll
        for (int ai = 0; ai < 2; ++ai)
#pragma unroll
            for (int m = 0; m < 4; ++m) { const int row = u.pm * 256 + ai * 128 + wr * 64 + m * 16 + fr;
                if (row < cfg::NBAT) {
#pragma unroll
                    for (int bj = 0; bj < 2; ++bj)
#pragma unroll
                        for (int n = 0; n < 2; ++n) { const int col = u.pn * 256 + bj * 128 + wc * 32 + 8 * fq + 4 * n;
                            *(f32x4*)(MOD + (size_t)row * cfg::NMOD + col) = acc[ai][bj][m][n] + *(const f32x4*)(bada + col); } } }
    }
};

struct EpiIn {
    static constexpr bool PERM = true, AFTER_DRAIN = false;
    float* XA; float* U; bf16_t* Q; bf16_t* KB; bf16_t* VB; bf16_t* GT; const float* ropec; const float* ropes; float* out; int layer;
    __device__ __forceinline__ void operator()(const f32x4 (&acc)[2][2][4][2], const Unit& u, int wr, int wc, int fr, int fq) const {
        const int pn = u.pn;
#pragma unroll
        for (int ai = 0; ai < 2; ++ai)
#pragma unroll
            for (int m = 0; m < 4; ++m) { const int row = u.pm * 256 + ai * 128 + wr * 64 + m * 16 + fr;
#pragma unroll
                for (int bj = 0; bj < 2; ++bj)
#pragma unroll
                    for (int n = 0; n < 2; ++n) { const int tc = bj * 128 + wc * 32 + 8 * fq + 4 * n; f32x4 v = acc[ai][bj][m][n];
                        if (pn < 2) { *(f32x4*)(XA + (size_t)row * 512 + pn * 256 + tc) = v; }
                        else if (pn <= 4) {
                            const bool isv = (pn == 4 && bj == 1);
                            if (!isv && (wc & 1) == 0) {
                                const int tix = row < cfg::MP ? (row & 2047) : 2048 + (row & 3);
                                const f32x4 cs = *(const f32x4*)(ropec + tix * 8 + 4 * n), sn = *(const f32x4*)(ropes + tix * 8 + 4 * n);
#pragma unroll
                                for (int i = 0; i < 4; ++i) { const float p = shx16(v[i], fq & 1); const float rv = v[i] * cs[i] + (fq == 0 ? -p : p) * sn[i]; v[i] = fq < 2 ? rv : v[i]; }
                            }
                            if (pn < 4) st_bf4(Q + (size_t)row * 512 + (pn - 2) * 256 + tc, v);
                            else { st_bf4((bj == 0 ? KB : VB) + (size_t)row * 128 + (tc & 127), v);
                                bool w = false; size_t o = 0;
                                if (row < cfg::MP) { const int t = row & 2047; if (t >= 1920) { w = true; o = (bj == 0 ? cfg::OFF_KP : cfg::OFF_VP) + ((size_t)(layer * 8 + (row >> 11)) * 128 + (t - 1920)) * 128 + (tc & 127); } }
                                else { const int rs = row - cfg::MP; w = true; o = (bj == 0 ? cfg::OFF_KS : cfg::OFF_VS) + ((size_t)(layer * 128 + (rs >> 2)) * 128 + 124 + (rs & 3)) * 128 + (tc & 127); }
                                if (w) *(f32x4*)(out + o) = v; }
                        }
                        else if (pn < 7) { *(f32x4*)(U + (size_t)row * 512 + (pn - 5) * 256 + tc) = v; }
                        else { f32x4 s; s[0] = sigm(v[0]); s[1] = sigm(v[1]); s[2] = sigm(v[2]); s[3] = sigm(v[3]); st_bf4(GT + (size_t)row * 3072 + (pn - 7) * 256 + tc, s); }
                    } }
    }
};

struct EpiGlu {
    static constexpr bool PERM = true, AFTER_DRAIN = false;
    const bf16_t* YC0; bf16_t* YC;
    __device__ __forceinline__ void operator()(const f32x4 (&acc)[2][2][4][2], const Unit& u, int wr, int wc, int fr, int fq) const {
#pragma unroll
        for (int ai = 0; ai < 2; ++ai)
#pragma unroll
            for (int m = 0; m < 4; ++m) { const int row = u.pm * 256 + ai * 128 + wr * 64 + m * 16 + fr;
#pragma unroll
                for (int bj = 0; bj < 2; ++bj)
#pragma unroll
                    for (int n = 0; n < 2; ++n) { const int col = u.pn * 256 + bj * 128 + wc * 32 + 8 * fq + 4 * n; const f32x4 v = acc[ai][bj][m][n];
                        const f32x4 y0 = ld_bf4(YC0 + (size_t)row * 512 + col); f32x4 o;
#pragma unroll
                        for (int i = 0; i < 4; ++i) o[i] = y0[i] * sigm(v[i]);
                        st_bf4(YC + (size_t)row * 512 + col, o); } }
    }
};

struct EpiMerge {
    static constexpr bool PERM = true, AFTER_DRAIN = false;
    const bf16_t* GT; float* M32; bf16_t* M16;
    __device__ __forceinline__ void operator()(const f32x4 (&acc)[2][2][4][2], const Unit& u, int wr, int wc, int fr, int fq) const {
        const int br = u.pm / 66, pm = u.pm - br * 66, pn = u.pn & 3;
        if (br > 0) asm volatile("s_waitcnt vmcnt(0)" ::: "memory");
#pragma unroll
        for (int ai = 0; ai < 2; ++ai)
#pragma unroll
            for (int m = 0; m < 4; ++m) { const int row = pm * 256 + ai * 128 + wr * 64 + m * 16 + fr;
#pragma unroll
                for (int bj = 0; bj < 2; ++bj)
#pragma unroll
                    for (int n = 0; n < 2; ++n) { const int col = pn * 256 + bj * 128 + wc * 32 + 8 * fq + 4 * n; const f32x4 v = acc[ai][bj][m][n];
                        const f32x4 g = ld_bf4(GT + (size_t)row * 3072 + br * 1024 + col);
                        bf16_t* mp = M16 + (size_t)row * 1024 + col;
                        if (br == 0) st_bf4(mp, g * v); else st_bf4(mp, ld_bf4(mp) + g * v); } }
    }
};

struct EpiRes {
    static constexpr bool PERM = true, AFTER_DRAIN = false;
    const float* xin; float* X; const float* MODG;
    __device__ __forceinline__ void operator()(const f32x4 (&acc)[2][2][4][2], const Unit& u, int wr, int wc, int fr, int fq) const {
        const float* gp = MODG + (size_t)(u.pm >> 3) * cfg::NMOD + u.pn * 256 + wc * 32 + 8 * fq;
        f32x4 g[2][2];
#pragma unroll
        for (int bj = 0; bj < 2; ++bj)
#pragma unroll
            for (int n = 0; n < 2; ++n) g[bj][n] = *(const f32x4*)(gp + bj * 128 + n * 4);
#pragma unroll
        for (int ai = 0; ai < 2; ++ai)
#pragma unroll
            for (int m = 0; m < 4; ++m) { const int row = u.pm * 256 + ai * 128 + wr * 64 + m * 16 + fr;
#pragma unroll
                for (int bj = 0; bj < 2; ++bj)
#pragma unroll
                    for (int n = 0; n < 2; ++n) { const size_t o = (size_t)row * 1024 + u.pn * 256 + bj * 128 + wc * 32 + 8 * fq + 4 * n;
                        *(f32x4*)(X + o) = *(const f32x4*)(xin + o) + g[bj][n] * acc[ai][bj][m][n]; } }
    }
};

struct EpiPart {
    static constexpr bool PERM = true, AFTER_DRAIN = false;
    float* P; const bf16_t* GT; int nks;
    __device__ __forceinline__ void operator()(const f32x4 (&acc)[2][2][4][2], const Unit& u, int wr, int wc, int fr, int fq) const {
        const int br = u.pm / 66, pmr = u.pm - br * 66 - 64, pn = u.pn & 3, slice = br * nks + (u.k0 >> 7);
#pragma unroll
        for (int ai = 0; ai < 2; ++ai)
#pragma unroll
            for (int m = 0; m < 4; ++m) { const int rs = pmr * 256 + ai * 128 + wr * 64 + m * 16 + fr;
#pragma unroll
                for (int bj = 0; bj < 2; ++bj)
#pragma unroll
                    for (int n = 0; n < 2; ++n) { const int col = pn * 256 + bj * 128 + wc * 32 + 8 * fq + 4 * n; f32x4 v = acc[ai][bj][m][n];
                        if (GT) v = v * ld_bf4(GT + (size_t)(cfg::MP + rs) * 3072 + br * 1024 + col);
                        *(f32x4*)(P + ((size_t)slice * 512 + rs) * 1024 + col) = v; } }
    }
};

struct EpiFfn {
    static constexpr bool PERM = true, AFTER_DRAIN = false;
    bf16_t* ACT;
    __device__ __forceinline__ void operator()(const f32x4 (&acc)[2][2][4][2], const Unit& u, int wr, int wc, int fr, int fq) const {
#pragma unroll
        for (int ai = 0; ai < 2; ++ai)
#pragma unroll
            for (int m = 0; m < 4; ++m) { const int row = u.pm * 256 + ai * 128 + wr * 64 + m * 16 + fr;
#pragma unroll
                for (int n = 0; n < 2; ++n) { const int col = u.pn * 128 + wc * 32 + 8 * fq + 4 * n; const f32x4 a = acc[ai][0][m][n], b = acc[ai][1][m][n]; f32x4 o;
#pragma unroll
                    for (int i = 0; i < 4; ++i) o[i] = a[i] * sigm(a[i]) * b[i];
                    st_bf4(ACT + (size_t)row * cfg::DFF + col, o); } }
    }
};

struct BranchOrder {
    int G, c;
    __host__ __device__ bool next(int i, Unit& u) const { const int tile = c + (i / 3) * G; if (tile >= 256) return false; const int br = i % 3; u.pm = br * 66 + (tile >> 2); u.pn = br * 4 + (tile & 3); u.k0 = 0; return true; }
    __device__ __forceinline__ void a_ready(const Unit&) const {}
    __device__ __forceinline__ void done(const Unit&) const {}
};
struct SplitOrder {
    int G, c, nks, nbr;
    __host__ __device__ bool next(int i, Unit& u) const { const int j = c + i * G; if (j >= 8 * nbr * nks) return false; const int ks = j % nks, t = j / nks, br = t % nbr, tile = t / nbr;
        u.pm = br * 66 + 64 + (tile >> 2); u.pn = br * 4 + (tile & 3); u.k0 = ks * 128; return true; }
    __device__ __forceinline__ void a_ready(const Unit&) const {}
    __device__ __forceinline__ void done(const Unit&) const {}
};

template <class Epi, class Sched, bool ALIGN_EPI = false, bool SP2 = false>
__device__ __forceinline__ void gemm_phase(PG8_LAS unsigned char* lds, const Gemm g, const Sched& S, const Epi& E, const int tid_in) {
    int tid_l = tid_in; asm volatile("" : "+v"(tid_l));
    const int tid = tid_l, wid = __builtin_amdgcn_readfirstlane(tid >> 6), lane = tid & 63, wr = wid >> 2, wc = wid & 3, fr = lane & 15, fq = lane >> 4;
    const int K = g.K, nt = K / BK, lda = g.lda ? g.lda : K, ldb = lda;
    unsigned voffA[2], voffB[2];
#pragma unroll
    for (int i = 0; i < 2; ++i) { int R, C; stage_rc(tid * 16 + i * 8192, R, C); const int Rb = Epi::PERM ? ((R & ~31) + perm32(R & 31)) : R;
        voffA[i] = (unsigned)(R * lda + C) * 2u; voffB[i] = (unsigned)(Rb * ldb + C) * 2u; }
    const size_t kstep = (size_t)(BK * 2);
    const size_t hstepA = (size_t)HALF * lda * 2, hstepB = (size_t)HALF * ldb * 2;
    const size_t tstepA = 2 * hstepA, tstepB = 2 * hstepB;
    const unsigned ldsw = (unsigned)wid * 1024u;
    const int aoff = lds_byte(wr * 64 + fr, fq * 8), boff = lds_byte(wc * 32 + fr, fq * 8);
#define PG8_SA(b, h) (((b) * 2 + (h)) * HTB)
#define PG8_SB(b, h) ((4 + (b) * 2 + (h)) * HTB)
#define PG8_STAGE(bufoff, gbase, voff) do { _Pragma("unroll") for (int _i = 0; _i < 2; ++_i) \
        __builtin_amdgcn_global_load_lds((const unsigned*)((const char*)(gbase) + (voff)[_i]), (PG8_LAS unsigned*)(lds + (bufoff) + ldsw + _i * 8192), 16, 0, 0); } while (0)
#define PG8_LDA(dst, b, h) do { _Pragma("unroll") for (int m = 0; m < 4; ++m) _Pragma("unroll") for (int k = 0; k < 2; ++k) dst[m][k] = *(const PG8_LAS bf16x8*)(lds + PG8_SA(b, h) + aoff + m * 2048 + k * 1024); } while (0)
#define PG8_LDB(dst, b, h) do { _Pragma("unroll") for (int n = 0; n < 2; ++n) _Pragma("unroll") for (int k = 0; k < 2; ++k) dst[n][k] = *(const PG8_LAS bf16x8*)(lds + PG8_SB(b, h) + boff + n * 2048 + k * 1024); } while (0)
#define PG8_MMA(ai, bj, At, Bt) do { __builtin_amdgcn_s_setprio(1); _Pragma("unroll") for (int m = 0; m < 4; ++m) _Pragma("unroll") for (int n = 0; n < 2; ++n) _Pragma("unroll") for (int k = 0; k < 2; ++k) \
        acc[ai][bj][m][n] = __builtin_amdgcn_mfma_f32_16x16x32_bf16(Bt[n][k], At[m][k], acc[ai][bj][m][n], 0, 0, 0); __builtin_amdgcn_s_setprio(0); } while (0)
#define PG8_WAIT_V(n) asm volatile("s_waitcnt vmcnt(" #n ")" ::: "memory")
#define PG8_WAIT_L(n) asm volatile("s_waitcnt lgkmcnt(" #n ")" ::: "memory")
#define PG8_BAR __builtin_amdgcn_s_barrier()
#define PG8_SCHED __builtin_amdgcn_sched_barrier(0)
    Unit cur, nxt; int ui = 0;
    if (!S.next(0, cur)) return;
    f32x4 acc[2][2][4][2];
#pragma unroll
    for (int a = 0; a < 2; ++a)
#pragma unroll
        for (int b = 0; b < 2; ++b)
#pragma unroll
            for (int m = 0; m < 4; ++m)
#pragma unroll
                for (int n = 0; n < 2; ++n) acc[a][b][m][n] = (f32x4){0.f, 0.f, 0.f, 0.f};
    bf16x8 At[4][2], B0[2][2], B1[2][2];
    const char* cA = (const char*)g.A + (size_t)cur.pm * tstepA + (size_t)cur.k0 * 2; const char* cB = (const char*)g.Bt + (size_t)cur.pn * tstepB + (size_t)cur.k0 * 2;
    S.a_ready(cur);
    if constexpr (SP2) {
        PG8_STAGE(PG8_SB(0, 0), cB, voffB); PG8_STAGE(PG8_SB(0, 1), cB + hstepB, voffB); PG8_STAGE(PG8_SA(0, 0), cA, voffA); PG8_STAGE(PG8_SA(0, 1), cA + hstepA, voffA);
        if (wr == 1) PG8_BAR;
        PG8_WAIT_V(2); PG8_BAR;
        PG8_STAGE(PG8_SB(1, 0), cB + kstep, voffB); PG8_STAGE(PG8_SA(1, 0), cA + kstep, voffA); PG8_STAGE(PG8_SB(1, 1), cB + hstepB + kstep, voffB);
        PG8_WAIT_V(6); PG8_BAR;
    } else {
        PG8_STAGE(PG8_SB(0, 0), cB, voffB); PG8_STAGE(PG8_SA(0, 0), cA, voffA); PG8_STAGE(PG8_SB(0, 1), cB + hstepB, voffB); PG8_STAGE(PG8_SA(0, 1), cA + hstepA, voffA);
        if (wr == 1) PG8_BAR;
        PG8_WAIT_V(4); PG8_BAR;
        PG8_STAGE(PG8_SB(1, 0), cB + kstep, voffB); PG8_STAGE(PG8_SA(1, 0), cA + kstep, voffA); PG8_STAGE(PG8_SB(1, 1), cB + hstepB + kstep, voffB);
        PG8_WAIT_V(6); PG8_BAR;
    }
    for (;;) {
        const bool has_next = S.next(ui + 1, nxt);
        const char* nA = has_next ? (const char*)g.A + (size_t)nxt.pm * tstepA + (size_t)nxt.k0 * 2 : cA; const char* nB = has_next ? (const char*)g.Bt + (size_t)nxt.pn * tstepB + (size_t)nxt.k0 * 2 : cB;
        for (int t = 0; t < nt; t += 2) {
            const bool last = (t == nt - 2);
            const char* a1 = cA + (size_t)(t + 1) * kstep;
            const char* a2 = last ? nA : cA + (size_t)(t + 2) * kstep; const char* b2 = last ? nB : cB + (size_t)(t + 2) * kstep;
            const char* a3 = a2 + kstep; const char* b3 = b2 + kstep;
            if (last && has_next) S.a_ready(nxt);
            if constexpr (SP2) {
            PG8_LDB(B0, 0, 0); PG8_LDB(B1, 0, 1); PG8_SCHED; PG8_LDA(At, 0, 0); PG8_STAGE(PG8_SA(1, 1), a1 + hstepA, voffA);
            PG8_WAIT_V(8); PG8_WAIT_L(0); PG8_BAR; PG8_MMA(0, 0, At, B0); PG8_MMA(0, 1, At, B1); PG8_BAR; PG8_SCHED;
            PG8_LDA(At, 0, 1); PG8_STAGE(PG8_SB(0, 0), b2, voffB); PG8_STAGE(PG8_SB(0, 1), b2 + hstepB, voffB); PG8_STAGE(PG8_SA(0, 0), a2, voffA);
            PG8_WAIT_V(8); PG8_WAIT_L(0); PG8_BAR; PG8_MMA(1, 0, At, B0); PG8_MMA(1, 1, At, B1); PG8_BAR; PG8_SCHED;
            PG8_LDB(B0, 1, 0); PG8_LDB(B1, 1, 1); PG8_SCHED; PG8_LDA(At, 1, 0); PG8_STAGE(PG8_SA(0, 1), a2 + hstepA, voffA);
            PG8_WAIT_V(8); PG8_WAIT_L(0); PG8_BAR; PG8_MMA(0, 0, At, B0); PG8_MMA(0, 1, At, B1); PG8_BAR; PG8_SCHED;
            PG8_LDA(At, 1, 1); PG8_STAGE(PG8_SB(1, 0), b3, voffB); PG8_STAGE(PG8_SB(1, 1), b3 + hstepB, voffB); PG8_STAGE(PG8_SA(1, 0), a3, voffA);
            PG8_WAIT_V(8); PG8_WAIT_L(0); PG8_BAR; PG8_MMA(1, 0, At, B0); PG8_MMA(1, 1, At, B1); PG8_BAR; PG8_SCHED;
            } else {
            PG8_LDB(B0, 0, 0); PG8_SCHED; PG8_LDA(At, 0, 0); PG8_STAGE(PG8_SA(1, 1), a1 + hstepA, voffA);
            PG8_WAIT_L(8); PG8_BAR; PG8_WAIT_L(0); PG8_MMA(0, 0, At, B0); PG8_BAR; PG8_SCHED;
            PG8_LDB(B1, 0, 1); PG8_STAGE(PG8_SB(0, 0), b2, voffB);
            PG8_BAR; PG8_WAIT_L(0); PG8_MMA(0, 1, At, B1); PG8_BAR;
            PG8_LDA(At, 0, 1); PG8_STAGE(PG8_SA(0, 0), a2, voffA);
            PG8_BAR; PG8_WAIT_L(0); PG8_MMA(1, 0, At, B0); PG8_BAR; PG8_SCHED;
            PG8_STAGE(PG8_SB(0, 1), b2 + hstepB, voffB);
            PG8_WAIT_V(6); PG8_BAR; PG8_MMA(1, 1, At, B1); PG8_BAR;
            PG8_LDB(B0, 1, 0); PG8_SCHED; PG8_LDA(At, 1, 0); PG8_STAGE(PG8_SA(0, 1), a2 + hstepA, voffA);
            PG8_WAIT_L(8); PG8_BAR; PG8_WAIT_L(0); PG8_MMA(0, 0, At, B0); PG8_BAR; PG8_SCHED;
            PG8_LDB(B1, 1, 1); PG8_STAGE(PG8_SB(1, 0), b3, voffB);
            PG8_BAR; PG8_WAIT_L(0); PG8_MMA(0, 1, At, B1); PG8_BAR;
            PG8_LDA(At, 1, 1); PG8_STAGE(PG8_SA(1, 0), a3, voffA);
            PG8_BAR; PG8_WAIT_L(0); PG8_MMA(1, 0, At, B0); PG8_BAR; PG8_SCHED;
            PG8_STAGE(PG8_SB(1, 1), b3 + hstepB, voffB);
            PG8_WAIT_V(6); PG8_BAR; PG8_MMA(1, 1, At, B1); PG8_BAR;
            }
        }
        if constexpr (ALIGN_EPI) { if (wr == 0) PG8_BAR; }
        if constexpr (!Epi::AFTER_DRAIN) { E(acc, cur, wr, wc, fr, fq); S.done(cur); }
        if (!has_next) break;
#pragma unroll
        for (int a = 0; a < 2; ++a)
#pragma unroll
            for (int b = 0; b < 2; ++b)
#pragma unroll
                for (int m = 0; m < 4; ++m)
#pragma unroll
                    for (int n = 0; n < 2; ++n) acc[a][b][m][n] = (f32x4){0.f, 0.f, 0.f, 0.f};
        cur = nxt; cA = nA; cB = nB; ++ui;
        if constexpr (ALIGN_EPI) { if (wr == 1) PG8_BAR; }
    }
    PG8_WAIT_V(0);
    if constexpr (!ALIGN_EPI) { if (wr == 0) PG8_BAR; }
    PG8_BAR;
    if constexpr (Epi::AFTER_DRAIN) { E.fused(acc, cur, wr, wc, fr, fq, lds, wid, lane); S.done(cur); }
#undef PG8_SA
#undef PG8_SB
#undef PG8_STAGE
#undef PG8_LDA
#undef PG8_LDB
#undef PG8_MMA
#undef PG8_WAIT_V
#undef PG8_WAIT_L
#undef PG8_BAR
#undef PG8_SCHED
}
}

#define LAS __attribute__((address_space(3)))
#define DI __device__ __forceinline__
typedef unsigned short bf16_t;
typedef short bf16x8 __attribute__((ext_vector_type(8)));
typedef short s16x4 __attribute__((ext_vector_type(4)));
typedef float f32x4 __attribute__((ext_vector_type(4)));
typedef float f32x16 __attribute__((ext_vector_type(16)));
typedef unsigned u32x4 __attribute__((ext_vector_type(4)));
typedef unsigned u32x2 __attribute__((ext_vector_type(2)));
using pg8::cvt_pk_bf16; using pg8::sigm; using pg8::ld_bf4; using pg8::st_bf4; using pg8::batch_of;
using namespace cfg;

DI float bf2f(bf16_t b) { return __uint_as_float((unsigned)b << 16); }
DI unsigned f2bf(float f) { unsigned u = __float_as_uint(f); return (u + 0x7fffu + ((u >> 16) & 1u)) >> 16; }
DI float wave_sum(float v, int lane) {
#pragma unroll
    for (int o = 1; o < 64; o <<= 1) v += shx(v, o, lane);
    return v;
}
DI float wave_max(float v, int lane) {
#pragma unroll
    for (int o = 1; o < 64; o <<= 1) v = fmaxf(v, shx(v, o, lane));
    return v;
}
DI bf16x8 pack8(const f32x4 a, const f32x4 b) { u32x4 p; p.x = cvt_pk_bf16(a[0], a[1]); p.y = cvt_pk_bf16(a[2], a[3]); p.z = cvt_pk_bf16(b[0], b[1]); p.w = cvt_pk_bf16(b[2], b[3]); return __builtin_bit_cast(bf16x8, p); }
#define MFMA16(a, b, c) __builtin_amdgcn_mfma_f32_16x16x32_bf16((a), (b), (c), 0, 0, 0)
#define MFMA32(a, b, c) __builtin_amdgcn_mfma_f32_32x32x16_bf16((a), (b), (c), 0, 0, 0)

#define XB_TMO      128
#define XB_XCNT(j)  (256  + 64 * (j))
#define XB_XSUB(j)  (1280 + 64 * (j))
#define XB_XGEN(j)  (2304 + 64 * (j))
#define XB_TOP      3328
#define XB_TOPGEN   3392
#define XCD_BAR_WORDS 3456
#define XB_SPIN_CAP (1u << 18)

__device__ __forceinline__ unsigned xb_ld(unsigned* p)              { return __hip_atomic_load(p, __ATOMIC_RELAXED, __HIP_MEMORY_SCOPE_AGENT); }
__device__ __forceinline__ unsigned xb_add(unsigned* p, unsigned v) { return __hip_atomic_fetch_add(p, v, __ATOMIC_RELAXED, __HIP_MEMORY_SCOPE_AGENT); }
__device__ __forceinline__ unsigned xb_xcc_id() { return (unsigned)__builtin_amdgcn_s_getreg((3 << 11) | 20) & 0xFu; }
#define XB_SPIN(cond, bar) do { unsigned _sp = 0; while (cond) { __builtin_amdgcn_s_sleep(1); \
    if ((++_sp & 255u) == 0u) { if (xb_ld(&(bar)[XB_TMO])) break; if (_sp > XB_SPIN_CAP) { atomicAdd(&(bar)[XB_TMO], 1u); break; } } } } while (0)

struct XcdBarrier {
    unsigned* bar; unsigned x;
    volatile LAS unsigned* st;
};

__device__ __forceinline__ XcdBarrier xcd_barrier_post(unsigned* bar, volatile LAS unsigned* st) {
    XcdBarrier b; b.bar = bar; b.x = xb_xcc_id(); b.st = st;
    if (threadIdx.x == 0) (void)xb_add(&bar[XB_XCNT(b.x)], 1u);
    return b;
}
__device__ __forceinline__ void xcd_barrier_complete(unsigned* bar, unsigned x, unsigned& nloc, unsigned& nx) {
    const unsigned G = gridDim.x * gridDim.y * gridDim.z;
    unsigned sum, cnt, mine, sp = 0u;
    for (;;) {
        sum = 0u; cnt = 0u; mine = 0u;
#pragma unroll
        for (unsigned j = 0; j < 16; ++j) { const unsigned c = xb_ld(&bar[XB_XCNT(j)]); sum += c; cnt += (c > 0u) ? 1u : 0u; mine = (j == x) ? c : mine; }
        if (sum == G) break;
        __builtin_amdgcn_s_sleep(1);
        if ((++sp & 255u) == 0u) { if (xb_ld(&bar[XB_TMO])) break; if (sp > XB_SPIN_CAP) { atomicAdd(&bar[XB_TMO], 1u); break; } }
    }
    nloc = mine > 0u ? mine : 1u; nx = cnt > 0u ? cnt : 1u;
}

__device__ __forceinline__ void xcd_barrier(const XcdBarrier& b) {
    asm volatile("s_waitcnt vmcnt(0)" ::: "memory");
    __syncthreads();
    if (threadIdx.x == 0) {
        unsigned* bar = b.bar;
        __builtin_amdgcn_s_waitcnt(0);
        unsigned nloc = b.st[0], nx = b.st[1];
        if (nloc == 0u) { xcd_barrier_complete(bar, b.x, nloc, nx); b.st[0] = nloc; b.st[1] = nx; }
        const unsigned old = xb_add(&bar[XB_XSUB(b.x)], 1u);
        const unsigned gen = old / nloc;
        if (old + 1u == (gen + 1u) * nloc) {
            __builtin_amdgcn_fence(__ATOMIC_RELEASE, "agent");
            asm volatile("s_waitcnt vmcnt(0)" ::: "memory");
            const unsigned og = xb_add(&bar[XB_TOP], 1u);
            const unsigned tg = og / nx;
            if (og + 1u == (tg + 1u) * nx) xb_add(&bar[XB_TOPGEN], 1u);
            else XB_SPIN(xb_ld(&bar[XB_TOPGEN]) == tg, bar);
            __builtin_amdgcn_fence(__ATOMIC_ACQUIRE, "agent");
            xb_add(&bar[XB_XGEN(b.x)], 1u);
            asm volatile("s_waitcnt vmcnt(0)" ::: "memory");
        } else {
            XB_SPIN(xb_ld(&bar[XB_XGEN(b.x)]) == gen, bar);
            __builtin_amdgcn_fence(__ATOMIC_ACQUIRE, "agent");
            asm volatile("s_waitcnt vmcnt(0)" ::: "memory");
        }
    }
    __syncthreads();
}

#ifndef MIXM
#define MIXM 0
#endif
#ifndef SYNC2
#define SYNC2 0
#endif
#ifndef REPM
#define REPM 0
#endif
#ifndef GM
#define GM 0xff
#endif
#ifndef PHM
#define PHM 0xff
#endif
struct Args { const float* in[33]; float* out; unsigned char* ws; unsigned long long rfix[8]; int ph_lo, ph_hi; };
typedef const Args __attribute__((address_space(4)))* ArgsP;

DI void tr_item(const float* W, int K, int N, bf16_t* WT, int k0, int n0, int drow0, LAS float* scr, int lane) {
#pragma unroll 8
    for (int i = 0; i < 32; ++i) { const int kk = 2 * i + (lane >> 5); scr[kk * 33 + (lane & 31)] = W[(size_t)(k0 + kk) * N + n0 + (lane & 31)]; }
    asm volatile("s_waitcnt lgkmcnt(0)" ::: "memory");
    const int c = lane & 7;
#pragma unroll
    for (int j = 0; j < 4; ++j) { const int n = (lane >> 3) + 8 * j; const LAS float* s = scr + (8 * c) * 33 + n;
        u32x4 o; o.x = cvt_pk_bf16(s[0 * 33], s[1 * 33]); o.y = cvt_pk_bf16(s[2 * 33], s[3 * 33]); o.z = cvt_pk_bf16(s[4 * 33], s[5 * 33]); o.w = cvt_pk_bf16(s[6 * 33], s[7 * 33]);
        *(u32x4*)(WT + (size_t)(drow0 + n) * K + k0 + 8 * c) = o; }
    asm volatile("s_waitcnt lgkmcnt(0)" ::: "memory");
}
DI void fold_item(const float* Pw  , const float* Sc  , const float* Wa  , bf16_t* WT  , int k0, int n0, LAS float* scr, int lane) {
    const int g = k0 >> 7, nn = lane & 31, hi = lane >> 5;
    for (int jc = 0; jc < 4; ++jc) {
        float w[32];
#pragma unroll
        for (int jj = 0; jj < 32; ++jj) { const int j = g * 128 + jc * 32 + jj; w[jj] = Sc[j] * Wa[(size_t)j * 1024 + n0 + nn]; }
#pragma unroll 1
        for (int i = 0; i < 32; ++i) { const float* pr = Pw + ((size_t)g * 128 + ((k0 & 127) + 2 * i + hi)) * 128 + jc * 32; float acc = 0.f;
#pragma unroll
            for (int j4 = 0; j4 < 8; ++j4) { const f32x4 p = *(const f32x4*)(pr + 4 * j4);
                acc += p[0] * w[4 * j4] + p[1] * w[4 * j4 + 1] + p[2] * w[4 * j4 + 2] + p[3] * w[4 * j4 + 3]; }
            LAS float* sp = scr + (2 * i + hi) * 33 + nn; if (jc == 0) *sp = acc; else *sp += acc; }
    }
    asm volatile("s_waitcnt lgkmcnt(0)" ::: "memory");
    const int c = lane & 7;
#pragma unroll
    for (int j = 0; j < 4; ++j) { const int n = (lane >> 3) + 8 * j; const LAS float* s = scr + (8 * c) * 33 + n;
        u32x4 o; o.x = cvt_pk_bf16(s[0 * 33], s[1 * 33]); o.y = cvt_pk_bf16(s[2 * 33], s[3 * 33]); o.z = cvt_pk_bf16(s[4 * 33], s[5 * 33]); o.w = cvt_pk_bf16(s[6 * 33], s[7 * 33]);
        *(u32x4*)(WT + (size_t)(n0 + n) * 512 + k0 + 8 * c) = o; }
    asm volatile("s_waitcnt lgkmcnt(0)" ::: "memory");
}
DI void sincos_frac(float f  , float& c, float& s) { s = __builtin_amdgcn_sinf(f); c = __builtin_amdgcn_cosf(f); }

DI void prologue(ArgsP a, LAS unsigned char* lds, int tid) {
    const int lane = tid & 63, wave = tid >> 6;
    const int gw = blockIdx.x * 8 + wave, NGW = gridDim.x * 8;
    const int gt = blockIdx.x * 512 + tid, NT = gridDim.x * 512;
    unsigned char* ws = a->ws;
    LAS float* scr = (LAS float*)(lds + wave * 16384);
    constexpr int I_IN = 16 * 152, I_GLU = 8 * 16, I_BR = 8 * 32, I_OUT = 16 * 32, I_FI = 16 * 176, I_FO = 44 * 32, I_ADA = 16 * 192, I_FOLD = 8 * 32;
    constexpr int PER_L = I_IN + I_GLU + 2 * I_BR + I_OUT + I_FI + I_FO + I_ADA + I_FOLD;
    for (int it = gw; it < PER_L * 4; it += NGW) {
        const int l = it & 3; int r = it >> 2;
        if (r < I_FOLD) { fold_item(a->in[14] + (size_t)l * 4 * 128 * 128, a->in[15] + l * 512, a->in[26] + (size_t)l * 512 * 1024, (bf16_t*)(ws + WS_WBR) + (size_t)l * 3072 * 512, (r >> 5) * 64, (r & 31) * 32, scr, lane); continue; } r -= I_FOLD;
        if (r < I_IN) { const int kb = r / 152, nb = r % 152; tr_item(a->in[13] + (size_t)l * 1024 * IN_COLS, 1024, IN_COLS, (bf16_t*)(ws + WS_WIN) + (size_t)l * IN_COLS * 1024, kb * 64, nb * 32, nb * 32, scr, lane); continue; } r -= I_IN;
        if (r < I_GLU) { const int kb = r / 16, nb = r % 16; tr_item(a->in[25] + (size_t)l * 512 * 512, 512, 512, (bf16_t*)(ws + WS_WGLU) + (size_t)l * 512 * 512, kb * 64, nb * 32, nb * 32, scr, lane); continue; } r -= I_GLU;
        if (r < I_BR) { const int kb = r / 32, nb = r % 32; tr_item(a->in[27] + (size_t)l * 512 * 1024, 512, 1024, (bf16_t*)(ws + WS_WBR) + (size_t)l * 3072 * 512, kb * 64, nb * 32, 1024 + nb * 32, scr, lane); continue; } r -= I_BR;
        if (r < I_BR) { const int kb = r / 32, nb = r % 32; tr_item(a->in[28] + (size_t)l * 512 * 1024, 512, 1024, (bf16_t*)(ws + WS_WBR) + (size_t)l * 3072 * 512, kb * 64, nb * 32, 2048 + nb * 32, scr, lane); continue; } r -= I_BR;
        if (r < I_OUT) { const int kb = r / 32, nb = r % 32; tr_item(a->in[29] + (size_t)l * 1024 * 1024, 1024, 1024, (bf16_t*)(ws + WS_WOUT) + (size_t)l * 1024 * 1024, kb * 64, nb * 32, nb * 32, scr, lane); continue; } r -= I_OUT;
        if (r < I_FI) { const int kb = r / 176, nb = r % 176; const int n0 = nb * 32, half = n0 / DFF, j = n0 - half * DFF;
            tr_item(a->in[30] + (size_t)l * 1024 * 2 * DFF, 1024, 2 * DFF, (bf16_t*)(ws + WS_WFI) + (size_t)l * 2 * DFF * 1024, kb * 64, n0, 256 * (j >> 7) + 128 * half + (j & 127), scr, lane); continue; } r -= I_FI;
        if (r < I_FO) { const int kb = r / 32, nb = r % 32; tr_item(a->in[31] + (size_t)l * DFF * 1024, DFF, 1024, (bf16_t*)(ws + WS_WFO) + (size_t)l * 1024 * DFF, kb * 64, nb * 32, nb * 32, scr, lane); continue; } r -= I_FO;
        { const int kb = r / 192, nb = r % 192; tr_item(a->in[11] + (size_t)l * 1024 * 6144, 1024, 6144, (bf16_t*)(ws + WS_GT), kb * 64, nb * 32, l * 6144 + nb * 32, scr, lane); }
    }
    { bf16_t* CA = (bf16_t*)(ws + WS_CA);
      for (int i = gt; i < 256 * 1024; i += NT) { const int r = i >> 10, c = i & 1023; float v = 0.f;
          if (r < 8) v = a->in[7][r * 1024 + c]; else if (r < NBAT) v = a->in[8][(r - 8) * 1024 + c];
          CA[i] = (bf16_t)f2bf(v * sigm(v)); } }
    { float* rc = (float*)(ws + WS_TAB + TB_ROPEC); float* rs = (float*)(ws + WS_TAB + TB_ROPES);
      for (int i = gt; i < 2052 * 8; i += NT) { const int ti = i >> 3, j = i & 7; const int pos = ti < 2048 ? ti : 8192 + (ti - 2048);
          const unsigned long long fx = (unsigned long long)pos * a->rfix[j];
          float c, s; sincos_frac((float)(unsigned)(fx >> 40) * 5.9604644775390625e-08f, c, s); rc[i] = c; rs[i] = s; } }
    { float* AB = (float*)(ws + WS_TAB + TB_ABAR); float* AB256 = (float*)(ws + WS_TAB + TB_ABAR256); bf16_t* BBF = (bf16_t*)(ws + WS_TAB + TB_BBF);
      for (int i = gt; i < 4 * 32 * 64; i += NT) { const int lg = i >> 6, p = i & 63;
          const float dt = expf(a->in[19][lg]); const float ar = a->in[17][i], ai = a->in[18][i];
          const float x = ar * dt; const float yt = ai * dt * 0.15915494309189535f;
          float c, s; sincos_frac(yt, c, s); float ch, sh; sincos_frac(0.5f * yt, ch, sh);
          const float em1 = x * (1.f + x * (0.5f + x * (0.16666667f + x * (0.041666668f + x * 0.0083333338f))));
          const float ex = 1.f + em1;
          const float abr = ex * c, abi = ex * s;
          const float nr = em1 * c - (sh + sh) * sh, ni = abi;
          const float den = 1.f / (ar * ar + ai * ai);
          const float cr = (nr * ar + ni * ai) * den, ci = (ni * ar - nr * ai) * den;
          AB[2 * i] = abr; AB[2 * i + 1] = abi;
          float pr = abr, pi = abi;
#pragma unroll
          for (int k = 0; k < 8; ++k) { const float t = pr * pr - pi * pi; pi = (pr + pr) * pi; pr = t; }
          AB256[2 * i] = pr; AB256[2 * i + 1] = pi;
          const float* br = a->in[20] + (size_t)i * 16; const float* bi = a->in[21] + (size_t)i * 16;
          const int st = p >> 5;
#pragma unroll
          for (int half = 0; half < 2; ++half) { u32x4 ore, oim; unsigned* pre = (unsigned*)&ore; unsigned* pim = (unsigned*)&oim; (void)pre; (void)pim;
              float vr[8], vi[8];
#pragma unroll
              for (int j = 0; j < 8; ++j) { const float b_r = br[half * 8 + j], b_i = bi[half * 8 + j]; vr[j] = cr * b_r - ci * b_i; vi[j] = cr * b_i + ci * b_r; }
              ore.x = cvt_pk_bf16(vr[0], vr[1]); ore.y = cvt_pk_bf16(vr[2], vr[3]); ore.z = cvt_pk_bf16(vr[4], vr[5]); ore.w = cvt_pk_bf16(vr[6], vr[7]);
              oim.x = cvt_pk_bf16(vi[0], vi[1]); oim.y = cvt_pk_bf16(vi[2], vi[3]); oim.z = cvt_pk_bf16(vi[4], vi[5]); oim.w = cvt_pk_bf16(vi[6], vi[7]);
              *(u32x4*)(BBF + (((size_t)lg * 4 + 0 + st) * 64 + half * 32 + (p & 31)) * 8) = ore;
              *(u32x4*)(BBF + (((size_t)lg * 4 + 2 + st) * 64 + half * 32 + (p & 31)) * 8) = oim; } } }
    { bf16_t* CF = (bf16_t*)(ws + WS_TAB + TB_CF);
      for (int i = gt; i < 4 * 32 * 4 * 64; i += NT) { const int ln = i & 63, ks = (i >> 6) & 3, lg = i >> 8; const int c = ln & 15, quad = ln >> 4;
          float v[8];
#pragma unroll
          for (int j = 0; j < 8; ++j) { const int k = ks * 32 + quad * 8 + j; v[j] = k < 64 ? a->in[22][((size_t)lg * 16 + c) * 64 + k] : -a->in[23][((size_t)lg * 16 + c) * 64 + (k - 64)]; }
          u32x4 o; o.x = cvt_pk_bf16(v[0], v[1]); o.y = cvt_pk_bf16(v[2], v[3]); o.z = cvt_pk_bf16(v[4], v[5]); o.w = cvt_pk_bf16(v[6], v[7]);
          *(u32x4*)(CF + (size_t)i * 8) = o; } }
    { for (int i = gt; i < 4 * 128 * 124 * 32; i += NT) { const int c4 = i & 31, j = (i >> 5) % 124, lb = (i >> 5) / 124;
          *(f32x4*)(a->out + OFF_KS + ((size_t)lb * 128 + j) * 128 + c4 * 4) = *(const f32x4*)(a->in[2] + ((size_t)lb * 128 + j + 4) * 128 + c4 * 4);
          *(f32x4*)(a->out + OFF_VS + ((size_t)lb * 128 + j) * 128 + c4 * 4) = *(const f32x4*)(a->in[3] + ((size_t)lb * 128 + j + 4) * 128 + c4 * 4); }
      for (int i = gt; i < 4 * 128 * 11 * 128; i += NT) { const int c4 = i & 127, j = (i >> 7) % 11, lb = (i >> 7) / 11;
          *(f32x4*)(a->out + OFF_PS + ((size_t)lb * 15 + j) * 512 + c4 * 4) = *(const f32x4*)(a->in[4] + ((size_t)lb * 15 + j + 4) * 512 + c4 * 4); } }
}

DI void norm_phase(const float* xp, const float* xs, const float* gvec, const float* MODL  , int sc_off, bf16_t* H, int tid,
                   const float* P, int nparts, const float* pgate, float* X) {
    const int lane = tid & 63, gw = blockIdx.x * 8 + (tid >> 6), NGW = gridDim.x * 8;
    for (int it = gw; it < M; it += NGW) {
        const int row = it < MS ? MP + it : it - MS;
        const int bi = batch_of(row);
        const float* xr = (row < MP ? xp : xs) + (size_t)row * 1024; const float* mr = MODL + (size_t)bi * NMOD;
        f32x4 v[4]; float ss = 0.f;
#pragma unroll
        for (int j = 0; j < 4; ++j) v[j] = *(const f32x4*)(xr + 4 * lane + 256 * j);
        if (row >= MP && nparts > 0) {
            f32x4 s[4];
#pragma unroll
            for (int j = 0; j < 4; ++j) s[j] = (f32x4){0.f, 0.f, 0.f, 0.f};
            for (int p = 0; p < nparts; ++p) { const float* pr = P + ((size_t)p * 512 + (row - MP)) * 1024 + 4 * lane;
#pragma unroll
                for (int j = 0; j < 4; ++j) s[j] += *(const f32x4*)(pr + 256 * j); }
#pragma unroll
            for (int j = 0; j < 4; ++j) { v[j] += *(const f32x4*)(pgate + (size_t)bi * NMOD + 4 * lane + 256 * j) * s[j]; *(f32x4*)(X + (size_t)row * 1024 + 4 * lane + 256 * j) = v[j]; }
        }
#pragma unroll
        for (int j = 0; j < 4; ++j) ss += v[j][0] * v[j][0] + v[j][1] * v[j][1] + v[j][2] * v[j][2] + v[j][3] * v[j][3];
        const float r = rsqrtf(wave_sum(ss, lane) * (1.f / 1024.f) + 1e-6f);
        if (H) {
#pragma unroll
            for (int j = 0; j < 4; ++j) { const int c = 4 * lane + 256 * j; const f32x4 g = *(const f32x4*)(gvec + c), sh = *(const f32x4*)(mr + c), sc = *(const f32x4*)(mr + sc_off + c);
                st_bf4(H + (size_t)row * 1024 + c, v[j] * r * g * (1.f + sc) + sh); }
        } else {
#pragma unroll
            for (int j = 0; j < 4; ++j) { const int c = 4 * lane + 256 * j; *(f32x4*)(X + (size_t)row * 1024 + c) = v[j] * r * *(const f32x4*)(gvec + c); }
        }
    }
}

template <int W>
DI void pool_run(const float* XA, bf16_t* Dm, float* out, int l, int row0, int c4) {
    const int t0 = row0 & 2047;
    f32x4 x[W + 7];
#pragma unroll
    for (int i = 0; i < W + 7; ++i) { const int dt = i - (W - 1); x[i] = (t0 + dt >= 0) ? *(const f32x4*)(XA + (size_t)(row0 + dt) * 512 + c4) : (f32x4){0.f, 0.f, 0.f, 0.f}; }
    f32x4 s = x[0];
#pragma unroll
    for (int i = 1; i < W - 1; ++i) s += x[i];
#pragma unroll
    for (int k = 0; k < 8; ++k) { s += x[W - 1 + k]; const int t = t0 + k; const float cnt = (float)((t + 1 < W) ? t + 1 : W);
        st_bf4(Dm + (size_t)(row0 + k) * 512 + c4, s * (1.f / cnt) - x[W - 1 + k]);
        if (t >= 2033) *(f32x4*)(out + OFF_PP + ((size_t)(l * 8 + (row0 >> 11)) * 15 + (t - 2033)) * 512 + c4) = x[W - 1 + k];
        s -= x[k]; }
}
DI void pool_phase(ArgsP a, int l, const float* XA, bf16_t* Dm, int tid) {
    const int gt = blockIdx.x * 512 + tid, NT = gridDim.x * 512;
    constexpr int NRUN = MP / 8;
    for (int item = gt; item < 4 * NRUN * 32; item += NT) {
        const int c4l = item & 31, gr = item >> 5, g = gr / NRUN, run = gr - g * NRUN; const int c4 = g * 128 + c4l * 4, row0 = run * 8;
        if (g == 0) pool_run<2>(XA, Dm, a->out, l, row0, c4); else if (g == 1) pool_run<4>(XA, Dm, a->out, l, row0, c4);
        else if (g == 2) pool_run<8>(XA, Dm, a->out, l, row0, c4); else pool_run<16>(XA, Dm, a->out, l, row0, c4);
    }
    for (int idx = gt; idx < MS * 128; idx += NT) {
        const int row = MP + (idx >> 7), c4 = (idx & 127) * 4, w = 2 << (c4 >> 7);
        const f32x4 x = *(const f32x4*)(XA + (size_t)row * 512 + c4); f32x4 sum = x;
        const int rs = row - MP, bs = rs >> 2, t = rs & 3;
        for (int s = 1; s < w; ++s) { const int pos = t - s;
            sum += pos >= 0 ? *(const f32x4*)(XA + (size_t)(row - s) * 512 + c4) : *(const f32x4*)(a->in[4] + ((size_t)(l * 128 + bs) * 15 + 15 + pos) * 512 + c4); }
        *(f32x4*)(a->out + OFF_PS + ((size_t)(l * 128 + bs) * 15 + 11 + t) * 512 + c4) = x;
        st_bf4(Dm + (size_t)row * 512 + c4, sum * (1.f / (float)w) - x);
    }
}

DI void attn_prompt_unit(LAS unsigned char* lds, int unit, const bf16_t* Q, const bf16_t* KB, const bf16_t* VB, bf16_t* YB, const float* sinks, int tid) {
    const int b = unit >> 5, g = (unit >> 4) & 1, nb = unit & 15;
    LAS bf16_t* Ks = (LAS bf16_t*)lds;
    LAS bf16_t* Vt = (LAS bf16_t*)(lds + 36864);
    const int krow0 = b * 2048 + (nb - 1) * 128;
#pragma unroll
    for (int it = 0; it < 4; ++it) {
        const int chunk = tid + 512 * it, j = chunk >> 3, c8 = chunk & 7;
        u32x4 kv = {0u, 0u, 0u, 0u}, vv = {0u, 0u, 0u, 0u};
        if (nb > 0 || j >= 128) { const size_t off = (size_t)(krow0 + j) * 128 + g * 64 + c8 * 8; kv = *(const u32x4*)(KB + off); vv = *(const u32x4*)(VB + off); }
        *(LAS u32x4*)(Ks + j * 72 + c8 * 8) = kv;
        LAS bf16_t* vp = Vt + (c8 * 8) * 264 + j;
        vp[0 * 264] = (bf16_t)(vv.x & 0xffffu); vp[1 * 264] = (bf16_t)(vv.x >> 16); vp[2 * 264] = (bf16_t)(vv.y & 0xffffu); vp[3 * 264] = (bf16_t)(vv.y >> 16);
        vp[4 * 264] = (bf16_t)(vv.z & 0xffffu); vp[5 * 264] = (bf16_t)(vv.z >> 16); vp[6 * 264] = (bf16_t)(vv.w & 0xffffu); vp[7 * 264] = (bf16_t)(vv.w >> 16);
    }
    __syncthreads();
    const int wave = tid >> 6, lane = tid & 63, l15 = lane & 15, quad = lane >> 4;
    const int r = wave >> 1, hq = g * 4 + r;
    const float sc2 = 0.125f * 1.4426950408889634f;
    const float sk2 = sinks[hq] * 1.4426950408889634f;
    const int kt0 = wave & 1;
#pragma unroll 1
    for (int qh = 0; qh < 2; ++qh) {
        const int q0 = (wave & 1) * 64 + qh * 32;
        const int qrow0 = b * 2048 + nb * 128 + q0;
        bf16x8 qf[2][2];
#pragma unroll
        for (int qt = 0; qt < 2; ++qt)
#pragma unroll
            for (int ds = 0; ds < 2; ++ds) qf[qt][ds] = *(const bf16x8*)(Q + (size_t)(qrow0 + qt * 16 + l15) * 512 + hq * 64 + ds * 32 + quad * 8);
        float m2[2], ls[2]; f32x4 o[4][2];
#pragma unroll
        for (int qt = 0; qt < 2; ++qt) { m2[qt] = sk2; ls[qt] = quad == 0 ? 1.f : 0.f;
#pragma unroll
            for (int dt = 0; dt < 4; ++dt) o[dt][qt] = (f32x4){0.f, 0.f, 0.f, 0.f}; }
#pragma unroll 1
        for (int kk = 0; kk < 3; ++kk) {
            const int kt = kt0 + kk;
            if (nb == 0 && kt < 2) continue;
            f32x4 s[4][2];
#pragma unroll
            for (int sub = 0; sub < 4; ++sub) { const LAS bf16_t* kp = Ks + (kt * 64 + sub * 16 + l15) * 72 + quad * 8;
                const bf16x8 k0 = *(const LAS bf16x8*)kp, k1 = *(const LAS bf16x8*)(kp + 32);
#pragma unroll
                for (int qt = 0; qt < 2; ++qt) { s[sub][qt] = MFMA16(k0, qf[qt][0], ((f32x4){0.f, 0.f, 0.f, 0.f})); s[sub][qt] = MFMA16(k1, qf[qt][1], s[sub][qt]); } }
#pragma unroll
            for (int qt = 0; qt < 2; ++qt) { const int i = q0 + qt * 16 + l15; float mx = -INFINITY;
#pragma unroll
                for (int sub = 0; sub < 4; ++sub)
#pragma unroll
                    for (int jj = 0; jj < 4; ++jj) { const int j = kt * 64 + sub * 16 + quad * 4 + jj; const bool valid = (j > i) && (j <= i + 128) && (nb > 0 || j >= 128);
                        const float v = valid ? s[sub][qt][jj] * sc2 : -INFINITY; s[sub][qt][jj] = v; mx = fmaxf(mx, v); }
                mx = fmaxf(mx, shx16(mx, quad & 1)); mx = fmaxf(mx, shx32(mx, quad >> 1));
                const float mn = fmaxf(m2[qt], mx), alpha = __builtin_amdgcn_exp2f(m2[qt] - mn); m2[qt] = mn; float sum = 0.f;
#pragma unroll
                for (int sub = 0; sub < 4; ++sub)
#pragma unroll
                    for (int jj = 0; jj < 4; ++jj) { const float p = __builtin_amdgcn_exp2f(s[sub][qt][jj] - mn); s[sub][qt][jj] = p; sum += p; }
                ls[qt] = ls[qt] * alpha + sum;
#pragma unroll
                for (int dt = 0; dt < 4; ++dt) o[dt][qt] *= alpha; }
#pragma unroll
            for (int s2 = 0; s2 < 2; ++s2) { bf16x8 pf[2];
#pragma unroll
                for (int qt = 0; qt < 2; ++qt) pf[qt] = pack8(s[2 * s2][qt], s[2 * s2 + 1][qt]);
#pragma unroll
                for (int dt = 0; dt < 4; ++dt) { const LAS bf16_t* vp = Vt + (dt * 16 + l15) * 264 + kt * 64 + s2 * 32 + quad * 4;
                    const s16x4 v0 = *(const LAS s16x4*)vp, v1 = *(const LAS s16x4*)(vp + 16);
                    const bf16x8 vf = __builtin_shufflevector(v0, v1, 0, 1, 2, 3, 4, 5, 6, 7);
#pragma unroll
                    for (int qt = 0; qt < 2; ++qt) o[dt][qt] = MFMA16(vf, pf[qt], o[dt][qt]); } }
        }
#pragma unroll
        for (int qt = 0; qt < 2; ++qt) { float lt = ls[qt]; lt += shx16(lt, quad & 1); lt += shx32(lt, quad >> 1); const float inv = 1.f / lt;
            bf16_t* yp = YB + (size_t)(qrow0 + qt * 16 + l15) * 512 + hq * 64 + quad * 4;
#pragma unroll
            for (int dt = 0; dt < 4; ++dt) st_bf4(yp + dt * 16, o[dt][qt] * inv); }
    }
    __syncthreads();
}

DI void attn_sample_task(LAS unsigned char* wl, int task, int l, ArgsP a, const bf16_t* Q, bf16_t* YB, int lane) {
    const int b = task >> 3, h = task & 7, g = h >> 2;
    LAS float* qs = (LAS float*)wl;
    LAS float* ps = qs + 256;
#pragma unroll
    for (int t = 0; t < 4; ++t) qs[t * 64 + lane] = bf2f(Q[(size_t)(MP + b * 4 + t) * 512 + h * 64 + lane]);
    const float* ck = a->in[2] + (size_t)(l * 128 + b) * 128 * 128 + g * 64;
    const float* cv = a->in[3] + (size_t)(l * 128 + b) * 128 * 128 + g * 64;
    const float* nk = a->out + OFF_KS + ((size_t)(l * 128 + b) * 128 + 124) * 128 + g * 64;
    const float* nv = a->out + OFF_VS + ((size_t)(l * 128 + b) * 128 + 124) * 128 + g * 64;
    const float sink = a->in[16][l * 8 + h];
    float mx[4] = {sink, sink, sink, sink};
    for (int rr = 0; rr < 3; ++rr) { const int j = rr * 64 + lane; float s[4] = {0.f, 0.f, 0.f, 0.f};
        if (j < 132) { const float* kp = j < 128 ? ck + (size_t)j * 128 : nk + (size_t)(j - 128) * 128;
#pragma unroll 4
            for (int d4 = 0; d4 < 16; ++d4) { const f32x4 k4 = *(const f32x4*)(kp + 4 * d4);
#pragma unroll
                for (int t = 0; t < 4; ++t) { const f32x4 q4 = *(const LAS f32x4*)(qs + t * 64 + 4 * d4); s[t] += k4[0] * q4[0] + k4[1] * q4[1] + k4[2] * q4[2] + k4[3] * q4[3]; } } }
#pragma unroll
        for (int t = 0; t < 4; ++t) { const bool valid = (j < 132) && (j >= t + 1) && (j <= t + 128); const float v = valid ? s[t] * 0.125f : -INFINITY;
            if (j < 136) ps[t * 136 + j] = v; mx[t] = fmaxf(mx[t], v); } }
    float den[4];
#pragma unroll
    for (int t = 0; t < 4; ++t) { mx[t] = wave_max(mx[t], lane); float sum = 0.f;
        for (int rr = 0; rr < 3; ++rr) { const int j = rr * 64 + lane; if (j < 132) { const float p = __expf(ps[t * 136 + j] - mx[t]); ps[t * 136 + j] = p; sum += p; } }
        den[t] = wave_sum(sum, lane) + __expf(sink - mx[t]); }
    float o[4] = {0.f, 0.f, 0.f, 0.f};
    for (int j = 0; j < 132; ++j) { const float v = (j < 128 ? cv + (size_t)j * 128 : nv + (size_t)(j - 128) * 128)[lane];
#pragma unroll
        for (int t = 0; t < 4; ++t) o[t] += ps[t * 136 + j] * v; }
#pragma unroll
    for (int t = 0; t < 4; ++t) YB[(size_t)(MP + b * 4 + t) * 512 + h * 64 + lane] = (bf16_t)f2bf(o[t] / den[t]);
}

struct S5C { bf16x8 bbf[4]; bf16x8 cf[4]; float are[2], aim[2]; };
DI float gelu_tanh(float y) { const float z = 1.5957691216057308f * (y + 0.044715f * y * y * y); return y * sigm(z); }
template <bool OUT>
DI void s5_tile(const S5C& K, const float* U, int row0, int g, int nruns, int nvalid, float (&hre)[2], float (&him)[2], LAS bf16_t* Hs, const float* dvec, bf16_t* YC0, int lane) {
    const int tok = lane & 31, half = lane >> 5;
    bf16x8 af = {0, 0, 0, 0, 0, 0, 0, 0};
    if (tok < nvalid) { const float* up = U + (size_t)(row0 + tok) * 512 + g * 16 + half * 8; af = pack8(*(const f32x4*)up, *(const f32x4*)(up + 4)); }
    f32x16 z16;
#pragma unroll
    for (int i = 0; i < 16; ++i) z16[i] = 0.f;
    f32x16 dre[2], dim[2];
#pragma unroll
    for (int st = 0; st < 2; ++st) { dre[st] = MFMA32(af, K.bbf[st], z16); dim[st] = MFMA32(af, K.bbf[2 + st], z16); }
#pragma unroll
    for (int r = 0; r < 8; ++r) {
        if (r < nruns) {
            const int hf = r & 1, i0 = 4 * (r >> 1);
            if (half == hf) {
#pragma unroll
                for (int k = 0; k < 4; ++k)
#pragma unroll
                    for (int st = 0; st < 2; ++st) { const float nr = K.are[st] * hre[st] - K.aim[st] * him[st] + dre[st][i0 + k]; const float ni = K.are[st] * him[st] + K.aim[st] * hre[st] + dim[st][i0 + k];
                        hre[st] = nr; him[st] = ni; dre[st][i0 + k] = nr; dim[st][i0 + k] = ni; }
            }
#pragma unroll
            for (int st = 0; st < 2; ++st) { const float pr = __shfl_xor(hre[st], 32), pi = __shfl_xor(him[st], 32); if (half != hf) { hre[st] = pr; him[st] = pi; } }
        }
    }
    if (OUT) {
#pragma unroll
        for (int i = 0; i < 16; ++i) { const int tr = (i & 3) + 8 * (i >> 2) + 4 * half; LAS bf16_t* hp = Hs + tr * 136 + tok;
#pragma unroll
            for (int st = 0; st < 2; ++st) { hp[st * 32] = (bf16_t)f2bf(dre[st][i]); hp[64 + st * 32] = (bf16_t)f2bf(dim[st][i]); } }
        const int l15 = lane & 15, quad = lane >> 4;
#pragma unroll
        for (int tt = 0; tt < 2; ++tt) {
            if (tt * 16 < nvalid) {
                f32x4 acc = {0.f, 0.f, 0.f, 0.f};
#pragma unroll
                for (int ks = 0; ks < 4; ++ks) { const bf16x8 hf8 = *(const LAS bf16x8*)(Hs + (tt * 16 + l15) * 136 + ks * 32 + quad * 8); acc = MFMA16(K.cf[ks], hf8, acc); }
                const int tk = tt * 16 + l15;
                if (tk < nvalid) { const size_t ro = (size_t)(row0 + tk) * 512 + g * 16 + quad * 4;
                    const f32x4 u4 = *(const f32x4*)(U + ro), d4 = *(const f32x4*)(dvec + quad * 4); f32x4 y = acc + d4 * u4;
                    y[0] = gelu_tanh(y[0]); y[1] = gelu_tanh(y[1]); y[2] = gelu_tanh(y[2]); y[3] = gelu_tanh(y[3]);
                    st_bf4(YC0 + ro, y); }
            }
        }
    }
}
DI void s5_load_consts(S5C& K, const unsigned char* ws, int lg, int lane) {
    const bf16_t* BBF = (const bf16_t*)(ws + WS_TAB + TB_BBF); const bf16_t* CF = (const bf16_t*)(ws + WS_TAB + TB_CF); const float* AB = (const float*)(ws + WS_TAB + TB_ABAR);
#pragma unroll
    for (int t = 0; t < 4; ++t) { K.bbf[t] = *(const bf16x8*)(BBF + (((size_t)lg * 4 + t) * 64 + lane) * 8); K.cf[t] = *(const bf16x8*)(CF + (((size_t)lg * 4 + t) * 64 + lane) * 8); }
#pragma unroll
    for (int st = 0; st < 2; ++st) { const int p = st * 32 + (lane & 31); K.are[st] = AB[((size_t)lg * 64 + p) * 2]; K.aim[st] = AB[((size_t)lg * 64 + p) * 2 + 1]; }
}
DI void s5_prompt_task(LAS unsigned char* lds, int task, int l, ArgsP a, const float* U, bf16_t* YC0, int tid) {
    const int b = task >> 5, g = task & 31, lg = l * 32 + g, wave = tid >> 6, lane = tid & 63;
    LAS bf16_t* Hs = (LAS bf16_t*)(lds + wave * 8704);
    LAS float* Es = (LAS float*)(lds + 8 * 8704);
    S5C K; s5_load_consts(K, a->ws, lg, lane);
    const float* dvec = a->in[24] + l * 512 + g * 16;
    const int rowb = b * 2048 + wave * 256;
    float hre[2] = {0.f, 0.f}, him[2] = {0.f, 0.f};
    for (int tl = 0; tl < 8; ++tl) s5_tile<false>(K, U, rowb + tl * 32, g, 8, 32, hre, him, Hs, dvec, YC0, lane);
    if (lane < 32) { Es[(wave * 4 + 0) * 32 + lane] = hre[0]; Es[(wave * 4 + 1) * 32 + lane] = hre[1]; Es[(wave * 4 + 2) * 32 + lane] = him[0]; Es[(wave * 4 + 3) * 32 + lane] = him[1]; }
    __syncthreads();
    { const float* A256 = (const float*)(a->ws + WS_TAB + TB_ABAR256); float pr[2], pi[2];
#pragma unroll
      for (int st = 0; st < 2; ++st) { const int p = st * 32 + (lane & 31); pr[st] = A256[((size_t)lg * 64 + p) * 2]; pi[st] = A256[((size_t)lg * 64 + p) * 2 + 1]; hre[st] = 0.f; him[st] = 0.f; }
      for (int w = 0; w < wave; ++w) {
#pragma unroll
          for (int st = 0; st < 2; ++st) { const float er = Es[(w * 4 + st) * 32 + (lane & 31)], ei = Es[(w * 4 + 2 + st) * 32 + (lane & 31)];
              const float nr = pr[st] * hre[st] - pi[st] * him[st] + er, ni = pr[st] * him[st] + pi[st] * hre[st] + ei; hre[st] = nr; him[st] = ni; } } }
    for (int tl = 0; tl < 8; ++tl) s5_tile<true>(K, U, rowb + tl * 32, g, 8, 32, hre, him, Hs, dvec, YC0, lane);
    if (wave == 7 && lane < 32) {
#pragma unroll
        for (int st = 0; st < 2; ++st) { a->out[OFF_SRP + ((size_t)(l * 8 + b) * 32 + g) * 64 + st * 32 + lane] = hre[st]; a->out[OFF_SIP + ((size_t)(l * 8 + b) * 32 + g) * 64 + st * 32 + lane] = him[st]; } }
    __syncthreads();
}
DI void s5_sample_task(LAS unsigned char* lds, int task, int l, ArgsP a, const float* U, bf16_t* YC0, int tid) {
    const int bs = task >> 5, g = task & 31, lg = l * 32 + g, wave = tid >> 6, lane = tid & 63;
    LAS bf16_t* Hs = (LAS bf16_t*)(lds + wave * 8704);
    S5C K; s5_load_consts(K, a->ws, lg, lane);
    const size_t so = ((size_t)(l * 128 + bs) * 32 + g) * 64;
    float hre[2], him[2];
#pragma unroll
    for (int st = 0; st < 2; ++st) { hre[st] = a->in[5][so + st * 32 + (lane & 31)]; him[st] = a->in[6][so + st * 32 + (lane & 31)]; }
    s5_tile<true>(K, U, MP + bs * 4, g, 1, 4, hre, him, Hs, a->in[24] + l * 512 + g * 16, YC0, lane);
    if (lane < 32) {
#pragma unroll
        for (int st = 0; st < 2; ++st) { a->out[OFF_SRS + so + st * 32 + lane] = hre[st]; a->out[OFF_SIS + so + st * 32 + lane] = him[st]; } }
}

DI void mixers_phase(ArgsP a, LAS unsigned char* lds, int l, int tid) {
    unsigned char* ws = a->ws;
    const float* XA = (const float*)(ws + WS_XA); const float* U = (const float*)(ws + WS_U);
    const bf16_t* Q = (const bf16_t*)(ws + WS_Q); const bf16_t* KB = (const bf16_t*)(ws + WS_K); const bf16_t* VB = (const bf16_t*)(ws + WS_V);
    bf16_t* Dm = (bf16_t*)(ws + WS_DYY); bf16_t* YB = Dm + (size_t)M * 512; bf16_t* YC0 = (bf16_t*)(ws + WS_YC0);
    const int wave = tid >> 6, lane = tid & 63, gw = blockIdx.x * 8 + wave, NGW = gridDim.x * 8;
    for (int rp = 0; rp < 1 + ((MIXM >> 0) & 1); ++rp) for (int u = blockIdx.x; u < 256; u += gridDim.x) attn_prompt_unit(lds, u, Q, KB, VB, YB, a->in[16] + l * 8, tid);
    for (int rp = 0; rp < 1 + ((MIXM >> 1) & 1); ++rp) for (int t = blockIdx.x; t < 256; t += gridDim.x) s5_prompt_task(lds, t, l, a, U, YC0, tid);
    for (int rp = 0; rp < 1 + ((MIXM >> 2) & 1); ++rp) for (int t = gw; t < 4096; t += NGW) s5_sample_task(lds, t, l, a, U, YC0, tid);
    __syncthreads();
    for (int rp = 0; rp < 1 + ((MIXM >> 3) & 1); ++rp) for (int t = gw; t < 1024; t += NGW) attn_sample_task(lds + wave * 4096, t, l, a, Q, YB, lane);
    for (int rp = 0; rp < 1 + ((MIXM >> 4) & 1); ++rp) pool_phase(a, l, XA, Dm, tid);
}

__global__ void __launch_bounds__(512, 2) mega(Args a_unused) {
    extern __shared__ __attribute__((aligned(16))) unsigned char lds_raw[];
    LAS unsigned char* lds = (LAS unsigned char*)lds_raw;
    cg::grid_group grid = cg::this_grid();
    const int wave_s = __builtin_amdgcn_readfirstlane((int)threadIdx.x >> 6);
    volatile LAS unsigned* bst = (volatile LAS unsigned*)(lds + 135168);
    if (threadIdx.x < 2) bst[threadIdx.x] = 0u;
    __syncthreads();
    XcdBarrier xbar = xcd_barrier_post((unsigned*)(((ArgsP)__builtin_amdgcn_kernarg_segment_ptr())->ws), bst);
    const int ph_lo = ((ArgsP)__builtin_amdgcn_kernarg_segment_ptr())->ph_lo, ph_hi = ((ArgsP)__builtin_amdgcn_kernarg_segment_ptr())->ph_hi;
    for (int ph = ph_lo; ph < ph_hi; ++ph) {
        const int kk9 = (ph - 2) % 9;
        const int cls = ph == 0 ? 0 : ph == 1 ? 1 : ph == NPHASE - 1 ? 10 : (kk9 == 0 || kk9 == 6) ? 2 : kk9 == 1 ? 3 : kk9 == 2 ? 4 : kk9 == 3 ? 5 : kk9 == 4 ? 6 : kk9 == 5 ? 7 : kk9 == 7 ? 8 : 9;
        const int nrep = 1 + ((REPM >> cls) & 1);
        for (int rep = 0; rep < nrep; ++rep) {
        ArgsP a = (ArgsP)__builtin_amdgcn_kernarg_segment_ptr(); asm volatile("" : "+s"(a));
        int G = gridDim.x, c = blockIdx.x; asm volatile("" : "+s"(G), "+s"(c));
        int tid = wave_s * 64 + lane_id_v(); asm volatile("" : "+v"(tid));
        unsigned char* ws = a->ws;
        float* X = a->out;
        float* MOD = (float*)(ws + WS_MOD);
        bf16_t* H = (bf16_t*)(ws + WS_H);
        if (ph == 0) { if (PHM & 1) prologue(a, lds, tid); }
        else if (ph == 1) { if (PHM & 4) {
            pg8::Gemm g{(const bf16_t*)(ws + WS_CA), (const bf16_t*)(ws + WS_GT), 256, NMOD, 1024}; pg8::StaticOrder S; S.init(256, NMOD, G, c);
            pg8::EpiMod E{MOD, a->in[12]};
            pg8::gemm_phase<pg8::EpiMod, pg8::StaticOrder, true, true>(lds, g, S, E, wave_s * 64 + lane_id_v()); }
        } else if (ph == NPHASE - 1) norm_phase(X, X, a->in[32], MOD, 0, nullptr, tid, (const float*)(ws + WS_DYY), 22, MOD + 3 * 6144 + 5120, X);
        else {
            const int l = (ph - 2) / 9, k = (ph - 2) % 9;
            const float* xp = l == 0 ? a->in[0] : X; const float* xs = l == 0 ? a->in[1] - (size_t)MP * 1024 : X;
            if (k == 0) norm_phase(xp, xs, a->in[9] + l * 1024, MOD + l * 6144, 1024, H, tid, (const float*)(ws + WS_DYY), l == 0 ? 0 : 22, MOD + (l - 1) * 6144 + 5120, X);
            else if (k == 1) { if (GM & 1) {
                pg8::Gemm g{H, (const bf16_t*)(ws + WS_WIN) + (size_t)l * IN_COLS * 1024, M, IN_COLS, 1024}; pg8::StaticOrder S; S.init(M, IN_COLS, G, c);
                pg8::EpiIn E{(float*)(ws + WS_XA), (float*)(ws + WS_U), (bf16_t*)(ws + WS_Q), (bf16_t*)(ws + WS_K), (bf16_t*)(ws + WS_V), (bf16_t*)(ws + WS_GT),
                             (const float*)(ws + WS_TAB + TB_ROPEC), (const float*)(ws + WS_TAB + TB_ROPES), a->out, l};
                pg8::gemm_phase<pg8::EpiIn, pg8::StaticOrder, true, true>(lds, g, S, E, wave_s * 64 + lane_id_v()); }
            } else if (k == 2) { if (PHM & 2) mixers_phase(a, lds, l, tid); }
            else if (k == 3) { if (GM & 2) {
                pg8::Gemm g{(const bf16_t*)(ws + WS_YC0), (const bf16_t*)(ws + WS_WGLU) + (size_t)l * 512 * 512, M, 512, 512}; pg8::StaticOrder S; S.init(M, 512, G, c);
                pg8::EpiGlu E{(const bf16_t*)(ws + WS_YC0), (bf16_t*)(ws + WS_DYY) + (size_t)2 * M * 512};
                pg8::gemm_phase<pg8::EpiGlu, pg8::StaticOrder, true, true>(lds, g, S, E, wave_s * 64 + lane_id_v()); }
            } else if (k == 4) { if (GM & 4) {
                { pg8::Gemm g{(const bf16_t*)(ws + WS_DYY), (const bf16_t*)(ws + WS_WBR) + (size_t)l * 3072 * 512, 3 * M, 3072, 512, 0, 0}; pg8::BranchOrder S{G, c};
                  pg8::EpiMerge E{(const bf16_t*)(ws + WS_GT), (float*)(ws + WS_XA), H};
                  pg8::gemm_phase<pg8::EpiMerge, pg8::BranchOrder, true, true>(lds, g, S, E, wave_s * 64 + lane_id_v()); }
                { pg8::Gemm g{(const bf16_t*)(ws + WS_DYY), (const bf16_t*)(ws + WS_WBR) + (size_t)l * 3072 * 512, 3 * M, 3072, 128, 512, 512}; pg8::SplitOrder S{G, c, 4, 3};
                  pg8::EpiPart E{(float*)(ws + WS_Q), (const bf16_t*)(ws + WS_GT), 4};
                  pg8::gemm_phase<pg8::EpiPart, pg8::SplitOrder, true, true>(lds, g, S, E, wave_s * 64 + lane_id_v()); } }
            } else if (k == 5) { if (GM & 8) {
                { pg8::Gemm g{H, (const bf16_t*)(ws + WS_WOUT) + (size_t)l * 1024 * 1024, MP, 1024, 1024, 0, 0}; pg8::StaticOrder S; S.init(MP, 1024, G, c);
                  pg8::EpiRes E{xp, rep ? (float*)(ws + WS_XA) : X, MOD + l * 6144 + 2048};
                  pg8::gemm_phase<pg8::EpiRes, pg8::StaticOrder, true, true>(lds, g, S, E, wave_s * 64 + lane_id_v()); }
                for (int j = c; j < 64; j += G) { const int ks = j & 7, pmr = j >> 5; const float* Pm = (const float*)(ws + WS_Q);
                    for (int e2 = wave_s * 64 + lane_id_v(); e2 < 256 * 32; e2 += 512) { const int rs = pmr * 256 + (e2 >> 5), c4 = ks * 128 + (e2 & 31) * 4; f32x4 s = {0.f, 0.f, 0.f, 0.f};
#pragma unroll
                        for (int p = 0; p < 12; ++p) s += *(const f32x4*)(Pm + ((size_t)p * 512 + rs) * 1024 + c4);
                        st_bf4(H + (size_t)(MP + rs) * 1024 + c4, s); } }
                asm volatile("s_waitcnt vmcnt(0)" ::: "memory"); __syncthreads();
                { pg8::Gemm g{H, (const bf16_t*)(ws + WS_WOUT) + (size_t)l * 1024 * 1024, M, 1024, 128, 1024, 1024}; pg8::SplitOrder S{G, c, 8, 1};
                  pg8::EpiPart E{(float*)(ws + WS_YC0), nullptr, 8};
                  pg8::gemm_phase<pg8::EpiPart, pg8::SplitOrder, true, true>(lds, g, S, E, wave_s * 64 + lane_id_v()); } }
            } else if (k == 6) norm_phase(X, xs, a->in[10] + l * 1024, MOD + l * 6144 + 3072, 1024, H, tid, (const float*)(ws + WS_YC0), 8, MOD + l * 6144 + 2048, X);
            else if (k == 7) { if (GM & 16) {
                pg8::Gemm g{H, (const bf16_t*)(ws + WS_WFI) + (size_t)l * 2 * DFF * 1024, M, 2 * DFF, 1024}; pg8::StaticOrder S; S.init(M, 2 * DFF, G, c);
                pg8::EpiFfn E{(bf16_t*)(ws + WS_GT)};
                pg8::gemm_phase<pg8::EpiFfn, pg8::StaticOrder, true, true>(lds, g, S, E, wave_s * 64 + lane_id_v()); }
            } else if (GM & 32) {
                { pg8::Gemm g{(const bf16_t*)(ws + WS_GT), (const bf16_t*)(ws + WS_WFO) + (size_t)l * 1024 * DFF, MP, 1024, DFF, 0, 0}; pg8::StaticOrder S; S.init(MP, 1024, G, c);
                  pg8::EpiRes E{X, rep ? (float*)(ws + WS_XA) : X, MOD + l * 6144 + 5120};
                  pg8::gemm_phase<pg8::EpiRes, pg8::StaticOrder, true, true>(lds, g, S, E, wave_s * 64 + lane_id_v()); }
                { pg8::Gemm g{(const bf16_t*)(ws + WS_GT), (const bf16_t*)(ws + WS_WFO) + (size_t)l * 1024 * DFF, M, 1024, 128, DFF, DFF}; pg8::SplitOrder S{G, c, 22, 1};
                  pg8::EpiPart E{(float*)(ws + WS_DYY), nullptr, 22};
                  pg8::gemm_phase<pg8::EpiPart, pg8::SplitOrder, true, true>(lds, g, S, E, wave_s * 64 + lane_id_v()); }
            }
        }
        if (REPM && rep + 1 < nrep) __syncthreads();
        }
        if (ph + 1 < ph_hi) { if (SYNC2 == 1 || ph_hi > 1000) grid.sync(); else { XcdBarrier xb = xbar; asm volatile("" : "+s"(xb.x), "+s"(xb.bar));
            xcd_barrier(xb); if (SYNC2 == 2) xcd_barrier(xb); } }
    }
}

extern "C" void kernel_launch(void* const* d_in, const int* in_sizes, int n_in, void* d_out, int out_size, void* d_ws, size_t ws_size, hipStream_t stream) {
    static int grid = 0;
    if (grid == 0) {
        if (n_in != 33 || (size_t)out_size != OUT_TOTAL || ws_size < WS_END) { fprintf(stderr, "kernel_launch: unexpected shapes: n_in %d out %d ws %zu (need %zu)\n", n_in, out_size, ws_size, (size_t)WS_END); grid = -1; return; }
        int dev = 0, cus = 0, per_cu = 0;
        (void)hipGetDevice(&dev); (void)hipDeviceGetAttribute(&cus, hipDeviceAttributeMultiprocessorCount, dev);
        if (hipFuncSetAttribute((const void*)mega, hipFuncAttributeMaxDynamicSharedMemorySize, LDS_BYTES) != hipSuccess) { fprintf(stderr, "kernel_launch: hipFuncSetAttribute failed\n"); grid = -1; return; }
        if (hipOccupancyMaxActiveBlocksPerMultiprocessor(&per_cu, (const void*)mega, 512, LDS_BYTES) != hipSuccess || per_cu < 1) { fprintf(stderr, "kernel_launch: occupancy query says %d\n", per_cu); per_cu = 1; }
        (void)hipGetLastError();
        grid = cus * 1;
        if (grid <= 0) grid = 256;
    }
    if (grid < 0) return;
    Args a{};
    for (int i = 0; i < 33; ++i) a.in[i] = (const float*)d_in[i];
    a.out = (float*)d_out; a.ws = (unsigned char*)d_ws;
    for (int j = 0; j < 8; ++j) a.rfix[j] = (unsigned long long)ldexpl(powl(500000.0L, -(long double)j / 8.0L) / (2.0L * 3.14159265358979323846264338327950288L), 64);
#if MK_MULTI
    for (int ph = 0; ph < NPHASE; ++ph) { a.ph_lo = ph; a.ph_hi = ph + 1; hipLaunchKernelGGL(mega, dim3(grid), dim3(512), LDS_BYTES, stream, a); }
#else
    a.ph_lo = 0; a.ph_hi = NPHASE;
    if (hipMemsetAsync(d_ws, 0, 16384, stream) != hipSuccess) { fprintf(stderr, "kernel_launch: memset failed\n"); return; }
    void* args[] = {&a};
    hipError_t e = hipLaunchCooperativeKernel((const void*)mega, dim3(grid), dim3(512), args, LDS_BYTES, stream);
    if (e != hipSuccess) fprintf(stderr, "kernel_launch: cooperative launch failed: %s (grid %d)\n", hipGetErrorString(e), grid);
#endif
}
```

```cpp
#include <hip/hip_runtime.h>
#include <hip/hip_cooperative_groups.h>
#include <cstdio>
#include <cstdint>
#include <cmath>
namespace cg = cooperative_groups;

#ifndef MK_MULTI
#define MK_MULTI 0
#endif

__device__ __forceinline__ int lane_id_v() { int l; asm volatile("v_mbcnt_lo_u32_b32 %0, -1, 0\n\tv_mbcnt_hi_u32_b32 %0, -1, %0" : "=v"(l)); return l; }
__device__ __forceinline__ float shx(float v, int mask, int lane) { return __builtin_bit_cast(float, __builtin_amdgcn_ds_bpermute((lane ^ mask) << 2, __builtin_bit_cast(int, v))); }

__device__ __forceinline__ float shx32(float v, int upper  ) { const unsigned x = __builtin_bit_cast(unsigned, v); auto r = __builtin_amdgcn_permlane32_swap(x, x, false, false); return __builtin_bit_cast(float, upper ? r[0] : r[1]); }
__device__ __forceinline__ float shx16(float v, int odd  ) { const unsigned x = __builtin_bit_cast(unsigned, v); auto r = __builtin_amdgcn_permlane16_swap(x, x, false, false); return __builtin_bit_cast(float, odd ? r[0] : r[1]); }

namespace cfg {
constexpr int D = 1024, MP = 16384, MS = 512, M = MP + MS, SEQ = 2048, NBAT = 136, DEPTH = 4;
constexpr int IN_COLS = 4864, DFF = 2816, NMOD = 6 * D * DEPTH;
constexpr size_t OFF_Y = 0;
constexpr size_t OFF_KP = (size_t)M * D;
constexpr size_t OFF_VP = OFF_KP + (size_t)4 * 8 * 128 * 128;
constexpr size_t OFF_PP = OFF_VP + (size_t)4 * 8 * 128 * 128;
constexpr size_t OFF_SRP = OFF_PP + (size_t)4 * 8 * 15 * 512;
constexpr size_t OFF_SIP = OFF_SRP + (size_t)4 * 8 * 32 * 64;
constexpr size_t OFF_KS = OFF_SIP + (size_t)4 * 8 * 32 * 64;
constexpr size_t OFF_VS = OFF_KS + (size_t)4 * 128 * 128 * 128;
constexpr size_t OFF_PS = OFF_VS + (size_t)4 * 128 * 128 * 128;
constexpr size_t OFF_SRS = OFF_PS + (size_t)4 * 128 * 15 * 512;
constexpr size_t OFF_SIS = OFF_SRS + (size_t)4 * 128 * 32 * 64;
constexpr size_t OUT_TOTAL = OFF_SIS + (size_t)4 * 128 * 32 * 64;
static_assert(OUT_TOTAL == 41533440, "output size");
constexpr size_t MiB = 1u << 20;
constexpr size_t WS_WIN = 1 * MiB;
constexpr size_t WS_WGLU = WS_WIN + 38 * MiB;
constexpr size_t WS_WBR = WS_WGLU + 2 * MiB;
constexpr size_t WS_WOUT = WS_WBR + 12 * MiB;
constexpr size_t WS_WFI = WS_WOUT + 8 * MiB;
constexpr size_t WS_WFO = WS_WFI + 44 * MiB;
constexpr size_t WS_MOD = WS_WFO + 22 * MiB;
constexpr size_t WS_CA = WS_MOD + 13 * MiB;
constexpr size_t WS_TAB = WS_CA + 1 * MiB;
constexpr size_t WS_H = WS_TAB + 2 * MiB;
constexpr size_t WS_XA = WS_H + 33 * MiB;
constexpr size_t WS_U = WS_XA + 33 * MiB;
constexpr size_t WS_Q = WS_U + 33 * MiB;
constexpr size_t WS_K = WS_Q + 17 * MiB;
constexpr size_t WS_V = WS_K + 5 * MiB;
constexpr size_t WS_DYY = WS_V + 5 * MiB;
constexpr size_t WS_YC0 = WS_DYY + 50 * MiB;
constexpr size_t WS_GT = WS_YC0 + 17 * MiB;
constexpr size_t WS_END = WS_GT + 99 * MiB;
static_assert((size_t)M * 512 * 2 * 3 <= 50 * MiB && (size_t)M * 3072 * 2 <= 99 * MiB && (size_t)M * 1024 * 2 <= 33 * MiB, "ws map");
constexpr size_t TB_ROPEC = 0;
constexpr size_t TB_ROPES = 65664;
constexpr size_t TB_ABAR = 131328;
constexpr size_t TB_ABAR256 = TB_ABAR + 65536;
constexpr size_t TB_BBF = 262400;
constexpr size_t TB_CF = TB_BBF + 524288;
static_assert(TB_CF + 524288 <= 2 * MiB, "tables");
constexpr int LDS_BYTES = 147456;
constexpr int NPHASE = 2 + 9 * DEPTH + 1;
}

namespace pg8 {
#define PG8_LAS __attribute__((address_space(3)))
typedef unsigned short bf16_t;
typedef short bf16x8 __attribute__((ext_vector_type(8)));
typedef float f32x4 __attribute__((ext_vector_type(4)));
typedef unsigned u32x4 __attribute__((ext_vector_type(4)));
constexpr int BM = 256, BK = 64, HALF = 128, HTB = HALF * BK * 2  , STAGE_BYTES = 8 * HTB, NXCD = 8, WGM = 8;

__host__ __device__ __forceinline__ int lds_byte(int r, int c) { const int st = (r >> 4) * 2 + (c >> 5), rr = r & 15, cc = c & 31, ob = rr * 64 + cc * 2; return st * 1024 + (ob ^ (((ob >> 9) & 1) << 5)); }
__host__ __device__ __forceinline__ void stage_rc(int b, int& R, int& C) { const int st = b / 1024, sb = b % 1024, swz = sb ^ (((sb >> 9) & 1) << 5); R = (st >> 1) * 16 + swz / 64; C = (st & 1) * 32 + (swz % 64) / 2; }
__host__ __device__ __forceinline__ int perm32(int rho) { const int n = rho >> 4, i = rho & 15; return 8 * (i >> 2) + 4 * n + (i & 3); }

struct Unit { int pm, pn, k0; };
struct Gemm { const bf16_t* A; const bf16_t* Bt; int M, N, K, lda, ldb; };

struct StaticOrder {
    int nM, nN, nwg, G, c;
    __host__ __device__ void init(int M, int N, int G_, int c_) { nM = M / BM; nN = N / BM; nwg = nM * nN; G = G_; c = c_; }
    __host__ __device__ bool next(int i, Unit& u) const {
        const long L = (long)i * G + c; if (L >= nwg) return false;
        int wgid = (int)L; { const int q = nwg / NXCD, r = nwg % NXCD, xcd = wgid % NXCD, off = wgid / NXCD; wgid = (xcd < r ? xcd * (q + 1) : r * (q + 1) + (xcd - r) * q) + off; }
        const int nig = WGM * nN, gid = wgid / nig, fm = gid * WGM, gsz = (nM - fm) < WGM ? (nM - fm) : WGM;
        u.pm = fm + ((wgid % nig) % gsz); u.pn = (wgid % nig) / gsz; u.k0 = 0; return true;
    }
    __device__ __forceinline__ void a_ready(const Unit&) const {}
    __device__ __forceinline__ void done(const Unit&) const {}
};

__device__ __forceinline__ unsigned cvt_pk_bf16(float lo, float hi) { unsigned r; asm volatile("v_cvt_pk_bf16_f32 %0, %1, %2" : "=v"(r) : "v"(lo), "v"(hi)); return r; }
typedef unsigned u32x2 __attribute__((ext_vector_type(2)));
__device__ __forceinline__ float sigm(float x) { return __builtin_amdgcn_rcpf(1.f + __expf(-x)); }
__device__ __forceinline__ f32x4 ld_bf4(const bf16_t* p) { const u32x2 w = *(const u32x2*)p; f32x4 r; r[0] = __uint_as_float(w.x << 16); r[1] = __uint_as_float(w.x & 0xffff0000u); r[2] = __uint_as_float(w.y << 16); r[3] = __uint_as_float(w.y & 0xffff0000u); return r; }
__device__ __forceinline__ void st_bf4(bf16_t* p, const f32x4 v) { u32x2 w; w.x = cvt_pk_bf16(v[0], v[1]); w.y = cvt_pk_bf16(v[2], v[3]); *(u32x2*)p = w; }
__device__ __forceinline__ int batch_of(int row) { return row < cfg::MP ? (row >> 11) : 8 + ((row - cfg::MP) >> 2); }

struct EpiMod {
    static constexpr bool PERM = true, AFTER_DRAIN = false;
    float* MOD; const float* bada;
    __device__ __forceinline__ void operator()(const f32x4 (&acc)[2][2][4][2], const Unit& u, int wr, int wc, int fr, int fq) const {
#pragma unroll
        for (int ai = 0; ai < 2; ++ai)
#pragma unroll
            for (int m = 0; m < 4; ++m) { const int row = u.pm * 256 + ai * 128 + wr * 64 + m * 16 + fr;
                if (row < cfg::NBAT) {
#pragma unroll
                    for (int bj = 0; bj < 2; ++bj)
#pragma unroll
                        for (int n = 0; n < 2; ++n) { const int col = u.pn * 256 + bj * 128 + wc * 32 + 8 * fq + 4 * n;
                            *(f32x4*)(MOD + (size_t)row * cfg::NMOD + col) = acc[ai][bj][m][n] + *(const f32x4*)(bada + col); } } }
    }
};

struct EpiIn {
    static constexpr bool PERM = true, AFTER_DRAIN = false;
    float* XA; float* U; bf16_t* Q; bf16_t* KB; bf16_t* VB; bf16_t* GT; const float* ropec; const float* ropes; float* out; int layer;
    __device__ __forceinline__ void operator()(const f32x4 (&acc)[2][2][4][2], const Unit& u, int wr, int wc, int fr, int fq) const {
        const int pn = u.pn;
#pragma unroll
        for (int ai = 0; ai < 2; ++ai)
#pragma unroll
            for (int m = 0; m < 4; ++m) { const int row = u.pm * 256 + ai * 128 + wr * 64 + m * 16 + fr;
#pragma unroll
                for (int bj = 0; bj < 2; ++bj)
#pragma unroll
                    for (int n = 0; n < 2; ++n) { const int tc = bj * 128 + wc * 32 + 8 * fq + 4 * n; f32x4 v = acc[ai][bj][m][n];
                        if (pn < 2) { *(f32x4*)(XA + (size_t)row * 512 + pn * 256 + tc) = v; }
                        else if (pn <= 4) {
                            const bool isv = (pn == 4 && bj == 1);
                            if (!isv && (wc & 1) == 0) {
                                const int tix = row < cfg::MP ? (row & 2047) : 2048 + (row & 3);
                                const f32x4 cs = *(const f32x4*)(ropec + tix * 8 + 4 * n), sn = *(const f32x4*)(ropes + tix * 8 + 4 * n);
#pragma unroll
                                for (int i = 0; i < 4; ++i) { const float p = shx16(v[i], fq & 1); const float rv = v[i] * cs[i] + (fq == 0 ? -p : p) * sn[i]; v[i] = fq < 2 ? rv : v[i]; }
                            }
                            if (pn < 4) st_bf4(Q + (size_t)row * 512 + (pn - 2) * 256 + tc, v);
                            else { st_bf4((bj == 0 ? KB : VB) + (size_t)row * 128 + (tc & 127), v);
                                bool w = false; size_t o = 0;
                                if (row < cfg::MP) { const int t = row & 2047; if (t >= 1920) { w = true; o = (bj == 0 ? cfg::OFF_KP : cfg::OFF_VP) + ((size_t)(layer * 8 + (row >> 11)) * 128 + (t - 1920)) * 128 + (tc & 127); } }
                                else { const int rs = row - cfg::MP; w = true; o = (bj == 0 ? cfg::OFF_KS : cfg::OFF_VS) + ((size_t)(layer * 128 + (rs >> 2)) * 128 + 124 + (rs & 3)) * 128 + (tc & 127); }
                                if (w) *(f32x4*)(out + o) = v; }
                        }
                        else if (pn < 7) { *(f32x4*)(U + (size_t)row * 512 + (pn - 5) * 256 + tc) = v; }
                        else { f32x4 s; s[0] = sigm(v[0]); s[1] = sigm(v[1]); s[2] = sigm(v[2]); s[3] = sigm(v[3]); st_bf4(GT + (size_t)row * 3072 + (pn - 7) * 256 + tc, s); }
                    } }
    }
};

struct EpiGlu {
    static constexpr bool PERM = true, AFTER_DRAIN = false;
    const bf16_t* YC0; bf16_t* YC;
    __device__ __forceinline__ void operator()(const f32x4 (&acc)[2][2][4][2], const Unit& u, int wr, int wc, int fr, int fq) const {
#pragma unroll
        for (int ai = 0; ai < 2; ++ai)
#pragma unroll
            for (int m = 0; m < 4; ++m) { const int row = u.pm * 256 + ai * 128 + wr * 64 + m * 16 + fr;
#pragma unroll
                for (int bj = 0; bj < 2; ++bj)
#pragma unroll
                    for (int n = 0; n < 2; ++n) { const int col = u.pn * 256 + bj * 128 + wc * 32 + 8 * fq + 4 * n; const f32x4 v = acc[ai][bj][m][n];
                        const f32x4 y0 = ld_bf4(YC0 + (size_t)row * 512 + col); f32x4 o;
#pragma unroll
                        for (int i = 0; i < 4; ++i) o[i] = y0[i] * sigm(v[i]);
                        st_bf4(YC + (size_t)row * 512 + col, o); } }
    }
};

struct EpiMerge {
    static constexpr bool PERM = true, AFTER_DRAIN = false;
    const bf16_t* GT; float* M32; bf16_t* M16;
    __device__ __forceinline__ void operator()(const f32x4 (&acc)[2][2][4][2], const Unit& u, int wr, int wc, int fr, int fq) const {
        const int br = u.pm / 66, pm = u.pm - br * 66, pn = u.pn & 3;
        if (br > 0) asm volatile("s_waitcnt vmcnt(0)" ::: "memory");
#pragma unroll
        for (int ai = 0; ai < 2; ++ai)
#pragma unroll
            for (int m = 0; m < 4; ++m) { const int row = pm * 256 + ai * 128 + wr * 64 + m * 16 + fr;
#pragma unroll
                for (int bj = 0; bj < 2; ++bj)
#pragma unroll
                    for (int n = 0; n < 2; ++n) { const int col = pn * 256 + bj * 128 + wc * 32 + 8 * fq + 4 * n; const f32x4 v = acc[ai][bj][m][n];
                        const f32x4 g = ld_bf4(GT + (size_t)row * 3072 + br * 1024 + col);
                        bf16_t* mp = M16 + (size_t)row * 1024 + col;
                        if (br == 0) st_bf4(mp, g * v); else st_bf4(mp, ld_bf4(mp) + g * v); } }
    }
};

struct EpiRes {
    static constexpr bool PERM = true, AFTER_DRAIN = false;
    const float* xin; float* X; const float* MODG;
    __device__ __forceinline__ void operator()(const f32x4 (&acc)[2][2][4][2], const Unit& u, int wr, int wc, int fr, int fq) const {
        const float* gp = MODG + (size_t)(u.pm >> 3) * cfg::NMOD + u.pn * 256 + wc * 32 + 8 * fq;
        f32x4 g[2][2];
#pragma unroll
        for (int bj = 0; bj < 2; ++bj)
#pragma unroll
            for (int n = 0; n < 2; ++n) g[bj][n] = *(const f32x4*)(gp + bj * 128 + n * 4);
#pragma unroll
        for (int ai = 0; ai < 2; ++ai)
#pragma unroll
            for (int m = 0; m < 4; ++m) { const int row = u.pm * 256 + ai * 128 + wr * 64 + m * 16 + fr;
#pragma unroll
                for (int bj = 0; bj < 2; ++bj)
#pragma unroll
                    for (int n = 0; n < 2; ++n) { const size_t o = (size_t)row * 1024 + u.pn * 256 + bj * 128 + wc * 32 + 8 * fq + 4 * n;
                        *(f32x4*)(X + o) = *(const f32x4*)(xin + o) + g[bj][n] * acc[ai][bj][m][n]; } }
    }
};

struct EpiPart {
    static constexpr bool PERM = true, AFTER_DRAIN = false;
    float* P; const bf16_t* GT; int nks;
    __device__ __forceinline__ void operator()(const f32x4 (&acc)[2][2][4][2], const Unit& u, int wr, int wc, int fr, int fq) const {
        const int br = u.pm / 66, pmr = u.pm - br * 66 - 64, pn = u.pn & 3, slice = br * nks + (u.k0 >> 7);
#pragma unroll
        for (int ai = 0; ai < 2; ++ai)
#pragma unroll
            for (int m = 0; m < 4; ++m) { const int rs = pmr * 256 + ai * 128 + wr * 64 + m * 16 + fr;
#pragma unroll
                for (int bj = 0; bj < 2; ++bj)
#pragma unroll
                    for (int n = 0; n < 2; ++n) { const int col = pn * 256 + bj * 128 + wc * 32 + 8 * fq + 4 * n; f32x4 v = acc[ai][bj][m][n];
                        if (GT) v = v * ld_bf4(GT + (size_t)(cfg::MP + rs) * 3072 + br * 1024 + col);
                        *(f32x4*)(P + ((size_t)slice * 512 + rs) * 1024 + col) = v; } }
    }
};

struct EpiFfn {
    static constexpr bool PERM = true, AFTER_DRAIN = false;
    bf16_t* ACT;
    __device__ __forceinline__ void operator()(const f32x4 (&acc)[2][2][4][2], const Unit& u, int wr, int wc, int fr, int fq) const {
#pragma unroll
        for (int ai = 0; ai < 2; ++ai)
#pragma unroll
            for (int m = 0; m < 4; ++m) { const int row = u.pm * 256 + ai * 128 + wr * 64 + m * 16 + fr;
#pragma unroll
                for (int n = 0; n < 2; ++n) { const int col = u.pn * 128 + wc * 32 + 8 * fq + 4 * n; const f32x4 a = acc[ai][0][m][n], b = acc[ai][1][m][n]; f32x4 o;
#pragma unroll
                    for (int i = 0; i < 4; ++i) o[i] = a[i] * sigm(a[i]) * b[i];
                    st_bf4(ACT + (size_t)row * cfg::DFF + col, o); } }
    }
};

struct BranchOrder {
    int G, c;
    __host__ __device__ bool next(int i, Unit& u) const { const int tile = c + (i / 3) * G; if (tile >= 256) return false; const int br = i % 3; u.pm = br * 66 + (tile >> 2); u.pn = br * 4 + (tile & 3); u.k0 = 0; return true; }
    __device__ __forceinline__ void a_ready(const Unit&) const {}
    __device__ __forceinline__ void done(const Unit&) const {}
};
struct SplitOrder {
    int G, c, nks, nbr;
    __host__ __device__ bool next(int i, Unit& u) const { const int j = c + i * G; if (j >= 8 * nbr * nks) return false; const int ks = j % nks, t = j / nks, br = t % nbr, tile = t / nbr;
        u.pm = br * 66 + 64 + (tile >> 2); u.pn = br * 4 + (tile & 3); u.k0 = ks * 128; return true; }
    __device__ __forceinline__ void a_ready(const Unit&) const {}
    __device__ __forceinline__ void done(const Unit&) const {}
};

template <class Epi, class Sched, bool ALIGN_EPI = false, bool SP2 = false>
__device__ __forceinline__ void gemm_phase(PG8_LAS unsigned char* lds, const Gemm g, const Sched& S, const Epi& E, const int tid_in) {
    int tid_l = tid_in; asm volatile("" : "+v"(tid_l));
    const int tid = tid_l, wid = __builtin_amdgcn_readfirstlane(tid >> 6), lane = tid & 63, wr = wid >> 2, wc = wid & 3, fr = lane & 15, fq = lane >> 4;
    const int K = g.K, nt = K / BK, lda = g.lda ? g.lda : K, ldb = lda;
    unsigned voffA[2], voffB[2];
#pragma unroll
    for (int i = 0; i < 2; ++i) { int R, C; stage_rc(tid * 16 + i * 8192, R, C); const int Rb = Epi::PERM ? ((R & ~31) + perm32(R & 31)) : R;
        voffA[i] = (unsigned)(R * lda + C) * 2u; voffB[i] = (unsigned)(Rb * ldb + C) * 2u; }
    const size_t kstep = (size_t)(BK * 2);
    const size_t hstepA = (size_t)HALF * lda * 2, hstepB = (size_t)HALF * ldb * 2;
    const size_t tstepA = 2 * hstepA, tstepB = 2 * hstepB;
    const unsigned ldsw = (unsigned)wid * 1024u;
    const int aoff = lds_byte(wr * 64 + fr, fq * 8), boff = lds_byte(wc * 32 + fr, fq * 8);
#define PG8_SA(b, h) (((b) * 2 + (h)) * HTB)
#define PG8_SB(b, h) ((4 + (b) * 2 + (h)) * HTB)
#define PG8_STAGE(bufoff, gbase, voff) do { _Pragma("unroll") for (int _i = 0; _i < 2; ++_i) \
        __builtin_amdgcn_global_load_lds((const unsigned*)((const char*)(gbase) + (voff)[_i]), (PG8_LAS unsigned*)(lds + (bufoff) + ldsw + _i * 8192), 16, 0, 0); } while (0)
#define PG8_LDA(dst, b, h) do { _Pragma("unroll") for (int m = 0; m < 4; ++m) _Pragma("unroll") for (int k = 0; k < 2; ++k) dst[m][k] = *(const PG8_LAS bf16x8*)(lds + PG8_SA(b, h) + aoff + m * 2048 + k * 1024); } while (0)
#define PG8_LDB(dst, b, h) do { _Pragma("unroll") for (int n = 0; n < 2; ++n) _Pragma("unroll") for (int k = 0; k < 2; ++k) dst[n][k] = *(const PG8_LAS bf16x8*)(lds + PG8_SB(b, h) + boff + n * 2048 + k * 1024); } while (0)
#define PG8_MMA(ai, bj, At, Bt) do { __builtin_amdgcn_s_setprio(1); _Pragma("unroll") for (int m = 0; m < 4; ++m) _Pragma("unroll") for (int n = 0; n < 2; ++n) _Pragma("unroll") for (int k = 0; k < 2; ++k) \
        acc[ai][bj][m][n] = __builtin_amdgcn_mfma_f32_16x16x32_bf16(Bt[n][k], At[m][k], acc[ai][bj][m][n], 0, 0, 0); __builtin_amdgcn_s_setprio(0); } while (0)
#define PG8_WAIT_V(n) asm volatile("s_waitcnt vmcnt(" #n ")" ::: "memory")
#define PG8_WAIT_L(n) asm volatile("s_waitcnt lgkmcnt(" #n ")" ::: "memory")
#define PG8_BAR __builtin_amdgcn_s_barrier()
#define PG8_SCHED __builtin_amdgcn_sched_barrier(0)
    Unit cur, nxt; int ui = 0;
    if (!S.next(0, cur)) return;
    f32x4 acc[2][2][4][2];
#pragma unroll
    for (int a = 0; a < 2; ++a)
#pragma unroll
        for (int b = 0; b < 2; ++b)
#pragma unroll
            for (int m = 0; m < 4; ++m)
#pragma unroll
                for (int n = 0; n < 2; ++n) acc[a][b][m][n] = (f32x4){0.f, 0.f, 0.f, 0.f};
    bf16x8 At[4][2], B0[2][2], B1[2][2];
    const char* cA = (const char*)g.A + (size_t)cur.pm * tstepA + (size_t)cur.k0 * 2; const char* cB = (const char*)g.Bt + (size_t)cur.pn * tstepB + (size_t)cur.k0 * 2;
    S.a_ready(cur);
    if constexpr (SP2) {
        PG8_STAGE(PG8_SB(0, 0), cB, voffB); PG8_STAGE(PG8_SB(0, 1), cB + hstepB, voffB); PG8_STAGE(PG8_SA(0, 0), cA, voffA); PG8_STAGE(PG8_SA(0, 1), cA + hstepA, voffA);
        if (wr == 1) PG8_BAR;
        PG8_WAIT_V(2); PG8_BAR;
        PG8_STAGE(PG8_SB(1, 0), cB + kstep, voffB); PG8_STAGE(PG8_SA(1, 0), cA + kstep, voffA); PG8_STAGE(PG8_SB(1, 1), cB + hstepB + kstep, voffB);
        PG8_WAIT_V(6); PG8_BAR;
    } else {
        PG8_STAGE(PG8_SB(0, 0), cB, voffB); PG8_STAGE(PG8_SA(0, 0), cA, voffA); PG8_STAGE(PG8_SB(0, 1), cB + hstepB, voffB); PG8_STAGE(PG8_SA(0, 1), cA + hstepA, voffA);
        if (wr == 1) PG8_BAR;
        PG8_WAIT_V(4); PG8_BAR;
        PG8_STAGE(PG8_SB(1, 0), cB + kstep, voffB); PG8_STAGE(PG8_SA(1, 0), cA + kstep, voffA); PG8_STAGE(PG8_SB(1, 1), cB + hstepB + kstep, voffB);
        PG8_WAIT_V(6); PG8_BAR;
    }
    for (;;) {
        const bool has_next = S.next(ui + 1, nxt);
        const char* nA = has_next ? (const char*)g.A + (size_t)nxt.pm * tstepA + (size_t)nxt.k0 * 2 : cA; const char* nB = has_next ? (const char*)g.Bt + (size_t)nxt.pn * tstepB + (size_t)nxt.k0 * 2 : cB;
        for (int t = 0; t < nt; t += 2) {
            const bool last = (t == nt - 2);
            const char* a1 = cA + (size_t)(t + 1) * kstep;
            const char* a2 = last ? nA : cA + (size_t)(t + 2) * kstep; const char* b2 = last ? nB : cB + (size_t)(t + 2) * kstep;
            const char* a3 = a2 + kstep; const char* b3 = b2 + kstep;
            if (last && has_next) S.a_ready(nxt);
            if constexpr (SP2) {
            PG8_LDB(B0, 0, 0); PG8_LDB(B1, 0, 1); PG8_SCHED; PG8_LDA(At, 0, 0); PG8_STAGE(PG8_SA(1, 1), a1 + hstepA, voffA);
            PG8_WAIT_V(8); PG8_WAIT_L(0); PG8_BAR; PG8_MMA(0, 0, At, B0); PG8_MMA(0, 1, At, B1); PG8_BAR; PG8_SCHED;
            PG8_LDA(At, 0, 1); PG8_STAGE(PG8_SB(0, 0), b2, voffB); PG8_STAGE(PG8_SB(0, 1), b2 + hstepB, voffB); PG8_STAGE(PG8_SA(0, 0), a2, voffA);
            PG8_WAIT_V(8); PG8_WAIT_L(0); PG8_BAR; PG8_MMA(1, 0, At, B0); PG8_MMA(1, 1, At, B1); PG8_BAR; PG8_SCHED;
            PG8_LDB(B0, 1, 0); PG8_LDB(B1, 1, 1); PG8_SCHED; PG8_LDA(At, 1, 0); PG8_STAGE(PG8_SA(0, 1), a2 + hstepA, voffA);
            PG8_WAIT_V(8); PG8_WAIT_L(0); PG8_BAR; PG8_MMA(0, 0, At, B0); PG8_MMA(0, 1, At, B1); PG8_BAR; PG8_SCHED;
            PG8_LDA(At, 1, 1); PG8_STAGE(PG8_SB(1, 0), b3, voffB); PG8_STAGE(PG8_SB(1, 1), b3 + hstepB, voffB); PG8_STAGE(PG8_SA(1, 0), a3, voffA);
            PG8_WAIT_V(8); PG8_WAIT_L(0); PG8_BAR; PG8_MMA(1, 0, At, B0); PG8_MMA(1, 1, At, B1); PG8_BAR; PG8_SCHED;
            } else {
            PG8_LDB(B0, 0, 0); PG8_SCHED; PG8_LDA(At, 0, 0); PG8_STAGE(PG8_SA(1, 1), a1 + hstepA, voffA);
            PG8_WAIT_L(8); PG8_BAR; PG8_WAIT_L(0); PG8_MMA(0, 0, At, B0); PG8_BAR; PG8_SCHED;
            PG8_LDB(B1, 0, 1); PG8_STAGE(PG8_SB(0, 0), b2, voffB);
            PG8_BAR; PG8_WAIT_L(0); PG8_MMA(0, 1, At, B1); PG8_BAR;
            PG8_LDA(At, 0, 1); PG8_STAGE(PG8_SA(0, 0), a2, voffA);
            PG8_BAR; PG8_WAIT_L(0); PG8_MMA(1, 0, At, B0); PG8_BAR; PG8_SCHED;
            PG8_STAGE(PG8_SB(0, 1), b2 + hstepB, voffB);
            PG8_WAIT_V(6); PG8_BAR; PG8_MMA(1, 1, At, B1); PG8_BAR;
            PG8_LDB(B0, 1, 0); PG8_SCHED; PG8_LDA(At, 1, 0); PG8_STAGE(PG8_SA(0, 1), a2 + hstepA, voffA);
            PG8_WAIT_L(8); PG8_BAR; PG8_WAIT_L(0); PG8_MMA(0, 0, At, B0); PG8_BAR; PG8_SCHED;
            PG8_LDB(B1, 1, 1); PG8_STAGE(PG8_SB(1, 0), b3, voffB);
            PG8_BAR; PG8_WAIT_L(0); PG8_MMA(0, 1, At, B1); PG8_BAR;
            PG8_LDA(At, 1, 1); PG8_STAGE(PG8_SA(1, 0), a3, voffA);
            PG8_BAR; PG8_WAIT_L(0); PG8_MMA(1, 0, At, B0); PG8_BAR; PG8_SCHED;
            PG8_STAGE(PG8_SB(1, 1), b3 + hstepB, voffB);
            PG8_WAIT_V(6); PG8_BAR; PG8_MMA(1, 1, At, B1); PG8_BAR;
            }
        }
        if constexpr (ALIGN_EPI) { if (wr == 0) PG8_BAR; }
        if constexpr (!Epi::AFTER_DRAIN) { E(acc, cur, wr, wc, fr, fq); S.done(cur); }
        if (!has_next) break;
#pragma unroll
        for (int a = 0; a < 2; ++a)
#pragma unroll
            for (int b = 0; b < 2; ++b)
#pragma unroll
                for (int m = 0; m < 4; ++m)
#pragma unroll
                    for (int n = 0; n < 2; ++n) acc[a][b][m][n] = (f32x4){0.f, 0.f, 0.f, 0.f};
        cur = nxt; cA = nA; cB = nB; ++ui;
        if constexpr (ALIGN_EPI) { if (wr == 1) PG8_BAR; }
    }
    PG8_WAIT_V(0);
    if constexpr (!ALIGN_EPI) { if (wr == 0) PG8_BAR; }
    PG8_BAR;
    if constexpr (Epi::AFTER_DRAIN) { E.fused(acc, cur, wr, wc, fr, fq, lds, wid, lane); S.done(cur); }
#undef PG8_SA
#undef PG8_SB
#undef PG8_STAGE
#undef PG8_LDA
#undef PG8_LDB
#undef PG8_MMA
#undef PG8_WAIT_V
#undef PG8_WAIT_L
#undef PG8_BAR
#undef PG8_SCHED
}
}

#define LAS __attribute__((address_space(3)))
#define DI __device__ __forceinline__
typedef unsigned short bf16_t;
typedef short bf16x8 __attribute__((ext_vector_type(8)));
typedef short s16x4 __attribute__((ext_vector_type(4)));
typedef float f32x4 __attribute__((ext_vector_type(4)));
typedef float f32x16 __attribute__((ext_vector_type(16)));
typedef unsigned u32x4 __attribute__((ext_vector_type(4)));
typedef unsigned u32x2 __attribute__((ext_vector_type(2)));
using pg8::cvt_pk_bf16; using pg8::sigm; using pg8::ld_bf4; using pg8::st_bf4; using pg8::batch_of;
using namespace cfg;

DI float bf2f(bf16_t b) { return __uint_as_float((unsigned)b << 16); }
DI unsigned f2bf(float f) { unsigned u = __float_as_uint(f); return (u + 0x7fffu + ((u >> 16) & 1u)) >> 16; }
DI float wave_sum(float v, int lane) {
#pragma unroll
    for (int o = 1; o < 64; o <<= 1) v += shx(v, o, lane);
    return v;
}
DI float wave_max(float v, int lane) {
#pragma unroll
    for (int o = 1; o < 64; o <<= 1) v = fmaxf(v, shx(v, o, lane));
    return v;
}
DI bf16x8 pack8(const f32x4 a, const f32x4 b) { u32x4 p; p.x = cvt_pk_bf16(a[0], a[1]); p.y = cvt_pk_bf16(a[2], a[3]); p.z = cvt_pk_bf16(b[0], b[1]); p.w = cvt_pk_bf16(b[2], b[3]); return __builtin_bit_cast(bf16x8, p); }
#define MFMA16(a, b, c) __builtin_amdgcn_mfma_f32_16x16x32_bf16((a), (b), (c), 0, 0, 0)
#define MFMA32(a, b, c) __builtin_amdgcn_mfma_f32_32x32x16_bf16((a), (b), (c), 0, 0, 0)

#define XB_TMO      128
#define XB_XCNT(j)  (256  + 64 * (j))
#define XB_XSUB(j)  (1280 + 64 * (j))
#define XB_XGEN(j)  (2304 + 64 * (j))
#define XB_TOP      3328
#define XB_TOPGEN   3392
#define XCD_BAR_WORDS 3456
#define XB_SPIN_CAP (1u << 18)

__device__ __forceinline__ unsigned xb_ld(unsigned* p)              { return __hip_atomic_load(p, __ATOMIC_RELAXED, __HIP_MEMORY_SCOPE_AGENT); }
__device__ __forceinline__ unsigned xb_add(unsigned* p, unsigned v) { return __hip_atomic_fetch_add(p, v, __ATOMIC_RELAXED, __HIP_MEMORY_SCOPE_AGENT); }
__device__ __forceinline__ unsigned xb_xcc_id() { return (unsigned)__builtin_amdgcn_s_getreg((3 << 11) | 20) & 0xFu; }
#define XB_SPIN(cond, bar) do { unsigned _sp = 0; while (cond) { __builtin_amdgcn_s_sleep(1); \
    if ((++_sp & 255u) == 0u) { if (xb_ld(&(bar)[XB_TMO])) break; if (_sp > XB_SPIN_CAP) { atomicAdd(&(bar)[XB_TMO], 1u); break; } } } } while (0)

struct XcdBarrier {
    unsigned* bar; unsigned x;
    volatile LAS unsigned* st;
};

__device__ __forceinline__ XcdBarrier xcd_barrier_post(unsigned* bar, volatile LAS unsigned* st) {
    XcdBarrier b; b.bar = bar; b.x = xb_xcc_id(); b.st = st;
    if (threadIdx.x == 0) (void)xb_add(&bar[XB_XCNT(b.x)], 1u);
    return b;
}
__device__ __forceinline__ void xcd_barrier_complete(unsigned* bar, unsigned x, unsigned& nloc, unsigned& nx) {
    const unsigned G = gridDim.x * gridDim.y * gridDim.z;
    unsigned sum, cnt, mine, sp = 0u;
    for (;;) {
        sum = 0u; cnt = 0u; mine = 0u;
#pragma unroll
        for (unsigned j = 0; j < 16; ++j) { const unsigned c = xb_ld(&bar[XB_XCNT(j)]); sum += c; cnt += (c > 0u) ? 1u : 0u; mine = (j == x) ? c : mine; }
        if (sum == G) break;
        __builtin_amdgcn_s_sleep(1);
        if ((++sp & 255u) == 0u) { if (xb_ld(&bar[XB_TMO])) break; if (sp > XB_SPIN_CAP) { atomicAdd(&bar[XB_TMO], 1u); break; } }
    }
    nloc = mine > 0u ? mine : 1u; nx = cnt > 0u ? cnt : 1u;
}

__device__ __forceinline__ void xcd_barrier(const XcdBarrier& b) {
    asm volatile("s_waitcnt vmcnt(0)" ::: "memory");
    __syncthreads();
    if (threadIdx.x == 0) {
        unsigned* bar = b.bar;
        __builtin_amdgcn_s_waitcnt(0);
        unsigned nloc = b.st[0], nx = b.st[1];
        if (nloc == 0u) { xcd_barrier_complete(bar, b.x, nloc, nx); b.st[0] = nloc; b.st[1] = nx; }
        const unsigned old = xb_add(&bar[XB_XSUB(b.x)], 1u);
        const unsigned gen = old / nloc;
        if (old + 1u == (gen + 1u) * nloc) {
            __builtin_amdgcn_fence(__ATOMIC_RELEASE, "agent");
            asm volatile("s_waitcnt vmcnt(0)" ::: "memory");
            const unsigned og = xb_add(&bar[XB_TOP], 1u);
            const unsigned tg = og / nx;
            if (og + 1u == (tg + 1u) * nx) xb_add(&bar[XB_TOPGEN], 1u);
            else XB_SPIN(xb_ld(&bar[XB_TOPGEN]) == tg, bar);
            __builtin_amdgcn_fence(__ATOMIC_ACQUIRE, "agent");
            xb_add(&bar[XB_XGEN(b.x)], 1u);
            asm volatile("s_waitcnt vmcnt(0)" ::: "memory");
        } else {
            XB_SPIN(xb_ld(&bar[XB_XGEN(b.x)]) == gen, bar);
            __builtin_amdgcn_fence(__ATOMIC_ACQUIRE, "agent");
            asm volatile("s_waitcnt vmcnt(0)" ::: "memory");
        }
    }
    __syncthreads();
}

#ifndef MIXM
#define MIXM 0
#endif
#ifndef SYNC2
#define SYNC2 0
#endif
#ifndef REPM
#define REPM 0
#endif
#ifndef GM
#define GM 0xff
#endif
#ifndef PHM
#define PHM 0xff
#endif
struct Args { const float* in[33]; float* out; unsigned char* ws; unsigned long long rfix[8]; int ph_lo, ph_hi; };
typedef const Args __attribute__((address_space(4)))* ArgsP;

DI void tr_item(const float* W, int K, int N, bf16_t* WT, int k0, int n0, int drow0, LAS float* scr, int lane) {
#pragma unroll 8
    for (int i = 0; i < 32; ++i) { const int kk = 2 * i + (lane >> 5); scr[kk * 33 + (lane & 31)] = W[(size_t)(k0 + kk) * N + n0 + (lane & 31)]; }
    asm volatile("s_waitcnt lgkmcnt(0)" ::: "memory");
    const int c = lane & 7;
#pragma unroll
    for (int j = 0; j < 4; ++j) { const int n = (lane >> 3) + 8 * j; const LAS float* s = scr + (8 * c) * 33 + n;
        u32x4 o; o.x = cvt_pk_bf16(s[0 * 33], s[1 * 33]); o.y = cvt_pk_bf16(s[2 * 33], s[3 * 33]); o.z = cvt_pk_bf16(s[4 * 33], s[5 * 33]); o.w = cvt_pk_bf16(s[6 * 33], s[7 * 33]);
        *(u32x4*)(WT + (size_t)(drow0 + n) * K + k0 + 8 * c) = o; }
    asm volatile("s_waitcnt lgkmcnt(0)" ::: "memory");
}
DI void fold_item(const float* Pw  , const float* Sc  , const float* Wa  , bf16_t* WT  , int k0, int n0, LAS float* scr, int lane) {
    const int g = k0 >> 7, nn = lane & 31, hi = lane >> 5;
    for (int jc = 0; jc < 4; ++jc) {
        float w[32];
#pragma unroll
        for (int jj = 0; jj < 32; ++jj) { const int j = g * 128 + jc * 32 + jj; w[jj] = Sc[j] * Wa[(size_t)j * 1024 + n0 + nn]; }
#pragma unroll 1
        for (int i = 0; i < 32; ++i) { const float* pr = Pw + ((size_t)g * 128 + ((k0 & 127) + 2 * i + hi)) * 128 + jc * 32; float acc = 0.f;
#pragma unroll
            for (int j4 = 0; j4 < 8; ++j4) { const f32x4 p = *(const f32x4*)(pr + 4 * j4);
                acc += p[0] * w[4 * j4] + p[1] * w[4 * j4 + 1] + p[2] * w[4 * j4 + 2] + p[3] * w[4 * j4 + 3]; }
            LAS float* sp = scr + (2 * i + hi) * 33 + nn; if (jc == 0) *sp = acc; else *sp += acc; }
    }
    asm volatile("s_waitcnt lgkmcnt(0)" ::: "memory");
    const int c = lane & 7;
#pragma unroll
    for (int j = 0; j < 4; ++j) { const int n = (lane >> 3) + 8 * j; const LAS float* s = scr + (8 * c) * 33 + n;
        u32x4 o; o.x = cvt_pk_bf16(s[0 * 33], s[1 * 33]); o.y = cvt_pk_bf16(s[2 * 33], s[3 * 33]); o.z = cvt_pk_bf16(s[4 * 33], s[5 * 33]); o.w = cvt_pk_bf16(s[6 * 33], s[7 * 33]);
        *(u32x4*)(WT + (size_t)(n0 + n) * 512 + k0 + 8 * c) = o; }
    asm volatile("s_waitcnt lgkmcnt(0)" ::: "memory");
}
DI void sincos_frac(float f  , float& c, float& s) { s = __builtin_amdgcn_sinf(f); c = __builtin_amdgcn_cosf(f); }

DI void prologue(ArgsP a, LAS unsigned char* lds, int tid) {
    const int lane = tid & 63, wave = tid >> 6;
    const int gw = blockIdx.x * 8 + wave, NGW = gridDim.x * 8;
    const int gt = blockIdx.x * 512 + tid, NT = gridDim.x * 512;
    unsigned char* ws = a->ws;
    LAS float* scr = (LAS float*)(lds + wave * 16384);
    constexpr int I_IN = 16 * 152, I_GLU = 8 * 16, I_BR = 8 * 32, I_OUT = 16 * 32, I_FI = 16 * 176, I_FO = 44 * 32, I_ADA = 16 * 192, I_FOLD = 8 * 32;
    constexpr int PER_L = I_IN + I_GLU + 2 * I_BR + I_OUT + I_FI + I_FO + I_ADA + I_FOLD;
    for (int it = gw; it < PER_L * 4; it += NGW) {
        const int l = it & 3; int r = it >> 2;
        if (r < I_FOLD) { fold_item(a->in[14] + (size_t)l * 4 * 128 * 128, a->in[15] + l * 512, a->in[26] + (size_t)l * 512 * 1024, (bf16_t*)(ws + WS_WBR) + (size_t)l * 3072 * 512, (r >> 5) * 64, (r & 31) * 32, scr, lane); continue; } r -= I_FOLD;
        if (r < I_IN) { const int kb = r / 152, nb = r % 152; tr_item(a->in[13] + (size_t)l * 1024 * IN_COLS, 1024, IN_COLS, (bf16_t*)(ws + WS_WIN) + (size_t)l * IN_COLS * 1024, kb * 64, nb * 32, nb * 32, scr, lane); continue; } r -= I_IN;
        if (r < I_GLU) { const int kb = r / 16, nb = r % 16; tr_item(a->in[25] + (size_t)l * 512 * 512, 512, 512, (bf16_t*)(ws + WS_WGLU) + (size_t)l * 512 * 512, kb * 64, nb * 32, nb * 32, scr, lane); continue; } r -= I_GLU;
        if (r < I_BR) { const int kb = r / 32, nb = r % 32; tr_item(a->in[27] + (size_t)l * 512 * 1024, 512, 1024, (bf16_t*)(ws + WS_WBR) + (size_t)l * 3072 * 512, kb * 64, nb * 32, 1024 + nb * 32, scr, lane); continue; } r -= I_BR;
        if (r < I_BR) { const int kb = r / 32, nb = r % 32; tr_item(a->in[28] + (size_t)l * 512 * 1024, 512, 1024, (bf16_t*)(ws + WS_WBR) + (size_t)l * 3072 * 512, kb * 64, nb * 32, 2048 + nb * 32, scr, lane); continue; } r -= I_BR;
        if (r < I_OUT) { const int kb = r / 32, nb = r % 32; tr_item(a->in[29] + (size_t)l * 1024 * 1024, 1024, 1024, (bf16_t*)(ws + WS_WOUT) + (size_t)l * 1024 * 1024, kb * 64, nb * 32, nb * 32, scr, lane); continue; } r -= I_OUT;
        if (r < I_FI) { const int kb = r / 176, nb = r % 176; const int n0 = nb * 32, half = n0 / DFF, j = n0 - half * DFF;
            tr_item(a->in[30] + (size_t)l * 1024 * 2 * DFF, 1024, 2 * DFF, (bf16_t*)(ws + WS_WFI) + (size_t)l * 2 * DFF * 1024, kb * 64, n0, 256 * (j >> 7) + 128 * half + (j & 127), scr, lane); continue; } r -= I_FI;
        if (r < I_FO) { const int kb = r / 32, nb = r % 32; tr_item(a->in[31] + (size_t)l * DFF * 1024, DFF, 1024, (bf16_t*)(ws + WS_WFO) + (size_t)l * 1024 * DFF, kb * 64, nb * 32, nb * 32, scr, lane); continue; } r -= I_FO;
        { const int kb = r / 192, nb = r % 192; tr_item(a->in[11] + (size_t)l * 1024 * 6144, 1024, 6144, (bf16_t*)(ws + WS_GT), kb * 64, nb * 32, l * 6144 + nb * 32, scr, lane); }
    }
    { bf16_t* CA = (bf16_t*)(ws + WS_CA);
      for (int i = gt; i < 256 * 1024; i += NT) { const int r = i >> 10, c = i & 1023; float v = 0.f;
          if (r < 8) v = a->in[7][r * 1024 + c]; else if (r < NBAT) v = a->in[8][(r - 8) * 1024 + c];
          CA[i] = (bf16_t)f2bf(v * sigm(v)); } }
    { float* rc = (float*)(ws + WS_TAB + TB_ROPEC); float* rs = (float*)(ws + WS_TAB + TB_ROPES);
      for (int i = gt; i < 2052 * 8; i += NT) { const int ti = i >> 3, j = i & 7; const int pos = ti < 2048 ? ti : 8192 + (ti - 2048);
          const unsigned long long fx = (unsigned long long)pos * a->rfix[j];
          float c, s; sincos_frac((float)(unsigned)(fx >> 40) * 5.9604644775390625e-08f, c, s); rc[i] = c; rs[i] = s; } }
    { float* AB = (float*)(ws + WS_TAB + TB_ABAR); float* AB256 = (float*)(ws + WS_TAB + TB_ABAR256); bf16_t* BBF = (bf16_t*)(ws + WS_TAB + TB_BBF);
      for (int i = gt; i < 4 * 32 * 64; i += NT) { const int lg = i >> 6, p = i & 63;
          const float dt = expf(a->in[19][lg]); const float ar = a->in[17][i], ai = a->in[18][i];
          const float x = ar * dt; const float yt = ai * dt * 0.15915494309189535f;
          float c, s; sincos_frac(yt, c, s); float ch, sh; sincos_frac(0.5f * yt, ch, sh);
          const float em1 = x * (1.f + x * (0.5f + x * (0.16666667f + x * (0.041666668f + x * 0.0083333338f))));
          const float ex = 1.f + em1;
          const float abr = ex * c, abi = ex * s;
          const float nr = em1 * c - (sh + sh) * sh, ni = abi;
          const float den = 1.f / (ar * ar + ai * ai);
          const float cr = (nr * ar + ni * ai) * den, ci = (ni * ar - nr * ai) * den;
          AB[2 * i] = abr; AB[2 * i + 1] = abi;
          float pr = abr, pi = abi;
#pragma unroll
          for (int k = 0; k < 8; ++k) { const float t = pr * pr - pi * pi; pi = (pr + pr) * pi; pr = t; }
          AB256[2 * i] = pr; AB256[2 * i + 1] = pi;
          const float* br = a->in[20] + (size_t)i * 16; const float* bi = a->in[21] + (size_t)i * 16;
          const int st = p >> 5;
#pragma unroll
          for (int half = 0; half < 2; ++half) { u32x4 ore, oim; unsigned* pre = (unsigned*)&ore; unsigned* pim = (unsigned*)&oim; (void)pre; (void)pim;
              float vr[8], vi[8];
#pragma unroll
              for (int j = 0; j < 8; ++j) { const float b_r = br[half * 8 + j], b_i = bi[half * 8 + j]; vr[j] = cr * b_r - ci * b_i; vi[j] = cr * b_i + ci * b_r; }
              ore.x = cvt_pk_bf16(vr[0], vr[1]); ore.y = cvt_pk_bf16(vr[2], vr[3]); ore.z = cvt_pk_bf16(vr[4], vr[5]); ore.w = cvt_pk_bf16(vr[6], vr[7]);
              oim.x = cvt_pk_bf16(vi[0], vi[1]); oim.y = cvt_pk_bf16(vi[2], vi[3]); oim.z = cvt_pk_bf16(vi[4], vi[5]); oim.w = cvt_pk_bf16(vi[6], vi[7]);
              *(u32x4*)(BBF + (((size_t)lg * 4 + 0 + st) * 64 + half * 32 + (p & 31)) * 8) = ore;
              *(u32x4*)(BBF + (((size_t)lg * 4 + 2 + st) * 64 + half * 32 + (p & 31)) * 8) = oim; } } }
    { bf16_t* CF = (bf16_t*)(ws + WS_TAB + TB_CF);
      for (int i = gt; i < 4 * 32 * 4 * 64; i += NT) { const int ln = i & 63, ks = (i >> 6) & 3, lg = i >> 8; const int c = ln & 15, quad = ln >> 4;
          float v[8];
#pragma unroll
          for (int j = 0; j < 8; ++j) { const int k = ks * 32 + quad * 8 + j; v[j] = k < 64 ? a->in[22][((size_t)lg * 16 + c) * 64 + k] : -a->in[23][((size_t)lg * 16 + c) * 64 + (k - 64)]; }
          u32x4 o; o.x = cvt_pk_bf16(v[0], v[1]); o.y = cvt_pk_bf16(v[2], v[3]); o.z = cvt_pk_bf16(v[4], v[5]); o.w = cvt_pk_bf16(v[6], v[7]);
          *(u32x4*)(CF + (size_t)i * 8) = o; } }
    { for (int i = gt; i < 4 * 128 * 124 * 32; i += NT) { const int c4 = i & 31, j = (i >> 5) % 124, lb = (i >> 5) / 124;
          *(f32x4*)(a->out + OFF_KS + ((size_t)lb * 128 + j) * 128 + c4 * 4) = *(const f32x4*)(a->in[2] + ((size_t)lb * 128 + j + 4) * 128 + c4 * 4);
          *(f32x4*)(a->out + OFF_VS + ((size_t)lb * 128 + j) * 128 + c4 * 4) = *(const f32x4*)(a->in[3] + ((size_t)lb * 128 + j + 4) * 128 + c4 * 4); }
      for (int i = gt; i < 4 * 128 * 11 * 128; i += NT) { const int c4 = i & 127, j = (i >> 7) % 11, lb = (i >> 7) / 11;
          *(f32x4*)(a->out + OFF_PS + ((size_t)lb * 15 + j) * 512 + c4 * 4) = *(const f32x4*)(a->in[4] + ((size_t)lb * 15 + j + 4) * 512 + c4 * 4); } }
}

DI void norm_phase(const float* xp, const float* xs, const float* gvec, const float* MODL  , int sc_off, bf16_t* H, int tid,
                   const float* P, int nparts, const float* pgate, float* X) {
    const int lane = tid & 63, gw = blockIdx.x * 8 + (tid >> 6), NGW = gridDim.x * 8;
    for (int it = gw; it < M; it += NGW) {
        const int row = it < MS ? MP + it : it - MS;
        const int bi = batch_of(row);
        const float* xr = (row < MP ? xp : xs) + (size_t)row * 1024; const float* mr = MODL + (size_t)bi * NMOD;
        f32x4 v[4]; float ss = 0.f;
#pragma unroll
        for (int j = 0; j < 4; ++j) v[j] = *(const f32x4*)(xr + 4 * lane + 256 * j);
        if (row >= MP && nparts > 0) {
            f32x4 s[4];
#pragma unroll
            for (int j = 0; j < 4; ++j) s[j] = (f32x4){0.f, 0.f, 0.f, 0.f};
            for (int p = 0; p < nparts; ++p) { const float* pr = P + ((size_t)p * 512 + (row - MP)) * 1024 + 4 * lane;
#pragma unroll
                for (int j = 0; j < 4; ++j) s[j] += *(const f32x4*)(pr + 256 * j); }
#pragma unroll
            for (int j = 0; j < 4; ++j) { v[j] += *(const f32x4*)(pgate + (size_t)bi * NMOD + 4 * lane + 256 * j) * s[j]; *(f32x4*)(X + (size_t)row * 1024 + 4 * lane + 256 * j) = v[j]; }
        }
#pragma unroll
        for (int j = 0; j < 4; ++j) ss += v[j][0] * v[j][0] + v[j][1] * v[j][1] + v[j][2] * v[j][2] + v[j][3] * v[j][3];
        const float r = rsqrtf(wave_sum(ss, lane) * (1.f / 1024.f) + 1e-6f);
        if (H) {
#pragma unroll
            for (int j = 0; j < 4; ++j) { const int c = 4 * lane + 256 * j; const f32x4 g = *(const f32x4*)(gvec + c), sh = *(const f32x4*)(mr + c), sc = *(const f32x4*)(mr + sc_off + c);
                st_bf4(H + (size_t)row * 1024 + c, v[j] * r * g * (1.f + sc) + sh); }
        } else {
#pragma unroll
            for (int j = 0; j < 4; ++j) { const int c = 4 * lane + 256 * j; *(f32x4*)(X + (size_t)row * 1024 + c) = v[j] * r * *(const f32x4*)(gvec + c); }
        }
    }
}

template <int W>
DI void pool_run(const float* XA, bf16_t* Dm, float* out, int l, int row0, int c4) {
    const int t0 = row0 & 2047;
    f32x4 x[W + 7];
#pragma unroll
    for (int i = 0; i < W + 7; ++i) { const int dt = i - (W - 1); x[i] = (t0 + dt >= 0) ? *(const f32x4*)(XA + (size_t)(row0 + dt) * 512 + c4) : (f32x4){0.f, 0.f, 0.f, 0.f}; }
    f32x4 s = x[0];
#pragma unroll
    for (int i = 1; i < W - 1; ++i) s += x[i];
#pragma unroll
    for (int k = 0; k < 8; ++k) { s += x[W - 1 + k]; const int t = t0 + k; const float cnt = (float)((t + 1 < W) ? t + 1 : W);
        st_bf4(Dm + (size_t)(row0 + k) * 512 + c4, s * (1.f / cnt) - x[W - 1 + k]);
        if (t >= 2033) *(f32x4*)(out + OFF_PP + ((size_t)(l * 8 + (row0 >> 11)) * 15 + (t - 2033)) * 512 + c4) = x[W - 1 + k];
        s -= x[k]; }
}
DI void pool_phase(ArgsP a, int l, const float* XA, bf16_t* Dm, int gt  , int NT  , int lo, int hi  , bool do_sample) {
    constexpr int NRUN = MP / 8;
    for (int item = lo + gt; item < hi; item += NT) {
        const int c4l = item & 31, gr = item >> 5, g = gr / NRUN, run = gr - g * NRUN; const int c4 = g * 128 + c4l * 4, row0 = run * 8;
        if (g == 0) pool_run<2>(XA, Dm, a->out, l, row0, c4); else if (g == 1) pool_run<4>(XA, Dm, a->out, l, row0, c4);
        else if (g == 2) pool_run<8>(XA, Dm, a->out, l, row0, c4); else pool_run<16>(XA, Dm, a->out, l, row0, c4);
    }
    if (do_sample) for (int idx = gt; idx < MS * 128; idx += NT) {
        const int row = MP + (idx >> 7), c4 = (idx & 127) * 4, w = 2 << (c4 >> 7);
        const f32x4 x = *(const f32x4*)(XA + (size_t)row * 512 + c4); f32x4 sum = x;
        const int rs = row - MP, bs = rs >> 2, t = rs & 3;
        for (int s = 1; s < w; ++s) { const int pos = t - s;
            sum += pos >= 0 ? *(const f32x4*)(XA + (size_t)(row - s) * 512 + c4) : *(const f32x4*)(a->in[4] + ((size_t)(l * 128 + bs) * 15 + 15 + pos) * 512 + c4); }
        *(f32x4*)(a->out + OFF_PS + ((size_t)(l * 128 + bs) * 15 + 11 + t) * 512 + c4) = x;
        st_bf4(Dm + (size_t)row * 512 + c4, sum * (1.f / (float)w) - x);
    }
}

DI void attn_prompt_unit(LAS unsigned char* lds, int unit, const bf16_t* Q, const bf16_t* KB, const bf16_t* VB, bf16_t* YB, const float* sinks, int tid) {
    const int b = unit >> 5, g = (unit >> 4) & 1, nb = unit & 15;
    LAS bf16_t* Ks = (LAS bf16_t*)lds;
    LAS bf16_t* Vt = (LAS bf16_t*)(lds + 36864);
    const int krow0 = b * 2048 + (nb - 1) * 128;
#pragma unroll
    for (int it = 0; it < 4; ++it) {
        const int chunk = tid + 512 * it, j = chunk >> 3, c8 = chunk & 7;
        u32x4 kv = {0u, 0u, 0u, 0u}, vv = {0u, 0u, 0u, 0u};
        if (nb > 0 || j >= 128) { const size_t off = (size_t)(krow0 + j) * 128 + g * 64 + c8 * 8; kv = *(const u32x4*)(KB + off); vv = *(const u32x4*)(VB + off); }
        *(LAS u32x4*)(Ks + j * 72 + c8 * 8) = kv;
        LAS bf16_t* vp = Vt + (c8 * 8) * 264 + j;
        vp[0 * 264] = (bf16_t)(vv.x & 0xffffu); vp[1 * 264] = (bf16_t)(vv.x >> 16); vp[2 * 264] = (bf16_t)(vv.y & 0xffffu); vp[3 * 264] = (bf16_t)(vv.y >> 16);
        vp[4 * 264] = (bf16_t)(vv.z & 0xffffu); vp[5 * 264] = (bf16_t)(vv.z >> 16); vp[6 * 264] = (bf16_t)(vv.w & 0xffffu); vp[7 * 264] = (bf16_t)(vv.w >> 16);
    }
    __syncthreads();
    const int wave = tid >> 6, lane = tid & 63, l15 = lane & 15, quad = lane >> 4;
    const int r = wave >> 1, hq = g * 4 + r;
    const float sc2 = 0.125f * 1.4426950408889634f;
    const float sk2 = sinks[hq] * 1.4426950408889634f;
    const int kt0 = wave & 1;
#pragma unroll 1
    for (int qh = 0; qh < 2; ++qh) {
        const int q0 = (wave & 1) * 64 + qh * 32;
        const int qrow0 = b * 2048 + nb * 128 + q0;
        bf16x8 qf[2][2];
#pragma unroll
        for (int qt = 0; qt < 2; ++qt)
#pragma unroll
            for (int ds = 0; ds < 2; ++ds) qf[qt][ds] = *(const bf16x8*)(Q + (size_t)(qrow0 + qt * 16 + l15) * 512 + hq * 64 + ds * 32 + quad * 8);
        float m2[2], ls[2]; f32x4 o[4][2];
#pragma unroll
        for (int qt = 0; qt < 2; ++qt) { m2[qt] = sk2; ls[qt] = quad == 0 ? 1.f : 0.f;
#pragma unroll
            for (int dt = 0; dt < 4; ++dt) o[dt][qt] = (f32x4){0.f, 0.f, 0.f, 0.f}; }
#pragma unroll 1
        for (int kk = 0; kk < 3; ++kk) {
            const int kt = kt0 + kk;
            if (nb == 0 && kt < 2) continue;
            f32x4 s[4][2];
#pragma unroll
            for (int sub = 0; sub < 4; ++sub) { const LAS bf16_t* kp = Ks + (kt * 64 + sub * 16 + l15) * 72 + quad * 8;
                const bf16x8 k0 = *(const LAS bf16x8*)kp, k1 = *(const LAS bf16x8*)(kp + 32);
#pragma unroll
                for (int qt = 0; qt < 2; ++qt) { s[sub][qt] = MFMA16(k0, qf[qt][0], ((f32x4){0.f, 0.f, 0.f, 0.f})); s[sub][qt] = MFMA16(k1, qf[qt][1], s[sub][qt]); } }
#pragma unroll
            for (int qt = 0; qt < 2; ++qt) { const int i = q0 + qt * 16 + l15; float mx = -INFINITY;
#pragma unroll
                for (int sub = 0; sub < 4; ++sub)
#pragma unroll
                    for (int jj = 0; jj < 4; ++jj) { const int j = kt * 64 + sub * 16 + quad * 4 + jj; const bool valid = (j > i) && (j <= i + 128) && (nb > 0 || j >= 128);
                        const float v = valid ? s[sub][qt][jj] * sc2 : -INFINITY; s[sub][qt][jj] = v; mx = fmaxf(mx, v); }
                mx = fmaxf(mx, shx16(mx, quad & 1)); mx = fmaxf(mx, shx32(mx, quad >> 1));
                const float mn = fmaxf(m2[qt], mx), alpha = __builtin_amdgcn_exp2f(m2[qt] - mn); m2[qt] = mn; float sum = 0.f;
#pragma unroll
                for (int sub = 0; sub < 4; ++sub)
#pragma unroll
                    for (int jj = 0; jj < 4; ++jj) { const float p = __builtin_amdgcn_exp2f(s[sub][qt][jj] - mn); s[sub][qt][jj] = p; sum += p; }
                ls[qt] = ls[qt] * alpha + sum;
#pragma unroll
                for (int dt = 0; dt < 4; ++dt) o[dt][qt] *= alpha; }
#pragma unroll
            for (int s2 = 0; s2 < 2; ++s2) { bf16x8 pf[2];
#pragma unroll
                for (int qt = 0; qt < 2; ++qt) pf[qt] = pack8(s[2 * s2][qt], s[2 * s2 + 1][qt]);
#pragma unroll
                for (int dt = 0; dt < 4; ++dt) { const LAS bf16_t* vp = Vt + (dt * 16 + l15) * 264 + kt * 64 + s2 * 32 + quad * 4;
                    const s16x4 v0 = *(const LAS s16x4*)vp, v1 = *(const LAS s16x4*)(vp + 16);
                    const bf16x8 vf = __builtin_shufflevector(v0, v1, 0, 1, 2, 3, 4, 5, 6, 7);
#pragma unroll
                    for (int qt = 0; qt < 2; ++qt) o[dt][qt] = MFMA16(vf, pf[qt], o[dt][qt]); } }
        }
#pragma unroll
        for (int qt = 0; qt < 2; ++qt) { float lt = ls[qt]; lt += shx16(lt, quad & 1); lt += shx32(lt, quad >> 1); const float inv = 1.f / lt;
            bf16_t* yp = YB + (size_t)(qrow0 + qt * 16 + l15) * 512 + hq * 64 + quad * 4;
#pragma unroll
            for (int dt = 0; dt < 4; ++dt) st_bf4(yp + dt * 16, o[dt][qt] * inv); }
    }
    __syncthreads();
}

DI void attn_sample_task(LAS unsigned char* wl, int task, int l, ArgsP a, const bf16_t* Q, bf16_t* YB, int lane) {
    const int b = task >> 3, h = task & 7, g = h >> 2;
    LAS float* qs = (LAS float*)wl;
    LAS float* ps = qs + 256;
#pragma unroll
    for (int t = 0; t < 4; ++t) qs[t * 64 + lane] = bf2f(Q[(size_t)(MP + b * 4 + t) * 512 + h * 64 + lane]);
    const float* ck = a->in[2] + (size_t)(l * 128 + b) * 128 * 128 + g * 64;
    const float* cv = a->in[3] + (size_t)(l * 128 + b) * 128 * 128 + g * 64;
    const float* nk = a->out + OFF_KS + ((size_t)(l * 128 + b) * 128 + 124) * 128 + g * 64;
    const float* nv = a->out + OFF_VS + ((size_t)(l * 128 + b) * 128 + 124) * 128 + g * 64;
    const float sink = a->in[16][l * 8 + h];
    float mx[4] = {sink, sink, sink, sink};
    for (int rr = 0; rr < 3; ++rr) { const int j = rr * 64 + lane; float s[4] = {0.f, 0.f, 0.f, 0.f};
        if (j < 132) { const float* kp = j < 128 ? ck + (size_t)j * 128 : nk + (size_t)(j - 128) * 128;
#pragma unroll 4
            for (int d4 = 0; d4 < 16; ++d4) { const f32x4 k4 = *(const f32x4*)(kp + 4 * d4);
#pragma unroll
                for (int t = 0; t < 4; ++t) { const f32x4 q4 = *(const LAS f32x4*)(qs + t * 64 + 4 * d4); s[t] += k4[0] * q4[0] + k4[1] * q4[1] + k4[2] * q4[2] + k4[3] * q4[3]; } } }
#pragma unroll
        for (int t = 0; t < 4; ++t) { const bool valid = (j < 132) && (j >= t + 1) && (j <= t + 128); const float v = valid ? s[t] * 0.125f : -INFINITY;
            if (j < 136) ps[t * 136 + j] = v; mx[t] = fmaxf(mx[t], v); } }
    float den[4];
#pragma unroll
    for (int t = 0; t < 4; ++t) { mx[t] = wave_max(mx[t], lane); float sum = 0.f;
        for (int rr = 0; rr < 3; ++rr) { const int j = rr * 64 + lane; if (j < 132) { const float p = __expf(ps[t * 136 + j] - mx[t]); ps[t * 136 + j] = p; sum += p; } }
        den[t] = wave_sum(sum, lane) + __expf(sink - mx[t]); }
    float o[4] = {0.f, 0.f, 0.f, 0.f};
    for (int j = 0; j < 132; ++j) { const float v = (j < 128 ? cv + (size_t)j * 128 : nv + (size_t)(j - 128) * 128)[lane];
#pragma unroll
        for (int t = 0; t < 4; ++t) o[t] += ps[t * 136 + j] * v; }
#pragma unroll
    for (int t = 0; t < 4; ++t) YB[(size_t)(MP + b * 4 + t) * 512 + h * 64 + lane] = (bf16_t)f2bf(o[t] / den[t]);
}

struct S5C { bf16x8 bbf[4]; bf16x8 cf[4]; float are[2], aim[2]; };
DI float gelu_tanh(float y) { const float z = 1.5957691216057308f * (y + 0.044715f * y * y * y); return y * sigm(z); }
template <bool OUT>
DI void s5_tile(const S5C& K, const float* U, int row0, int g, int nruns, int nvalid, float (&hre)[2], float (&him)[2], LAS bf16_t* Hs, const float* dvec, bf16_t* YC0, int lane) {
    const int tok = lane & 31, half = lane >> 5;
    bf16x8 af = {0, 0, 0, 0, 0, 0, 0, 0};
    if (tok < nvalid) { const float* up = U + (size_t)(row0 + tok) * 512 + g * 16 + half * 8; af = pack8(*(const f32x4*)up, *(const f32x4*)(up + 4)); }
    f32x16 z16;
#pragma unroll
    for (int i = 0; i < 16; ++i) z16[i] = 0.f;
    f32x16 dre[2], dim[2];
#pragma unroll
    for (int st = 0; st < 2; ++st) { dre[st] = MFMA32(af, K.bbf[st], z16); dim[st] = MFMA32(af, K.bbf[2 + st], z16); }
#pragma unroll
    for (int r = 0; r < 8; ++r) {
        if (r < nruns) {
            const int hf = r & 1, i0 = 4 * (r >> 1);
            if (half == hf) {
#pragma unroll
                for (int k = 0; k < 4; ++k)
#pragma unroll
                    for (int st = 0; st < 2; ++st) { const float nr = K.are[st] * hre[st] - K.aim[st] * him[st] + dre[st][i0 + k]; const float ni = K.are[st] * him[st] + K.aim[st] * hre[st] + dim[st][i0 + k];
                        hre[st] = nr; him[st] = ni; dre[st][i0 + k] = nr; dim[st][i0 + k] = ni; }
            }
#pragma unroll
            for (int st = 0; st < 2; ++st) { const float pr = __shfl_xor(hre[st], 32), pi = __shfl_xor(him[st], 32); if (half != hf) { hre[st] = pr; him[st] = pi; } }
        }
    }
    if (OUT) {
#pragma unroll
        for (int i = 0; i < 16; ++i) { const int tr = (i & 3) + 8 * (i >> 2) + 4 * half; LAS bf16_t* hp = Hs + tr * 136 + tok;
#pragma unroll
            for (int st = 0; st < 2; ++st) { hp[st * 32] = (bf16_t)f2bf(dre[st][i]); hp[64 + st * 32] = (bf16_t)f2bf(dim[st][i]); } }
        const int l15 = lane & 15, quad = lane >> 4;
#pragma unroll
        for (int tt = 0; tt < 2; ++tt) {
            if (tt * 16 < nvalid) {
                f32x4 acc = {0.f, 0.f, 0.f, 0.f};
#pragma unroll
                for (int ks = 0; ks < 4; ++ks) { const bf16x8 hf8 = *(const LAS bf16x8*)(Hs + (tt * 16 + l15) * 136 + ks * 32 + quad * 8); acc = MFMA16(K.cf[ks], hf8, acc); }
                const int tk = tt * 16 + l15;
                if (tk < nvalid) { const size_t ro = (size_t)(row0 + tk) * 512 + g * 16 + quad * 4;
                    const f32x4 u4 = *(const f32x4*)(U + ro), d4 = *(const f32x4*)(dvec + quad * 4); f32x4 y = acc + d4 * u4;
                    y[0] = gelu_tanh(y[0]); y[1] = gelu_tanh(y[1]); y[2] = gelu_tanh(y[2]); y[3] = gelu_tanh(y[3]);
                    st_bf4(YC0 + ro, y); }
            }
        }
    }
}
DI void s5_load_consts(S5C& K, const unsigned char* ws, int lg, int lane) {
    const bf16_t* BBF = (const bf16_t*)(ws + WS_TAB + TB_BBF); const bf16_t* CF = (const bf16_t*)(ws + WS_TAB + TB_CF); const float* AB = (const float*)(ws + WS_TAB + TB_ABAR);
#pragma unroll
    for (int t = 0; t < 4; ++t) { K.bbf[t] = *(const bf16x8*)(BBF + (((size_t)lg * 4 + t) * 64 + lane) * 8); K.cf[t] = *(const bf16x8*)(CF + (((size_t)lg * 4 + t) * 64 + lane) * 8); }
#pragma unroll
    for (int st = 0; st < 2; ++st) { const int p = st * 32 + (lane & 31); K.are[st] = AB[((size_t)lg * 64 + p) * 2]; K.aim[st] = AB[((size_t)lg * 64 + p) * 2 + 1]; }
}
DI void s5_prompt_task(LAS unsigned char* lds, int task, int l, ArgsP a, const float* U, bf16_t* YC0, int tid) {
    const int b = task >> 5, g = task & 31, lg = l * 32 + g, wave = tid >> 6, lane = tid & 63;
    LAS bf16_t* Hs = (LAS bf16_t*)(lds + wave * 8704);
    LAS float* Es = (LAS float*)(lds + 8 * 8704);
    S5C K; s5_load_consts(K, a->ws, lg, lane);
    const float* dvec = a->in[24] + l * 512 + g * 16;
    const int rowb = b * 2048 + wave * 256;
    float hre[2] = {0.f, 0.f}, him[2] = {0.f, 0.f};
    for (int tl = 0; tl < 8; ++tl) s5_tile<false>(K, U, rowb + tl * 32, g, 8, 32, hre, him, Hs, dvec, YC0, lane);
    if (lane < 32) { Es[(wave * 4 + 0) * 32 + lane] = hre[0]; Es[(wave * 4 + 1) * 32 + lane] = hre[1]; Es[(wave * 4 + 2) * 32 + lane] = him[0]; Es[(wave * 4 + 3) * 32 + lane] = him[1]; }
    __syncthreads();
    { const float* A256 = (const float*)(a->ws + WS_TAB + TB_ABAR256); float pr[2], pi[2];
#pragma unroll
      for (int st = 0; st < 2; ++st) { const int p = st * 32 + (lane & 31); pr[st] = A256[((size_t)lg * 64 + p) * 2]; pi[st] = A256[((size_t)lg * 64 + p) * 2 + 1]; hre[st] = 0.f; him[st] = 0.f; }
      for (int w = 0; w < wave; ++w) {
#pragma unroll
          for (int st = 0; st < 2; ++st) { const float er = Es[(w * 4 + st) * 32 + (lane & 31)], ei = Es[(w * 4 + 2 + st) * 32 + (lane & 31)];
              const float nr = pr[st] * hre[st] - pi[st] * him[st] + er, ni = pr[st] * him[st] + pi[st] * hre[st] + ei; hre[st] = nr; him[st] = ni; } } }
    for (int tl = 0; tl < 8; ++tl) s5_tile<true>(K, U, rowb + tl * 32, g, 8, 32, hre, him, Hs, dvec, YC0, lane);
    if (wave == 7 && lane < 32) {
#pragma unroll
        for (int st = 0; st < 2; ++st) { a->out[OFF_SRP + ((size_t)(l * 8 + b) * 32 + g) * 64 + st * 32 + lane] = hre[st]; a->out[OFF_SIP + ((size_t)(l * 8 + b) * 32 + g) * 64 + st * 32 + lane] = him[st]; } }
    __syncthreads();
}
DI void s5_sample_task(LAS unsigned char* lds, int task, int l, ArgsP a, const float* U, bf16_t* YC0, int tid) {
    const int bs = task >> 5, g = task & 31, lg = l * 32 + g, wave = tid >> 6, lane = tid & 63;
    LAS bf16_t* Hs = (LAS bf16_t*)(lds + wave * 8704);
    S5C K; s5_load_consts(K, a->ws, lg, lane);
    const size_t so = ((size_t)(l * 128 + bs) * 32 + g) * 64;
    float hre[2], him[2];
#pragma unroll
    for (int st = 0; st < 2; ++st) { hre[st] = a->in[5][so + st * 32 + (lane & 31)]; him[st] = a->in[6][so + st * 32 + (lane & 31)]; }
    s5_tile<true>(K, U, MP + bs * 4, g, 1, 4, hre, him, Hs, a->in[24] + l * 512 + g * 16, YC0, lane);
    if (lane < 32) {
#pragma unroll
        for (int st = 0; st < 2; ++st) { a->out[OFF_SRS + so + st * 32 + lane] = hre[st]; a->out[OFF_SIS + so + st * 32 + lane] = him[st]; } }
}

DI void mixers_phase(ArgsP a, LAS unsigned char* lds, int l, int tid) {
    unsigned char* ws = a->ws;
    const float* XA = (const float*)(ws + WS_XA); const float* U = (const float*)(ws + WS_U);
    const bf16_t* Q = (const bf16_t*)(ws + WS_Q); const bf16_t* KB = (const bf16_t*)(ws + WS_K); const bf16_t* VB = (const bf16_t*)(ws + WS_V);
    bf16_t* Dm = (bf16_t*)(ws + WS_DYY); bf16_t* YB = Dm + (size_t)M * 512; bf16_t* YC0 = (bf16_t*)(ws + WS_YC0);
    const int wave = tid >> 6, lane = tid & 63, gw = blockIdx.x * 8 + wave, NGW = gridDim.x * 8;
    for (int rp = 0; rp < 1 + ((MIXM >> 0) & 1); ++rp) for (int u = blockIdx.x; u < 256; u += gridDim.x) attn_prompt_unit(lds, u, Q, KB, VB, YB, a->in[16] + l * 8, tid);
    for (int rp = 0; rp < 1 + ((MIXM >> 1) & 1); ++rp) for (int t = blockIdx.x; t < 256; t += gridDim.x) s5_prompt_task(lds, t, l, a, U, YC0, tid);
    for (int rp = 0; rp < 1 + ((MIXM >> 2) & 1); ++rp) for (int t = gw; t < 4096; t += NGW) s5_sample_task(lds, t, l, a, U, YC0, tid);
    __syncthreads();
    for (int rp = 0; rp < 1 + ((MIXM >> 3) & 1); ++rp) for (int t = gw; t < 1024; t += NGW) attn_sample_task(lds + wave * 4096, t, l, a, Q, YB, lane);
}

__global__ void __launch_bounds__(512, 2) mega(Args a_unused) {
    extern __shared__ __attribute__((aligned(16))) unsigned char lds_raw[];
    LAS unsigned char* lds = (LAS unsigned char*)lds_raw;
    cg::grid_group grid = cg::this_grid();
    const int wave_s = __builtin_amdgcn_readfirstlane((int)threadIdx.x >> 6);
    volatile LAS unsigned* bst = (volatile LAS unsigned*)(lds + 135168);
    if (threadIdx.x < 2) bst[threadIdx.x] = 0u;
    __syncthreads();
    XcdBarrier xbar = xcd_barrier_post((unsigned*)(((ArgsP)__builtin_amdgcn_kernarg_segment_ptr())->ws), bst);
    const int ph_lo = ((ArgsP)__builtin_amdgcn_kernarg_segment_ptr())->ph_lo, ph_hi = ((ArgsP)__builtin_amdgcn_kernarg_segment_ptr())->ph_hi;
    for (int ph = ph_lo; ph < ph_hi; ++ph) {
        const int kk9 = (ph - 2) % 9;
        const int cls = ph == 0 ? 0 : ph == 1 ? 1 : ph == NPHASE - 1 ? 10 : (kk9 == 0 || kk9 == 6) ? 2 : kk9 == 1 ? 3 : kk9 == 2 ? 4 : kk9 == 3 ? 5 : kk9 == 4 ? 6 : kk9 == 5 ? 7 : kk9 == 7 ? 8 : 9;
        const int nrep = 1 + ((REPM >> cls) & 1);
        for (int rep = 0; rep < nrep; ++rep) {
        ArgsP a = (ArgsP)__builtin_amdgcn_kernarg_segment_ptr(); asm volatile("" : "+s"(a));
        int G = gridDim.x, c = blockIdx.x; asm volatile("" : "+s"(G), "+s"(c));
        int tid = wave_s * 64 + lane_id_v(); asm volatile("" : "+v"(tid));
        unsigned char* ws = a->ws;
        float* X = a->out;
        float* MOD = (float*)(ws + WS_MOD);
        bf16_t* H = (bf16_t*)(ws + WS_H);
        if (ph == 0) { if (PHM & 1) prologue(a, lds, tid); }
        else if (ph == 1) { if (PHM & 4) {
            pg8::Gemm g{(const bf16_t*)(ws + WS_CA), (const bf16_t*)(ws + WS_GT), 256, NMOD, 1024}; pg8::StaticOrder S; S.init(256, NMOD, G, c);
            pg8::EpiMod E{MOD, a->in[12]};
            pg8::gemm_phase<pg8::EpiMod, pg8::StaticOrder, true, true>(lds, g, S, E, wave_s * 64 + lane_id_v()); }
        } else if (ph == NPHASE - 1) norm_phase(X, X, a->in[32], MOD, 0, nullptr, tid, (const float*)(ws + WS_DYY), 22, MOD + 3 * 6144 + 5120, X);
        else {
            const int l = (ph - 2) / 9, k = (ph - 2) % 9;
            const float* xp = l == 0 ? a->in[0] : X; const float* xs = l == 0 ? a->in[1] - (size_t)MP * 1024 : X;
            if (k == 0) norm_phase(xp, xs, a->in[9] + l * 1024, MOD + l * 6144, 1024, H, tid, (const float*)(ws + WS_DYY), l == 0 ? 0 : 22, MOD + (l - 1) * 6144 + 5120, X);
            else if (k == 1) { if (GM & 1) {
                pg8::Gemm g{H, (const bf16_t*)(ws + WS_WIN) + (size_t)l * IN_COLS * 1024, M, IN_COLS, 1024}; pg8::StaticOrder S; S.init(M, IN_COLS, G, c);
                pg8::EpiIn E{(float*)(ws + WS_XA), (float*)(ws + WS_U), (bf16_t*)(ws + WS_Q), (bf16_t*)(ws + WS_K), (bf16_t*)(ws + WS_V), (bf16_t*)(ws + WS_GT),
                             (const float*)(ws + WS_TAB + TB_ROPEC), (const float*)(ws + WS_TAB + TB_ROPES), a->out, l};
                pg8::gemm_phase<pg8::EpiIn, pg8::StaticOrder, true, true>(lds, g, S, E, wave_s * 64 + lane_id_v()); }
            } else if (k == 2) { if (PHM & 2) mixers_phase(a, lds, l, tid); }
            else if (k == 3) { if (GM & 2) {
                pg8::Gemm g{(const bf16_t*)(ws + WS_YC0), (const bf16_t*)(ws + WS_WGLU) + (size_t)l * 512 * 512, M, 512, 512}; pg8::StaticOrder S; S.init(M, 512, G, c);
                pg8::EpiGlu E{(const bf16_t*)(ws + WS_YC0), (bf16_t*)(ws + WS_DYY) + (size_t)2 * M * 512};
                pg8::gemm_phase<pg8::EpiGlu, pg8::StaticOrder, true, true>(lds, g, S, E, wave_s * 64 + lane_id_v());
                {
                  constexpr int NI = 4 * (MP / 8) * 32; const float* XAp = (const float*)(ws + WS_XA); bf16_t* Dp = (bf16_t*)(ws + WS_DYY); const int t_ = wave_s * 64 + lane_id_v();
                  if (G > 132) { constexpr int SPLIT = (NI / 6 * 5) & ~63;
                      if (c >= 132) pool_phase(a, l, XAp, Dp, (c - 132) * 512 + t_, (G - 132) * 512, 0, SPLIT, true);
                      else pool_phase(a, l, XAp, Dp, c * 512 + t_, 132 * 512, SPLIT, NI, false); }
                  else pool_phase(a, l, XAp, Dp, c * 512 + t_, G * 512, 0, NI, true); } }
            } else if (k == 4) { if (GM & 4) {
                { pg8::Gemm g{(const bf16_t*)(ws + WS_DYY), (const bf16_t*)(ws + WS_WBR) + (size_t)l * 3072 * 512, 3 * M, 3072, 512, 0, 0}; pg8::BranchOrder S{G, c};
                  pg8::EpiMerge E{(const bf16_t*)(ws + WS_GT), (float*)(ws + WS_XA), H};
                  pg8::gemm_phase<pg8::EpiMerge, pg8::BranchOrder, true, true>(lds, g, S, E, wave_s * 64 + lane_id_v()); }
                { pg8::Gemm g{(const bf16_t*)(ws + WS_DYY), (const bf16_t*)(ws + WS_WBR) + (size_t)l * 3072 * 512, 3 * M, 3072, 128, 512, 512}; pg8::SplitOrder S{G, c, 4, 3};
                  pg8::EpiPart E{(float*)(ws + WS_Q), (const bf16_t*)(ws + WS_GT), 4};
                  pg8::gemm_phase<pg8::EpiPart, pg8::SplitOrder, true, true>(lds, g, S, E, wave_s * 64 + lane_id_v()); } }
            } else if (k == 5) { if (GM & 8) {
                { pg8::Gemm g{H, (const bf16_t*)(ws + WS_WOUT) + (size_t)l * 1024 * 1024, MP, 1024, 1024, 0, 0}; pg8::StaticOrder S; S.init(MP, 1024, G, c);
                  pg8::EpiRes E{xp, rep ? (float*)(ws + WS_XA) : X, MOD + l * 6144 + 2048};
                  pg8::gemm_phase<pg8::EpiRes, pg8::StaticOrder, true, true>(lds, g, S, E, wave_s * 64 + lane_id_v()); }
                for (int j = c; j < 64; j += G) { const int ks = j & 7, pmr = j >> 5; const float* Pm = (const float*)(ws + WS_Q);
                    for (int e2 = wave_s * 64 + lane_id_v(); e2 < 256 * 32; e2 += 512) { const int rs = pmr * 256 + (e2 >> 5), c4 = ks * 128 + (e2 & 31) * 4; f32x4 s = {0.f, 0.f, 0.f, 0.f};
#pragma unroll
                        for (int p = 0; p < 12; ++p) s += *(const f32x4*)(Pm + ((size_t)p * 512 + rs) * 1024 + c4);
                        st_bf4(H + (size_t)(MP + rs) * 1024 + c4, s); } }
                asm volatile("s_waitcnt vmcnt(0)" ::: "memory"); __syncthreads();
                { pg8::Gemm g{H, (const bf16_t*)(ws + WS_WOUT) + (size_t)l * 1024 * 1024, M, 1024, 128, 1024, 1024}; pg8::SplitOrder S{G, c, 8, 1};
                  pg8::EpiPart E{(float*)(ws + WS_YC0), nullptr, 8};
                  pg8::gemm_phase<pg8::EpiPart, pg8::SplitOrder, true, true>(lds, g, S, E, wave_s * 64 + lane_id_v()); } }
            } else if (k == 6) norm_phase(X, xs, a->in[10] + l * 1024, MOD + l * 6144 + 3072, 1024, H, tid, (const float*)(ws + WS_YC0), 8, MOD + l * 6144 + 2048, X);
            else if (k == 7) { if (GM & 16) {
                pg8::Gemm g{H, (const bf16_t*)(ws + WS_WFI) + (size_t)l * 2 * DFF * 1024, M, 2 * DFF, 1024}; pg8::StaticOrder S; S.init(M, 2 * DFF, G, c);
                pg8::EpiFfn E{(bf16_t*)(ws + WS_GT)};
                pg8::gemm_phase<pg8::EpiFfn, pg8::StaticOrder, true, true>(lds, g, S, E, wave_s * 64 + lane_id_v()); }
            } else if (GM & 32) {
                { pg8::Gemm g{(const bf16_t*)(ws + WS_GT), (const bf16_t*)(ws + WS_WFO) + (size_t)l * 1024 * DFF, MP, 1024, DFF, 0, 0}; pg8::StaticOrder S; S.init(MP, 1024, G, c);
                  pg8::EpiRes E{X, rep ? (float*)(ws + WS_XA) : X, MOD + l * 6144 + 5120};
                  pg8::gemm_phase<pg8::EpiRes, pg8::StaticOrder, true, true>(lds, g, S, E, wave_s * 64 + lane_id_v()); }
                { pg8::Gemm g{(const bf16_t*)(ws + WS_GT), (const bf16_t*)(ws + WS_WFO) + (size_t)l * 1024 * DFF, M, 1024, 128, DFF, DFF}; pg8::SplitOrder S{G, c, 22, 1};
                  pg8::EpiPart E{(float*)(ws + WS_DYY), nullptr, 22};
                  pg8::gemm_phase<pg8::EpiPart, pg8::SplitOrder, true, true>(lds, g, S, E, wave_s * 64 + lane_id_v()); }
            }
        }
        if (REPM && rep + 1 < nrep) __syncthreads();
        }
        if (ph + 1 < ph_hi) { if (SYNC2 == 1 || ph_hi > 1000) grid.sync(); else { XcdBarrier xb = xbar; asm volatile("" : "+s"(xb.x), "+s"(xb.bar));
            xcd_barrier(xb); if (SYNC2 == 2) xcd_barrier(xb); } }
    }
}

extern "C" void kernel_launch(void* const* d_in, const int* in_sizes, int n_in, void* d_out, int out_size, void* d_ws, size_t ws_size, hipStream_t stream) {
    static int grid = 0;
    if (grid == 0) {
        if (n_in != 33 || (size_t)out_size != OUT_TOTAL || ws_size < WS_END) { fprintf(stderr, "kernel_launch: unexpected shapes: n_in %d out %d ws %zu (need %zu)\n", n_in, out_size, ws_size, (size_t)WS_END); grid = -1; return; }
        int dev = 0, cus = 0, per_cu = 0;
        (void)hipGetDevice(&dev); (void)hipDeviceGetAttribute(&cus, hipDeviceAttributeMultiprocessorCount, dev);
        if (hipFuncSetAttribute((const void*)mega, hipFuncAttributeMaxDynamicSharedMemorySize, LDS_BYTES) != hipSuccess) { fprintf(stderr, "kernel_launch: hipFuncSetAttribute failed\n"); grid = -1; return; }
        if (hipOccupancyMaxActiveBlocksPerMultiprocessor(&per_cu, (const void*)mega, 512, LDS_BYTES) != hipSuccess || per_cu < 1) { fprintf(stderr, "kernel_launch: occupancy query says %d\n", per_cu); per_cu = 1; }
        (void)hipGetLastError();
        grid = cus * 1;
        if (grid <= 0) grid = 256;
    }
    if (grid < 0) return;
    Args a{};
    for (int i = 0; i < 33; ++i) a.in[i] = (const float*)d_in[i];
    a.out = (float*)d_out; a.ws = (unsigned char*)d_ws;
    for (int j = 0; j < 8; ++j) a.rfix[j] = (unsigned long long)ldexpl(powl(500000.0L, -(long double)j / 8.0L) / (2.0L * 3.14159265358979323846264338327950288L), 64);
#if MK_MULTI
    for (int ph = 0; ph < NPHASE; ++ph) { a.ph_lo = ph; a.ph_hi = ph + 1; hipLaunchKernelGGL(mega, dim3(grid), dim3(512), LDS_BYTES, stream, a); }
#else
    a.ph_lo = 0; a.ph_hi = NPHASE;
    if (hipMemsetAsync(d_ws, 0, 16384, stream) != hipSuccess) { fprintf(stderr, "kernel_launch: memset failed\n"); return; }
    void* args[] = {&a};
    hipError_t e = hipLaunchCooperativeKernel((const void*)mega, dim3(grid), dim3(512), args, LDS_BYTES, stream);
    if (e != hipSuccess) fprintf(stderr, "kernel_launch: cooperative launch failed: %s (grid %d)\n", hipGetErrorString(e), grid);
#endif
}
```

```cpp
#include <hip/hip_runtime.h>
#include <hip/hip_cooperative_groups.h>
#include <cstdio>
#include <cstdint>
#include <cmath>
namespace cg = cooperative_groups;

#ifndef MK_MULTI
#define MK_MULTI 0
#endif

__device__ __forceinline__ int lane_id_v() { int l; asm volatile("v_mbcnt_lo_u32_b32 %0, -1, 0\n\tv_mbcnt_hi_u32_b32 %0, -1, %0" : "=v"(l)); return l; }
__device__ __forceinline__ float shx(float v, int mask, int lane) { return __builtin_bit_cast(float, __builtin_amdgcn_ds_bpermute((lane ^ mask) << 2, __builtin_bit_cast(int, v))); }

__device__ __forceinline__ float shx32(float v, int upper  ) { const unsigned x = __builtin_bit_cast(unsigned, v); auto r = __builtin_amdgcn_permlane32_swap(x, x, false, false); return __builtin_bit_cast(float, upper ? r[0] : r[1]); }
__device__ __forceinline__ float shx16(float v, int odd  ) { const unsigned x = __builtin_bit_cast(unsigned, v); auto r = __builtin_amdgcn_permlane16_swap(x, x, false, false); return __builtin_bit_cast(float, odd ? r[0] : r[1]); }

namespace cfg {
constexpr int D = 1024, MP = 16384, MS = 512, M = MP + MS, SEQ = 2048, NBAT = 136, DEPTH = 4;
constexpr int IN_COLS = 4864, DFF = 2816, NMOD = 6 * D * DEPTH;
constexpr size_t OFF_Y = 0;
constexpr size_t OFF_KP = (size_t)M * D;
constexpr size_t OFF_VP = OFF_KP + (size_t)4 * 8 * 128 * 128;
constexpr size_t OFF_PP = OFF_VP + (size_t)4 * 8 * 128 * 128;
constexpr size_t OFF_SRP = OFF_PP + (size_t)4 * 8 * 15 * 512;
constexpr size_t OFF_SIP = OFF_SRP + (size_t)4 * 8 * 32 * 64;
constexpr size_t OFF_KS = OFF_SIP + (size_t)4 * 8 * 32 * 64;
constexpr size_t OFF_VS = OFF_KS + (size_t)4 * 128 * 128 * 128;
constexpr size_t OFF_PS = OFF_VS + (size_t)4 * 128 * 128 * 128;
constexpr size_t OFF_SRS = OFF_PS + (size_t)4 * 128 * 15 * 512;
constexpr size_t OFF_SIS = OFF_SRS + (size_t)4 * 128 * 32 * 64;
constexpr size_t OUT_TOTAL = OFF_SIS + (size_t)4 * 128 * 32 * 64;
static_assert(OUT_TOTAL == 41533440, "output size");
constexpr size_t MiB = 1u << 20;
constexpr size_t WS_WIN = 1 * MiB;
constexpr size_t WS_WGLU = WS_WIN + 38 * MiB;
constexpr size_t WS_WBR = WS_WGLU + 2 * MiB;
constexpr size_t WS_WOUT = WS_WBR + 12 * MiB;
constexpr size_t WS_WFI = WS_WOUT + 8 * MiB;
constexpr size_t WS_WFO = WS_WFI + 44 * MiB;
constexpr size_t WS_MOD = WS_WFO + 22 * MiB;
constexpr size_t WS_CA = WS_MOD + 13 * MiB;
constexpr size_t WS_TAB = WS_CA + 1 * MiB;
constexpr size_t WS_H = WS_TAB + 2 * MiB;
constexpr size_t WS_XA = WS_H + 33 * MiB;
constexpr size_t WS_U = WS_XA + 33 * MiB;
constexpr size_t WS_Q = WS_U + 33 * MiB;
constexpr size_t WS_K = WS_Q + 17 * MiB;
constexpr size_t WS_V = WS_K + 5 * MiB;
constexpr size_t WS_DYY = WS_V + 5 * MiB;
constexpr size_t WS_YC0 = WS_DYY + 50 * MiB;
constexpr size_t WS_GT = WS_YC0 + 17 * MiB;
constexpr size_t WS_END = WS_GT + 99 * MiB;
static_assert((size_t)M * 512 * 2 * 3 <= 50 * MiB && (size_t)M * 3072 * 2 <= 99 * MiB && (size_t)M * 1024 * 2 <= 33 * MiB, "ws map");
constexpr size_t TB_ROPEC = 0;
constexpr size_t TB_ROPES = 65664;
constexpr size_t TB_ABAR = 131328;
constexpr size_t TB_ABAR256 = TB_ABAR + 65536;
constexpr size_t TB_BBF = 262400;
constexpr size_t TB_CF = TB_BBF + 524288;
static_assert(TB_CF + 524288 <= 2 * MiB, "tables");
constexpr int LDS_BYTES = 147456;
constexpr int NPHASE = 2 + 9 * DEPTH + 1;
}

namespace pg8 {
#define PG8_LAS __attribute__((address_space(3)))
typedef unsigned short bf16_t;
typedef short bf16x8 __attribute__((ext_vector_type(8)));
typedef float f32x4 __attribute__((ext_vector_type(4)));
typedef unsigned u32x4 __attribute__((ext_vector_type(4)));
constexpr int BM = 256, BK = 64, HALF = 128, HTB = HALF * BK * 2  , STAGE_BYTES = 8 * HTB, NXCD = 8, WGM = 8;

__host__ __device__ __forceinline__ int lds_byte(int r, int c) { const int st = (r >> 4) * 2 + (c >> 5), rr = r & 15, cc = c & 31, ob = rr * 64 + cc * 2; return st * 1024 + (ob ^ (((ob >> 9) & 1) << 5)); }
__host__ __device__ __forceinline__ void stage_rc(int b, int& R, int& C) { const int st = b / 1024, sb = b % 1024, swz = sb ^ (((sb >> 9) & 1) << 5); R = (st >> 1) * 16 + swz / 64; C = (st & 1) * 32 + (swz % 64) / 2; }
__host__ __device__ __forceinline__ int perm32(int rho) { const int n = rho >> 4, i = rho & 15; return 8 * (i >> 2) + 4 * n + (i & 3); }

struct Unit { int pm, pn, k0; };
struct Gemm { const bf16_t* A; const bf16_t* Bt; int M, N, K, lda, ldb; };

struct StaticOrder {
    int nM, nN, nwg, G, c;
    __host__ __device__ void init(int M, int N, int G_, int c_) { nM = M / BM; nN = N / BM; nwg = nM * nN; G = G_; c = c_; }
    __host__ __device__ bool next(int i, Unit& u) const {
        const long L = (long)i * G + c; if (L >= nwg) return false;
        int wgid = (int)L; { const int q = nwg / NXCD, r = nwg % NXCD, xcd = wgid % NXCD, off = wgid / NXCD; wgid = (xcd < r ? xcd * (q + 1) : r * (q + 1) + (xcd - r) * q) + off; }
        const int nig = WGM * nN, gid = wgid / nig, fm = gid * WGM, gsz = (nM - fm) < WGM ? (nM - fm) : WGM;
        u.pm = fm + ((wgid % nig) % gsz); u.pn = (wgid % nig) / gsz; u.k0 = 0; return true;
    }
    __device__ __forceinline__ void a_ready(const Unit&) const {}
    __device__ __forceinline__ void done(const Unit&) const {}
};

__device__ __forceinline__ unsigned cvt_pk_bf16(float lo, float hi) { unsigned r; asm volatile("v_cvt_pk_bf16_f32 %0, %1, %2" : "=v"(r) : "v"(lo), "v"(hi)); return r; }
typedef unsigned u32x2 __attribute__((ext_vector_type(2)));
__device__ __forceinline__ float sigm(float x) { return __builtin_amdgcn_rcpf(1.f + __expf(-x)); }
__device__ __forceinline__ f32x4 ld_bf4(const bf16_t* p) { const u32x2 w = *(const u32x2*)p; f32x4 r; r[0] = __uint_as_float(w.x << 16); r[1] = __uint_as_float(w.x & 0xffff0000u); r[2] = __uint_as_float(w.y << 16); r[3] = __uint_as_float(w.y & 0xffff0000u); return r; }
__device__ __forceinline__ void st_bf4(bf16_t* p, const f32x4 v) { u32x2 w; w.x = cvt_pk_bf16(v[0], v[1]); w.y = cvt_pk_bf16(v[2], v[3]); *(u32x2*)p = w; }
__device__ __forceinline__ int batch_of(int row) { return row < cfg::MP ? (row >> 11) : 8 + ((row - cfg::MP) >> 2); }

struct EpiMod {
    static constexpr bool PERM = true, AFTER_DRAIN = false;
    float* MOD; const float* bada;
    __device__ __forceinline__ void operator()(const f32x4 (&acc)[2][2][4][2], const Unit& u, int wr, int wc, int fr, int fq) const {
#pragma unroll
        for (int ai = 0; ai < 2; ++ai)
#pragma unroll
            for (int m = 0; m < 4; ++m) { const int row = u.pm * 256 + ai * 128 + wr * 64 + m * 16 + fr;
                if (row < cfg::NBAT) {
#pragma unroll
                    for (int bj = 0; bj < 2; ++bj)
#pragma unroll
                        for (int n = 0; n < 2; ++n) { const int col = u.pn * 256 + bj * 128 + wc * 32 + 8 * fq + 4 * n;
                            *(f32x4*)(MOD + (size_t)row * cfg::NMOD + col) = acc[ai][bj][m][n] + *(const f32x4*)(bada + col); } } }
    }
};

struct EpiIn {
    static constexpr bool PERM = true, AFTER_DRAIN = false;
    float* XA; float* U; bf16_t* Q; bf16_t* KB; bf16_t* VB; bf16_t* GT; const float* ropec; const float* ropes; float* out; int layer;
    __device__ __forceinline__ void operator()(const f32x4 (&acc)[2][2][4][2], const Unit& u, int wr, int wc, int fr, int fq) const {
        const int pn = u.pn;
#pragma unroll
        for (int ai = 0; ai < 2; ++ai)
#pragma unroll
            for (int m = 0; m < 4; ++m) { const int row = u.pm * 256 + ai * 128 + wr * 64 + m * 16 + fr;
#pragma unroll
                for (int bj = 0; bj < 2; ++bj)
#pragma unroll
                    for (int n = 0; n < 2; ++n) { const int tc = bj * 128 + wc * 32 + 8 * fq + 4 * n; f32x4 v = acc[ai][bj][m][n];
                        if (pn < 2) { *(f32x4*)(XA + (size_t)row * 512 + pn * 256 + tc) = v; }
                        else if (pn <= 4) {
                            const bool isv = (pn == 4 && bj == 1);
                            if (!isv && (wc & 1) == 0) {
                                const int tix = row < cfg::MP ? (row & 2047) : 2048 + (row & 3);
                                const f32x4 cs = *(const f32x4*)(ropec + tix * 8 + 4 * n), sn = *(const f32x4*)(ropes + tix * 8 + 4 * n);
#pragma unroll
                                for (int i = 0; i < 4; ++i) { const float p = shx16(v[i], fq & 1); const float rv = v[i] * cs[i] + (fq == 0 ? -p : p) * sn[i]; v[i] = fq < 2 ? rv : v[i]; }
                            }
                            if (pn < 4) st_bf4(Q + (size_t)row * 512 + (pn - 2) * 256 + tc, v);
                            else { st_bf4((bj == 0 ? KB : VB) + (size_t)row * 128 + (tc & 127), v);
                                bool w = false; size_t o = 0;
                                if (row < cfg::MP) { const int t = row & 2047; if (t >= 1920) { w = true; o = (bj == 0 ? cfg::OFF_KP : cfg::OFF_VP) + ((size_t)(layer * 8 + (row >> 11)) * 128 + (t - 1920)) * 128 + (tc & 127); } }
                                else { const int rs = row - cfg::MP; w = true; o = (bj == 0 ? cfg::OFF_KS : cfg::OFF_VS) + ((size_t)(layer * 128 + (rs >> 2)) * 128 + 124 + (rs & 3)) * 128 + (tc & 127); }
                                if (w) *(f32x4*)(out + o) = v; }
                        }
                        else if (pn < 7) { *(f32x4*)(U + (size_t)row * 512 + (pn - 5) * 256 + tc) = v; }
                        else { f32x4 s; s[0] = sigm(v[0]); s[1] = sigm(v[1]); s[2] = sigm(v[2]); s[3] = sigm(v[3]); st_bf4(GT + (size_t)row * 3072 + (pn - 7) * 256 + tc, s); }
                    } }
    }
};

struct EpiGlu {
    static constexpr bool PERM = true, AFTER_DRAIN = false;
    const bf16_t* YC0; bf16_t* YC;
    __device__ __forceinline__ void operator()(const f32x4 (&acc)[2][2][4][2], const Unit& u, int wr, int wc, int fr, int fq) const {
#pragma unroll
        for (int ai = 0; ai < 2; ++ai)
#pragma unroll
            for (int m = 0; m < 4; ++m) { const int row = u.pm * 256 + ai * 128 + wr * 64 + m * 16 + fr;
#pragma unroll
                for (int bj = 0; bj < 2; ++bj)
#pragma unroll
                    for (int n = 0; n < 2; ++n) { const int col = u.pn * 256 + bj * 128 + wc * 32 + 8 * fq + 4 * n; const f32x4 v = acc[ai][bj][m][n];
                        const f32x4 y0 = ld_bf4(YC0 + (size_t)row * 512 + col); f32x4 o;
#pragma unroll
                        for (int i = 0; i < 4; ++i) o[i] = y0[i] * sigm(v[i]);
                        st_bf4(YC + (size_t)row * 512 + col, o); } }
    }
};

struct EpiMerge {
    static constexpr bool PERM = true, AFTER_DRAIN = false;
    const bf16_t* GT; float* M32; bf16_t* M16;
    __device__ __forceinline__ void operator()(const f32x4 (&acc)[2][2][4][2], const Unit& u, int wr, int wc, int fr, int fq) const {
        const int br = u.pm / 66, pm = u.pm - br * 66, pn = u.pn & 3;
        if (br > 0) asm volatile("s_waitcnt vmcnt(0)" ::: "memory");
#pragma unroll
        for (int ai = 0; ai < 2; ++ai)
#pragma unroll
            for (int m = 0; m < 4; ++m) { const int row = pm * 256 + ai * 128 + wr * 64 + m * 16 + fr;
#pragma unroll
                for (int bj = 0; bj < 2; ++bj)
#pragma unroll
                    for (int n = 0; n < 2; ++n) { const int col = pn * 256 + bj * 128 + wc * 32 + 8 * fq + 4 * n; const f32x4 v = acc[ai][bj][m][n];
                        const f32x4 g = ld_bf4(GT + (size_t)row * 3072 + br * 1024 + col);
                        bf16_t* mp = M16 + (size_t)row * 1024 + col;
                        if (br == 0) st_bf4(mp, g * v); else st_bf4(mp, ld_bf4(mp) + g * v); } }
    }
};

struct EpiRes {
    static constexpr bool PERM = true, AFTER_DRAIN = false;
    const float* xin; float* X; const float* MODG;
    __device__ __forceinline__ void operator()(const f32x4 (&acc)[2][2][4][2], const Unit& u, int wr, int wc, int fr, int fq) const {
        const float* gp = MODG + (size_t)(u.pm >> 3) * cfg::NMOD + u.pn * 256 + wc * 32 + 8 * fq;
        f32x4 g[2][2];
#pragma unroll
        for (int bj = 0; bj < 2; ++bj)
#pragma unroll
            for (int n = 0; n < 2; ++n) g[bj][n] = *(const f32x4*)(gp + bj * 128 + n * 4);
#pragma unroll
        for (int ai = 0; ai < 2; ++ai)
#pragma unroll
            for (int m = 0; m < 4; ++m) { const int row = u.pm * 256 + ai * 128 + wr * 64 + m * 16 + fr;
#pragma unroll
                for (int bj = 0; bj < 2; ++bj)
#pragma unroll
                    for (int n = 0; n < 2; ++n) { const size_t o = (size_t)row * 1024 + u.pn * 256 + bj * 128 + wc * 32 + 8 * fq + 4 * n;
                        *(f32x4*)(X + o) = *(const f32x4*)(xin + o) + g[bj][n] * acc[ai][bj][m][n]; } }
    }
};

struct EpiPart {
    static constexpr bool PERM = true, AFTER_DRAIN = false;
    float* P; const bf16_t* GT; int nks;
    __device__ __forceinline__ void operator()(const f32x4 (&acc)[2][2][4][2], const Unit& u, int wr, int wc, int fr, int fq) const {
        const int br = u.pm / 66, pmr = u.pm - br * 66 - 64, pn = u.pn & 3, slice = br * nks + (u.k0 >> 7);
#pragma unroll
        for (int ai = 0; ai < 2; ++ai)
#pragma unroll
            for (int m = 0; m < 4; ++m) { const int rs = pmr * 256 + ai * 128 + wr * 64 + m * 16 + fr;
#pragma unroll
                for (int bj = 0; bj < 2; ++bj)
#pragma unroll
                    for (int n = 0; n < 2; ++n) { const int col = pn * 256 + bj * 128 + wc * 32 + 8 * fq + 4 * n; f32x4 v = acc[ai][bj][m][n];
                        if (GT) v = v * ld_bf4(GT + (size_t)(cfg::MP + rs) * 3072 + br * 1024 + col);
                        *(f32x4*)(P + ((size_t)slice * 512 + rs) * 1024 + col) = v; } }
    }
};

struct EpiFfn {
    static constexpr bool PERM = true, AFTER_DRAIN = false;
    bf16_t* ACT;
    __device__ __forceinline__ void operator()(const f32x4 (&acc)[2][2][4][2], const Unit& u, int wr, int wc, int fr, int fq) const {
#pragma unroll
        for (int ai = 0; ai < 2; ++ai)
#pragma unroll
            for (int m = 0; m < 4; ++m) { const int row = u.pm * 256 + ai * 128 + wr * 64 + m * 16 + fr;
#pragma unroll
                for (int n = 0; n < 2; ++n) { const int col = u.pn * 128 + wc * 32 + 8 * fq + 4 * n; const f32x4 a = acc[ai][0][m][n], b = acc[ai][1][m][n]; f32x4 o;
#pragma unroll
                    for (int i = 0; i < 4; ++i) o[i] = a[i] * sigm(a[i]) * b[i];
                    st_bf4(ACT + (size_t)row * cfg::DFF + col, o); } }
    }
};

struct BranchOrder {
    int G, c;
    __host__ __device__ bool next(int i, Unit& u) const { const int tile = c + (i / 3) * G; if (tile >= 256) return false; const int br = i % 3; u.pm = br * 66 + (tile >> 2); u.pn = br * 4 + (tile & 3); u.k0 = 0; return true; }
    __device__ __forceinline__ void a_ready(const Unit&) const {}
    __device__ __forceinline__ void done(const Unit&) const {}
};
struct SplitOrder {
    int G, c, nks, nbr;
    __host__ __device__ bool next(int i, Unit& u) const { const int j = c + i * G; if (j >= 8 * nbr * nks) return false; const int ks = j % nks, t = j / nks, br = t % nbr, tile = t / nbr;
        u.pm = br * 66 + 64 + (tile >> 2); u.pn = br * 4 + (tile & 3); u.k0 = ks * 128; return true; }
    __device__ __forceinline__ void a_ready(const Unit&) const {}
    __device__ __forceinline__ void done(const Unit&) const {}
};

template <class Epi, class Sched, bool ALIGN_EPI = false, bool SP2 = false>
__device__ __forceinline__ void gemm_phase(PG8_LAS unsigned char* lds, const Gemm g, const Sched& S, const Epi& E, const int tid_in) {
    int tid_l = tid_in; asm volatile("" : "+v"(tid_l));
    const int tid = tid_l, wid = __builtin_amdgcn_readfirstlane(tid >> 6), lane = tid & 63, wr = wid >> 2, wc = wid & 3, fr = lane & 15, fq = lane >> 4;
    const int K = g.K, nt = K / BK, lda = g.lda ? g.lda : K, ldb = lda;
    unsigned voffA[2], voffB[2];
#pragma unroll
    for (int i = 0; i < 2; ++i) { int R, C; stage_rc(tid * 16 + i * 8192, R, C); const int Rb = Epi::PERM ? ((R & ~31) + perm32(R & 31)) : R;
        voffA[i] = (unsigned)(R * lda + C) * 2u; voffB[i] = (unsigned)(Rb * ldb + C) * 2u; }
    const size_t kstep = (size_t)(BK * 2);
    const size_t hstepA = (size_t)HALF * lda * 2, hstepB = (size_t)HALF * ldb * 2;
    const size_t tstepA = 2 * hstepA, tstepB = 2 * hstepB;
    const unsigned ldsw = (unsigned)wid * 1024u;
    const int aoff = lds_byte(wr * 64 + fr, fq * 8), boff = lds_byte(wc * 32 + fr, fq * 8);
#define PG8_SA(b, h) (((b) * 2 + (h)) * HTB)
#define PG8_SB(b, h) ((4 + (b) * 2 + (h)) * HTB)
#define PG8_STAGE(bufoff, gbase, voff) do { _Pragma("unroll") for (int _i = 0; _i < 2; ++_i) \
        __builtin_amdgcn_global_load_lds((const unsigned*)((const char*)(gbase) + (voff)[_i]), (PG8_LAS unsigned*)(lds + (bufoff) + ldsw + _i * 8192), 16, 0, 0); } while (0)
#define PG8_LDA(dst, b, h) do { _Pragma("unroll") for (int m = 0; m < 4; ++m) _Pragma("unroll") for (int k = 0; k < 2; ++k) dst[m][k] = *(const PG8_LAS bf16x8*)(lds + PG8_SA(b, h) + aoff + m * 2048 + k * 1024); } while (0)
#define PG8_LDB(dst, b, h) do { _Pragma("unroll") for (int n = 0; n < 2; ++n) _Pragma("unroll") for (int k = 0; k < 2; ++k) dst[n][k] = *(const PG8_LAS bf16x8*)(lds + PG8_SB(b, h) + boff + n * 2048 + k * 1024); } while (0)
#define PG8_MMA(ai, bj, At, Bt) do { __builtin_amdgcn_s_setprio(1); _Pragma("unroll") for (int m = 0; m < 4; ++m) _Pragma("unroll") for (int n = 0; n < 2; ++n) _Pragma("unroll") for (int k = 0; k < 2; ++k) \
        acc[ai][bj][m][n] = __builtin_amdgcn_mfma_f32_16x16x32_bf16(Bt[n][k], At[m][k], acc[ai][bj][m][n], 0, 0, 0); __builtin_amdgcn_s_setprio(0); } while (0)
#define PG8_WAIT_V(n) asm volatile("s_waitcnt vmcnt(" #n ")" ::: "memory")
#define PG8_WAIT_L(n) asm volatile("s_waitcnt lgkmcnt(" #n ")" ::: "memory")
#define PG8_BAR __builtin_amdgcn_s_barrier()
#define PG8_SCHED __builtin_amdgcn_sched_barrier(0)
    Unit cur, nxt; int ui = 0;
    if (!S.next(0, cur)) return;
    f32x4 acc[2][2][4][2];
#pragma unroll
    for (int a = 0; a < 2; ++a)
#pragma unroll
        for (int b = 0; b < 2; ++b)
#pragma unroll
            for (int m = 0; m < 4; ++m)
#pragma unroll
                for (int n = 0; n < 2; ++n) acc[a][b][m][n] = (f32x4){0.f, 0.f, 0.f, 0.f};
    bf16x8 At[4][2], B0[2][2], B1[2][2];
    const char* cA = (const char*)g.A + (size_t)cur.pm * tstepA + (size_t)cur.k0 * 2; const char* cB = (const char*)g.Bt + (size_t)cur.pn * tstepB + (size_t)cur.k0 * 2;
    S.a_ready(cur);
    if constexpr (SP2) {
        PG8_STAGE(PG8_SB(0, 0), cB, voffB); PG8_STAGE(PG8_SB(0, 1), cB + hstepB, voffB); PG8_STAGE(PG8_SA(0, 0), cA, voffA); PG8_STAGE(PG8_SA(0, 1), cA + hstepA, voffA);
        if (wr == 1) PG8_BAR;
        PG8_WAIT_V(2); PG8_BAR;
        PG8_STAGE(PG8_SB(1, 0), cB + kstep, voffB); PG8_STAGE(PG8_SA(1, 0), cA + kstep, voffA); PG8_STAGE(PG8_SB(1, 1), cB + hstepB + kstep, voffB);
        PG8_WAIT_V(6); PG8_BAR;
    } else {
        PG8_STAGE(PG8_SB(0, 0), cB, voffB); PG8_STAGE(PG8_SA(0, 0), cA, voffA); PG8_STAGE(PG8_SB(0, 1), cB + hstepB, voffB); PG8_STAGE(PG8_SA(0, 1), cA + hstepA, voffA);
        if (wr == 1) PG8_BAR;
        PG8_WAIT_V(4); PG8_BAR;
        PG8_STAGE(PG8_SB(1, 0), cB + kstep, voffB); PG8_STAGE(PG8_SA(1, 0), cA + kstep, voffA); PG8_STAGE(PG8_SB(1, 1), cB + hstepB + kstep, voffB);
        PG8_WAIT_V(6); PG8_BAR;
    }
    for (;;) {
        const bool has_next = S.next(ui + 1, nxt);
        const char* nA = has_next ? (const char*)g.A + (size_t)nxt.pm * tstepA + (size_t)nxt.k0 * 2 : cA; const char* nB = has_next ? (const char*)g.Bt + (size_t)nxt.pn * tstepB + (size_t)nxt.k0 * 2 : cB;
        for (int t = 0; t < nt; t += 2) {
            const bool last = (t == nt - 2);
            const char* a1 = cA + (size_t)(t + 1) * kstep;
            const char* a2 = last ? nA : cA + (size_t)(t + 2) * kstep; const char* b2 = last ? nB : cB + (size_t)(t + 2) * kstep;
            const char* a3 = a2 + kstep; const char* b3 = b2 + kstep;
            if (last && has_next) S.a_ready(nxt);
            if constexpr (SP2) {
            PG8_LDB(B0, 0, 0); PG8_LDB(B1, 0, 1); PG8_SCHED; PG8_LDA(At, 0, 0); PG8_STAGE(PG8_SA(1, 1), a1 + hstepA, voffA);
            PG8_WAIT_V(8); PG8_WAIT_L(0); PG8_BAR; PG8_MMA(0, 0, At, B0); PG8_MMA(0, 1, At, B1); PG8_BAR; PG8_SCHED;
            PG8_LDA(At, 0, 1); PG8_STAGE(PG8_SB(0, 0), b2, voffB); PG8_STAGE(PG8_SB(0, 1), b2 + hstepB, voffB); PG8_STAGE(PG8_SA(0, 0), a2, voffA);
            PG8_WAIT_V(8); PG8_WAIT_L(0); PG8_BAR; PG8_MMA(1, 0, At, B0); PG8_MMA(1, 1, At, B1); PG8_BAR; PG8_SCHED;
            PG8_LDB(B0, 1, 0); PG8_LDB(B1, 1, 1); PG8_SCHED; PG8_LDA(At, 1, 0); PG8_STAGE(PG8_SA(0, 1), a2 + hstepA, voffA);
            PG8_WAIT_V(8); PG8_WAIT_L(0); PG8_BAR; PG8_MMA(0, 0, At, B0); PG8_MMA(0, 1, At, B1); PG8_BAR; PG8_SCHED;
            PG8_LDA(At, 1, 1); PG8_STAGE(PG8_SB(1, 0), b3, voffB); PG8_STAGE(PG8_SB(1, 1), b3 + hstepB, voffB); PG8_STAGE(PG8_SA(1, 0), a3, voffA);
            PG8_WAIT_V(8); PG8_WAIT_L(0); PG8_BAR; PG8_MMA(1, 0, At, B0); PG8_MMA(1, 1, At, B1); PG8_BAR; PG8_SCHED;
            } else {
            PG8_LDB(B0, 0, 0); PG8_SCHED; PG8_LDA(At, 0, 0); PG8_STAGE(PG8_SA(1, 1), a1 + hstepA, voffA);
            PG8_WAIT_L(8); PG8_BAR; PG8_WAIT_L(0); PG8_MMA(0, 0, At, B0); PG8_BAR; PG8_SCHED;
            PG8_LDB(B1, 0, 1); PG8_STAGE(PG8_SB(0, 0), b2, voffB);
            PG8_BAR; PG8_WAIT_L(0); PG8_MMA(0, 1, At, B1); PG8_BAR;
            PG8_LDA(At, 0, 1); PG8_STAGE(PG8_SA(0, 0), a2, voffA);
            PG8_BAR; PG8_WAIT_L(0); PG8_MMA(1, 0, At, B0); PG8_BAR; PG8_SCHED;
            PG8_STAGE(PG8_SB(0, 1), b2 + hstepB, voffB);
            PG8_WAIT_V(6); PG8_BAR; PG8_MMA(1, 1, At, B1); PG8_BAR;
            PG8_LDB(B0, 1, 0); PG8_SCHED; PG8_LDA(At, 1, 0); PG8_STAGE(PG8_SA(0, 1), a2 + hstepA, voffA);
            PG8_WAIT_L(8); PG8_BAR; PG8_WAIT_L(0); PG8_MMA(0, 0, At, B0); PG8_BAR; PG8_SCHED;
            PG8_LDB(B1, 1, 1); PG8_STAGE(PG8_SB(1, 0), b3, voffB);
            PG8_BAR; PG8_WAIT_L(0); PG8_MMA(0, 1, At, B1); PG8_BAR;
            PG8_LDA(At, 1, 1); PG8_STAGE(PG8_SA(1, 0), a3, voffA);
            PG8_BAR; PG8_WAIT_L(0); PG8_MMA(1, 0, At, B0); PG8_BAR; PG8_SCHED;
            PG8_STAGE(PG8_SB(1, 1), b3 + hstepB, voffB);
            PG8_WAIT_V(6); PG8_BAR; PG8_MMA(1, 1, At, B1); PG8_BAR;
            }
        }
        if constexpr (ALIGN_EPI) { if (wr == 0) PG8_BAR; }
        if constexpr (!Epi::AFTER_DRAIN) { E(acc, cur, wr, wc, fr, fq); S.done(cur); }
        if (!has_next) break;
#pragma unroll
        for (int a = 0; a < 2; ++a)
#pragma unroll
            for (int b = 0; b < 2; ++b)
#pragma unroll
                for (int m = 0; m < 4; ++m)
#pragma unroll
                    for (int n = 0; n < 2; ++n) acc[a][b][m][n] = (f32x4){0.f, 0.f, 0.f, 0.f};
        cur = nxt; cA = nA; cB = nB; ++ui;
        if constexpr (ALIGN_EPI) { if (wr == 1) PG8_BAR; }
    }
    PG8_WAIT_V(0);
    if constexpr (!ALIGN_EPI) { if (wr == 0) PG8_BAR; }
    PG8_BAR;
    if constexpr (Epi::AFTER_DRAIN) { E.fused(acc, cur, wr, wc, fr, fq, lds, wid, lane); S.done(cur); }
#undef PG8_SA
#undef PG8_SB
#undef PG8_STAGE
#undef PG8_LDA
#undef PG8_LDB
#undef PG8_MMA
#undef PG8_WAIT_V
#undef PG8_WAIT_L
#undef PG8_BAR
#undef PG8_SCHED
}
}

#define LAS __attribute__((address_space(3)))
#define DI __device__ __forceinline__
typedef unsigned short bf16_t;
typedef short bf16x8 __attribute__((ext_vector_type(8)));
typedef short s16x4 __attribute__((ext_vector_type(4)));
typedef float f32x4 __attribute__((ext_vector_type(4)));
typedef float f32x16 __attribute__((ext_vector_type(16)));
typedef unsigned u32x4 __attribute__((ext_vector_type(4)));
typedef unsigned u32x2 __attribute__((ext_vector_type(2)));
using pg8::cvt_pk_bf16; using pg8::sigm; using pg8::ld_bf4; using pg8::st_bf4; using pg8::batch_of;
using namespace cfg;

DI float bf2f(bf16_t b) { return __uint_as_float((unsigned)b << 16); }
DI unsigned f2bf(float f) { unsigned u = __float_as_uint(f); return (u + 0x7fffu + ((u >> 16) & 1u)) >> 16; }
DI float wave_sum(float v, int lane) {
#pragma unroll
    for (int o = 1; o < 64; o <<= 1) v += shx(v, o, lane);
    return v;
}
DI float wave_max(float v, int lane) {
#pragma unroll
    for (int o = 1; o < 64; o <<= 1) v = fmaxf(v, shx(v, o, lane));
    return v;
}
DI bf16x8 pack8(const f32x4 a, const f32x4 b) { u32x4 p; p.x = cvt_pk_bf16(a[0], a[1]); p.y = cvt_pk_bf16(a[2], a[3]); p.z = cvt_pk_bf16(b[0], b[1]); p.w = cvt_pk_bf16(b[2], b[3]); return __builtin_bit_cast(bf16x8, p); }
#define MFMA16(a, b, c) __builtin_amdgcn_mfma_f32_16x16x32_bf16((a), (b), (c), 0, 0, 0)
#define MFMA32(a, b, c) __builtin_amdgcn_mfma_f32_32x32x16_bf16((a), (b), (c), 0, 0, 0)

#define XB_TMO      128
#define XB_XCNT(j)  (256  + 64 * (j))
#define XB_XSUB(j)  (1280 + 64 * (j))
#define XB_XGEN(j)  (2304 + 64 * (j))
#define XB_TOP      3328
#define XB_TOPGEN   3392
#define XCD_BAR_WORDS 3456
#define XB_SPIN_CAP (1u << 18)

__device__ __forceinline__ unsigned xb_ld(unsigned* p)              { return __hip_atomic_load(p, __ATOMIC_RELAXED, __HIP_MEMORY_SCOPE_AGENT); }
__device__ __forceinline__ unsigned xb_add(unsigned* p, unsigned v) { return __hip_atomic_fetch_add(p, v, __ATOMIC_RELAXED, __HIP_MEMORY_SCOPE_AGENT); }
__device__ __forceinline__ unsigned xb_xcc_id() { return (unsigned)__builtin_amdgcn_s_getreg((3 << 11) | 20) & 0xFu; }
#define XB_SPIN(cond, bar) do { unsigned _sp = 0; while (cond) { __builtin_amdgcn_s_sleep(1); \
    if ((++_sp & 255u) == 0u) { if (xb_ld(&(bar)[XB_TMO])) break; if (_sp > XB_SPIN_CAP) { atomicAdd(&(bar)[XB_TMO], 1u); break; } } } } while (0)

struct XcdBarrier {
    unsigned* bar; unsigned x;
    volatile LAS unsigned* st;
};

__device__ __forceinline__ XcdBarrier xcd_barrier_post(unsigned* bar, volatile LAS unsigned* st) {
    XcdBarrier b; b.bar = bar; b.x = xb_xcc_id(); b.st = st;
    if (threadIdx.x == 0) (void)xb_add(&bar[XB_XCNT(b.x)], 1u);
    return b;
}
__device__ __forceinline__ void xcd_barrier_complete(unsigned* bar, unsigned x, unsigned& nloc, unsigned& nx) {
    const unsigned G = gridDim.x * gridDim.y * gridDim.z;
    unsigned sum, cnt, mine, sp = 0u;
    for (;;) {
        sum = 0u; cnt = 0u; mine = 0u;
#pragma unroll
        for (unsigned j = 0; j < 16; ++j) { const unsigned c = xb_ld(&bar[XB_XCNT(j)]); sum += c; cnt += (c > 0u) ? 1u : 0u; mine = (j == x) ? c : mine; }
        if (sum == G) break;
        __builtin_amdgcn_s_sleep(1);
        if ((++sp & 255u) == 0u) { if (xb_ld(&bar[XB_TMO])) break; if (sp > XB_SPIN_CAP) { atomicAdd(&bar[XB_TMO], 1u); break; } }
    }
    nloc = mine > 0u ? mine : 1u; nx = cnt > 0u ? cnt : 1u;
}

__device__ __forceinline__ void xcd_barrier(const XcdBarrier& b) {
    asm volatile("s_waitcnt vmcnt(0)" ::: "memory");
    __syncthreads();
    if (threadIdx.x == 0) {
        unsigned* bar = b.bar;
        __builtin_amdgcn_s_waitcnt(0);
        unsigned nloc = b.st[0], nx = b.st[1];
        if (nloc == 0u) { xcd_barrier_complete(bar, b.x, nloc, nx); b.st[0] = nloc; b.st[1] = nx; }
        const unsigned old = xb_add(&bar[XB_XSUB(b.x)], 1u);
        const unsigned gen = old / nloc;
        if (old + 1u == (gen + 1u) * nloc) {
            __builtin_amdgcn_fence(__ATOMIC_RELEASE, "agent");
            asm volatile("s_waitcnt vmcnt(0)" ::: "memory");
            const unsigned og = xb_add(&bar[XB_TOP], 1u);
            const unsigned tg = og / nx;
            if (og + 1u == (tg + 1u) * nx) xb_add(&bar[XB_TOPGEN], 1u);
            else XB_SPIN(xb_ld(&bar[XB_TOPGEN]) == tg, bar);
            __builtin_amdgcn_fence(__ATOMIC_ACQUIRE, "agent");
            xb_add(&bar[XB_XGEN(b.x)], 1u);
            asm volatile("s_waitcnt vmcnt(0)" ::: "memory");
        } else {
            XB_SPIN(xb_ld(&bar[XB_XGEN(b.x)]) == gen, bar);
            __builtin_amdgcn_fence(__ATOMIC_ACQUIRE, "agent");
            asm volatile("s_waitcnt vmcnt(0)" ::: "memory");
        }
    }
    __syncthreads();
}

#ifndef MIXM
#define MIXM 0
#endif
#ifndef SYNC2
#define SYNC2 0
#endif
#ifndef REPM
#define REPM 0
#endif
#ifndef GM
#define GM 0xff
#endif
#ifndef PHM
#define PHM 0xff
#endif
struct Args { const float* in[33]; float* out; unsigned char* ws; unsigned long long rfix[8]; int ph_lo, ph_hi; };
typedef const Args __attribute__((address_space(4)))* ArgsP;

DI void tr_item(const float* W, int K, int N, bf16_t* WT, int k0, int n0, int drow0, LAS float* scr, int lane) {
#pragma unroll 8
    for (int i = 0; i < 32; ++i) { const int kk = 2 * i + (lane >> 5); scr[kk * 33 + (lane & 31)] = W[(size_t)(k0 + kk) * N + n0 + (lane & 31)]; }
    asm volatile("s_waitcnt lgkmcnt(0)" ::: "memory");
    const int c = lane & 7;
#pragma unroll
    for (int j = 0; j < 4; ++j) { const int n = (lane >> 3) + 8 * j; const LAS float* s = scr + (8 * c) * 33 + n;
        u32x4 o; o.x = cvt_pk_bf16(s[0 * 33], s[1 * 33]); o.y = cvt_pk_bf16(s[2 * 33], s[3 * 33]); o.z = cvt_pk_bf16(s[4 * 33], s[5 * 33]); o.w = cvt_pk_bf16(s[6 * 33], s[7 * 33]);
        *(u32x4*)(WT + (size_t)(drow0 + n) * K + k0 + 8 * c) = o; }
    asm volatile("s_waitcnt lgkmcnt(0)" ::: "memory");
}
DI void fold_item(const float* Pw  , const float* Sc  , const float* Wa  , bf16_t* WT  , int k0, int n0, LAS float* scr, int lane) {
    const int g = k0 >> 7, nn = lane & 31, hi = lane >> 5;
    for (int jc = 0; jc < 4; ++jc) {
        float w[32];
#pragma unroll
        for (int jj = 0; jj < 32; ++jj) { const int j = g * 128 + jc * 32 + jj; w[jj] = Sc[j] * Wa[(size_t)j * 1024 + n0 + nn]; }
#pragma unroll 1
        for (int i = 0; i < 32; ++i) { const float* pr = Pw + ((size_t)g * 128 + ((k0 & 127) + 2 * i + hi)) * 128 + jc * 32; float acc = 0.f;
#pragma unroll
            for (int j4 = 0; j4 < 8; ++j4) { const f32x4 p = *(const f32x4*)(pr + 4 * j4);
                acc += p[0] * w[4 * j4] + p[1] * w[4 * j4 + 1] + p[2] * w[4 * j4 + 2] + p[3] * w[4 * j4 + 3]; }
            LAS float* sp = scr + (2 * i + hi) * 33 + nn; if (jc == 0) *sp = acc; else *sp += acc; }
    }
    asm volatile("s_waitcnt lgkmcnt(0)" ::: "memory");
    const int c = lane & 7;
#pragma unroll
    for (int j = 0; j < 4; ++j) { const int n = (lane >> 3) + 8 * j; const LAS float* s = scr + (8 * c) * 33 + n;
        u32x4 o; o.x = cvt_pk_bf16(s[0 * 33], s[1 * 33]); o.y = cvt_pk_bf16(s[2 * 33], s[3 * 33]); o.z = cvt_pk_bf16(s[4 * 33], s[5 * 33]); o.w = cvt_pk_bf16(s[6 * 33], s[7 * 33]);
        *(u32x4*)(WT + (size_t)(n0 + n) * 512 + k0 + 8 * c) = o; }
    asm volatile("s_waitcnt lgkmcnt(0)" ::: "memory");
}
DI void sincos_frac(float f  , float& c, float& s) { s = __builtin_amdgcn_sinf(f); c = __builtin_amdgcn_cosf(f); }

DI void prologue(ArgsP a, LAS unsigned char* lds, int tid) {
    const int lane = tid & 63, wave = tid >> 6;
    const int gw = blockIdx.x * 8 + wave, NGW = gridDim.x * 8;
    const int gt = blockIdx.x * 512 + tid, NT = gridDim.x * 512;
    unsigned char* ws = a->ws;
    LAS float* scr = (LAS float*)(lds + wave * 16384);
    constexpr int I_IN = 16 * 152, I_GLU = 8 * 16, I_BR = 8 * 32, I_OUT = 16 * 32, I_FI = 16 * 176, I_FO = 44 * 32, I_ADA = 16 * 192, I_FOLD = 8 * 32;
    constexpr int PER_L = I_IN + I_GLU + 2 * I_BR + I_OUT + I_FI + I_FO + I_ADA + I_FOLD;
    for (int it = gw; it < PER_L * 4; it += NGW) {
        const int l = it & 3; int r = it >> 2;
        if (r < I_FOLD) { fold_item(a->in[14] + (size_t)l * 4 * 128 * 128, a->in[15] + l * 512, a->in[26] + (size_t)l * 512 * 1024, (bf16_t*)(ws + WS_WBR) + (size_t)l * 3072 * 512, (r >> 5) * 64, (r & 31) * 32, scr, lane); continue; } r -= I_FOLD;
        if (r < I_IN) { const int kb = r / 152, nb = r % 152; tr_item(a->in[13] + (size_t)l * 1024 * IN_COLS, 1024, IN_COLS, (bf16_t*)(ws + WS_WIN) + (size_t)l * IN_COLS * 1024, kb * 64, nb * 32, nb * 32, scr, lane); continue; } r -= I_IN;
        if (r < I_GLU) { const int kb = r / 16, nb = r % 16; tr_item(a->in[25] + (size_t)l * 512 * 512, 512, 512, (bf16_t*)(ws + WS_WGLU) + (size_t)l * 512 * 512, kb * 64, nb * 32, nb * 32, scr, lane); continue; } r -= I_GLU;
        if (r < I_BR) { const int kb = r / 32, nb = r % 32; tr_item(a->in[27] + (size_t)l * 512 * 1024, 512, 1024, (bf16_t*)(ws + WS_WBR) + (size_t)l * 3072 * 512, kb * 64, nb * 32, 1024 + nb * 32, scr, lane); continue; } r -= I_BR;
        if (r < I_BR) { const int kb = r / 32, nb = r % 32; tr_item(a->in[28] + (size_t)l * 512 * 1024, 512, 1024, (bf16_t*)(ws + WS_WBR) + (size_t)l * 3072 * 512, kb * 64, nb * 32, 2048 + nb * 32, scr, lane); continue; } r -= I_BR;
        if (r < I_OUT) { const int kb = r / 32, nb = r % 32; tr_item(a->in[29] + (size_t)l * 1024 * 1024, 1024, 1024, (bf16_t*)(ws + WS_WOUT) + (size_t)l * 1024 * 1024, kb * 64, nb * 32, nb * 32, scr, lane); continue; } r -= I_OUT;
        if (r < I_FI) { const int kb = r / 176, nb = r % 176; const int n0 = nb * 32, half = n0 / DFF, j = n0 - half * DFF;
            tr_item(a->in[30] + (size_t)l * 1024 * 2 * DFF, 1024, 2 * DFF, (bf16_t*)(ws + WS_WFI) + (size_t)l * 2 * DFF * 1024, kb * 64, n0, 256 * (j >> 7) + 128 * half + (j & 127), scr, lane); continue; } r -= I_FI;
        if (r < I_FO) { const int kb = r / 32, nb = r % 32; tr_item(a->in[31] + (size_t)l * DFF * 1024, DFF, 1024, (bf16_t*)(ws + WS_WFO) + (size_t)l * 1024 * DFF, kb * 64, nb * 32, nb * 32, scr, lane); continue; } r -= I_FO;
        { const int kb = r / 192, nb = r % 192; tr_item(a->in[11] + (size_t)l * 1024 * 6144, 1024, 6144, (bf16_t*)(ws + WS_GT), kb * 64, nb * 32, l * 6144 + nb * 32, scr, lane); }
    }
    { bf16_t* CA = (bf16_t*)(ws + WS_CA);
      for (int i = gt; i < 256 * 1024; i += NT) { const int r = i >> 10, c = i & 1023; float v = 0.f;
          if (r < 8) v = a->in[7][r * 1024 + c]; else if (r < NBAT) v = a->in[8][(r - 8) * 1024 + c];
          CA[i] = (bf16_t)f2bf(v * sigm(v)); } }
    { float* rc = (float*)(ws + WS_TAB + TB_ROPEC); float* rs = (float*)(ws + WS_TAB + TB_ROPES);
      for (int i = gt; i < 2052 * 8; i += NT) { const int ti = i >> 3, j = i & 7; const int pos = ti < 2048 ? ti : 8192 + (ti - 2048);
          const unsigned long long fx = (unsigned long long)pos * a->rfix[j];
          float c, s; sincos_frac((float)(unsigned)(fx >> 40) * 5.9604644775390625e-08f, c, s); rc[i] = c; rs[i] = s; } }
    { float* AB = (float*)(ws + WS_TAB + TB_ABAR); float* AB256 = (float*)(ws + WS_TAB + TB_ABAR256); bf16_t* BBF = (bf16_t*)(ws + WS_TAB + TB_BBF);
      for (int i = gt; i < 4 * 32 * 64; i += NT) { const int lg = i >> 6, p = i & 63;
          const float dt = expf(a->in[19][lg]); const float ar = a->in[17][i], ai = a->in[18][i];
          const float x = ar * dt; const float yt = ai * dt * 0.15915494309189535f;
          float c, s; sincos_frac(yt, c, s); float ch, sh; sincos_frac(0.5f * yt, ch, sh);
          const float em1 = x * (1.f + x * (0.5f + x * (0.16666667f + x * (0.041666668f + x * 0.0083333338f))));
          const float ex = 1.f + em1;
          const float abr = ex * c, abi = ex * s;
          const float nr = em1 * c - (sh + sh) * sh, ni = abi;
          const float den = 1.f / (ar * ar + ai * ai);
          const float cr = (nr * ar + ni * ai) * den, ci = (ni * ar - nr * ai) * den;
          AB[2 * i] = abr; AB[2 * i + 1] = abi;
          float pr = abr, pi = abi;
#pragma unroll
          for (int k = 0; k < 8; ++k) { const float t = pr * pr - pi * pi; pi = (pr + pr) * pi; pr = t; }
          AB256[2 * i] = pr; AB256[2 * i + 1] = pi;
          const float* br = a->in[20] + (size_t)i * 16; const float* bi = a->in[21] + (size_t)i * 16;
          const int st = p >> 5;
#pragma unroll
          for (int half = 0; half < 2; ++half) { u32x4 ore, oim; unsigned* pre = (unsigned*)&ore; unsigned* pim = (unsigned*)&oim; (void)pre; (void)pim;
              float vr[8], vi[8];
#pragma unroll
              for (int j = 0; j < 8; ++j) { const float b_r = br[half * 8 + j], b_i = bi[half * 8 + j]; vr[j] = cr * b_r - ci * b_i; vi[j] = cr * b_i + ci * b_r; }
              ore.x = cvt_pk_bf16(vr[0], vr[1]); ore.y = cvt_pk_bf16(vr[2], vr[3]); ore.z = cvt_pk_bf16(vr[4], vr[5]); ore.w = cvt_pk_bf16(vr[6], vr[7]);
              oim.x = cvt_pk_bf16(vi[0], vi[1]); oim.y = cvt_pk_bf16(vi[2], vi[3]); oim.z = cvt_pk_bf16(vi[4], vi[5]); oim.w = cvt_pk_bf16(vi[6], vi[7]);
              *(u32x4*)(BBF + (((size_t)lg * 4 + 0 + st) * 64 + half * 32 + (p & 31)) * 8) = ore;
              *(u32x4*)(BBF + (((size_t)lg * 4 + 2 + st) * 64 + half * 32 + (p & 31)) * 8) = oim; } } }
    { bf16_t* CF = (bf16_t*)(ws + WS_TAB + TB_CF);
      for (int i = gt; i < 4 * 32 * 4 * 64; i += NT) { const int ln = i & 63, ks = (i >> 6) & 3, lg = i >> 8; const int c = ln & 15, quad = ln >> 4;
          float v[8];
#pragma unroll
          for (int j = 0; j < 8; ++j) { const int k = ks * 32 + quad * 8 + j; v[j] = k < 64 ? a->in[22][((size_t)lg * 16 + c) * 64 + k] : -a->in[23][((size_t)lg * 16 + c) * 64 + (k - 64)]; }
          u32x4 o; o.x = cvt_pk_bf16(v[0], v[1]); o.y = cvt_pk_bf16(v[2], v[3]); o.z = cvt_pk_bf16(v[4], v[5]); o.w = cvt_pk_bf16(v[6], v[7]);
          *(u32x4*)(CF + (size_t)i * 8) = o; } }
}

DI void cache_shift(ArgsP a, int gt, int NT) {
    for (int i = gt; i < 4 * 128 * 124 * 32; i += NT) { const int c4 = i & 31, j = (i >> 5) % 124, lb = (i >> 5) / 124;
        *(f32x4*)(a->out + OFF_KS + ((size_t)lb * 128 + j) * 128 + c4 * 4) = *(const f32x4*)(a->in[2] + ((size_t)lb * 128 + j + 4) * 128 + c4 * 4);
        *(f32x4*)(a->out + OFF_VS + ((size_t)lb * 128 + j) * 128 + c4 * 4) = *(const f32x4*)(a->in[3] + ((size_t)lb * 128 + j + 4) * 128 + c4 * 4); }
    for (int i = gt; i < 4 * 128 * 11 * 128; i += NT) { const int c4 = i & 127, j = (i >> 7) % 11, lb = (i >> 7) / 11;
        *(f32x4*)(a->out + OFF_PS + ((size_t)lb * 15 + j) * 512 + c4 * 4) = *(const f32x4*)(a->in[4] + ((size_t)lb * 15 + j + 4) * 512 + c4 * 4); }
}

DI void norm_phase(const float* xp, const float* xs, const float* gvec, const float* MODL  , int sc_off, bf16_t* H, int tid,
                   const float* P, int nparts, const float* pgate, float* X) {
    const int lane = tid & 63, gw = blockIdx.x * 8 + (tid >> 6), NGW = gridDim.x * 8;
    for (int it = gw; it < M; it += NGW) {
        const int row = it < MS ? MP + it : it - MS;
        const int bi = batch_of(row);
        const float* xr = (row < MP ? xp : xs) + (size_t)row * 1024; const float* mr = MODL + (size_t)bi * NMOD;
        f32x4 v[4]; float ss = 0.f;
#pragma unroll
        for (int j = 0; j < 4; ++j) v[j] = *(const f32x4*)(xr + 4 * lane + 256 * j);
        if (row >= MP && nparts > 0) {
            f32x4 s[4];
#pragma unroll
            for (int j = 0; j < 4; ++j) s[j] = (f32x4){0.f, 0.f, 0.f, 0.f};
            for (int p = 0; p < nparts; ++p) { const float* pr = P + ((size_t)p * 512 + (row - MP)) * 1024 + 4 * lane;
#pragma unroll
                for (int j = 0; j < 4; ++j) s[j] += *(const f32x4*)(pr + 256 * j); }
#pragma unroll
            for (int j = 0; j < 4; ++j) { v[j] += *(const f32x4*)(pgate + (size_t)bi * NMOD + 4 * lane + 256 * j) * s[j]; *(f32x4*)(X + (size_t)row * 1024 + 4 * lane + 256 * j) = v[j]; }
        }
#pragma unroll
        for (int j = 0; j < 4; ++j) ss += v[j][0] * v[j][0] + v[j][1] * v[j][1] + v[j][2] * v[j][2] + v[j][3] * v[j][3];
        const float r = rsqrtf(wave_sum(ss, lane) * (1.f / 1024.f) + 1e-6f);
        if (H) {
#pragma unroll
            for (int j = 0; j < 4; ++j) { const int c = 4 * lane + 256 * j; const f32x4 g = *(const f32x4*)(gvec + c), sh = *(const f32x4*)(mr + c), sc = *(const f32x4*)(mr + sc_off + c);
                st_bf4(H + (size_t)row * 1024 + c, v[j] * r * g * (1.f + sc) + sh); }
        } else {
#pragma unroll
            for (int j = 0; j < 4; ++j) { const int c = 4 * lane + 256 * j; *(f32x4*)(X + (size_t)row * 1024 + c) = v[j] * r * *(const f32x4*)(gvec + c); }
        }
    }
}

template <int W>
DI void pool_run(const float* XA, bf16_t* Dm, float* out, int l, int row0, int c4) {
    const int t0 = row0 & 2047;
    f32x4 x[W + 7];
#pragma unroll
    for (int i = 0; i < W + 7; ++i) { const int dt = i - (W - 1); x[i] = (t0 + dt >= 0) ? *(const f32x4*)(XA + (size_t)(row0 + dt) * 512 + c4) : (f32x4){0.f, 0.f, 0.f, 0.f}; }
    f32x4 s = x[0];
#pragma unroll
    for (int i = 1; i < W - 1; ++i) s += x[i];
#pragma unroll
    for (int k = 0; k < 8; ++k) { s += x[W - 1 + k]; const int t = t0 + k; const float cnt = (float)((t + 1 < W) ? t + 1 : W);
        st_bf4(Dm + (size_t)(row0 + k) * 512 + c4, s * (1.f / cnt) - x[W - 1 + k]);
        if (t >= 2033) *(f32x4*)(out + OFF_PP + ((size_t)(l * 8 + (row0 >> 11)) * 15 + (t - 2033)) * 512 + c4) = x[W - 1 + k];
        s -= x[k]; }
}
DI void pool_phase(ArgsP a, int l, const float* XA, bf16_t* Dm, int gt  , int NT  , int lo, int hi  , bool do_sample) {
    constexpr int NRUN = MP / 8;
    for (int item = lo + gt; item < hi; item += NT) {
        const int c4l = item & 31, gr = item >> 5, g = gr / NRUN, run = gr - g * NRUN; const int c4 = g * 128 + c4l * 4, row0 = run * 8;
        if (g == 0) pool_run<2>(XA, Dm, a->out, l, row0, c4); else if (g == 1) pool_run<4>(XA, Dm, a->out, l, row0, c4);
        else if (g == 2) pool_run<8>(XA, Dm, a->out, l, row0, c4); else pool_run<16>(XA, Dm, a->out, l, row0, c4);
    }
    if (do_sample) for (int idx = gt; idx < MS * 128; idx += NT) {
        const int row = MP + (idx >> 7), c4 = (idx & 127) * 4, w = 2 << (c4 >> 7);
        const f32x4 x = *(const f32x4*)(XA + (size_t)row * 512 + c4); f32x4 sum = x;
        const int rs = row - MP, bs = rs >> 2, t = rs & 3;
        for (int s = 1; s < w; ++s) { const int pos = t - s;
            sum += pos >= 0 ? *(const f32x4*)(XA + (size_t)(row - s) * 512 + c4) : *(const f32x4*)(a->in[4] + ((size_t)(l * 128 + bs) * 15 + 15 + pos) * 512 + c4); }
        *(f32x4*)(a->out + OFF_PS + ((size_t)(l * 128 + bs) * 15 + 11 + t) * 512 + c4) = x;
        st_bf4(Dm + (size_t)row * 512 + c4, sum * (1.f / (float)w) - x);
    }
}

DI void attn_prompt_unit(LAS unsigned char* lds, int unit, const bf16_t* Q, const bf16_t* KB, const bf16_t* VB, bf16_t* YB, const float* sinks, int tid) {
    const int b = unit >> 5, g = (unit >> 4) & 1, nb = unit & 15;
    LAS bf16_t* Ks = (LAS bf16_t*)lds;
    LAS bf16_t* Vt = (LAS bf16_t*)(lds + 36864);
    const int krow0 = b * 2048 + (nb - 1) * 128;
#pragma unroll
    for (int it = 0; it < 4; ++it) {
        const int chunk = tid + 512 * it, j = chunk >> 3, c8 = chunk & 7;
        u32x4 kv = {0u, 0u, 0u, 0u}, vv = {0u, 0u, 0u, 0u};
        if (nb > 0 || j >= 128) { const size_t off = (size_t)(krow0 + j) * 128 + g * 64 + c8 * 8; kv = *(const u32x4*)(KB + off); vv = *(const u32x4*)(VB + off); }
        *(LAS u32x4*)(Ks + j * 72 + c8 * 8) = kv;
        LAS bf16_t* vp = Vt + (c8 * 8) * 264 + j;
        vp[0 * 264] = (bf16_t)(vv.x & 0xffffu); vp[1 * 264] = (bf16_t)(vv.x >> 16); vp[2 * 264] = (bf16_t)(vv.y & 0xffffu); vp[3 * 264] = (bf16_t)(vv.y >> 16);
        vp[4 * 264] = (bf16_t)(vv.z & 0xffffu); vp[5 * 264] = (bf16_t)(vv.z >> 16); vp[6 * 264] = (bf16_t)(vv.w & 0xffffu); vp[7 * 264] = (bf16_t)(vv.w >> 16);
    }
    __syncthreads();
    const int wave = tid >> 6, lane = tid & 63, l15 = lane & 15, quad = lane >> 4;
    const int r = wave >> 1, hq = g * 4 + r;
    const float sc2 = 0.125f * 1.4426950408889634f;
    const float sk2 = sinks[hq] * 1.4426950408889634f;
    const int kt0 = wave & 1;
#pragma unroll 1
    for (int qh = 0; qh < 2; ++qh) {
        const int q0 = (wave & 1) * 64 + qh * 32;
        const int qrow0 = b * 2048 + nb * 128 + q0;
        bf16x8 qf[2][2];
#pragma unroll
        for (int qt = 0; qt < 2; ++qt)
#pragma unroll
            for (int ds = 0; ds < 2; ++ds) qf[qt][ds] = *(const bf16x8*)(Q + (size_t)(qrow0 + qt * 16 + l15) * 512 + hq * 64 + ds * 32 + quad * 8);
        float m2[2], ls[2]; f32x4 o[4][2];
#pragma unroll
        for (int qt = 0; qt < 2; ++qt) { m2[qt] = sk2; ls[qt] = quad == 0 ? 1.f : 0.f;
#pragma unroll
            for (int dt = 0; dt < 4; ++dt) o[dt][qt] = (f32x4){0.f, 0.f, 0.f, 0.f}; }
#pragma unroll 1
        for (int kk = 0; kk < 3; ++kk) {
            const int kt = kt0 + kk;
            if (nb == 0 && kt < 2) continue;
            f32x4 s[4][2];
#pragma unroll
            for (int sub = 0; sub < 4; ++sub) { const LAS bf16_t* kp = Ks + (kt * 64 + sub * 16 + l15) * 72 + quad * 8;
                const bf16x8 k0 = *(const LAS bf16x8*)kp, k1 = *(const LAS bf16x8*)(kp + 32);
#pragma unroll
                for (int qt = 0; qt < 2; ++qt) { s[sub][qt] = MFMA16(k0, qf[qt][0], ((f32x4){0.f, 0.f, 0.f, 0.f})); s[sub][qt] = MFMA16(k1, qf[qt][1], s[sub][qt]); } }
#pragma unroll
            for (int qt = 0; qt < 2; ++qt) { const int i = q0 + qt * 16 + l15; float mx = -INFINITY;
#pragma unroll
                for (int sub = 0; sub < 4; ++sub)
#pragma unroll
                    for (int jj = 0; jj < 4; ++jj) { const int j = kt * 64 + sub * 16 + quad * 4 + jj; const bool valid = (j > i) && (j <= i + 128) && (nb > 0 || j >= 128);
                        const float v = valid ? s[sub][qt][jj] * sc2 : -INFINITY; s[sub][qt][jj] = v; mx = fmaxf(mx, v); }
                mx = fmaxf(mx, shx16(mx, quad & 1)); mx = fmaxf(mx, shx32(mx, quad >> 1));
                const float mn = fmaxf(m2[qt], mx), alpha = __builtin_amdgcn_exp2f(m2[qt] - mn); m2[qt] = mn; float sum = 0.f;
#pragma unroll
                for (int sub = 0; sub < 4; ++sub)
#pragma unroll
                    for (int jj = 0; jj < 4; ++jj) { const float p = __builtin_amdgcn_exp2f(s[sub][qt][jj] - mn); s[sub][qt][jj] = p; sum += p; }
                ls[qt] = ls[qt] * alpha + sum;
#pragma unroll
                for (int dt = 0; dt < 4; ++dt) o[dt][qt] *= alpha; }
#pragma unroll
            for (int s2 = 0; s2 < 2; ++s2) { bf16x8 pf[2];
#pragma unroll
                for (int qt = 0; qt < 2; ++qt) pf[qt] = pack8(s[2 * s2][qt], s[2 * s2 + 1][qt]);
#pragma unroll
                for (int dt = 0; dt < 4; ++dt) { const LAS bf16_t* vp = Vt + (dt * 16 + l15) * 264 + kt * 64 + s2 * 32 + quad * 4;
                    const s16x4 v0 = *(const LAS s16x4*)vp, v1 = *(const LAS s16x4*)(vp + 16);
                    const bf16x8 vf = __builtin_shufflevector(v0, v1, 0, 1, 2, 3, 4, 5, 6, 7);
#pragma unroll
                    for (int qt = 0; qt < 2; ++qt) o[dt][qt] = MFMA16(vf, pf[qt], o[dt][qt]); } }
        }
#pragma unroll
        for (int qt = 0; qt < 2; ++qt) { float lt = ls[qt]; lt += shx16(lt, quad & 1); lt += shx32(lt, quad >> 1); const float inv = 1.f / lt;
            bf16_t* yp = YB + (size_t)(qrow0 + qt * 16 + l15) * 512 + hq * 64 + quad * 4;
#pragma unroll
            for (int dt = 0; dt < 4; ++dt) st_bf4(yp + dt * 16, o[dt][qt] * inv); }
    }
    __syncthreads();
}

DI void attn_sample_task(LAS unsigned char* wl, int task, int l, ArgsP a, const bf16_t* Q, bf16_t* YB, int lane) {
    const int b = task >> 3, h = task & 7, g = h >> 2;
    LAS float* qs = (LAS float*)wl;
    LAS float* ps = qs + 256;
#pragma unroll
    for (int t = 0; t < 4; ++t) qs[t * 64 + lane] = bf2f(Q[(size_t)(MP + b * 4 + t) * 512 + h * 64 + lane]);
    const float* ck = a->in[2] + (size_t)(l * 128 + b) * 128 * 128 + g * 64;
    const float* cv = a->in[3] + (size_t)(l * 128 + b) * 128 * 128 + g * 64;
    const float* nk = a->out + OFF_KS + ((size_t)(l * 128 + b) * 128 + 124) * 128 + g * 64;
    const float* nv = a->out + OFF_VS + ((size_t)(l * 128 + b) * 128 + 124) * 128 + g * 64;
    const float sink = a->in[16][l * 8 + h];
    float mx[4] = {sink, sink, sink, sink};
    for (int rr = 0; rr < 3; ++rr) { const int j = rr * 64 + lane; float s[4] = {0.f, 0.f, 0.f, 0.f};
        if (j < 132) { const float* kp = j < 128 ? ck + (size_t)j * 128 : nk + (size_t)(j - 128) * 128;
#pragma unroll 4
            for (int d4 = 0; d4 < 16; ++d4) { const f32x4 k4 = *(const f32x4*)(kp + 4 * d4);
#pragma unroll
                for (int t = 0; t < 4; ++t) { const f32x4 q4 = *(const LAS f32x4*)(qs + t * 64 + 4 * d4); s[t] += k4[0] * q4[0] + k4[1] * q4[1] + k4[2] * q4[2] + k4[3] * q4[3]; } } }
#pragma unroll
        for (int t = 0; t < 4; ++t) { const bool valid = (j < 132) && (j >= t + 1) && (j <= t + 128); const float v = valid ? s[t] * 0.125f : -INFINITY;
            if (j < 136) ps[t * 136 + j] = v; mx[t] = fmaxf(mx[t], v); } }
    float den[4];
#pragma unroll
    for (int t = 0; t < 4; ++t) { mx[t] = wave_max(mx[t], lane); float sum = 0.f;
        for (int rr = 0; rr < 3; ++rr) { const int j = rr * 64 + lane; if (j < 132) { const float p = __expf(ps[t * 136 + j] - mx[t]); ps[t * 136 + j] = p; sum += p; } }
        den[t] = wave_sum(sum, lane) + __expf(sink - mx[t]); }
    float o[4] = {0.f, 0.f, 0.f, 0.f};
    for (int j = 0; j < 132; ++j) { const float v = (j < 128 ? cv + (size_t)j * 128 : nv + (size_t)(j - 128) * 128)[lane];
#pragma unroll
        for (int t = 0; t < 4; ++t) o[t] += ps[t * 136 + j] * v; }
#pragma unroll
    for (int t = 0; t < 4; ++t) YB[(size_t)(MP + b * 4 + t) * 512 + h * 64 + lane] = (bf16_t)f2bf(o[t] / den[t]);
}

struct S5C { bf16x8 bbf[4]; bf16x8 cf[4]; float are[2], aim[2]; };
DI float gelu_tanh(float y) { const float z = 1.5957691216057308f * (y + 0.044715f * y * y * y); return y * sigm(z); }
template <bool OUT>
DI void s5_tile(const S5C& K, const float* U, int row0, int g, int nruns, int nvalid, float (&hre)[2], float (&him)[2], LAS bf16_t* Hs, const float* dvec, bf16_t* YC0, int lane) {
    const int tok = lane & 31, half = lane >> 5;
    bf16x8 af = {0, 0, 0, 0, 0, 0, 0, 0};
    if (tok < nvalid) { const float* up = U + (size_t)(row0 + tok) * 512 + g * 16 + half * 8; af = pack8(*(const f32x4*)up, *(const f32x4*)(up + 4)); }
    f32x16 z16;
#pragma unroll
    for (int i = 0; i < 16; ++i) z16[i] = 0.f;
    f32x16 dre[2], dim[2];
#pragma unroll
    for (int st = 0; st < 2; ++st) { dre[st] = MFMA32(af, K.bbf[st], z16); dim[st] = MFMA32(af, K.bbf[2 + st], z16); }
#pragma unroll
    for (int r = 0; r < 8; ++r) {
        if (r < nruns) {
            const int hf = r & 1, i0 = 4 * (r >> 1);
            if (half == hf) {
#pragma unroll
                for (int k = 0; k < 4; ++k)
#pragma unroll
                    for (int st = 0; st < 2; ++st) { const float nr = K.are[st] * hre[st] - K.aim[st] * him[st] + dre[st][i0 + k]; const float ni = K.are[st] * him[st] + K.aim[st] * hre[st] + dim[st][i0 + k];
                        hre[st] = nr; him[st] = ni; dre[st][i0 + k] = nr; dim[st][i0 + k] = ni; }
            }
#pragma unroll
            for (int st = 0; st < 2; ++st) { const float pr = __shfl_xor(hre[st], 32), pi = __shfl_xor(him[st], 32); if (half != hf) { hre[st] = pr; him[st] = pi; } }
        }
    }
    if (OUT) {
#pragma unroll
        for (int i = 0; i < 16; ++i) { const int tr = (i & 3) + 8 * (i >> 2) + 4 * half; LAS bf16_t* hp = Hs + tr * 136 + tok;
#pragma unroll
            for (int st = 0; st < 2; ++st) { hp[st * 32] = (bf16_t)f2bf(dre[st][i]); hp[64 + st * 32] = (bf16_t)f2bf(dim[st][i]); } }
        const int l15 = lane & 15, quad = lane >> 4;
#pragma unroll
        for (int tt = 0; tt < 2; ++tt) {
            if (tt * 16 < nvalid) {
                f32x4 acc = {0.f, 0.f, 0.f, 0.f};
#pragma unroll
                for (int ks = 0; ks < 4; ++ks) { const bf16x8 hf8 = *(const LAS bf16x8*)(Hs + (tt * 16 + l15) * 136 + ks * 32 + quad * 8); acc = MFMA16(K.cf[ks], hf8, acc); }
                const int tk = tt * 16 + l15;
                if (tk < nvalid) { const size_t ro = (size_t)(row0 + tk) * 512 + g * 16 + quad * 4;
                    const f32x4 u4 = *(const f32x4*)(U + ro), d4 = *(const f32x4*)(dvec + quad * 4); f32x4 y = acc + d4 * u4;
                    y[0] = gelu_tanh(y[0]); y[1] = gelu_tanh(y[1]); y[2] = gelu_tanh(y[2]); y[3] = gelu_tanh(y[3]);
                    st_bf4(YC0 + ro, y); }
            }
        }
    }
}
DI void s5_load_consts(S5C& K, const unsigned char* ws, int lg, int lane) {
    const bf16_t* BBF = (const bf16_t*)(ws + WS_TAB + TB_BBF); const bf16_t* CF = (const bf16_t*)(ws + WS_TAB + TB_CF); const float* AB = (const float*)(ws + WS_TAB + TB_ABAR);
#pragma unroll
    for (int t = 0; t < 4; ++t) { K.bbf[t] = *(const bf16x8*)(BBF + (((size_t)lg * 4 + t) * 64 + lane) * 8); K.cf[t] = *(const bf16x8*)(CF + (((size_t)lg * 4 + t) * 64 + lane) * 8); }
#pragma unroll
    for (int st = 0; st < 2; ++st) { const int p = st * 32 + (lane & 31); K.are[st] = AB[((size_t)lg * 64 + p) * 2]; K.aim[st] = AB[((size_t)lg * 64 + p) * 2 + 1]; }
}
DI void s5_prompt_task(LAS unsigned char* lds, int task, int l, ArgsP a, const float* U, bf16_t* YC0, int tid) {
    const int b = task >> 5, g = task & 31, lg = l * 32 + g, wave = tid >> 6, lane = tid & 63;
    LAS bf16_t* Hs = (LAS bf16_t*)(lds + wave * 8704);
    LAS float* Es = (LAS float*)(lds + 8 * 8704);
    S5C K; s5_load_consts(K, a->ws, lg, lane);
    const float* dvec = a->in[24] + l * 512 + g * 16;
    const int rowb = b * 2048 + wave * 256;
    float hre[2] = {0.f, 0.f}, him[2] = {0.f, 0.f};
    for (int tl = 0; tl < 8; ++tl) s5_tile<false>(K, U, rowb + tl * 32, g, 8, 32, hre, him, Hs, dvec, YC0, lane);
    if (lane < 32) { Es[(wave * 4 + 0) * 32 + lane] = hre[0]; Es[(wave * 4 + 1) * 32 + lane] = hre[1]; Es[(wave * 4 + 2) * 32 + lane] = him[0]; Es[(wave * 4 + 3) * 32 + lane] = him[1]; }
    __syncthreads();
    { const float* A256 = (const float*)(a->ws + WS_TAB + TB_ABAR256); float pr[2], pi[2];
#pragma unroll
      for (int st = 0; st < 2; ++st) { const int p = st * 32 + (lane & 31); pr[st] = A256[((size_t)lg * 64 + p) * 2]; pi[st] = A256[((size_t)lg * 64 + p) * 2 + 1]; hre[st] = 0.f; him[st] = 0.f; }
      for (int w = 0; w < wave; ++w) {
#pragma unroll
          for (int st = 0; st < 2; ++st) { const float er = Es[(w * 4 + st) * 32 + (lane & 31)], ei = Es[(w * 4 + 2 + st) * 32 + (lane & 31)];
              const float nr = pr[st] * hre[st] - pi[st] * him[st] + er, ni = pr[st] * him[st] + pi[st] * hre[st] + ei; hre[st] = nr; him[st] = ni; } } }
    for (int tl = 0; tl < 8; ++tl) s5_tile<true>(K, U, rowb + tl * 32, g, 8, 32, hre, him, Hs, dvec, YC0, lane);
    if (wave == 7 && lane < 32) {
#pragma unroll
        for (int st = 0; st < 2; ++st) { a->out[OFF_SRP + ((size_t)(l * 8 + b) * 32 + g) * 64 + st * 32 + lane] = hre[st]; a->out[OFF_SIP + ((size_t)(l * 8 + b) * 32 + g) * 64 + st * 32 + lane] = him[st]; } }
    __syncthreads();
}
DI void s5_sample_task(LAS unsigned char* lds, int task, int l, ArgsP a, const float* U, bf16_t* YC0, int tid) {
    const int bs = task >> 5, g = task & 31, lg = l * 32 + g, wave = tid >> 6, lane = tid & 63;
    LAS bf16_t* Hs = (LAS bf16_t*)(lds + wave * 8704);
    S5C K; s5_load_consts(K, a->ws, lg, lane);
    const size_t so = ((size_t)(l * 128 + bs) * 32 + g) * 64;
    float hre[2], him[2];
#pragma unroll
    for (int st = 0; st < 2; ++st) { hre[st] = a->in[5][so + st * 32 + (lane & 31)]; him[st] = a->in[6][so + st * 32 + (lane & 31)]; }
    s5_tile<true>(K, U, MP + bs * 4, g, 1, 4, hre, him, Hs, a->in[24] + l * 512 + g * 16, YC0, lane);
    if (lane < 32) {
#pragma unroll
        for (int st = 0; st < 2; ++st) { a->out[OFF_SRS + so + st * 32 + lane] = hre[st]; a->out[OFF_SIS + so + st * 32 + lane] = him[st]; } }
}

DI void mixers_phase(ArgsP a, LAS unsigned char* lds, int l, int tid) {
    unsigned char* ws = a->ws;
    const float* XA = (const float*)(ws + WS_XA); const float* U = (const float*)(ws + WS_U);
    const bf16_t* Q = (const bf16_t*)(ws + WS_Q); const bf16_t* KB = (const bf16_t*)(ws + WS_K); const bf16_t* VB = (const bf16_t*)(ws + WS_V);
    bf16_t* Dm = (bf16_t*)(ws + WS_DYY); bf16_t* YB = Dm + (size_t)M * 512; bf16_t* YC0 = (bf16_t*)(ws + WS_YC0);
    const int wave = tid >> 6, lane = tid & 63, gw = blockIdx.x * 8 + wave, NGW = gridDim.x * 8;
    for (int rp = 0; rp < 1 + ((MIXM >> 0) & 1); ++rp) for (int u = blockIdx.x; u < 256; u += gridDim.x) attn_prompt_unit(lds, u, Q, KB, VB, YB, a->in[16] + l * 8, tid);
    for (int rp = 0; rp < 1 + ((MIXM >> 1) & 1); ++rp) for (int t = blockIdx.x; t < 256; t += gridDim.x) s5_prompt_task(lds, t, l, a, U, YC0, tid);
    for (int rp = 0; rp < 1 + ((MIXM >> 2) & 1); ++rp) for (int t = gw; t < 4096; t += NGW) s5_sample_task(lds, t, l, a, U, YC0, tid);
    __syncthreads();
    for (int rp = 0; rp < 1 + ((MIXM >> 3) & 1); ++rp) for (int t = gw; t < 1024; t += NGW) attn_sample_task(lds + wave * 4096, t, l, a, Q, YB, lane);
}

__global__ void __launch_bounds__(512, 2) mega(Args a_unused) {
    extern __shared__ __attribute__((aligned(16))) unsigned char lds_raw[];
    LAS unsigned char* lds = (LAS unsigned char*)lds_raw;
    cg::grid_group grid = cg::this_grid();
    const int wave_s = __builtin_amdgcn_readfirstlane((int)threadIdx.x >> 6);
    volatile LAS unsigned* bst = (volatile LAS unsigned*)(lds + 135168);
    if (threadIdx.x < 2) bst[threadIdx.x] = 0u;
    __syncthreads();
    XcdBarrier xbar = xcd_barrier_post((unsigned*)(((ArgsP)__builtin_amdgcn_kernarg_segment_ptr())->ws), bst);
    const int ph_lo = ((ArgsP)__builtin_amdgcn_kernarg_segment_ptr())->ph_lo, ph_hi = ((ArgsP)__builtin_amdgcn_kernarg_segment_ptr())->ph_hi;
    for (int ph = ph_lo; ph < ph_hi; ++ph) {
        const int kk9 = (ph - 2) % 9;
        const int cls = ph == 0 ? 0 : ph == 1 ? 1 : ph == NPHASE - 1 ? 10 : (kk9 == 0 || kk9 == 6) ? 2 : kk9 == 1 ? 3 : kk9 == 2 ? 4 : kk9 == 3 ? 5 : kk9 == 4 ? 6 : kk9 == 5 ? 7 : kk9 == 7 ? 8 : 9;
        const int nrep = 1 + ((REPM >> cls) & 1);
        for (int rep = 0; rep < nrep; ++rep) {
        ArgsP a = (ArgsP)__builtin_amdgcn_kernarg_segment_ptr(); asm volatile("" : "+s"(a));
        int G = gridDim.x, c = blockIdx.x; asm volatile("" : "+s"(G), "+s"(c));
        int tid = wave_s * 64 + lane_id_v(); asm volatile("" : "+v"(tid));
        unsigned char* ws = a->ws;
        float* X = a->out;
        float* MOD = (float*)(ws + WS_MOD);
        bf16_t* H = (bf16_t*)(ws + WS_H);
        if (ph == 0) { if (PHM & 1) prologue(a, lds, tid); }
        else if (ph == 1) { if (PHM & 4) {
            pg8::Gemm g{(const bf16_t*)(ws + WS_CA), (const bf16_t*)(ws + WS_GT), 256, NMOD, 1024}; pg8::StaticOrder S; S.init(256, NMOD, G, c);
            pg8::EpiMod E{MOD, a->in[12]};
            pg8::gemm_phase<pg8::EpiMod, pg8::StaticOrder, true, true>(lds, g, S, E, wave_s * 64 + lane_id_v());
            { const int t_ = wave_s * 64 + lane_id_v(); if (G > 96) { if (c >= 96) cache_shift(a, (c - 96) * 512 + t_, (G - 96) * 512); } else cache_shift(a, c * 512 + t_, G * 512); } }
        } else if (ph == NPHASE - 1) norm_phase(X, X, a->in[32], MOD, 0, nullptr, tid, (const float*)(ws + WS_DYY), 22, MOD + 3 * 6144 + 5120, X);
        else {
            const int l = (ph - 2) / 9, k = (ph - 2) % 9;
            const float* xp = l == 0 ? a->in[0] : X; const float* xs = l == 0 ? a->in[1] - (size_t)MP * 1024 : X;
            if (k == 0) norm_phase(xp, xs, a->in[9] + l * 1024, MOD + l * 6144, 1024, H, tid, (const float*)(ws + WS_DYY), l == 0 ? 0 : 22, MOD + (l - 1) * 6144 + 5120, X);
            else if (k == 1) { if (GM & 1) {
                pg8::Gemm g{H, (const bf16_t*)(ws + WS_WIN) + (size_t)l * IN_COLS * 1024, M, IN_COLS, 1024}; pg8::StaticOrder S; S.init(M, IN_COLS, G, c);
                pg8::EpiIn E{(float*)(ws + WS_XA), (float*)(ws + WS_U), (bf16_t*)(ws + WS_Q), (bf16_t*)(ws + WS_K), (bf16_t*)(ws + WS_V), (bf16_t*)(ws + WS_GT),
                             (const float*)(ws + WS_TAB + TB_ROPEC), (const float*)(ws + WS_TAB + TB_ROPES), a->out, l};
                pg8::gemm_phase<pg8::EpiIn, pg8::StaticOrder, true, true>(lds, g, S, E, wave_s * 64 + lane_id_v()); }
            } else if (k == 2) { if (PHM & 2) mixers_phase(a, lds, l, tid); }
            else if (k == 3) { if (GM & 2) {
                pg8::Gemm g{(const bf16_t*)(ws + WS_YC0), (const bf16_t*)(ws + WS_WGLU) + (size_t)l * 512 * 512, M, 512, 512}; pg8::StaticOrder S; S.init(M, 512, G, c);
                pg8::EpiGlu E{(const bf16_t*)(ws + WS_YC0), (bf16_t*)(ws + WS_DYY) + (size_t)2 * M * 512};
                pg8::gemm_phase<pg8::EpiGlu, pg8::StaticOrder, true, true>(lds, g, S, E, wave_s * 64 + lane_id_v());
                {
                  constexpr int NI = 4 * (MP / 8) * 32; const float* XAp = (const float*)(ws + WS_XA); bf16_t* Dp = (bf16_t*)(ws + WS_DYY); const int t_ = wave_s * 64 + lane_id_v();
                  if (G > 132) { constexpr int SPLIT = (NI / 6 * 5) & ~63;
                      if (c >= 132) pool_phase(a, l, XAp, Dp, (c - 132) * 512 + t_, (G - 132) * 512, 0, SPLIT, true);
                      else pool_phase(a, l, XAp, Dp, c * 512 + t_, 132 * 512, SPLIT, NI, false); }
                  else pool_phase(a, l, XAp, Dp, c * 512 + t_, G * 512, 0, NI, true); } }
            } else if (k == 4) { if (GM & 4) {
                { pg8::Gemm g{(const bf16_t*)(ws + WS_DYY), (const bf16_t*)(ws + WS_WBR) + (size_t)l * 3072 * 512, 3 * M, 3072, 512, 0, 0}; pg8::BranchOrder S{G, c};
                  pg8::EpiMerge E{(const bf16_t*)(ws + WS_GT), (float*)(ws + WS_XA), H};
                  pg8::gemm_phase<pg8::EpiMerge, pg8::BranchOrder, true, true>(lds, g, S, E, wave_s * 64 + lane_id_v()); }
                { pg8::Gemm g{(const bf16_t*)(ws + WS_DYY), (const bf16_t*)(ws + WS_WBR) + (size_t)l * 3072 * 512, 3 * M, 3072, 128, 512, 512}; pg8::SplitOrder S{G, c, 4, 3};
                  pg8::EpiPart E{(float*)(ws + WS_Q), (const bf16_t*)(ws + WS_GT), 4};
                  pg8::gemm_phase<pg8::EpiPart, pg8::SplitOrder, true, true>(lds, g, S, E, wave_s * 64 + lane_id_v()); } }
            } else if (k == 5) { if (GM & 8) {
                { pg8::Gemm g{H, (const bf16_t*)(ws + WS_WOUT) + (size_t)l * 1024 * 1024, MP, 1024, 1024, 0, 0}; pg8::StaticOrder S; S.init(MP, 1024, G, c);
                  pg8::EpiRes E{xp, rep ? (float*)(ws + WS_XA) : X, MOD + l * 6144 + 2048};
                  pg8::gemm_phase<pg8::EpiRes, pg8::StaticOrder, true, true>(lds, g, S, E, wave_s * 64 + lane_id_v()); }
                for (int j = c; j < 64; j += G) { const int ks = j & 7, pmr = j >> 5; const float* Pm = (const float*)(ws + WS_Q);
                    for (int e2 = wave_s * 64 + lane_id_v(); e2 < 256 * 32; e2 += 512) { const int rs = pmr * 256 + (e2 >> 5), c4 = ks * 128 + (e2 & 31) * 4; f32x4 s = {0.f, 0.f, 0.f, 0.f};
#pragma unroll
                        for (int p = 0; p < 12; ++p) s += *(const f32x4*)(Pm + ((size_t)p * 512 + rs) * 1024 + c4);
                        st_bf4(H + (size_t)(MP + rs) * 1024 + c4, s); } }
                asm volatile("s_waitcnt vmcnt(0)" ::: "memory"); __syncthreads();
                { pg8::Gemm g{H, (const bf16_t*)(ws + WS_WOUT) + (size_t)l * 1024 * 1024, M, 1024, 128, 1024, 1024}; pg8::SplitOrder S{G, c, 8, 1};
                  pg8::EpiPart E{(float*)(ws + WS_YC0), nullptr, 8};
                  pg8::gemm_phase<pg8::EpiPart, pg8::SplitOrder, true, true>(lds, g, S, E, wave_s * 64 + lane_id_v()); } }
            } else if (k == 6) norm_phase(X, xs, a->in[10] + l * 1024, MOD + l * 6144 + 3072, 1024, H, tid, (const float*)(ws + WS_YC0), 8, MOD + l * 6144 + 2048, X);
            else if (k == 7) { if (GM & 16) {
                pg8::Gemm g{H, (const bf16_t*)(ws + WS_WFI) + (size_t)l * 2 * DFF * 1024, M, 2 * DFF, 1024}; pg8::StaticOrder S; S.init(M, 2 * DFF, G, c);
                pg8::EpiFfn E{(bf16_t*)(ws + WS_GT)};
                pg8::gemm_phase<pg8::EpiFfn, pg8::StaticOrder, true, true>(lds, g, S, E, wave_s * 64 + lane_id_v()); }
            } else if (GM & 32) {
                { pg8::Gemm g{(const bf16_t*)(ws + WS_GT), (const bf16_t*)(ws + WS_WFO) + (size_t)l * 1024 * DFF, MP, 1024, DFF, 0, 0}; pg8::StaticOrder S; S.init(MP, 1024, G, c);
                  pg8::EpiRes E{X, rep ? (float*)(ws + WS_XA) : X, MOD + l * 6144 + 5120};
                  pg8::gemm_phase<pg8::EpiRes, pg8::StaticOrder, true, true>(lds, g, S, E, wave_s * 64 + lane_id_v()); }
                { pg8::Gemm g{(const bf16_t*)(ws + WS_GT), (const bf16_t*)(ws + WS_WFO) + (size_t)l * 1024 * DFF, M, 1024, 128, DFF, DFF}; pg8::SplitOrder S{G, c, 22, 1};
                  pg8::EpiPart E{(float*)(ws + WS_DYY), nullptr, 22};
                  pg8::gemm_phase<pg8::EpiPart, pg8::SplitOrder, true, true>(lds, g, S, E, wave_s * 64 + lane_id_v()); }
            }
        }
        if (REPM && rep + 1 < nrep) __syncthreads();
        }
        if (ph + 1 < ph_hi) { if (SYNC2 == 1 || ph_hi > 1000) grid.sync(); else { XcdBarrier xb = xbar; asm volatile("" : "+s"(xb.x), "+s"(xb.bar));
            xcd_barrier(xb); if (SYNC2 == 2) xcd_barrier(xb); } }
    }
}

extern "C" void kernel_launch(void* const* d_in, const int* in_sizes, int n_in, void* d_out, int out_size, void* d_ws, size_t ws_size, hipStream_t stream) {
    static int grid = 0;
    if (grid == 0) {
        if (n_in != 33 || (size_t)out_size != OUT_TOTAL || ws_size < WS_END) { fprintf(stderr, "kernel_launch: unexpected shapes: n_in %d out %d ws %zu (need %zu)\n", n_in, out_size, ws_size, (size_t)WS_END); grid = -1; return; }
        int dev = 0, cus = 0, per_cu = 0;
        (void)hipGetDevice(&dev); (void)hipDeviceGetAttribute(&cus, hipDeviceAttributeMultiprocessorCount, dev);
        if (hipFuncSetAttribute((const void*)mega, hipFuncAttributeMaxDynamicSharedMemorySize, LDS_BYTES) != hipSuccess) { fprintf(stderr, "kernel_launch: hipFuncSetAttribute failed\n"); grid = -1; return; }
        if (hipOccupancyMaxActiveBlocksPerMultiprocessor(&per_cu, (const void*)mega, 512, LDS_BYTES) != hipSuccess || per_cu < 1) { fprintf(stderr, "kernel_launch: occupancy query says %d\n", per_cu); per_cu = 1; }
        (void)hipGetLastError();
        grid = cus * 1;
        if (grid <= 0) grid = 256;
    }
    if (grid < 0) return;
    Args a{};
    for (int i = 0; i < 33; ++i) a.in[i] = (const float*)d_in[i];
    a.out = (float*)d_out; a.ws = (unsigned char*)d_ws;
    for (int j = 0; j < 8; ++j) a.rfix[j] = (unsigned long long)ldexpl(powl(500000.0L, -(long double)j / 8.0L) / (2.0L * 3.14159265358979323846264338327950288L), 64);
#if MK_MULTI
    for (int ph = 0; ph < NPHASE; ++ph) { a.ph_lo = ph; a.ph_hi = ph + 1; hipLaunchKernelGGL(mega, dim3(grid), dim3(512), LDS_BYTES, stream, a); }
#else
    a.ph_lo = 0; a.ph_hi = NPHASE;
    if (hipMemsetAsync(d_ws, 0, 16384, stream) != hipSuccess) { fprintf(stderr, "kernel_launch: memset failed\n"); return; }
    void* args[] = {&a};
    hipError_t e = hipLaunchCooperativeKernel((const void*)mega, dim3(grid), dim3(512), args, LDS_BYTES, stream);
    if (e != hipSuccess) fprintf(stderr, "kernel_launch: cooperative launch failed: %s (grid %d)\n", hipGetErrorString(e), grid);
#endif
}
```

```cpp
#include <hip/hip_runtime.h>
#include <hip/hip_cooperative_groups.h>
#include <cstdio>
#include <cstdint>
#include <cmath>
namespace cg = cooperative_groups;

#ifndef MK_MULTI
#define MK_MULTI 0
#endif

__device__ __forceinline__ int lane_id_v() { int l; asm volatile("v_mbcnt_lo_u32_b32 %0, -1, 0\n\tv_mbcnt_hi_u32_b32 %0, -1, %0" : "=v"(l)); return l; }
__device__ __forceinline__ float shx(float v, int mask, int lane) { return __builtin_bit_cast(float, __builtin_amdgcn_ds_bpermute((lane ^ mask) << 2, __builtin_bit_cast(int, v))); }

__device__ __forceinline__ float shx32(float v, int upper  ) { const unsigned x = __builtin_bit_cast(unsigned, v); auto r = __builtin_amdgcn_permlane32_swap(x, x, false, false); return __builtin_bit_cast(float, upper ? r[0] : r[1]); }
__device__ __forceinline__ float shx16(float v, int odd  ) { const unsigned x = __builtin_bit_cast(unsigned, v); auto r = __builtin_amdgcn_permlane16_swap(x, x, false, false); return __builtin_bit_cast(float, odd ? r[0] : r[1]); }

namespace cfg {
constexpr int D = 1024, MP = 16384, MS = 512, M = MP + MS, SEQ = 2048, NBAT = 136, DEPTH = 4;
constexpr int IN_COLS = 4864, DFF = 2816, NMOD = 6 * D * DEPTH;
constexpr size_t OFF_Y = 0;
constexpr size_t OFF_KP = (size_t)M * D;
constexpr size_t OFF_VP = OFF_KP + (size_t)4 * 8 * 128 * 128;
constexpr size_t OFF_PP = OFF_VP + (size_t)4 * 8 * 128 * 128;
constexpr size_t OFF_SRP = OFF_PP + (size_t)4 * 8 * 15 * 512;
constexpr size_t OFF_SIP = OFF_SRP + (size_t)4 * 8 * 32 * 64;
constexpr size_t OFF_KS = OFF_SIP + (size_t)4 * 8 * 32 * 64;
constexpr size_t OFF_VS = OFF_KS + (size_t)4 * 128 * 128 * 128;
constexpr size_t OFF_PS = OFF_VS + (size_t)4 * 128 * 128 * 128;
constexpr size_t OFF_SRS = OFF_PS + (size_t)4 * 128 * 15 * 512;
constexpr size_t OFF_SIS = OFF_SRS + (size_t)4 * 128 * 32 * 64;
constexpr size_t OUT_TOTAL = OFF_SIS + (size_t)4 * 128 * 32 * 64;
static_assert(OUT_TOTAL == 41533440, "output size");
constexpr size_t MiB = 1u << 20;
constexpr size_t WS_WIN = 1 * MiB;
constexpr size_t WS_WGLU = WS_WIN + 38 * MiB;
constexpr size_t WS_WBR = WS_WGLU + 2 * MiB;
constexpr size_t WS_WOUT = WS_WBR + 12 * MiB;
constexpr size_t WS_WFI = WS_WOUT + 8 * MiB;
constexpr size_t WS_WFO = WS_WFI + 44 * MiB;
constexpr size_t WS_MOD = WS_WFO + 22 * MiB;
constexpr size_t WS_CA = WS_MOD + 13 * MiB;
constexpr size_t WS_TAB = WS_CA + 1 * MiB;
constexpr size_t WS_H = WS_TAB + 2 * MiB;
constexpr size_t WS_XA = WS_H + 33 * MiB;
constexpr size_t WS_U = WS_XA + 33 * MiB;
constexpr size_t WS_Q = WS_U + 33 * MiB;
constexpr size_t WS_K = WS_Q + 17 * MiB;
constexpr size_t WS_V = WS_K + 5 * MiB;
constexpr size_t WS_DYY = WS_V + 5 * MiB;
constexpr size_t WS_YC0 = WS_DYY + 50 * MiB;
constexpr size_t WS_GT = WS_YC0 + 17 * MiB;
constexpr size_t WS_END = WS_GT + 99 * MiB;
static_assert((size_t)M * 512 * 2 * 3 <= 50 * MiB && (size_t)M * 3072 * 2 <= 99 * MiB && (size_t)M * 1024 * 2 <= 33 * MiB, "ws map");
constexpr size_t TB_ROPEC = 0;
constexpr size_t TB_ROPES = 65664;
constexpr size_t TB_ABAR = 131328;
constexpr size_t TB_ABAR256 = TB_ABAR + 65536;
constexpr size_t TB_BBF = 262400;
constexpr size_t TB_CF = TB_BBF + 524288;
static_assert(TB_CF + 524288 <= 2 * MiB, "tables");
constexpr int LDS_BYTES = 147456;
constexpr int NPHASE = 2 + 9 * DEPTH + 1;
}

namespace pg8 {
#define PG8_LAS __attribute__((address_space(3)))
typedef unsigned short bf16_t;
typedef short bf16x8 __attribute__((ext_vector_type(8)));
typedef float f32x4 __attribute__((ext_vector_type(4)));
typedef unsigned u32x4 __attribute__((ext_vector_type(4)));
constexpr int BM = 256, BK = 64, HALF = 128, HTB = HALF * BK * 2  , STAGE_BYTES = 8 * HTB, NXCD = 8, WGM = 8;

__host__ __device__ __forceinline__ int lds_byte(int r, int c) { const int st = (r >> 4) * 2 + (c >> 5), rr = r & 15, cc = c & 31, ob = rr * 64 + cc * 2; return st * 1024 + (ob ^ (((ob >> 9) & 1) << 5)); }
__host__ __device__ __forceinline__ void stage_rc(int b, int& R, int& C) { const int st = b / 1024, sb = b % 1024, swz = sb ^ (((sb >> 9) & 1) << 5); R = (st >> 1) * 16 + swz / 64; C = (st & 1) * 32 + (swz % 64) / 2; }
__host__ __device__ __forceinline__ int perm32(int rho) { const int n = rho >> 4, i = rho & 15; return 8 * (i >> 2) + 4 * n + (i & 3); }

struct Unit { int pm, pn, k0; };
struct Gemm { const bf16_t* A; const bf16_t* Bt; int M, N, K, lda, ldb; };

struct StaticOrder {
    int nM, nN, nwg, G, c;
    __host__ __device__ void init(int M, int N, int G_, int c_) { nM = M / BM; nN = N / BM; nwg = nM * nN; G = G_; c = c_; }
    __host__ __device__ bool next(int i, Unit& u) const {
        const long L = (long)i * G + c; if (L >= nwg) return false;
        int wgid = (int)L; { const int q = nwg / NXCD, r = nwg % NXCD, xcd = wgid % NXCD, off = wgid / NXCD; wgid = (xcd < r ? xcd * (q + 1) : r * (q + 1) + (xcd - r) * q) + off; }
        const int nig = WGM * nN, gid = wgid / nig, fm = gid * WGM, gsz = (nM - fm) < WGM ? (nM - fm) : WGM;
        u.pm = fm + ((wgid % nig) % gsz); u.pn = (wgid % nig) / gsz; u.k0 = 0; return true;
    }
    __device__ __forceinline__ void a_ready(const Unit&) const {}
    __device__ __forceinline__ void done(const Unit&) const {}
};

__device__ __forceinline__ unsigned cvt_pk_bf16(float lo, float hi) { unsigned r; asm volatile("v_cvt_pk_bf16_f32 %0, %1, %2" : "=v"(r) : "v"(lo), "v"(hi)); return r; }
typedef unsigned u32x2 __attribute__((ext_vector_type(2)));
__device__ __forceinline__ float sigm(float x) { return __builtin_amdgcn_rcpf(1.f + __expf(-x)); }
__device__ __forceinline__ f32x4 ld_bf4(const bf16_t* p) { const u32x2 w = *(const u32x2*)p; f32x4 r; r[0] = __uint_as_float(w.x << 16); r[1] = __uint_as_float(w.x & 0xffff0000u); r[2] = __uint_as_float(w.y << 16); r[3] = __uint_as_float(w.y & 0xffff0000u); return r; }
__device__ __forceinline__ void st_bf4(bf16_t* p, const f32x4 v) { u32x2 w; w.x = cvt_pk_bf16(v[0], v[1]); w.y = cvt_pk_bf16(v[2], v[3]); *(u32x2*)p = w; }
__device__ __forceinline__ int batch_of(int row) { return row < cfg::MP ? (row >> 11) : 8 + ((row - cfg::MP) >> 2); }

struct EpiMod {
    static constexpr bool PERM = true, AFTER_DRAIN = false;
    float* MOD; const float* bada;
    __device__ __forceinline__ void operator()(const f32x4 (&acc)[2][2][4][2], const Unit& u, int wr, int wc, int fr, int fq) const {
#pragma unroll
        for (int ai = 0; ai < 2; ++ai)
#pragma unroll
            for (int m = 0; m < 4; ++m) { const int row = u.pm * 256 + ai * 128 + wr * 64 + m * 16 + fr;
                if (row < cfg::NBAT) {
#pragma unroll
                    for (int bj = 0; bj < 2; ++bj)
#pragma unroll
                        for (int n = 0; n < 2; ++n) { const int col = u.pn * 256 + bj * 128 + wc * 32 + 8 * fq + 4 * n;
                            *(f32x4*)(MOD + (size_t)row * cfg::NMOD + col) = acc[ai][bj][m][n] + *(const f32x4*)(bada + col); } } }
    }
};

struct EpiIn {
    static constexpr bool PERM = true, AFTER_DRAIN = false;
    float* XA; float* U; bf16_t* Q; bf16_t* KB; bf16_t* VB; bf16_t* GT; const float* ropec; const float* ropes; float* out; int layer;
    __device__ __forceinline__ void operator()(const f32x4 (&acc)[2][2][4][2], const Unit& u, int wr, int wc, int fr, int fq) const {
        const int pn = u.pn;
#pragma unroll
        for (int ai = 0; ai < 2; ++ai)
#pragma unroll
            for (int m = 0; m < 4; ++m) { const int row = u.pm * 256 + ai * 128 + wr * 64 + m * 16 + fr;
#pragma unroll
                for (int bj = 0; bj < 2; ++bj)
#pragma unroll
                    for (int n = 0; n < 2; ++n) { const int tc = bj * 128 + wc * 32 + 8 * fq + 4 * n; f32x4 v = acc[ai][bj][m][n];
                        if (pn < 2) { *(f32x4*)(XA + (size_t)row * 512 + pn * 256 + tc) = v; }
                        else if (pn <= 4) {
                            const bool isv = (pn == 4 && bj == 1);
                            if (!isv && (wc & 1) == 0) {
                                const int tix = row < cfg::MP ? (row & 2047) : 2048 + (row & 3);
                                const f32x4 cs = *(const f32x4*)(ropec + tix * 8 + 4 * n), sn = *(const f32x4*)(ropes + tix * 8 + 4 * n);
#pragma unroll
                                for (int i = 0; i < 4; ++i) { const float p = shx16(v[i], fq & 1); const float rv = v[i] * cs[i] + (fq == 0 ? -p : p) * sn[i]; v[i] = fq < 2 ? rv : v[i]; }
                            }
                            if (pn < 4) st_bf4(Q + (size_t)row * 512 + (pn - 2) * 256 + tc, v);
                            else { st_bf4((bj == 0 ? KB : VB) + (size_t)row * 128 + (tc & 127), v);
                                bool w = false; size_t o = 0;
                                if (row < cfg::MP) { const int t = row & 2047; if (t >= 1920) { w = true; o = (bj == 0 ? cfg::OFF_KP : cfg::OFF_VP) + ((size_t)(layer * 8 + (row >> 11)) * 128 + (t - 1920)) * 128 + (tc & 127); } }
                                else { const int rs = row - cfg::MP; w = true; o = (bj == 0 ? cfg::OFF_KS : cfg::OFF_VS) + ((size_t)(layer * 128 + (rs >> 2)) * 128 + 124 + (rs & 3)) * 128 + (tc & 127); }
                                if (w) *(f32x4*)(out + o) = v; }
                        }
                        else if (pn < 7) { *(f32x4*)(U + (size_t)row * 512 + (pn - 5) * 256 + tc) = v; }
                        else { f32x4 s; s[0] = sigm(v[0]); s[1] = sigm(v[1]); s[2] = sigm(v[2]); s[3] = sigm(v[3]); st_bf4(GT + (size_t)row * 3072 + (pn - 7) * 256 + tc, s); }
                    } }
    }
};

struct EpiGlu {
    static constexpr bool PERM = true, AFTER_DRAIN = false;
    const bf16_t* YC0; bf16_t* YC;
    __device__ __forceinline__ void operator()(const f32x4 (&acc)[2][2][4][2], const Unit& u, int wr, int wc, int fr, int fq) const {
#pragma unroll
        for (int ai = 0; ai < 2; ++ai)
#pragma unroll
            for (int m = 0; m < 4; ++m) { const int row = u.pm * 256 + ai * 128 + wr * 64 + m * 16 + fr;
#pragma unroll
                for (int bj = 0; bj < 2; ++bj)
#pragma unroll
                    for (int n = 0; n < 2; ++n) { const int col = u.pn * 256 + bj * 128 + wc * 32 + 8 * fq + 4 * n; const f32x4 v = acc[ai][bj][m][n];
                        const f32x4 y0 = ld_bf4(YC0 + (size_t)row * 512 + col); f32x4 o;
#pragma unroll
                        for (int i = 0; i < 4; ++i) o[i] = y0[i] * sigm(v[i]);
                        st_bf4(YC + (size_t)row * 512 + col, o); } }
    }
};

struct EpiMerge {
    static constexpr bool PERM = true, AFTER_DRAIN = false;
    const bf16_t* GT; float* M32; bf16_t* M16;
    __device__ __forceinline__ void operator()(const f32x4 (&acc)[2][2][4][2], const Unit& u, int wr, int wc, int fr, int fq) const {
        const int br = u.pm / 66, pm = u.pm - br * 66, pn = u.pn & 3;
        if (br > 0) asm volatile("s_waitcnt vmcnt(0)" ::: "memory");
#pragma unroll
        for (int ai = 0; ai < 2; ++ai)
#pragma unroll
            for (int m = 0; m < 4; ++m) { const int row = pm * 256 + ai * 128 + wr * 64 + m * 16 + fr;
#pragma unroll
                for (int bj = 0; bj < 2; ++bj)
#pragma unroll
                    for (int n = 0; n < 2; ++n) { const int col = pn * 256 + bj * 128 + wc * 32 + 8 * fq + 4 * n; const f32x4 v = acc[ai][bj][m][n];
                        const f32x4 g = ld_bf4(GT + (size_t)row * 3072 + br * 1024 + col);
                        bf16_t* mp = M16 + (size_t)row * 1024 + col;
                        if (br == 0) st_bf4(mp, g * v); else st_bf4(mp, ld_bf4(mp) + g * v); } }
    }
};

struct EpiRes {
    static constexpr bool PERM = true, AFTER_DRAIN = false;
    const float* xin; float* X; const float* MODG;
    __device__ __forceinline__ void operator()(const f32x4 (&acc)[2][2][4][2], const Unit& u, int wr, int wc, int fr, int fq) const {
        const float* gp = MODG + (size_t)(u.pm >> 3) * cfg::NMOD + u.pn * 256 + wc * 32 + 8 * fq;
        f32x4 g[2][2];
#pragma unroll
        for (int bj = 0; bj < 2; ++bj)
#pragma unroll
            for (int n = 0; n < 2; ++n) g[bj][n] = *(const f32x4*)(gp + bj * 128 + n * 4);
#pragma unroll
        for (int ai = 0; ai < 2; ++ai)
#pragma unroll
            for (int m = 0; m < 4; ++m) { const int row = u.pm * 256 + ai * 128 + wr * 64 + m * 16 + fr;
#pragma unroll
                for (int bj = 0; bj < 2; ++bj)
#pragma unroll
                    for (int n = 0; n < 2; ++n) { const size_t o = (size_t)row * 1024 + u.pn * 256 + bj * 128 + wc * 32 + 8 * fq + 4 * n;
                        *(f32x4*)(X + o) = *(const f32x4*)(xin + o) + g[bj][n] * acc[ai][bj][m][n]; } }
    }
};

struct EpiPart {
    static constexpr bool PERM = true, AFTER_DRAIN = false;
    float* P; const bf16_t* GT; int nks;
    __device__ __forceinline__ void operator()(const f32x4 (&acc)[2][2][4][2], const Unit& u, int wr, int wc, int fr, int fq) const {
        const int br = u.pm / 66, pmr = u.pm - br * 66 - 64, pn = u.pn & 3, slice = br * nks + (u.k0 >> 7);
#pragma unroll
        for (int ai = 0; ai < 2; ++ai)
#pragma unroll
            for (int m = 0; m < 4; ++m) { const int rs = pmr * 256 + ai * 128 + wr * 64 + m * 16 + fr;
#pragma unroll
                for (int bj = 0; bj < 2; ++bj)
#pragma unroll
                    for (int n = 0; n < 2; ++n) { const int col = pn * 256 + bj * 128 + wc * 32 + 8 * fq + 4 * n; f32x4 v = acc[ai][bj][m][n];
                        if (GT) v = v * ld_bf4(GT + (size_t)(cfg::MP + rs) * 3072 + br * 1024 + col);
                        *(f32x4*)(P + ((size_t)slice * 512 + rs) * 1024 + col) = v; } }
    }
};

struct EpiFfn {
    static constexpr bool PERM = true, AFTER_DRAIN = false;
    bf16_t* ACT;
    __device__ __forceinline__ void operator()(const f32x4 (&acc)[2][2][4][2], const Unit& u, int wr, int wc, int fr, int fq) const {
#pragma unroll
        for (int ai = 0; ai < 2; ++ai)
#pragma unroll
            for (int m = 0; m < 4; ++m) { const int row = u.pm * 256 + ai * 128 + wr * 64 + m * 16 + fr;
#pragma unroll
                for (int n = 0; n < 2; ++n) { const int col = u.pn * 128 + wc * 32 + 8 * fq + 4 * n; const f32x4 a = acc[ai][0][m][n], b = acc[ai][1][m][n]; f32x4 o;
#pragma unroll
                    for (int i = 0; i < 4; ++i) o[i] = a[i] * sigm(a[i]) * b[i];
                    st_bf4(ACT + (size_t)row * cfg::DFF + col, o); } }
    }
};

struct BranchOrder {
    int G, c;
    __host__ __device__ bool next(int i, Unit& u) const { const int vc = (G % 8 == 0) ? (c % 8) * (G / 8) + c / 8 : c;
        const int tile = vc + (i / 3) * G; if (tile >= 256) return false; const int br = i % 3; u.pm = br * 66 + (tile >> 2); u.pn = br * 4 + (tile & 3); u.k0 = 0; return true; }
    __device__ __forceinline__ void a_ready(const Unit&) const {}
    __device__ __forceinline__ void done(const Unit&) const {}
};
struct SplitOrder {
    int G, c, nks, nbr;
    __host__ __device__ bool next(int i, Unit& u) const { const int j = c + i * G; if (j >= 8 * nbr * nks) return false; const int ks = j % nks, t = j / nks, br = t % nbr, tile = t / nbr;
        u.pm = br * 66 + 64 + (tile >> 2); u.pn = br * 4 + (tile & 3); u.k0 = ks * 128; return true; }
    __device__ __forceinline__ void a_ready(const Unit&) const {}
    __device__ __forceinline__ void done(const Unit&) const {}
};

template <class Epi, class Sched, bool ALIGN_EPI = false, bool SP2 = false>
__device__ __forceinline__ void gemm_phase(PG8_LAS unsigned char* lds, const Gemm g, const Sched& S, const Epi& E, const int tid_in) {
    int tid_l = tid_in; asm volatile("" : "+v"(tid_l));
    const int tid = tid_l, wid = __builtin_amdgcn_readfirstlane(tid >> 6), lane = tid & 63, wr = wid >> 2, wc = wid & 3, fr = lane & 15, fq = lane >> 4;
    const int K = g.K, nt = K / BK, lda = g.lda ? g.lda : K, ldb = lda;
    unsigned voffA[2], voffB[2];
#pragma unroll
    for (int i = 0; i < 2; ++i) { int R, C; stage_rc(tid * 16 + i * 8192, R, C); const int Rb = Epi::PERM ? ((R & ~31) + perm32(R & 31)) : R;
        voffA[i] = (unsigned)(R * lda + C) * 2u; voffB[i] = (unsigned)(Rb * ldb + C) * 2u; }
    const size_t kstep = (size_t)(BK * 2);
    const size_t hstepA = (size_t)HALF * lda * 2, hstepB = (size_t)HALF * ldb * 2;
    const size_t tstepA = 2 * hstepA, tstepB = 2 * hstepB;
    const unsigned ldsw = (unsigned)wid * 1024u;
    const int aoff = lds_byte(wr * 64 + fr, fq * 8), boff = lds_byte(wc * 32 + fr, fq * 8);
#define PG8_SA(b, h) (((b) * 2 + (h)) * HTB)
#define PG8_SB(b, h) ((4 + (b) * 2 + (h)) * HTB)
#define PG8_STAGE(bufoff, gbase, voff) do { _Pragma("unroll") for (int _i = 0; _i < 2; ++_i) \
        __builtin_amdgcn_global_load_lds((const unsigned*)((const char*)(gbase) + (voff)[_i]), (PG8_LAS unsigned*)(lds + (bufoff) + ldsw + _i * 8192), 16, 0, 0); } while (0)
#define PG8_LDA(dst, b, h) do { _Pragma("unroll") for (int m = 0; m < 4; ++m) _Pragma("unroll") for (int k = 0; k < 2; ++k) dst[m][k] = *(const PG8_LAS bf16x8*)(lds + PG8_SA(b, h) + aoff + m * 2048 + k * 1024); } while (0)
#define PG8_LDB(dst, b, h) do { _Pragma("unroll") for (int n = 0; n < 2; ++n) _Pragma("unroll") for (int k = 0; k < 2; ++k) dst[n][k] = *(const PG8_LAS bf16x8*)(lds + PG8_SB(b, h) + boff + n * 2048 + k * 1024); } while (0)
#define PG8_MMA(ai, bj, At, Bt) do { __builtin_amdgcn_s_setprio(1); _Pragma("unroll") for (int m = 0; m < 4; ++m) _Pragma("unroll") for (int n = 0; n < 2; ++n) _Pragma("unroll") for (int k = 0; k < 2; ++k) \
        acc[ai][bj][m][n] = __builtin_amdgcn_mfma_f32_16x16x32_bf16(Bt[n][k], At[m][k], acc[ai][bj][m][n], 0, 0, 0); __builtin_amdgcn_s_setprio(0); } while (0)
#define PG8_WAIT_V(n) asm volatile("s_waitcnt vmcnt(" #n ")" ::: "memory")
#define PG8_WAIT_L(n) asm volatile("s_waitcnt lgkmcnt(" #n ")" ::: "memory")
#define PG8_BAR __builtin_amdgcn_s_barrier()
#define PG8_SCHED __builtin_amdgcn_sched_barrier(0)
    Unit cur, nxt; int ui = 0;
    if (!S.next(0, cur)) return;
    f32x4 acc[2][2][4][2];
#pragma unroll
    for (int a = 0; a < 2; ++a)
#pragma unroll
        for (int b = 0; b < 2; ++b)
#pragma unroll
            for (int m = 0; m < 4; ++m)
#pragma unroll
                for (int n = 0; n < 2; ++n) acc[a][b][m][n] = (f32x4){0.f, 0.f, 0.f, 0.f};
    bf16x8 At[4][2], B0[2][2], B1[2][2];
    const char* cA = (const char*)g.A + (size_t)cur.pm * tstepA + (size_t)cur.k0 * 2; const char* cB = (const char*)g.Bt + (size_t)cur.pn * tstepB + (size_t)cur.k0 * 2;
    S.a_ready(cur);
    if constexpr (SP2) {
        PG8_STAGE(PG8_SB(0, 0), cB, voffB); PG8_STAGE(PG8_SB(0, 1), cB + hstepB, voffB); PG8_STAGE(PG8_SA(0, 0), cA, voffA); PG8_STAGE(PG8_SA(0, 1), cA + hstepA, voffA);
        if (wr == 1) PG8_BAR;
        PG8_WAIT_V(2); PG8_BAR;
        PG8_STAGE(PG8_SB(1, 0), cB + kstep, voffB); PG8_STAGE(PG8_SA(1, 0), cA + kstep, voffA); PG8_STAGE(PG8_SB(1, 1), cB + hstepB + kstep, voffB);
        PG8_WAIT_V(6); PG8_BAR;
    } else {
        PG8_STAGE(PG8_SB(0, 0), cB, voffB); PG8_STAGE(PG8_SA(0, 0), cA, voffA); PG8_STAGE(PG8_SB(0, 1), cB + hstepB, voffB); PG8_STAGE(PG8_SA(0, 1), cA + hstepA, voffA);
        if (wr == 1) PG8_BAR;
        PG8_WAIT_V(4); PG8_BAR;
        PG8_STAGE(PG8_SB(1, 0), cB + kstep, voffB); PG8_STAGE(PG8_SA(1, 0), cA + kstep, voffA); PG8_STAGE(PG8_SB(1, 1), cB + hstepB + kstep, voffB);
        PG8_WAIT_V(6); PG8_BAR;
    }
    for (;;) {
        const bool has_next = S.next(ui + 1, nxt);
        const char* nA = has_next ? (const char*)g.A + (size_t)nxt.pm * tstepA + (size_t)nxt.k0 * 2 : cA; const char* nB = has_next ? (const char*)g.Bt + (size_t)nxt.pn * tstepB + (size_t)nxt.k0 * 2 : cB;
        for (int t = 0; t < nt; t += 2) {
            const bool last = (t == nt - 2);
            const char* a1 = cA + (size_t)(t + 1) * kstep;
            const char* a2 = last ? nA : cA + (size_t)(t + 2) * kstep; const char* b2 = last ? nB : cB + (size_t)(t + 2) * kstep;
            const char* a3 = a2 + kstep; const char* b3 = b2 + kstep;
            if (last && has_next) S.a_ready(nxt);
            if constexpr (SP2) {
            PG8_LDB(B0, 0, 0); PG8_LDB(B1, 0, 1); PG8_SCHED; PG8_LDA(At, 0, 0); PG8_STAGE(PG8_SA(1, 1), a1 + hstepA, voffA);
            PG8_WAIT_V(8); PG8_WAIT_L(0); PG8_BAR; PG8_MMA(0, 0, At, B0); PG8_MMA(0, 1, At, B1); PG8_BAR; PG8_SCHED;
            PG8_LDA(At, 0, 1); PG8_STAGE(PG8_SB(0, 0), b2, voffB); PG8_STAGE(PG8_SB(0, 1), b2 + hstepB, voffB); PG8_STAGE(PG8_SA(0, 0), a2, voffA);
            PG8_WAIT_V(8); PG8_WAIT_L(0); PG8_BAR; PG8_MMA(1, 0, At, B0); PG8_MMA(1, 1, At, B1); PG8_BAR; PG8_SCHED;
            PG8_LDB(B0, 1, 0); PG8_LDB(B1, 1, 1); PG8_SCHED; PG8_LDA(At, 1, 0); PG8_STAGE(PG8_SA(0, 1), a2 + hstepA, voffA);
            PG8_WAIT_V(8); PG8_WAIT_L(0); PG8_BAR; PG8_MMA(0, 0, At, B0); PG8_MMA(0, 1, At, B1); PG8_BAR; PG8_SCHED;
            PG8_LDA(At, 1, 1); PG8_STAGE(PG8_SB(1, 0), b3, voffB); PG8_STAGE(PG8_SB(1, 1), b3 + hstepB, voffB); PG8_STAGE(PG8_SA(1, 0), a3, voffA);
            PG8_WAIT_V(8); PG8_WAIT_L(0); PG8_BAR; PG8_MMA(1, 0, At, B0); PG8_MMA(1, 1, At, B1); PG8_BAR; PG8_SCHED;
            } else {
            PG8_LDB(B0, 0, 0); PG8_SCHED; PG8_LDA(At, 0, 0); PG8_STAGE(PG8_SA(1, 1), a1 + hstepA, voffA);
            PG8_WAIT_L(8); PG8_BAR; PG8_WAIT_L(0); PG8_MMA(0, 0, At, B0); PG8_BAR; PG8_SCHED;
            PG8_LDB(B1, 0, 1); PG8_STAGE(PG8_SB(0, 0), b2, voffB);
            PG8_BAR; PG8_WAIT_L(0); PG8_MMA(0, 1, At, B1); PG8_BAR;
            PG8_LDA(At, 0, 1); PG8_STAGE(PG8_SA(0, 0), a2, voffA);
            PG8_BAR; PG8_WAIT_L(0); PG8_MMA(1, 0, At, B0); PG8_BAR; PG8_SCHED;
            PG8_STAGE(PG8_SB(0, 1), b2 + hstepB, voffB);
            PG8_WAIT_V(6); PG8_BAR; PG8_MMA(1, 1, At, B1); PG8_BAR;
            PG8_LDB(B0, 1, 0); PG8_SCHED; PG8_LDA(At, 1, 0); PG8_STAGE(PG8_SA(0, 1), a2 + hstepA, voffA);
            PG8_WAIT_L(8); PG8_BAR; PG8_WAIT_L(0); PG8_MMA(0, 0, At, B0); PG8_BAR; PG8_SCHED;
            PG8_LDB(B1, 1, 1); PG8_STAGE(PG8_SB(1, 0), b3, voffB);
            PG8_BAR; PG8_WAIT_L(0); PG8_MMA(0, 1, At, B1); PG8_BAR;
            PG8_LDA(At, 1, 1); PG8_STAGE(PG8_SA(1, 0), a3, voffA);
            PG8_BAR; PG8_WAIT_L(0); PG8_MMA(1, 0, At, B0); PG8_BAR; PG8_SCHED;
            PG8_STAGE(PG8_SB(1, 1), b3 + hstepB, voffB);
            PG8_WAIT_V(6); PG8_BAR; PG8_MMA(1, 1, At, B1); PG8_BAR;
            }
        }
        if constexpr (ALIGN_EPI) { if (wr == 0) PG8_BAR; }
        if constexpr (!Epi::AFTER_DRAIN) { E(acc, cur, wr, wc, fr, fq); S.done(cur); }
        if (!has_next) break;
#pragma unroll
        for (int a = 0; a < 2; ++a)
#pragma unroll
            for (int b = 0; b < 2; ++b)
#pragma unroll
                for (int m = 0; m < 4; ++m)
#pragma unroll
                    for (int n = 0; n < 2; ++n) acc[a][b][m][n] = (f32x4){0.f, 0.f, 0.f, 0.f};
        cur = nxt; cA = nA; cB = nB; ++ui;
        if constexpr (ALIGN_EPI) { if (wr == 1) PG8_BAR; }
    }
    PG8_WAIT_V(0);
    if constexpr (!ALIGN_EPI) { if (wr == 0) PG8_BAR; }
    PG8_BAR;
    if constexpr (Epi::AFTER_DRAIN) { E.fused(acc, cur, wr, wc, fr, fq, lds, wid, lane); S.done(cur); }
#undef PG8_SA
#undef PG8_SB
#undef PG8_STAGE
#undef PG8_LDA
#undef PG8_LDB
#undef PG8_MMA
#undef PG8_WAIT_V
#undef PG8_WAIT_L
#undef PG8_BAR
#undef PG8_SCHED
}
}

#define LAS __attribute__((address_space(3)))
#define DI __device__ __forceinline__
typedef unsigned short bf16_t;
typedef short bf16x8 __attribute__((ext_vector_type(8)));
typedef short s16x4 __attribute__((ext_vector_type(4)));
typedef float f32x4 __attribute__((ext_vector_type(4)));
typedef float f32x16 __attribute__((ext_vector_type(16)));
typedef unsigned u32x4 __attribute__((ext_vector_type(4)));
typedef unsigned u32x2 __attribute__((ext_vector_type(2)));
using pg8::cvt_pk_bf16; using pg8::sigm; using pg8::ld_bf4; using pg8::st_bf4; using pg8::batch_of;
using namespace cfg;

DI float bf2f(bf16_t b) { return __uint_as_float((unsigned)b << 16); }
DI unsigned f2bf(float f) { unsigned u = __float_as_uint(f); return (u + 0x7fffu + ((u >> 16) & 1u)) >> 16; }
DI float wave_sum(float v, int lane) {
#pragma unroll
    for (int o = 1; o < 64; o <<= 1) v += shx(v, o, lane);
    return v;
}
DI float wave_max(float v, int lane) {
#pragma unroll
    for (int o = 1; o < 64; o <<= 1) v = fmaxf(v, shx(v, o, lane));
    return v;
}
DI bf16x8 pack8(const f32x4 a, const f32x4 b) { u32x4 p; p.x = cvt_pk_bf16(a[0], a[1]); p.y = cvt_pk_bf16(a[2], a[3]); p.z = cvt_pk_bf16(b[0], b[1]); p.w = cvt_pk_bf16(b[2], b[3]); return __builtin_bit_cast(bf16x8, p); }
#define MFMA16(a, b, c) __builtin_amdgcn_mfma_f32_16x16x32_bf16((a), (b), (c), 0, 0, 0)
#define MFMA32(a, b, c) __builtin_amdgcn_mfma_f32_32x32x16_bf16((a), (b), (c), 0, 0, 0)

#define XB_TMO      128
#define XB_XCNT(j)  (256  + 64 * (j))
#define XB_XSUB(j)  (1280 + 64 * (j))
#define XB_XGEN(j)  (2304 + 64 * (j))
#define XB_TOP      3328
#define XB_TOPGEN   3392
#define XCD_BAR_WORDS 3456
#define XB_SPIN_CAP (1u << 18)

__device__ __forceinline__ unsigned xb_ld(unsigned* p)              { return __hip_atomic_load(p, __ATOMIC_RELAXED, __HIP_MEMORY_SCOPE_AGENT); }
__device__ __forceinline__ unsigned xb_add(unsigned* p, unsigned v) { return __hip_atomic_fetch_add(p, v, __ATOMIC_RELAXED, __HIP_MEMORY_SCOPE_AGENT); }
__device__ __forceinline__ unsigned xb_xcc_id() { return (unsigned)__builtin_amdgcn_s_getreg((3 << 11) | 20) & 0xFu; }
#define XB_SPIN(cond, bar) do { unsigned _sp = 0; while (cond) { __builtin_amdgcn_s_sleep(1); \
    if ((++_sp & 255u) == 0u) { if (xb_ld(&(bar)[XB_TMO])) break; if (_sp > XB_SPIN_CAP) { atomicAdd(&(bar)[XB_TMO], 1u); break; } } } } while (0)

struct XcdBarrier {
    unsigned* bar; unsigned x;
    volatile LAS unsigned* st;
};

__device__ __forceinline__ XcdBarrier xcd_barrier_post(unsigned* bar, volatile LAS unsigned* st) {
    XcdBarrier b; b.bar = bar; b.x = xb_xcc_id(); b.st = st;
    if (threadIdx.x == 0) (void)xb_add(&bar[XB_XCNT(b.x)], 1u);
    return b;
}
__device__ __forceinline__ void xcd_barrier_complete(unsigned* bar, unsigned x, unsigned& nloc, unsigned& nx) {
    const unsigned G = gridDim.x * gridDim.y * gridDim.z;
    unsigned sum, cnt, mine, sp = 0u;
    for (;;) {
        sum = 0u; cnt = 0u; mine = 0u;
#pragma unroll
        for (unsigned j = 0; j < 16; ++j) { const unsigned c = xb_ld(&bar[XB_XCNT(j)]); sum += c; cnt += (c > 0u) ? 1u : 0u; mine = (j == x) ? c : mine; }
        if (sum == G) break;
        __builtin_amdgcn_s_sleep(1);
        if ((++sp & 255u) == 0u) { if (xb_ld(&bar[XB_TMO])) break; if (sp > XB_SPIN_CAP) { atomicAdd(&bar[XB_TMO], 1u); break; } }
    }
    nloc = mine > 0u ? mine : 1u; nx = cnt > 0u ? cnt : 1u;
}

__device__ __forceinline__ void xcd_barrier(const XcdBarrier& b) {
    asm volatile("s_waitcnt vmcnt(0)" ::: "memory");
    __syncthreads();
    if (threadIdx.x == 0) {
        unsigned* bar = b.bar;
        __builtin_amdgcn_s_waitcnt(0);
        unsigned nloc = b.st[0], nx = b.st[1];
        if (nloc == 0u) { xcd_barrier_complete(bar, b.x, nloc, nx); b.st[0] = nloc; b.st[1] = nx; }
        const unsigned old = xb_add(&bar[XB_XSUB(b.x)], 1u);
        const unsigned gen = old / nloc;
        if (old + 1u == (gen + 1u) * nloc) {
            __builtin_amdgcn_fence(__ATOMIC_RELEASE, "agent");
            asm volatile("s_waitcnt vmcnt(0)" ::: "memory");
            const unsigned og = xb_add(&bar[XB_TOP], 1u);
            const unsigned tg = og / nx;
            if (og + 1u == (tg + 1u) * nx) xb_add(&bar[XB_TOPGEN], 1u);
            else XB_SPIN(xb_ld(&bar[XB_TOPGEN]) == tg, bar);
            __builtin_amdgcn_fence(__ATOMIC_ACQUIRE, "agent");
            xb_add(&bar[XB_XGEN(b.x)], 1u);
            asm volatile("s_waitcnt vmcnt(0)" ::: "memory");
        } else {
            XB_SPIN(xb_ld(&bar[XB_XGEN(b.x)]) == gen, bar);
            __builtin_amdgcn_fence(__ATOMIC_ACQUIRE, "agent");
            asm volatile("s_waitcnt vmcnt(0)" ::: "memory");
        }
    }
    __syncthreads();
}

#ifndef MIXM
#define MIXM 0
#endif
#ifndef SYNC2
#define SYNC2 0
#endif
#ifndef REPM
#define REPM 0
#endif
#ifndef GM
#define GM 0xff
#endif
#ifndef PHM
#define PHM 0xff
#endif
struct Args { const float* in[33]; float* out; unsigned char* ws; unsigned long long rfix[8]; int ph_lo, ph_hi; };
typedef const Args __attribute__((address_space(4)))* ArgsP;

DI void tr_item(const float* W, int K, int N, bf16_t* WT, int k0, int n0, int drow0, LAS float* scr, int lane) {
#pragma unroll 8
    for (int i = 0; i < 32; ++i) { const int kk = 2 * i + (lane >> 5); scr[kk * 33 + (lane & 31)] = W[(size_t)(k0 + kk) * N + n0 + (lane & 31)]; }
    asm volatile("s_waitcnt lgkmcnt(0)" ::: "memory");
    const int c = lane & 7;
#pragma unroll
    for (int j = 0; j < 4; ++j) { const int n = (lane >> 3) + 8 * j; const LAS float* s = scr + (8 * c) * 33 + n;
        u32x4 o; o.x = cvt_pk_bf16(s[0 * 33], s[1 * 33]); o.y = cvt_pk_bf16(s[2 * 33], s[3 * 33]); o.z = cvt_pk_bf16(s[4 * 33], s[5 * 33]); o.w = cvt_pk_bf16(s[6 * 33], s[7 * 33]);
        *(u32x4*)(WT + (size_t)(drow0 + n) * K + k0 + 8 * c) = o; }
    asm volatile("s_waitcnt lgkmcnt(0)" ::: "memory");
}
DI void fold_item(const float* Pw  , const float* Sc  , const float* Wa  , bf16_t* WT  , int k0, int n0, LAS float* scr, int lane) {
    const int g = k0 >> 7, nn = lane & 31, hi = lane >> 5;
    for (int jc = 0; jc < 4; ++jc) {
        float w[32];
#pragma unroll
        for (int jj = 0; jj < 32; ++jj) { const int j = g * 128 + jc * 32 + jj; w[jj] = Sc[j] * Wa[(size_t)j * 1024 + n0 + nn]; }
#pragma unroll 1
        for (int i = 0; i < 32; ++i) { const float* pr = Pw + ((size_t)g * 128 + ((k0 & 127) + 2 * i + hi)) * 128 + jc * 32; float acc = 0.f;
#pragma unroll
            for (int j4 = 0; j4 < 8; ++j4) { const f32x4 p = *(const f32x4*)(pr + 4 * j4);
                acc += p[0] * w[4 * j4] + p[1] * w[4 * j4 + 1] + p[2] * w[4 * j4 + 2] + p[3] * w[4 * j4 + 3]; }
            LAS float* sp = scr + (2 * i + hi) * 33 + nn; if (jc == 0) *sp = acc; else *sp += acc; }
    }
    asm volatile("s_waitcnt lgkmcnt(0)" ::: "memory");
    const int c = lane & 7;
#pragma unroll
    for (int j = 0; j < 4; ++j) { const int n = (lane >> 3) + 8 * j; const LAS float* s = scr + (8 * c) * 33 + n;
        u32x4 o; o.x = cvt_pk_bf16(s[0 * 33], s[1 * 33]); o.y = cvt_pk_bf16(s[2 * 33], s[3 * 33]); o.z = cvt_pk_bf16(s[4 * 33], s[5 * 33]); o.w = cvt_pk_bf16(s[6 * 33], s[7 * 33]);
        *(u32x4*)(WT + (size_t)(n0 + n) * 512 + k0 + 8 * c) = o; }
    asm volatile("s_waitcnt lgkmcnt(0)" ::: "memory");
}
DI void sincos_frac(float f  , float& c, float& s) { s = __builtin_amdgcn_sinf(f); c = __builtin_amdgcn_cosf(f); }

DI void prologue(ArgsP a, LAS unsigned char* lds, int tid) {
    const int lane = tid & 63, wave = tid >> 6;
    const int gw = blockIdx.x * 8 + wave, NGW = gridDim.x * 8;
    const int gt = blockIdx.x * 512 + tid, NT = gridDim.x * 512;
    unsigned char* ws = a->ws;
    LAS float* scr = (LAS float*)(lds + wave * 16384);
    constexpr int I_IN = 16 * 152, I_GLU = 8 * 16, I_BR = 8 * 32, I_OUT = 16 * 32, I_FI = 16 * 176, I_FO = 44 * 32, I_ADA = 16 * 192, I_FOLD = 8 * 32;
    constexpr int PER_L = I_IN + I_GLU + 2 * I_BR + I_OUT + I_FI + I_FO + I_ADA + I_FOLD;
    for (int it = gw; it < PER_L * 4; it += NGW) {
        const int l = it & 3; int r = it >> 2;
        if (r < I_FOLD) { fold_item(a->in[14] + (size_t)l * 4 * 128 * 128, a->in[15] + l * 512, a->in[26] + (size_t)l * 512 * 1024, (bf16_t*)(ws + WS_WBR) + (size_t)l * 3072 * 512, (r >> 5) * 64, (r & 31) * 32, scr, lane); continue; } r -= I_FOLD;
        if (r < I_IN) { const int kb = r / 152, nb = r % 152; tr_item(a->in[13] + (size_t)l * 1024 * IN_COLS, 1024, IN_COLS, (bf16_t*)(ws + WS_WIN) + (size_t)l * IN_COLS * 1024, kb * 64, nb * 32, nb * 32, scr, lane); continue; } r -= I_IN;
        if (r < I_GLU) { const int kb = r / 16, nb = r % 16; tr_item(a->in[25] + (size_t)l * 512 * 512, 512, 512, (bf16_t*)(ws + WS_WGLU) + (size_t)l * 512 * 512, kb * 64, nb * 32, nb * 32, scr, lane); continue; } r -= I_GLU;
        if (r < I_BR) { const int kb = r / 32, nb = r % 32; tr_item(a->in[27] + (size_t)l * 512 * 1024, 512, 1024, (bf16_t*)(ws + WS_WBR) + (size_t)l * 3072 * 512, kb * 64, nb * 32, 1024 + nb * 32, scr, lane); continue; } r -= I_BR;
        if (r < I_BR) { const int kb = r / 32, nb = r % 32; tr_item(a->in[28] + (size_t)l * 512 * 1024, 512, 1024, (bf16_t*)(ws + WS_WBR) + (size_t)l * 3072 * 512, kb * 64, nb * 32, 2048 + nb * 32, scr, lane); continue; } r -= I_BR;
        if (r < I_OUT) { const int kb = r / 32, nb = r % 32; tr_item(a->in[29] + (size_t)l * 1024 * 1024, 1024, 1024, (bf16_t*)(ws + WS_WOUT) + (size_t)l * 1024 * 1024, kb * 64, nb * 32, nb * 32, scr, lane); continue; } r -= I_OUT;
        if (r < I_FI) { const int kb = r / 176, nb = r % 176; const int n0 = nb * 32, half = n0 / DFF, j = n0 - half * DFF;
            tr_item(a->in[30] + (size_t)l * 1024 * 2 * DFF, 1024, 2 * DFF, (bf16_t*)(ws + WS_WFI) + (size_t)l * 2 * DFF * 1024, kb * 64, n0, 256 * (j >> 7) + 128 * half + (j & 127), scr, lane); continue; } r -= I_FI;
        if (r < I_FO) { const int kb = r / 32, nb = r % 32; tr_item(a->in[31] + (size_t)l * DFF * 1024, DFF, 1024, (bf16_t*)(ws + WS_WFO) + (size_t)l * 1024 * DFF, kb * 64, nb * 32, nb * 32, scr, lane); continue; } r -= I_FO;
        { const int kb = r / 192, nb = r % 192; tr_item(a->in[11] + (size_t)l * 1024 * 6144, 1024, 6144, (bf16_t*)(ws + WS_GT), kb * 64, nb * 32, l * 6144 + nb * 32, scr, lane); }
    }
    { bf16_t* CA = (bf16_t*)(ws + WS_CA);
      for (int i = gt; i < 256 * 1024; i += NT) { const int r = i >> 10, c = i & 1023; float v = 0.f;
          if (r < 8) v = a->in[7][r * 1024 + c]; else if (r < NBAT) v = a->in[8][(r - 8) * 1024 + c];
          CA[i] = (bf16_t)f2bf(v * sigm(v)); } }
    { float* rc = (float*)(ws + WS_TAB + TB_ROPEC); float* rs = (float*)(ws + WS_TAB + TB_ROPES);
      for (int i = gt; i < 2052 * 8; i += NT) { const int ti = i >> 3, j = i & 7; const int pos = ti < 2048 ? ti : 8192 + (ti - 2048);
          const unsigned long long fx = (unsigned long long)pos * a->rfix[j];
          float c, s; sincos_frac((float)(unsigned)(fx >> 40) * 5.9604644775390625e-08f, c, s); rc[i] = c; rs[i] = s; } }
    { float* AB = (float*)(ws + WS_TAB + TB_ABAR); float* AB256 = (float*)(ws + WS_TAB + TB_ABAR256); bf16_t* BBF = (bf16_t*)(ws + WS_TAB + TB_BBF);
      for (int i = gt; i < 4 * 32 * 64; i += NT) { const int lg = i >> 6, p = i & 63;
          const float dt = expf(a->in[19][lg]); const float ar = a->in[17][i], ai = a->in[18][i];
          const float x = ar * dt; const float yt = ai * dt * 0.15915494309189535f;
          float c, s; sincos_frac(yt, c, s); float ch, sh; sincos_frac(0.5f * yt, ch, sh);
          const float em1 = x * (1.f + x * (0.5f + x * (0.16666667f + x * (0.041666668f + x * 0.0083333338f))));
          const float ex = 1.f + em1;
          const float abr = ex * c, abi = ex * s;
          const float nr = em1 * c - (sh + sh) * sh, ni = abi;
          const float den = 1.f / (ar * ar + ai * ai);
          const float cr = (nr * ar + ni * ai) * den, ci = (ni * ar - nr * ai) * den;
          AB[2 * i] = abr; AB[2 * i + 1] = abi;
          float pr = abr, pi = abi;
#pragma unroll
          for (int k = 0; k < 8; ++k) { const float t = pr * pr - pi * pi; pi = (pr + pr) * pi; pr = t; }
          AB256[2 * i] = pr; AB256[2 * i + 1] = pi;
          const float* br = a->in[20] + (size_t)i * 16; const float* bi = a->in[21] + (size_t)i * 16;
          const int st = p >> 5;
#pragma unroll
          for (int half = 0; half < 2; ++half) { u32x4 ore, oim; unsigned* pre = (unsigned*)&ore; unsigned* pim = (unsigned*)&oim; (void)pre; (void)pim;
              float vr[8], vi[8];
#pragma unroll
              for (int j = 0; j < 8; ++j) { const float b_r = br[half * 8 + j], b_i = bi[half * 8 + j]; vr[j] = cr * b_r - ci * b_i; vi[j] = cr * b_i + ci * b_r; }
              ore.x = cvt_pk_bf16(vr[0], vr[1]); ore.y = cvt_pk_bf16(vr[2], vr[3]); ore.z = cvt_pk_bf16(vr[4], vr[5]); ore.w = cvt_pk_bf16(vr[6], vr[7]);
              oim.x = cvt_pk_bf16(vi[0], vi[1]); oim.y = cvt_pk_bf16(vi[2], vi[3]); oim.z = cvt_pk_bf16(vi[4], vi[5]); oim.w = cvt_pk_bf16(vi[6], vi[7]);
              *(u32x4*)(BBF + (((size_t)lg * 4 + 0 + st) * 64 + half * 32 + (p & 31)) * 8) = ore;
              *(u32x4*)(BBF + (((size_t)lg * 4 + 2 + st) * 64 + half * 32 + (p & 31)) * 8) = oim; } } }
    { bf16_t* CF = (bf16_t*)(ws + WS_TAB + TB_CF);
      for (int i = gt; i < 4 * 32 * 4 * 64; i += NT) { const int ln = i & 63, ks = (i >> 6) & 3, lg = i >> 8; const int c = ln & 15, quad = ln >> 4;
          float v[8];
#pragma unroll
          for (int j = 0; j < 8; ++j) { const int k = ks * 32 + quad * 8 + j; v[j] = k < 64 ? a->in[22][((size_t)lg * 16 + c) * 64 + k] : -a->in[23][((size_t)lg * 16 + c) * 64 + (k - 64)]; }
          u32x4 o; o.x = cvt_pk_bf16(v[0], v[1]); o.y = cvt_pk_bf16(v[2], v[3]); o.z = cvt_pk_bf16(v[4], v[5]); o.w = cvt_pk_bf16(v[6], v[7]);
          *(u32x4*)(CF + (size_t)i * 8) = o; } }
}

DI void cache_shift(ArgsP a, int gt, int NT) {
    for (int i = gt; i < 4 * 128 * 124 * 32; i += NT) { const int c4 = i & 31, j = (i >> 5) % 124, lb = (i >> 5) / 124;
        *(f32x4*)(a->out + OFF_KS + ((size_t)lb * 128 + j) * 128 + c4 * 4) = *(const f32x4*)(a->in[2] + ((size_t)lb * 128 + j + 4) * 128 + c4 * 4);
        *(f32x4*)(a->out + OFF_VS + ((size_t)lb * 128 + j) * 128 + c4 * 4) = *(const f32x4*)(a->in[3] + ((size_t)lb * 128 + j + 4) * 128 + c4 * 4); }
    for (int i = gt; i < 4 * 128 * 11 * 128; i += NT) { const int c4 = i & 127, j = (i >> 7) % 11, lb = (i >> 7) / 11;
        *(f32x4*)(a->out + OFF_PS + ((size_t)lb * 15 + j) * 512 + c4 * 4) = *(const f32x4*)(a->in[4] + ((size_t)lb * 15 + j + 4) * 512 + c4 * 4); }
}

DI void norm_phase(const float* xp, const float* xs, const float* gvec, const float* MODL  , int sc_off, bf16_t* H, int tid,
                   const float* P, int nparts, const float* pgate, float* X) {
    const int lane = tid & 63, gw = blockIdx.x * 8 + (tid >> 6), NGW = gridDim.x * 8;
    for (int it = gw; it < M; it += NGW) {
        const int row = it < MS ? MP + it : it - MS;
        const int bi = batch_of(row);
        const float* xr = (row < MP ? xp : xs) + (size_t)row * 1024; const float* mr = MODL + (size_t)bi * NMOD;
        f32x4 v[4]; float ss = 0.f;
#pragma unroll
        for (int j = 0; j < 4; ++j) v[j] = *(const f32x4*)(xr + 4 * lane + 256 * j);
        if (row >= MP && nparts > 0) {
            f32x4 s[4];
#pragma unroll
            for (int j = 0; j < 4; ++j) s[j] = (f32x4){0.f, 0.f, 0.f, 0.f};
            for (int p = 0; p < nparts; ++p) { const float* pr = P + ((size_t)p * 512 + (row - MP)) * 1024 + 4 * lane;
#pragma unroll
                for (int j = 0; j < 4; ++j) s[j] += *(const f32x4*)(pr + 256 * j); }
#pragma unroll
            for (int j = 0; j < 4; ++j) { v[j] += *(const f32x4*)(pgate + (size_t)bi * NMOD + 4 * lane + 256 * j) * s[j]; *(f32x4*)(X + (size_t)row * 1024 + 4 * lane + 256 * j) = v[j]; }
        }
#pragma unroll
        for (int j = 0; j < 4; ++j) ss += v[j][0] * v[j][0] + v[j][1] * v[j][1] + v[j][2] * v[j][2] + v[j][3] * v[j][3];
        const float r = rsqrtf(wave_sum(ss, lane) * (1.f / 1024.f) + 1e-6f);
        if (H) {
#pragma unroll
            for (int j = 0; j < 4; ++j) { const int c = 4 * lane + 256 * j; const f32x4 g = *(const f32x4*)(gvec + c), sh = *(const f32x4*)(mr + c), sc = *(const f32x4*)(mr + sc_off + c);
                st_bf4(H + (size_t)row * 1024 + c, v[j] * r * g * (1.f + sc) + sh); }
        } else {
#pragma unroll
            for (int j = 0; j < 4; ++j) { const int c = 4 * lane + 256 * j; *(f32x4*)(X + (size_t)row * 1024 + c) = v[j] * r * *(const f32x4*)(gvec + c); }
        }
    }
}

template <int W>
DI void pool_run(const float* XA, bf16_t* Dm, float* out, int l, int row0, int c4) {
    const int t0 = row0 & 2047;
    f32x4 x[W + 7];
#pragma unroll
    for (int i = 0; i < W + 7; ++i) { const int dt = i - (W - 1); x[i] = (t0 + dt >= 0) ? *(const f32x4*)(XA + (size_t)(row0 + dt) * 512 + c4) : (f32x4){0.f, 0.f, 0.f, 0.f}; }
    f32x4 s = x[0];
#pragma unroll
    for (int i = 1; i < W - 1; ++i) s += x[i];
#pragma unroll
    for (int k = 0; k < 8; ++k) { s += x[W - 1 + k]; const int t = t0 + k; const float cnt = (float)((t + 1 < W) ? t + 1 : W);
        st_bf4(Dm + (size_t)(row0 + k) * 512 + c4, s * (1.f / cnt) - x[W - 1 + k]);
        if (t >= 2033) *(f32x4*)(out + OFF_PP + ((size_t)(l * 8 + (row0 >> 11)) * 15 + (t - 2033)) * 512 + c4) = x[W - 1 + k];
        s -= x[k]; }
}
DI void pool_phase(ArgsP a, int l, const float* XA, bf16_t* Dm, int gt  , int NT  , int lo, int hi  , bool do_sample) {
    constexpr int NRUN = MP / 8;
    for (int item = lo + gt; item < hi; item += NT) {
        const int c4l = item & 31, gr = item >> 5, g = gr / NRUN, run = gr - g * NRUN; const int c4 = g * 128 + c4l * 4, row0 = run * 8;
        if (g == 0) pool_run<2>(XA, Dm, a->out, l, row0, c4); else if (g == 1) pool_run<4>(XA, Dm, a->out, l, row0, c4);
        else if (g == 2) pool_run<8>(XA, Dm, a->out, l, row0, c4); else pool_run<16>(XA, Dm, a->out, l, row0, c4);
    }
    if (do_sample) for (int idx = gt; idx < MS * 128; idx += NT) {
        const int row = MP + (idx >> 7), c4 = (idx & 127) * 4, w = 2 << (c4 >> 7);
        const f32x4 x = *(const f32x4*)(XA + (size_t)row * 512 + c4); f32x4 sum = x;
        const int rs = row - MP, bs = rs >> 2, t = rs & 3;
        for (int s = 1; s < w; ++s) { const int pos = t - s;
            sum += pos >= 0 ? *(const f32x4*)(XA + (size_t)(row - s) * 512 + c4) : *(const f32x4*)(a->in[4] + ((size_t)(l * 128 + bs) * 15 + 15 + pos) * 512 + c4); }
        *(f32x4*)(a->out + OFF_PS + ((size_t)(l * 128 + bs) * 15 + 11 + t) * 512 + c4) = x;
        st_bf4(Dm + (size_t)row * 512 + c4, sum * (1.f / (float)w) - x);
    }
}

DI void attn_prompt_unit(LAS unsigned char* lds, int unit, const bf16_t* Q, const bf16_t* KB, const bf16_t* VB, bf16_t* YB, const float* sinks, int tid) {
    const int b = unit >> 5, g = (unit >> 4) & 1, nb = unit & 15;
    LAS bf16_t* Ks = (LAS bf16_t*)lds;
    LAS bf16_t* Vt = (LAS bf16_t*)(lds + 36864);
    const int krow0 = b * 2048 + (nb - 1) * 128;
#pragma unroll
    for (int it = 0; it < 4; ++it) {
        const int chunk = tid + 512 * it, j = chunk >> 3, c8 = chunk & 7;
        u32x4 kv = {0u, 0u, 0u, 0u}, vv = {0u, 0u, 0u, 0u};
        if (nb > 0 || j >= 128) { const size_t off = (size_t)(krow0 + j) * 128 + g * 64 + c8 * 8; kv = *(const u32x4*)(KB + off); vv = *(const u32x4*)(VB + off); }
        *(LAS u32x4*)(Ks + j * 72 + c8 * 8) = kv;
        LAS bf16_t* vp = Vt + (c8 * 8) * 264 + j;
        vp[0 * 264] = (bf16_t)(vv.x & 0xffffu); vp[1 * 264] = (bf16_t)(vv.x >> 16); vp[2 * 264] = (bf16_t)(vv.y & 0xffffu); vp[3 * 264] = (bf16_t)(vv.y >> 16);
        vp[4 * 264] = (bf16_t)(vv.z & 0xffffu); vp[5 * 264] = (bf16_t)(vv.z >> 16); vp[6 * 264] = (bf16_t)(vv.w & 0xffffu); vp[7 * 264] = (bf16_t)(vv.w >> 16);
    }
    __syncthreads();
    const int wave = tid >> 6, lane = tid & 63, l15 = lane & 15, quad = lane >> 4;
    const int r = wave >> 1, hq = g * 4 + r;
    const float sc2 = 0.125f * 1.4426950408889634f;
    const float sk2 = sinks[hq] * 1.4426950408889634f;
    const int kt0 = wave & 1;
#pragma unroll 1
    for (int qh = 0; qh < 2; ++qh) {
        const int q0 = (wave & 1) * 64 + qh * 32;
        const int qrow0 = b * 2048 + nb * 128 + q0;
        bf16x8 qf[2][2];
#pragma unroll
        for (int qt = 0; qt < 2; ++qt)
#pragma unroll
            for (int ds = 0; ds < 2; ++ds) qf[qt][ds] = *(const bf16x8*)(Q + (size_t)(qrow0 + qt * 16 + l15) * 512 + hq * 64 + ds * 32 + quad * 8);
        float m2[2], ls[2]; f32x4 o[4][2];
#pragma unroll
        for (int qt = 0; qt < 2; ++qt) { m2[qt] = sk2; ls[qt] = quad == 0 ? 1.f : 0.f;
#pragma unroll
            for (int dt = 0; dt < 4; ++dt) o[dt][qt] = (f32x4){0.f, 0.f, 0.f, 0.f}; }
#pragma unroll 1
        for (int kk = 0; kk < 3; ++kk) {
            const int kt = kt0 + kk;
            if (nb == 0 && kt < 2) continue;
            f32x4 s[4][2];
#pragma unroll
            for (int sub = 0; sub < 4; ++sub) { const LAS bf16_t* kp = Ks + (kt * 64 + sub * 16 + l15) * 72 + quad * 8;
                const bf16x8 k0 = *(const LAS bf16x8*)kp, k1 = *(const LAS bf16x8*)(kp + 32);
#pragma unroll
                for (int qt = 0; qt < 2; ++qt) { s[sub][qt] = MFMA16(k0, qf[qt][0], ((f32x4){0.f, 0.f, 0.f, 0.f})); s[sub][qt] = MFMA16(k1, qf[qt][1], s[sub][qt]); } }
#pragma unroll
            for (int qt = 0; qt < 2; ++qt) { const int i = q0 + qt * 16 + l15; float mx = -INFINITY;
#pragma unroll
                for (int sub = 0; sub < 4; ++sub)
#pragma unroll
                    for (int jj = 0; jj < 4; ++jj) { const int j = kt * 64 + sub * 16 + quad * 4 + jj; const bool valid = (j > i) && (j <= i + 128) && (nb > 0 || j >= 128);
                        const float v = valid ? s[sub][qt][jj] * sc2 : -INFINITY; s[sub][qt][jj] = v; mx = fmaxf(mx, v); }
                mx = fmaxf(mx, shx16(mx, quad & 1)); mx = fmaxf(mx, shx32(mx, quad >> 1));
                const float mn = fmaxf(m2[qt], mx), alpha = __builtin_amdgcn_exp2f(m2[qt] - mn); m2[qt] = mn; float sum = 0.f;
#pragma unroll
                for (int sub = 0; sub < 4; ++sub)
#pragma unroll
                    for (int jj = 0; jj < 4; ++jj) { const float p = __builtin_amdgcn_exp2f(s[sub][qt][jj] - mn); s[sub][qt][jj] = p; sum += p; }
                ls[qt] = ls[qt] * alpha + sum;
#pragma unroll
                for (int dt = 0; dt < 4; ++dt) o[dt][qt] *= alpha; }
#pragma unroll
            for (int s2 = 0; s2 < 2; ++s2) { bf16x8 pf[2];
#pragma unroll
                for (int qt = 0; qt < 2; ++qt) pf[qt] = pack8(s[2 * s2][qt], s[2 * s2 + 1][qt]);
#pragma unroll
                for (int dt = 0; dt < 4; ++dt) { const LAS bf16_t* vp = Vt + (dt * 16 + l15) * 264 + kt * 64 + s2 * 32 + quad * 4;
                    const s16x4 v0 = *(const LAS s16x4*)vp, v1 = *(const LAS s16x4*)(vp + 16);
                    const bf16x8 vf = __builtin_shufflevector(v0, v1, 0, 1, 2, 3, 4, 5, 6, 7);
#pragma unroll
                    for (int qt = 0; qt < 2; ++qt) o[dt][qt] = MFMA16(vf, pf[qt], o[dt][qt]); } }
        }
#pragma unroll
        for (int qt = 0; qt < 2; ++qt) { float lt = ls[qt]; lt += shx16(lt, quad & 1); lt += shx32(lt, quad >> 1); const float inv = 1.f / lt;
            bf16_t* yp = YB + (size_t)(qrow0 + qt * 16 + l15) * 512 + hq * 64 + quad * 4;
#pragma unroll
            for (int dt = 0; dt < 4; ++dt) st_bf4(yp + dt * 16, o[dt][qt] * inv); }
    }
    __syncthreads();
}

DI void attn_sample_task(LAS unsigned char* wl, int task, int l, ArgsP a, const bf16_t* Q, bf16_t* YB, int lane) {
    const int b = task >> 3, h = task & 7, g = h >> 2;
    LAS float* qs = (LAS float*)wl;
    LAS float* ps = qs + 256;
#pragma unroll
    for (int t = 0; t < 4; ++t) qs[t * 64 + lane] = bf2f(Q[(size_t)(MP + b * 4 + t) * 512 + h * 64 + lane]);
    const float* ck = a->in[2] + (size_t)(l * 128 + b) * 128 * 128 + g * 64;
    const float* cv = a->in[3] + (size_t)(l * 128 + b) * 128 * 128 + g * 64;
    const float* nk = a->out + OFF_KS + ((size_t)(l * 128 + b) * 128 + 124) * 128 + g * 64;
    const float* nv = a->out + OFF_VS + ((size_t)(l * 128 + b) * 128 + 124) * 128 + g * 64;
    const float sink = a->in[16][l * 8 + h];
    float mx[4] = {sink, sink, sink, sink};
    for (int rr = 0; rr < 3; ++rr) { const int j = rr * 64 + lane; float s[4] = {0.f, 0.f, 0.f, 0.f};
        if (j < 132) { const float* kp = j < 128 ? ck + (size_t)j * 128 : nk + (size_t)(j - 128) * 128;
#pragma unroll 4
            for (int d4 = 0; d4 < 16; ++d4) { const f32x4 k4 = *(const f32x4*)(kp + 4 * d4);
#pragma unroll
                for (int t = 0; t < 4; ++t) { const f32x4 q4 = *(const LAS f32x4*)(qs + t * 64 + 4 * d4); s[t] += k4[0] * q4[0] + k4[1] * q4[1] + k4[2] * q4[2] + k4[3] * q4[3]; } } }
#pragma unroll
        for (int t = 0; t < 4; ++t) { const bool valid = (j < 132) && (j >= t + 1) && (j <= t + 128); const float v = valid ? s[t] * 0.125f : -INFINITY;
            if (j < 136) ps[t * 136 + j] = v; mx[t] = fmaxf(mx[t], v); } }
    float den[4];
#pragma unroll
    for (int t = 0; t < 4; ++t) { mx[t] = wave_max(mx[t], lane); float sum = 0.f;
        for (int rr = 0; rr < 3; ++rr) { const int j = rr * 64 + lane; if (j < 132) { const float p = __expf(ps[t * 136 + j] - mx[t]); ps[t * 136 + j] = p; sum += p; } }
        den[t] = wave_sum(sum, lane) + __expf(sink - mx[t]); }
    float o[4] = {0.f, 0.f, 0.f, 0.f};
    for (int j = 0; j < 132; ++j) { const float v = (j < 128 ? cv + (size_t)j * 128 : nv + (size_t)(j - 128) * 128)[lane];
#pragma unroll
        for (int t = 0; t < 4; ++t) o[t] += ps[t * 136 + j] * v; }
#pragma unroll
    for (int t = 0; t < 4; ++t) YB[(size_t)(MP + b * 4 + t) * 512 + h * 64 + lane] = (bf16_t)f2bf(o[t] / den[t]);
}

struct S5C { bf16x8 bbf[4]; bf16x8 cf[4]; float are[2], aim[2]; };
DI float gelu_tanh(float y) { const float z = 1.5957691216057308f * (y + 0.044715f * y * y * y); return y * sigm(z); }
template <bool OUT>
DI void s5_tile(const S5C& K, const float* U, int row0, int g, int nruns, int nvalid, float (&hre)[2], float (&him)[2], LAS bf16_t* Hs, const float* dvec, bf16_t* YC0, int lane) {
    const int tok = lane & 31, half = lane >> 5;
    bf16x8 af = {0, 0, 0, 0, 0, 0, 0, 0};
    if (tok < nvalid) { const float* up = U + (size_t)(row0 + tok) * 512 + g * 16 + half * 8; af = pack8(*(const f32x4*)up, *(const f32x4*)(up + 4)); }
    f32x16 z16;
#pragma unroll
    for (int i = 0; i < 16; ++i) z16[i] = 0.f;
    f32x16 dre[2], dim[2];
#pragma unroll
    for (int st = 0; st < 2; ++st) { dre[st] = MFMA32(af, K.bbf[st], z16); dim[st] = MFMA32(af, K.bbf[2 + st], z16); }
#pragma unroll
    for (int r = 0; r < 8; ++r) {
        if (r < nruns) {
            const int hf = r & 1, i0 = 4 * (r >> 1);
            if (half == hf) {
#pragma unroll
                for (int k = 0; k < 4; ++k)
#pragma unroll
                    for (int st = 0; st < 2; ++st) { const float nr = K.are[st] * hre[st] - K.aim[st] * him[st] + dre[st][i0 + k]; const float ni = K.are[st] * him[st] + K.aim[st] * hre[st] + dim[st][i0 + k];
                        hre[st] = nr; him[st] = ni; dre[st][i0 + k] = nr; dim[st][i0 + k] = ni; }
            }
#pragma unroll
            for (int st = 0; st < 2; ++st) { const float pr = __shfl_xor(hre[st], 32), pi = __shfl_xor(him[st], 32); if (half != hf) { hre[st] = pr; him[st] = pi; } }
        }
    }
    if (OUT) {
#pragma unroll
        for (int i = 0; i < 16; ++i) { const int tr = (i & 3) + 8 * (i >> 2) + 4 * half; LAS bf16_t* hp = Hs + tr * 136 + tok;
#pragma unroll
            for (int st = 0; st < 2; ++st) { hp[st * 32] = (bf16_t)f2bf(dre[st][i]); hp[64 + st * 32] = (bf16_t)f2bf(dim[st][i]); } }
        const int l15 = lane & 15, quad = lane >> 4;
#pragma unroll
        for (int tt = 0; tt < 2; ++tt) {
            if (tt * 16 < nvalid) {
                f32x4 acc = {0.f, 0.f, 0.f, 0.f};
#pragma unroll
                for (int ks = 0; ks < 4; ++ks) { const bf16x8 hf8 = *(const LAS bf16x8*)(Hs + (tt * 16 + l15) * 136 + ks * 32 + quad * 8); acc = MFMA16(K.cf[ks], hf8, acc); }
                const int tk = tt * 16 + l15;
                if (tk < nvalid) { const size_t ro = (size_t)(row0 + tk) * 512 + g * 16 + quad * 4;
                    const f32x4 u4 = *(const f32x4*)(U + ro), d4 = *(const f32x4*)(dvec + quad * 4); f32x4 y = acc + d4 * u4;
                    y[0] = gelu_tanh(y[0]); y[1] = gelu_tanh(y[1]); y[2] = gelu_tanh(y[2]); y[3] = gelu_tanh(y[3]);
                    st_bf4(YC0 + ro, y); }
            }
        }
    }
}
DI void s5_load_consts(S5C& K, const unsigned char* ws, int lg, int lane) {
    const bf16_t* BBF = (const bf16_t*)(ws + WS_TAB + TB_BBF); const bf16_t* CF = (const bf16_t*)(ws + WS_TAB + TB_CF); const float* AB = (const float*)(ws + WS_TAB + TB_ABAR);
#pragma unroll
    for (int t = 0; t < 4; ++t) { K.bbf[t] = *(const bf16x8*)(BBF + (((size_t)lg * 4 + t) * 64 + lane) * 8); K.cf[t] = *(const bf16x8*)(CF + (((size_t)lg * 4 + t) * 64 + lane) * 8); }
#pragma unroll
    for (int st = 0; st < 2; ++st) { const int p = st * 32 + (lane & 31); K.are[st] = AB[((size_t)lg * 64 + p) * 2]; K.aim[st] = AB[((size_t)lg * 64 + p) * 2 + 1]; }
}
DI void s5_prompt_task(LAS unsigned char* lds, int task, int l, ArgsP a, const float* U, bf16_t* YC0, int tid) {
    const int b = task >> 5, g = task & 31, lg = l * 32 + g, wave = tid >> 6, lane = tid & 63;
    LAS bf16_t* Hs = (LAS bf16_t*)(lds + wave * 8704);
    LAS float* Es = (LAS float*)(lds + 8 * 8704);
    S5C K; s5_load_consts(K, a->ws, lg, lane);
    const float* dvec = a->in[24] + l * 512 + g * 16;
    const int rowb = b * 2048 + wave * 256;
    float hre[2] = {0.f, 0.f}, him[2] = {0.f, 0.f};
    for (int tl = 0; tl < 8; ++tl) s5_tile<false>(K, U, rowb + tl * 32, g, 8, 32, hre, him, Hs, dvec, YC0, lane);
    if (lane < 32) { Es[(wave * 4 + 0) * 32 + lane] = hre[0]; Es[(wave * 4 + 1) * 32 + lane] = hre[1]; Es[(wave * 4 + 2) * 32 + lane] = him[0]; Es[(wave * 4 + 3) * 32 + lane] = him[1]; }
    __syncthreads();
    { const float* A256 = (const float*)(a->ws + WS_TAB + TB_ABAR256); float pr[2], pi[2];
#pragma unroll
      for (int st = 0; st < 2; ++st) { const int p = st * 32 + (lane & 31); pr[st] = A256[((size_t)lg * 64 + p) * 2]; pi[st] = A256[((size_t)lg * 64 + p) * 2 + 1]; hre[st] = 0.f; him[st] = 0.f; }
      for (int w = 0; w < wave; ++w) {
#pragma unroll
          for (int st = 0; st < 2; ++st) { const float er = Es[(w * 4 + st) * 32 + (lane & 31)], ei = Es[(w * 4 + 2 + st) * 32 + (lane & 31)];
              const float nr = pr[st] * hre[st] - pi[st] * him[st] + er, ni = pr[st] * him[st] + pi[st] * hre[st] + ei; hre[st] = nr; him[st] = ni; } } }
    for (int tl = 0; tl < 8; ++tl) s5_tile<true>(K, U, rowb + tl * 32, g, 8, 32, hre, him, Hs, dvec, YC0, lane);
    if (wave == 7 && lane < 32) {
#pragma unroll
        for (int st = 0; st < 2; ++st) { a->out[OFF_SRP + ((size_t)(l * 8 + b) * 32 + g) * 64 + st * 32 + lane] = hre[st]; a->out[OFF_SIP + ((size_t)(l * 8 + b) * 32 + g) * 64 + st * 32 + lane] = him[st]; } }
    __syncthreads();
}
DI void s5_sample_task(LAS unsigned char* lds, int task, int l, ArgsP a, const float* U, bf16_t* YC0, int tid) {
    const int bs = task >> 5, g = task & 31, lg = l * 32 + g, wave = tid >> 6, lane = tid & 63;
    LAS bf16_t* Hs = (LAS bf16_t*)(lds + wave * 8704);
    S5C K; s5_load_consts(K, a->ws, lg, lane);
    const size_t so = ((size_t)(l * 128 + bs) * 32 + g) * 64;
    float hre[2], him[2];
#pragma unroll
    for (int st = 0; st < 2; ++st) { hre[st] = a->in[5][so + st * 32 + (lane & 31)]; him[st] = a->in[6][so + st * 32 + (lane & 31)]; }
    s5_tile<true>(K, U, MP + bs * 4, g, 1, 4, hre, him, Hs, a->in[24] + l * 512 + g * 16, YC0, lane);
    if (lane < 32) {
#pragma unroll
        for (int st = 0; st < 2; ++st) { a->out[OFF_SRS + so + st * 32 + lane] = hre[st]; a->out[OFF_SIS + so + st * 32 + lane] = him[st]; } }
}

DI void mixers_phase(ArgsP a, LAS unsigned char* lds, int l, int tid) {
    unsigned char* ws = a->ws;
    const float* XA = (const float*)(ws + WS_XA); const float* U = (const float*)(ws + WS_U);
    const bf16_t* Q = (const bf16_t*)(ws + WS_Q); const bf16_t* KB = (const bf16_t*)(ws + WS_K); const bf16_t* VB = (const bf16_t*)(ws + WS_V);
    bf16_t* Dm = (bf16_t*)(ws + WS_DYY); bf16_t* YB = Dm + (size_t)M * 512; bf16_t* YC0 = (bf16_t*)(ws + WS_YC0);
    const int wave = tid >> 6, lane = tid & 63, gw = blockIdx.x * 8 + wave, NGW = gridDim.x * 8;
    const int vcb = (gridDim.x % 8 == 0) ? (blockIdx.x % 8) * (gridDim.x / 8) + blockIdx.x / 8 : blockIdx.x;
    for (int rp = 0; rp < 1 + ((MIXM >> 0) & 1); ++rp) for (int u = vcb; u < 256; u += gridDim.x) attn_prompt_unit(lds, u, Q, KB, VB, YB, a->in[16] + l * 8, tid);
    for (int rp = 0; rp < 1 + ((MIXM >> 1) & 1); ++rp) for (int t = vcb; t < 256; t += gridDim.x) s5_prompt_task(lds, t, l, a, U, YC0, tid);
    for (int rp = 0; rp < 1 + ((MIXM >> 2) & 1); ++rp) for (int t = gw; t < 4096; t += NGW) s5_sample_task(lds, t, l, a, U, YC0, tid);
    __syncthreads();
    for (int rp = 0; rp < 1 + ((MIXM >> 3) & 1); ++rp) for (int t = gw; t < 1024; t += NGW) attn_sample_task(lds + wave * 4096, t, l, a, Q, YB, lane);
}

__global__ void __launch_bounds__(512, 2) mega(Args a_unused) {
    extern __shared__ __attribute__((aligned(16))) unsigned char lds_raw[];
    LAS unsigned char* lds = (LAS unsigned char*)lds_raw;
    cg::grid_group grid = cg::this_grid();
    const int wave_s = __builtin_amdgcn_readfirstlane((int)threadIdx.x >> 6);
    volatile LAS unsigned* bst = (volatile LAS unsigned*)(lds + 135168);
    if (threadIdx.x < 2) bst[threadIdx.x] = 0u;
    __syncthreads();
    XcdBarrier xbar = xcd_barrier_post((unsigned*)(((ArgsP)__builtin_amdgcn_kernarg_segment_ptr())->ws), bst);
    const int ph_lo = ((ArgsP)__builtin_amdgcn_kernarg_segment_ptr())->ph_lo, ph_hi = ((ArgsP)__builtin_amdgcn_kernarg_segment_ptr())->ph_hi;
    for (int ph = ph_lo; ph < ph_hi; ++ph) {
        const int kk9 = (ph - 2) % 9;
        const int cls = ph == 0 ? 0 : ph == 1 ? 1 : ph == NPHASE - 1 ? 10 : (kk9 == 0 || kk9 == 6) ? 2 : kk9 == 1 ? 3 : kk9 == 2 ? 4 : kk9 == 3 ? 5 : kk9 == 4 ? 6 : kk9 == 5 ? 7 : kk9 == 7 ? 8 : 9;
        const int nrep = 1 + ((REPM >> cls) & 1);
        for (int rep = 0; rep < nrep; ++rep) {
        ArgsP a = (ArgsP)__builtin_amdgcn_kernarg_segment_ptr(); asm volatile("" : "+s"(a));
        int G = gridDim.x, c = blockIdx.x; asm volatile("" : "+s"(G), "+s"(c));
        int tid = wave_s * 64 + lane_id_v(); asm volatile("" : "+v"(tid));
        unsigned char* ws = a->ws;
        float* X = a->out;
        float* MOD = (float*)(ws + WS_MOD);
        bf16_t* H = (bf16_t*)(ws + WS_H);
        if (ph == 0) { if (PHM & 1) prologue(a, lds, tid); }
        else if (ph == 1) { if (PHM & 4) {
            pg8::Gemm g{(const bf16_t*)(ws + WS_CA), (const bf16_t*)(ws + WS_GT), 256, NMOD, 1024}; pg8::StaticOrder S; S.init(256, NMOD, G, c);
            pg8::EpiMod E{MOD, a->in[12]};
            pg8::gemm_phase<pg8::EpiMod, pg8::StaticOrder, true, true>(lds, g, S, E, wave_s * 64 + lane_id_v());
            { const int t_ = wave_s * 64 + lane_id_v(); if (G > 96) { if (c >= 96) cache_shift(a, (c - 96) * 512 + t_, (G - 96) * 512); } else cache_shift(a, c * 512 + t_, G * 512); } }
        } else if (ph == NPHASE - 1) norm_phase(X, X, a->in[32], MOD, 0, nullptr, tid, (const float*)(ws + WS_DYY), 22, MOD + 3 * 6144 + 5120, X);
        else {
            const int l = (ph - 2) / 9, k = (ph - 2) % 9;
            const float* xp = l == 0 ? a->in[0] : X; const float* xs = l == 0 ? a->in[1] - (size_t)MP * 1024 : X;
            if (k == 0) norm_phase(xp, xs, a->in[9] + l * 1024, MOD + l * 6144, 1024, H, tid, (const float*)(ws + WS_DYY), l == 0 ? 0 : 22, MOD + (l - 1) * 6144 + 5120, X);
            else if (k == 1) { if (GM & 1) {
                pg8::Gemm g{H, (const bf16_t*)(ws + WS_WIN) + (size_t)l * IN_COLS * 1024, M, IN_COLS, 1024}; pg8::StaticOrder S; S.init(M, IN_COLS, G, c);
                pg8::EpiIn E{(float*)(ws + WS_XA), (float*)(ws + WS_U), (bf16_t*)(ws + WS_Q), (bf16_t*)(ws + WS_K), (bf16_t*)(ws + WS_V), (bf16_t*)(ws + WS_GT),
                             (const float*)(ws + WS_TAB + TB_ROPEC), (const float*)(ws + WS_TAB + TB_ROPES), a->out, l};
                pg8::gemm_phase<pg8::EpiIn, pg8::StaticOrder, true, true>(lds, g, S, E, wave_s * 64 + lane_id_v()); }
            } else if (k == 2) { if (PHM & 2) mixers_phase(a, lds, l, tid); }
            else if (k == 3) { if (GM & 2) {
                pg8::Gemm g{(const bf16_t*)(ws + WS_YC0), (const bf16_t*)(ws + WS_WGLU) + (size_t)l * 512 * 512, M, 512, 512}; pg8::StaticOrder S; S.init(M, 512, G, c);
                pg8::EpiGlu E{(const bf16_t*)(ws + WS_YC0), (bf16_t*)(ws + WS_DYY) + (size_t)2 * M * 512};
                pg8::gemm_phase<pg8::EpiGlu, pg8::StaticOrder, true, true>(lds, g, S, E, wave_s * 64 + lane_id_v());
                {
                  constexpr int NI = 4 * (MP / 8) * 32; const float* XAp = (const float*)(ws + WS_XA); bf16_t* Dp = (bf16_t*)(ws + WS_DYY); const int t_ = wave_s * 64 + lane_id_v();
                  if (G > 132) { constexpr int SPLIT = (NI / 6 * 5) & ~63;
                      if (c >= 132) pool_phase(a, l, XAp, Dp, (c - 132) * 512 + t_, (G - 132) * 512, 0, SPLIT, true);
                      else pool_phase(a, l, XAp, Dp, c * 512 + t_, 132 * 512, SPLIT, NI, false); }
                  else pool_phase(a, l, XAp, Dp, c * 512 + t_, G * 512, 0, NI, true); } }
            } else if (k == 4) { if (GM & 4) {
                { pg8::Gemm g{(const bf16_t*)(ws + WS_DYY), (const bf16_t*)(ws + WS_WBR) + (size_t)l * 3072 * 512, 3 * M, 3072, 512, 0, 0}; pg8::BranchOrder S{G, c};
                  pg8::EpiMerge E{(const bf16_t*)(ws + WS_GT), (float*)(ws + WS_XA), H};
                  pg8::gemm_phase<pg8::EpiMerge, pg8::BranchOrder, true, true>(lds, g, S, E, wave_s * 64 + lane_id_v()); }
                { pg8::Gemm g{(const bf16_t*)(ws + WS_DYY), (const bf16_t*)(ws + WS_WBR) + (size_t)l * 3072 * 512, 3 * M, 3072, 128, 512, 512}; pg8::SplitOrder S{G, c, 4, 3};
                  pg8::EpiPart E{(float*)(ws + WS_Q), (const bf16_t*)(ws + WS_GT), 4};
                  pg8::gemm_phase<pg8::EpiPart, pg8::SplitOrder, true, true>(lds, g, S, E, wave_s * 64 + lane_id_v()); } }
            } else if (k == 5) { if (GM & 8) {
                { pg8::Gemm g{H, (const bf16_t*)(ws + WS_WOUT) + (size_t)l * 1024 * 1024, MP, 1024, 1024, 0, 0}; pg8::StaticOrder S; S.init(MP, 1024, G, c);
                  pg8::EpiRes E{xp, rep ? (float*)(ws + WS_XA) : X, MOD + l * 6144 + 2048};
                  pg8::gemm_phase<pg8::EpiRes, pg8::StaticOrder, true, true>(lds, g, S, E, wave_s * 64 + lane_id_v()); }
                for (int j = c; j < 64; j += G) { const int ks = j & 7, pmr = j >> 5; const float* Pm = (const float*)(ws + WS_Q);
                    for (int e2 = wave_s * 64 + lane_id_v(); e2 < 256 * 32; e2 += 512) { const int rs = pmr * 256 + (e2 >> 5), c4 = ks * 128 + (e2 & 31) * 4; f32x4 s = {0.f, 0.f, 0.f, 0.f};
#pragma unroll
                        for (int p = 0; p < 12; ++p) s += *(const f32x4*)(Pm + ((size_t)p * 512 + rs) * 1024 + c4);
                        st_bf4(H + (size_t)(MP + rs) * 1024 + c4, s); } }
                asm volatile("s_waitcnt vmcnt(0)" ::: "memory"); __syncthreads();
                { pg8::Gemm g{H, (const bf16_t*)(ws + WS_WOUT) + (size_t)l * 1024 * 1024, M, 1024, 128, 1024, 1024}; pg8::SplitOrder S{G, c, 8, 1};
                  pg8::EpiPart E{(float*)(ws + WS_YC0), nullptr, 8};
                  pg8::gemm_phase<pg8::EpiPart, pg8::SplitOrder, true, true>(lds, g, S, E, wave_s * 64 + lane_id_v()); } }
            } else if (k == 6) norm_phase(X, xs, a->in[10] + l * 1024, MOD + l * 6144 + 3072, 1024, H, tid, (const float*)(ws + WS_YC0), 8, MOD + l * 6144 + 2048, X);
            else if (k == 7) { if (GM & 16) {
                pg8::Gemm g{H, (const bf16_t*)(ws + WS_WFI) + (size_t)l * 2 * DFF * 1024, M, 2 * DFF, 1024}; pg8::StaticOrder S; S.init(M, 2 * DFF, G, c);
                pg8::EpiFfn E{(bf16_t*)(ws + WS_GT)};
                pg8::gemm_phase<pg8::EpiFfn, pg8::StaticOrder, true, true>(lds, g, S, E, wave_s * 64 + lane_id_v()); }
            } else if (GM & 32) {
                { pg8::Gemm g{(const bf16_t*)(ws + WS_GT), (const bf16_t*)(ws + WS_WFO) + (size_t)l * 1024 * DFF, MP, 1024, DFF, 0, 0}; pg8::StaticOrder S; S.init(MP, 1024, G, c);
                  pg8::EpiRes E{X, rep ? (float*)(ws + WS_XA) : X, MOD + l * 6144 + 5120};
                  pg8::gemm_phase<pg8::EpiRes, pg8::StaticOrder, true, true>(lds, g, S, E, wave_s * 64 + lane_id_v()); }
                { pg8::Gemm g{(const bf16_t*)(ws + WS_GT), (const bf16_t*)(ws + WS_WFO) + (size_t)l * 1024 * DFF, M, 1024, 128, DFF, DFF}; pg8::SplitOrder S{G, c, 22, 1};
                  pg8::EpiPart E{(float*)(ws + WS_DYY), nullptr, 22};
                  pg8::gemm_phase<pg8::EpiPart, pg8::SplitOrder, true, true>(lds, g, S, E, wave_s * 64 + lane_id_v()); }
            }
        }
        if (REPM && rep + 1 < nrep) __syncthreads();
        }
        if (ph + 1 < ph_hi) { if (SYNC2 == 1 || ph_hi > 1000) grid.sync(); else { XcdBarrier xb = xbar; asm volatile("" : "+s"(xb.x), "+s"(xb.bar));
            xcd_barrier(xb); if (SYNC2 == 2) xcd_barrier(xb); } }
    }
}

extern "C" void kernel_launch(void* const* d_in, const int* in_sizes, int n_in, void* d_out, int out_size, void* d_ws, size_t ws_size, hipStream_t stream) {
    static int grid = 0;
    if (grid == 0) {
        if (n_in != 33 || (size_t)out_size != OUT_TOTAL || ws_size < WS_END) { fprintf(stderr, "kernel_launch: unexpected shapes: n_in %d out %d ws %zu (need %zu)\n", n_in, out_size, ws_size, (size_t)WS_END); grid = -1; return; }
        int dev = 0, cus = 0, per_cu = 0;
        (void)hipGetDevice(&dev); (void)hipDeviceGetAttribute(&cus, hipDeviceAttributeMultiprocessorCount, dev);
        if (hipFuncSetAttribute((const void*)mega, hipFuncAttributeMaxDynamicSharedMemorySize, LDS_BYTES) != hipSuccess) { fprintf(stderr, "kernel_launch: hipFuncSetAttribute failed\n"); grid = -1; return; }
        if (hipOccupancyMaxActiveBlocksPerMultiprocessor(&per_cu, (const void*)mega, 512, LDS_BYTES) != hipSuccess || per_cu < 1) { fprintf(stderr, "kernel_launch: occupancy query says %d\n", per_cu); per_cu = 1; }
        (void)hipGetLastError();
        grid = cus * 1;
        if (grid <= 0) grid = 256;
    }
    if (grid < 0) return;
    Args a{};
    for (int i = 0; i < 33; ++i) a.in[i] = (const float*)d_in[i];
    a.out = (float*)d_out; a.ws = (unsigned char*)d_ws;
    for (int j = 0; j < 8; ++j) a.rfix[j] = (unsigned long long)ldexpl(powl(500000.0L, -(long double)j / 8.0L) / (2.0L * 3.14159265358979323846264338327950288L), 64);
#if MK_MULTI
    for (int ph = 0; ph < NPHASE; ++ph) { a.ph_lo = ph; a.ph_hi = ph + 1; hipLaunchKernelGGL(mega, dim3(grid), dim3(512), LDS_BYTES, stream, a); }
#else
    a.ph_lo = 0; a.ph_hi = NPHASE;
    if (hipMemsetAsync(d_ws, 0, 16384, stream) != hipSuccess) { fprintf(stderr, "kernel_launch: memset failed\n"); return; }
    void* args[] = {&a};
    hipError_t e = hipLaunchCooperativeKernel((const void*)mega, dim3(grid), dim3(512), args, LDS_BYTES, stream);
    if (e != hipSuccess) fprintf(stderr, "kernel_launch: cooperative launch failed: %s (grid %d)\n", hipGetErrorString(e), grid);
#endif
}
```

```cpp
#include <hip/hip_runtime.h>
#include <hip/hip_cooperative_groups.h>
#include <cstdio>
#include <cstdint>
#include <cmath>
namespace cg = cooperative_groups;

#ifndef MK_MULTI
#define MK_MULTI 0
#endif

__device__ __forceinline__ int lane_id_v() { int l; asm volatile("v_mbcnt_lo_u32_b32 %0, -1, 0\n\tv_mbcnt_hi_u32_b32 %0, -1, %0" : "=v"(l)); return l; }
__device__ __forceinline__ float shx(float v, int mask, int lane) { return __builtin_bit_cast(float, __builtin_amdgcn_ds_bpermute((lane ^ mask) << 2, __builtin_bit_cast(int, v))); }

__device__ __forceinline__ float shx32(float v, int upper  ) { const unsigned x = __builtin_bit_cast(unsigned, v); auto r = __builtin_amdgcn_permlane32_swap(x, x, false, false); return __builtin_bit_cast(float, upper ? r[0] : r[1]); }
__device__ __forceinline__ float shx16(float v, int odd  ) { const unsigned x = __builtin_bit_cast(unsigned, v); auto r = __builtin_amdgcn_permlane16_swap(x, x, false, false); return __builtin_bit_cast(float, odd ? r[0] : r[1]); }

namespace cfg {
constexpr int D = 1024, MP = 16384, MS = 512, M = MP + MS, SEQ = 2048, NBAT = 136, DEPTH = 4;
constexpr int IN_COLS = 4864, DFF = 2816, NMOD = 6 * D * DEPTH;
constexpr size_t OFF_Y = 0;
constexpr size_t OFF_KP = (size_t)M * D;
constexpr size_t OFF_VP = OFF_KP + (size_t)4 * 8 * 128 * 128;
constexpr size_t OFF_PP = OFF_VP + (size_t)4 * 8 * 128 * 128;
constexpr size_t OFF_SRP = OFF_PP + (size_t)4 * 8 * 15 * 512;
constexpr size_t OFF_SIP = OFF_SRP + (size_t)4 * 8 * 32 * 64;
constexpr size_t OFF_KS = OFF_SIP + (size_t)4 * 8 * 32 * 64;
constexpr size_t OFF_VS = OFF_KS + (size_t)4 * 128 * 128 * 128;
constexpr size_t OFF_PS = OFF_VS + (size_t)4 * 128 * 128 * 128;
constexpr size_t OFF_SRS = OFF_PS + (size_t)4 * 128 * 15 * 512;
constexpr size_t OFF_SIS = OFF_SRS + (size_t)4 * 128 * 32 * 64;
constexpr size_t OUT_TOTAL = OFF_SIS + (size_t)4 * 128 * 32 * 64;
static_assert(OUT_TOTAL == 41533440, "output size");
constexpr size_t MiB = 1u << 20;
constexpr size_t WS_WIN = 1 * MiB;
constexpr size_t WS_WGLU = WS_WIN + 38 * MiB;
constexpr size_t WS_WBR = WS_WGLU + 2 * MiB;
constexpr size_t WS_WOUT = WS_WBR + 12 * MiB;
constexpr size_t WS_WFI = WS_WOUT + 8 * MiB;
constexpr size_t WS_WFO = WS_WFI + 44 * MiB;
constexpr size_t WS_MOD = WS_WFO + 22 * MiB;
constexpr size_t WS_CA = WS_MOD + 13 * MiB;
constexpr size_t WS_TAB = WS_CA + 1 * MiB;
constexpr size_t WS_H = WS_TAB + 2 * MiB;
constexpr size_t WS_XA = WS_H + 33 * MiB;
constexpr size_t WS_U = WS_XA + 33 * MiB;
constexpr size_t WS_Q = WS_U + 33 * MiB;
constexpr size_t WS_K = WS_Q + 17 * MiB;
constexpr size_t WS_V = WS_K + 5 * MiB;
constexpr size_t WS_DYY = WS_V + 5 * MiB;
constexpr size_t WS_YC0 = WS_DYY + 50 * MiB;
constexpr size_t WS_GT = WS_YC0 + 17 * MiB;
constexpr size_t WS_END = WS_GT + 99 * MiB;
static_assert((size_t)M * 512 * 2 * 3 <= 50 * MiB && (size_t)M * 3072 * 2 <= 99 * MiB && (size_t)M * 1024 * 2 <= 33 * MiB, "ws map");
constexpr size_t TB_ROPEC = 0;
constexpr size_t TB_ROPES = 65664;
constexpr size_t TB_ABAR = 131328;
constexpr size_t TB_ABAR256 = TB_ABAR + 65536;
constexpr size_t TB_BBF = 262400;
constexpr size_t TB_CF = TB_BBF + 524288;
static_assert(TB_CF + 524288 <= 2 * MiB, "tables");
constexpr int LDS_BYTES = 147456;
constexpr int NPHASE = 2 + 9 * DEPTH + 1;
}

namespace pg8 {
#define PG8_LAS __attribute__((address_space(3)))
typedef unsigned short bf16_t;
typedef short bf16x8 __attribute__((ext_vector_type(8)));
typedef float f32x4 __attribute__((ext_vector_type(4)));
typedef unsigned u32x4 __attribute__((ext_vector_type(4)));
constexpr int BM = 256, BK = 64, HALF = 128, HTB = HALF * BK * 2  , STAGE_BYTES = 8 * HTB, NXCD = 8, WGM = 4;

__host__ __device__ __forceinline__ int lds_byte(int r, int c) { const int st = (r >> 4) * 2 + (c >> 5), rr = r & 15, cc = c & 31, ob = rr * 64 + cc * 2; return st * 1024 + (ob ^ (((ob >> 9) & 1) << 5)); }
__host__ __device__ __forceinline__ void stage_rc(int b, int& R, int& C) { const int st = b / 1024, sb = b % 1024, swz = sb ^ (((sb >> 9) & 1) << 5); R = (st >> 1) * 16 + swz / 64; C = (st & 1) * 32 + (swz % 64) / 2; }
__host__ __device__ __forceinline__ int perm32(int rho) { const int n = rho >> 4, i = rho & 15; return 8 * (i >> 2) + 4 * n + (i & 3); }

struct Unit { int pm, pn, k0; };
struct Gemm { const bf16_t* A; const bf16_t* Bt; int M, N, K, lda, ldb; };

struct StaticOrder {
    int nM, nN, nwg, G, c;
    __host__ __device__ void init(int M, int N, int G_, int c_) { nM = M / BM; nN = N / BM; nwg = nM * nN; G = G_; c = c_; }
    __host__ __device__ bool next(int i, Unit& u) const {
        const long L = (long)i * G + c; if (L >= nwg) return false;
        int wgid = (int)L; { const int q = nwg / NXCD, r = nwg % NXCD, xcd = wgid % NXCD, off = wgid / NXCD; wgid = (xcd < r ? xcd * (q + 1) : r * (q + 1) + (xcd - r) * q) + off; }
        const int nig = WGM * nN, gid = wgid / nig, fm = gid * WGM, gsz = (nM - fm) < WGM ? (nM - fm) : WGM;
        u.pm = fm + ((wgid % nig) % gsz); u.pn = (wgid % nig) / gsz; u.k0 = 0; return true;
    }
    __device__ __forceinline__ void a_ready(const Unit&) const {}
    __device__ __forceinline__ void done(const Unit&) const {}
};

__device__ __forceinline__ unsigned cvt_pk_bf16(float lo, float hi) { unsigned r; asm volatile("v_cvt_pk_bf16_f32 %0, %1, %2" : "=v"(r) : "v"(lo), "v"(hi)); return r; }
typedef unsigned u32x2 __attribute__((ext_vector_type(2)));
__device__ __forceinline__ float sigm(float x) { return __builtin_amdgcn_rcpf(1.f + __expf(-x)); }
__device__ __forceinline__ f32x4 ld_bf4(const bf16_t* p) { const u32x2 w = *(const u32x2*)p; f32x4 r; r[0] = __uint_as_float(w.x << 16); r[1] = __uint_as_float(w.x & 0xffff0000u); r[2] = __uint_as_float(w.y << 16); r[3] = __uint_as_float(w.y & 0xffff0000u); return r; }
__device__ __forceinline__ void st_bf4(bf16_t* p, const f32x4 v) { u32x2 w; w.x = cvt_pk_bf16(v[0], v[1]); w.y = cvt_pk_bf16(v[2], v[3]); *(u32x2*)p = w; }
__device__ __forceinline__ int batch_of(int row) { return row < cfg::MP ? (row >> 11) : 8 + ((row - cfg::MP) >> 2); }

struct EpiMod {
    static constexpr bool PERM = true, AFTER_DRAIN = false;
    float* MOD; const float* bada;
    __device__ __forceinline__ void operator()(const f32x4 (&acc)[2][2][4][2], const Unit& u, int wr, int wc, int fr, int fq) const {
#pragma unroll
        for (int ai = 0; ai < 2; ++ai)
#pragma unroll
            for (int m = 0; m < 4; ++m) { const int row = u.pm * 256 + ai * 128 + wr * 64 + m * 16 + fr;
                if (row < cfg::NBAT) {
#pragma unroll
                    for (int bj = 0; bj < 2; ++bj)
#pragma unroll
                        for (int n = 0; n < 2; ++n) { const int col = u.pn * 256 + bj * 128 + wc * 32 + 8 * fq + 4 * n;
                            *(f32x4*)(MOD + (size_t)row * cfg::NMOD + col) = acc[ai][bj][m][n] + *(const f32x4*)(bada + col); } } }
    }
};

struct EpiIn {
    static constexpr bool PERM = true, AFTER_DRAIN = false;
    float* XA; float* U; bf16_t* Q; bf16_t* KB; bf16_t* VB; bf16_t* GT; const float* ropec; const float* ropes; float* out; int layer;
    __device__ __forceinline__ void operator()(const f32x4 (&acc)[2][2][4][2], const Unit& u, int wr, int wc, int fr, int fq) const {
        const int pn = u.pn;
#pragma unroll
        for (int ai = 0; ai < 2; ++ai)
#pragma unroll
            for (int m = 0; m < 4; ++m) { const int row = u.pm * 256 + ai * 128 + wr * 64 + m * 16 + fr;
#pragma unroll
                for (int bj = 0; bj < 2; ++bj)
#pragma unroll
                    for (int n = 0; n < 2; ++n) { const int tc = bj * 128 + wc * 32 + 8 * fq + 4 * n; f32x4 v = acc[ai][bj][m][n];
                        if (pn < 2) { *(f32x4*)(XA + (size_t)row * 512 + pn * 256 + tc) = v; }
                        else if (pn <= 4) {
                            const bool isv = (pn == 4 && bj == 1);
                            if (!isv && (wc & 1) == 0) {
                                const int tix = row < cfg::MP ? (row & 2047) : 2048 + (row & 3);
                                const f32x4 cs = *(const f32x4*)(ropec + tix * 8 + 4 * n), sn = *(const f32x4*)(ropes + tix * 8 + 4 * n);
#pragma unroll
                                for (int i = 0; i < 4; ++i) { const float p = shx16(v[i], fq & 1); const float rv = v[i] * cs[i] + (fq == 0 ? -p : p) * sn[i]; v[i] = fq < 2 ? rv : v[i]; }
                            }
                            if (pn < 4) st_bf4(Q + (size_t)row * 512 + (pn - 2) * 256 + tc, v);
                            else { st_bf4((bj == 0 ? KB : VB) + (size_t)row * 128 + (tc & 127), v);
                                bool w = false; size_t o = 0;
                                if (row < cfg::MP) { const int t = row & 2047; if (t >= 1920) { w = true; o = (bj == 0 ? cfg::OFF_KP : cfg::OFF_VP) + ((size_t)(layer * 8 + (row >> 11)) * 128 + (t - 1920)) * 128 + (tc & 127); } }
                                else { const int rs = row - cfg::MP; w = true; o = (bj == 0 ? cfg::OFF_KS : cfg::OFF_VS) + ((size_t)(layer * 128 + (rs >> 2)) * 128 + 124 + (rs & 3)) * 128 + (tc & 127); }
                                if (w) *(f32x4*)(out + o) = v; }
                        }
                        else if (pn < 7) { *(f32x4*)(U + (size_t)row * 512 + (pn - 5) * 256 + tc) = v; }
                        else { f32x4 s; s[0] = sigm(v[0]); s[1] = sigm(v[1]); s[2] = sigm(v[2]); s[3] = sigm(v[3]); st_bf4(GT + (size_t)row * 3072 + (pn - 7) * 256 + tc, s); }
                    } }
    }
};

struct EpiGlu {
    static constexpr bool PERM = true, AFTER_DRAIN = false;
    const bf16_t* YC0; bf16_t* YC;
    __device__ __forceinline__ void operator()(const f32x4 (&acc)[2][2][4][2], const Unit& u, int wr, int wc, int fr, int fq) const {
#pragma unroll
        for (int ai = 0; ai < 2; ++ai)
#pragma unroll
            for (int m = 0; m < 4; ++m) { const int row = u.pm * 256 + ai * 128 + wr * 64 + m * 16 + fr;
#pragma unroll
                for (int bj = 0; bj < 2; ++bj)
#pragma unroll
                    for (int n = 0; n < 2; ++n) { const int col = u.pn * 256 + bj * 128 + wc * 32 + 8 * fq + 4 * n; const f32x4 v = acc[ai][bj][m][n];
                        const f32x4 y0 = ld_bf4(YC0 + (size_t)row * 512 + col); f32x4 o;
#pragma unroll
                        for (int i = 0; i < 4; ++i) o[i] = y0[i] * sigm(v[i]);
                        st_bf4(YC + (size_t)row * 512 + col, o); } }
    }
};

struct EpiMerge {
    static constexpr bool PERM = true, AFTER_DRAIN = false;
    const bf16_t* GT; float* M32; bf16_t* M16;
    __device__ __forceinline__ void operator()(const f32x4 (&acc)[2][2][4][2], const Unit& u, int wr, int wc, int fr, int fq) const {
        const int br = u.pm / 66, pm = u.pm - br * 66, pn = u.pn & 3;
        if (br > 0) asm volatile("s_waitcnt vmcnt(0)" ::: "memory");
#pragma unroll
        for (int ai = 0; ai < 2; ++ai)
#pragma unroll
            for (int m = 0; m < 4; ++m) { const int row = pm * 256 + ai * 128 + wr * 64 + m * 16 + fr;
#pragma unroll
                for (int bj = 0; bj < 2; ++bj)
#pragma unroll
                    for (int n = 0; n < 2; ++n) { const int col = pn * 256 + bj * 128 + wc * 32 + 8 * fq + 4 * n; const f32x4 v = acc[ai][bj][m][n];
                        const f32x4 g = ld_bf4(GT + (size_t)row * 3072 + br * 1024 + col);
                        bf16_t* mp = M16 + (size_t)row * 1024 + col;
                        if (br == 0) st_bf4(mp, g * v); else st_bf4(mp, ld_bf4(mp) + g * v); } }
    }
};

struct EpiRes {
    static constexpr bool PERM = true, AFTER_DRAIN = false;
    const float* xin; float* X; const float* MODG;
    __device__ __forceinline__ void operator()(const f32x4 (&acc)[2][2][4][2], const Unit& u, int wr, int wc, int fr, int fq) const {
        const float* gp = MODG + (size_t)(u.pm >> 3) * cfg::NMOD + u.pn * 256 + wc * 32 + 8 * fq;
        f32x4 g[2][2];
#pragma unroll
        for (int bj = 0; bj < 2; ++bj)
#pragma unroll
            for (int n = 0; n < 2; ++n) g[bj][n] = *(const f32x4*)(gp + bj * 128 + n * 4);
#pragma unroll
        for (int ai = 0; ai < 2; ++ai)
#pragma unroll
            for (int m = 0; m < 4; ++m) { const int row = u.pm * 256 + ai * 128 + wr * 64 + m * 16 + fr;
#pragma unroll
                for (int bj = 0; bj < 2; ++bj)
#pragma unroll
                    for (int n = 0; n < 2; ++n) { const size_t o = (size_t)row * 1024 + u.pn * 256 + bj * 128 + wc * 32 + 8 * fq + 4 * n;
                        *(f32x4*)(X + o) = *(const f32x4*)(xin + o) + g[bj][n] * acc[ai][bj][m][n]; } }
    }
};

struct EpiPart {
    static constexpr bool PERM = true, AFTER_DRAIN = false;
    float* P; const bf16_t* GT; int nks;
    __device__ __forceinline__ void operator()(const f32x4 (&acc)[2][2][4][2], const Unit& u, int wr, int wc, int fr, int fq) const {
        const int br = u.pm / 66, pmr = u.pm - br * 66 - 64, pn = u.pn & 3, slice = br * nks + (u.k0 >> 7);
#pragma unroll
        for (int ai = 0; ai < 2; ++ai)
#pragma unroll
            for (int m = 0; m < 4; ++m) { const int rs = pmr * 256 + ai * 128 + wr * 64 + m * 16 + fr;
#pragma unroll
                for (int bj = 0; bj < 2; ++bj)
#pragma unroll
                    for (int n = 0; n < 2; ++n) { const int col = pn * 256 + bj * 128 + wc * 32 + 8 * fq + 4 * n; f32x4 v = acc[ai][bj][m][n];
                        if (GT) v = v * ld_bf4(GT + (size_t)(cfg::MP + rs) * 3072 + br * 1024 + col);
                        *(f32x4*)(P + ((size_t)slice * 512 + rs) * 1024 + col) = v; } }
    }
};

struct EpiFfn {
    static constexpr bool PERM = true, AFTER_DRAIN = false;
    bf16_t* ACT;
    __device__ __forceinline__ void operator()(const f32x4 (&acc)[2][2][4][2], const Unit& u, int wr, int wc, int fr, int fq) const {
#pragma unroll
        for (int ai = 0; ai < 2; ++ai)
#pragma unroll
            for (int m = 0; m < 4; ++m) { const int row = u.pm * 256 + ai * 128 + wr * 64 + m * 16 + fr;
#pragma unroll
                for (int n = 0; n < 2; ++n) { const int col = u.pn * 128 + wc * 32 + 8 * fq + 4 * n; const f32x4 a = acc[ai][0][m][n], b = acc[ai][1][m][n]; f32x4 o;
#pragma unroll
                    for (int i = 0; i < 4; ++i) o[i] = a[i] * sigm(a[i]) * b[i];
                    st_bf4(ACT + (size_t)row * cfg::DFF + col, o); } }
    }
};

struct BranchOrder {
    int G, c;
    __host__ __device__ bool next(int i, Unit& u) const { const int vc = (G % 8 == 0) ? (c % 8) * (G / 8) + c / 8 : c;
        const int tile = vc + (i / 3) * G; if (tile >= 256) return false; const int br = i % 3; u.pm = br * 66 + (tile >> 2); u.pn = br * 4 + (tile & 3); u.k0 = 0; return true; }
    __device__ __forceinline__ void a_ready(const Unit&) const {}
    __device__ __forceinline__ void done(const Unit&) const {}
};
struct SplitOrder {
    int G, c, nks, nbr;
    __host__ __device__ bool next(int i, Unit& u) const { const int j = c + i * G; if (j >= 8 * nbr * nks) return false; const int ks = j % nks, t = j / nks, br = t % nbr, tile = t / nbr;
        u.pm = br * 66 + 64 + (tile >> 2); u.pn = br * 4 + (tile & 3); u.k0 = ks * 128; return true; }
    __device__ __forceinline__ void a_ready(const Unit&) const {}
    __device__ __forceinline__ void done(const Unit&) const {}
};

template <class Epi, class Sched, bool ALIGN_EPI = false, bool SP2 = false>
__device__ __forceinline__ void gemm_phase(PG8_LAS unsigned char* lds, const Gemm g, const Sched& S, const Epi& E, const int tid_in) {
    int tid_l = tid_in; asm volatile("" : "+v"(tid_l));
    const int tid = tid_l, wid = __builtin_amdgcn_readfirstlane(tid >> 6), lane = tid & 63, wr = wid >> 2, wc = wid & 3, fr = lane & 15, fq = lane >> 4;
    const int K = g.K, nt = K / BK, lda = g.lda ? g.lda : K, ldb = lda;
    unsigned voffA[2], voffB[2];
#pragma unroll
    for (int i = 0; i < 2; ++i) { int R, C; stage_rc(tid * 16 + i * 8192, R, C); const int Rb = Epi::PERM ? ((R & ~31) + perm32(R & 31)) : R;
        voffA[i] = (unsigned)(R * lda + C) * 2u; voffB[i] = (unsigned)(Rb * ldb + C) * 2u; }
    const size_t kstep = (size_t)(BK * 2);
    const size_t hstepA = (size_t)HALF * lda * 2, hstepB = (size_t)HALF * ldb * 2;
    const size_t tstepA = 2 * hstepA, tstepB = 2 * hstepB;
    const unsigned ldsw = (unsigned)wid * 1024u;
    const int aoff = lds_byte(wr * 64 + fr, fq * 8), boff = lds_byte(wc * 32 + fr, fq * 8);
#define PG8_SA(b, h) (((b) * 2 + (h)) * HTB)
#define PG8_SB(b, h) ((4 + (b) * 2 + (h)) * HTB)
#define PG8_STAGE(bufoff, gbase, voff) do { _Pragma("unroll") for (int _i = 0; _i < 2; ++_i) \
        __builtin_amdgcn_global_load_lds((const unsigned*)((const char*)(gbase) + (voff)[_i]), (PG8_LAS unsigned*)(lds + (bufoff) + ldsw + _i * 8192), 16, 0, 0); } while (0)
#define PG8_LDA(dst, b, h) do { _Pragma("unroll") for (int m = 0; m < 4; ++m) _Pragma("unroll") for (int k = 0; k < 2; ++k) dst[m][k] = *(const PG8_LAS bf16x8*)(lds + PG8_SA(b, h) + aoff + m * 2048 + k * 1024); } while (0)
#define PG8_LDB(dst, b, h) do { _Pragma("unroll") for (int n = 0; n < 2; ++n) _Pragma("unroll") for (int k = 0; k < 2; ++k) dst[n][k] = *(const PG8_LAS bf16x8*)(lds + PG8_SB(b, h) + boff + n * 2048 + k * 1024); } while (0)
#define PG8_MMA(ai, bj, At, Bt) do { __builtin_amdgcn_s_setprio(1); _Pragma("unroll") for (int m = 0; m < 4; ++m) _Pragma("unroll") for (int n = 0; n < 2; ++n) _Pragma("unroll") for (int k = 0; k < 2; ++k) \
        acc[ai][bj][m][n] = __builtin_amdgcn_mfma_f32_16x16x32_bf16(Bt[n][k], At[m][k], acc[ai][bj][m][n], 0, 0, 0); __builtin_amdgcn_s_setprio(0); } while (0)
#define PG8_WAIT_V(n) asm volatile("s_waitcnt vmcnt(" #n ")" ::: "memory")
#define PG8_WAIT_L(n) asm volatile("s_waitcnt lgkmcnt(" #n ")" ::: "memory")
#define PG8_BAR __builtin_amdgcn_s_barrier()
#define PG8_SCHED __builtin_amdgcn_sched_barrier(0)
    Unit cur, nxt; int ui = 0;
    if (!S.next(0, cur)) return;
    f32x4 acc[2][2][4][2];
#pragma unroll
    for (int a = 0; a < 2; ++a)
#pragma unroll
        for (int b = 0; b < 2; ++b)
#pragma unroll
            for (int m = 0; m < 4; ++m)
#pragma unroll
                for (int n = 0; n < 2; ++n) acc[a][b][m][n] = (f32x4){0.f, 0.f, 0.f, 0.f};
    bf16x8 At[4][2], B0[2][2], B1[2][2];
    const char* cA = (const char*)g.A + (size_t)cur.pm * tstepA + (size_t)cur.k0 * 2; const char* cB = (const char*)g.Bt + (size_t)cur.pn * tstepB + (size_t)cur.k0 * 2;
    S.a_ready(cur);
    if constexpr (SP2) {
        PG8_STAGE(PG8_SB(0, 0), cB, voffB); PG8_STAGE(PG8_SB(0, 1), cB + hstepB, voffB); PG8_STAGE(PG8_SA(0, 0), cA, voffA); PG8_STAGE(PG8_SA(0, 1), cA + hstepA, voffA);
        if (wr == 1) PG8_BAR;
        PG8_WAIT_V(2); PG8_BAR;
        PG8_STAGE(PG8_SB(1, 0), cB + kstep, voffB); PG8_STAGE(PG8_SA(1, 0), cA + kstep, voffA); PG8_STAGE(PG8_SB(1, 1), cB + hstepB + kstep, voffB);
        PG8_WAIT_V(6); PG8_BAR;
    } else {
        PG8_STAGE(PG8_SB(0, 0), cB, voffB); PG8_STAGE(PG8_SA(0, 0), cA, voffA); PG8_STAGE(PG8_SB(0, 1), cB + hstepB, voffB); PG8_STAGE(PG8_SA(0, 1), cA + hstepA, voffA);
        if (wr == 1) PG8_BAR;
        PG8_WAIT_V(4); PG8_BAR;
        PG8_STAGE(PG8_SB(1, 0), cB + kstep, voffB); PG8_STAGE(PG8_SA(1, 0), cA + kstep, voffA); PG8_STAGE(PG8_SB(1, 1), cB + hstepB + kstep, voffB);
        PG8_WAIT_V(6); PG8_BAR;
    }
    for (;;) {
        const bool has_next = S.next(ui + 1, nxt);
        const char* nA = has_next ? (const char*)g.A + (size_t)nxt.pm * tstepA + (size_t)nxt.k0 * 2 : cA; const char* nB = has_next ? (const char*)g.Bt + (size_t)nxt.pn * tstepB + (size_t)nxt.k0 * 2 : cB;
        for (int t = 0; t < nt; t += 2) {
            const bool last = (t == nt - 2);
            const char* a1 = cA + (size_t)(t + 1) * kstep;
            const char* a2 = last ? nA : cA + (size_t)(t + 2) * kstep; const char* b2 = last ? nB : cB + (size_t)(t + 2) * kstep;
            const char* a3 = a2 + kstep; const char* b3 = b2 + kstep;
            if (last && has_next) S.a_ready(nxt);
            if constexpr (SP2) {
            PG8_LDB(B0, 0, 0); PG8_LDB(B1, 0, 1); PG8_SCHED; PG8_LDA(At, 0, 0); PG8_STAGE(PG8_SA(1, 1), a1 + hstepA, voffA);
            PG8_WAIT_V(8); PG8_WAIT_L(0); PG8_BAR; PG8_MMA(0, 0, At, B0); PG8_MMA(0, 1, At, B1); PG8_BAR; PG8_SCHED;
            PG8_LDA(At, 0, 1); PG8_STAGE(PG8_SB(0, 0), b2, voffB); PG8_STAGE(PG8_SB(0, 1), b2 + hstepB, voffB); PG8_STAGE(PG8_SA(0, 0), a2, voffA);
            PG8_WAIT_V(8); PG8_WAIT_L(0); PG8_BAR; PG8_MMA(1, 0, At, B0); PG8_MMA(1, 1, At, B1); PG8_BAR; PG8_SCHED;
            PG8_LDB(B0, 1, 0); PG8_LDB(B1, 1, 1); PG8_SCHED; PG8_LDA(At, 1, 0); PG8_STAGE(PG8_SA(0, 1), a2 + hstepA, voffA);
            PG8_WAIT_V(8); PG8_WAIT_L(0); PG8_BAR; PG8_MMA(0, 0, At, B0); PG8_MMA(0, 1, At, B1); PG8_BAR; PG8_SCHED;
            PG8_LDA(At, 1, 1); PG8_STAGE(PG8_SB(1, 0), b3, voffB); PG8_STAGE(PG8_SB(1, 1), b3 + hstepB, voffB); PG8_STAGE(PG8_SA(1, 0), a3, voffA);
            PG8_WAIT_V(8); PG8_WAIT_L(0); PG8_BAR; PG8_MMA(1, 0, At, B0); PG8_MMA(1, 1, At, B1); PG8_BAR; PG8_SCHED;
            } else {
            PG8_LDB(B0, 0, 0); PG8_SCHED; PG8_LDA(At, 0, 0); PG8_STAGE(PG8_SA(1, 1), a1 + hstepA, voffA);
            PG8_WAIT_L(8); PG8_BAR; PG8_WAIT_L(0); PG8_MMA(0, 0, At, B0); PG8_BAR; PG8_SCHED;
            PG8_LDB(B1, 0, 1); PG8_STAGE(PG8_SB(0, 0), b2, voffB);
            PG8_BAR; PG8_WAIT_L(0); PG8_MMA(0, 1, At, B1); PG8_BAR;
            PG8_LDA(At, 0, 1); PG8_STAGE(PG8_SA(0, 0), a2, voffA);
            PG8_BAR; PG8_WAIT_L(0); PG8_MMA(1, 0, At, B0); PG8_BAR; PG8_SCHED;
            PG8_STAGE(PG8_SB(0, 1), b2 + hstepB, voffB);
            PG8_WAIT_V(6); PG8_BAR; PG8_MMA(1, 1, At, B1); PG8_BAR;
            PG8_LDB(B0, 1, 0); PG8_SCHED; PG8_LDA(At, 1, 0); PG8_STAGE(PG8_SA(0, 1), a2 + hstepA, voffA);
            PG8_WAIT_L(8); PG8_BAR; PG8_WAIT_L(0); PG8_MMA(0, 0, At, B0); PG8_BAR; PG8_SCHED;
            PG8_LDB(B1, 1, 1); PG8_STAGE(PG8_SB(1, 0), b3, voffB);
            PG8_BAR; PG8_WAIT_L(0); PG8_MMA(0, 1, At, B1); PG8_BAR;
            PG8_LDA(At, 1, 1); PG8_STAGE(PG8_SA(1, 0), a3, voffA);
            PG8_BAR; PG8_WAIT_L(0); PG8_MMA(1, 0, At, B0); PG8_BAR; PG8_SCHED;
            PG8_STAGE(PG8_SB(1, 1), b3 + hstepB, voffB);
            PG8_WAIT_V(6); PG8_BAR; PG8_MMA(1, 1, At, B1); PG8_BAR;
            }
        }
        if constexpr (ALIGN_EPI) { if (wr == 0) PG8_BAR; }
        if constexpr (!Epi::AFTER_DRAIN) { E(acc, cur, wr, wc, fr, fq); S.done(cur); }
        if (!has_next) break;
#pragma unroll
        for (int a = 0; a < 2; ++a)
#pragma unroll
            for (int b = 0; b < 2; ++b)
#pragma unroll
                for (int m = 0; m < 4; ++m)
#pragma unroll
                    for (int n = 0; n < 2; ++n) acc[a][b][m][n] = (f32x4){0.f, 0.f, 0.f, 0.f};
        cur = nxt; cA = nA; cB = nB; ++ui;
        if constexpr (ALIGN_EPI) { if (wr == 1) PG8_BAR; }
    }
    PG8_WAIT_V(0);
    if constexpr (!ALIGN_EPI) { if (wr == 0) PG8_BAR; }
    PG8_BAR;
    if constexpr (Epi::AFTER_DRAIN) { E.fused(acc, cur, wr, wc, fr, fq, lds, wid, lane); S.done(cur); }
#undef PG8_SA
#undef PG8_SB
#undef PG8_STAGE
#undef PG8_LDA
#undef PG8_LDB
#undef PG8_MMA
#undef PG8_WAIT_V
#undef PG8_WAIT_L
#undef PG8_BAR
#undef PG8_SCHED
}
}

#define LAS __attribute__((address_space(3)))
#define DI __device__ __forceinline__
typedef unsigned short bf16_t;
typedef short bf16x8 __attribute__((ext_vector_type(8)));
typedef short s16x4 __attribute__((ext_vector_type(4)));
typedef float f32x4 __attribute__((ext_vector_type(4)));
typedef float f32x16 __attribute__((ext_vector_type(16)));
typedef unsigned u32x4 __attribute__((ext_vector_type(4)));
typedef unsigned u32x2 __attribute__((ext_vector_type(2)));
using pg8::cvt_pk_bf16; using pg8::sigm; using pg8::ld_bf4; using pg8::st_bf4; using pg8::batch_of;
using namespace cfg;

DI float bf2f(bf16_t b) { return __uint_as_float((unsigned)b << 16); }
DI unsigned f2bf(float f) { unsigned u = __float_as_uint(f); return (u + 0x7fffu + ((u >> 16) & 1u)) >> 16; }
DI float wave_sum(float v, int lane) {
#pragma unroll
    for (int o = 1; o < 64; o <<= 1) v += shx(v, o, lane);
    return v;
}
DI float wave_max(float v, int lane) {
#pragma unroll
    for (int o = 1; o < 64; o <<= 1) v = fmaxf(v, shx(v, o, lane));
    return v;
}
DI bf16x8 pack8(const f32x4 a, const f32x4 b) { u32x4 p; p.x = cvt_pk_bf16(a[0], a[1]); p.y = cvt_pk_bf16(a[2], a[3]); p.z = cvt_pk_bf16(b[0], b[1]); p.w = cvt_pk_bf16(b[2], b[3]); return __builtin_bit_cast(bf16x8, p); }
#define MFMA16(a, b, c) __builtin_amdgcn_mfma_f32_16x16x32_bf16((a), (b), (c), 0, 0, 0)
#define MFMA32(a, b, c) __builtin_amdgcn_mfma_f32_32x32x16_bf16((a), (b), (c), 0, 0, 0)

#define XB_TMO      128
#define XB_XCNT(j)  (256  + 64 * (j))
#define XB_XSUB(j)  (1280 + 64 * (j))
#define XB_XGEN(j)  (2304 + 64 * (j))
#define XB_TOP      3328
#define XB_TOPGEN   3392
#define XCD_BAR_WORDS 3456
#define XB_SPIN_CAP (1u << 18)

__device__ __forceinline__ unsigned xb_ld(unsigned* p)              { return __hip_atomic_load(p, __ATOMIC_RELAXED, __HIP_MEMORY_SCOPE_AGENT); }
__device__ __forceinline__ unsigned xb_add(unsigned* p, unsigned v) { return __hip_atomic_fetch_add(p, v, __ATOMIC_RELAXED, __HIP_MEMORY_SCOPE_AGENT); }
__device__ __forceinline__ unsigned xb_xcc_id() { return (unsigned)__builtin_amdgcn_s_getreg((3 << 11) | 20) & 0xFu; }
#define XB_SPIN(cond, bar) do { unsigned _sp = 0; while (cond) { __builtin_amdgcn_s_sleep(1); \
    if ((++_sp & 255u) == 0u) { if (xb_ld(&(bar)[XB_TMO])) break; if (_sp > XB_SPIN_CAP) { atomicAdd(&(bar)[XB_TMO], 1u); break; } } } } while (0)

struct XcdBarrier {
    unsigned* bar; unsigned x;
    volatile LAS unsigned* st;
};

__device__ __forceinline__ XcdBarrier xcd_barrier_post(unsigned* bar, volatile LAS unsigned* st) {
    XcdBarrier b; b.bar = bar; b.x = xb_xcc_id(); b.st = st;
    if (threadIdx.x == 0) (void)xb_add(&bar[XB_XCNT(b.x)], 1u);
    return b;
}
__device__ __forceinline__ void xcd_barrier_complete(unsigned* bar, unsigned x, unsigned& nloc, unsigned& nx) {
    const unsigned G = gridDim.x * gridDim.y * gridDim.z;
    unsigned sum, cnt, mine, sp = 0u;
    for (;;) {
        sum = 0u; cnt = 0u; mine = 0u;
#pragma unroll
        for (unsigned j = 0; j < 16; ++j) { const unsigned c = xb_ld(&bar[XB_XCNT(j)]); sum += c; cnt += (c > 0u) ? 1u : 0u; mine = (j == x) ? c : mine; }
        if (sum == G) break;
        __builtin_amdgcn_s_sleep(1);
        if ((++sp & 255u) == 0u) { if (xb_ld(&bar[XB_TMO])) break; if (sp > XB_SPIN_CAP) { atomicAdd(&bar[XB_TMO], 1u); break; } }
    }
    nloc = mine > 0u ? mine : 1u; nx = cnt > 0u ? cnt : 1u;
}

__device__ __forceinline__ void xcd_barrier(const XcdBarrier& b) {
    asm volatile("s_waitcnt vmcnt(0)" ::: "memory");
    __syncthreads();
    if (threadIdx.x == 0) {
        unsigned* bar = b.bar;
        __builtin_amdgcn_s_waitcnt(0);
        unsigned nloc = b.st[0], nx = b.st[1];
        if (nloc == 0u) { xcd_barrier_complete(bar, b.x, nloc, nx); b.st[0] = nloc; b.st[1] = nx; }
        const unsigned old = xb_add(&bar[XB_XSUB(b.x)], 1u);
        const unsigned gen = old / nloc;
        if (old + 1u == (gen + 1u) * nloc) {
            __builtin_amdgcn_fence(__ATOMIC_RELEASE, "agent");
            asm volatile("s_waitcnt vmcnt(0)" ::: "memory");
            const unsigned og = xb_add(&bar[XB_TOP], 1u);
            const unsigned tg = og / nx;
            if (og + 1u == (tg + 1u) * nx) xb_add(&bar[XB_TOPGEN], 1u);
            else XB_SPIN(xb_ld(&bar[XB_TOPGEN]) == tg, bar);
            __builtin_amdgcn_fence(__ATOMIC_ACQUIRE, "agent");
            xb_add(&bar[XB_XGEN(b.x)], 1u);
            asm volatile("s_waitcnt vmcnt(0)" ::: "memory");
        } else {
            XB_SPIN(xb_ld(&bar[XB_XGEN(b.x)]) == gen, bar);
            __builtin_amdgcn_fence(__ATOMIC_ACQUIRE, "agent");
            asm volatile("s_waitcnt vmcnt(0)" ::: "memory");
        }
    }
    __syncthreads();
}

#ifndef MIXM
#define MIXM 0
#endif
#ifndef SYNC2
#define SYNC2 0
#endif
#ifndef REPM
#define REPM 0
#endif
#ifndef GM
#define GM 0xff
#endif
#ifndef PHM
#define PHM 0xff
#endif
struct Args { const float* in[33]; float* out; unsigned char* ws; unsigned long long rfix[8]; int ph_lo, ph_hi; };
typedef const Args __attribute__((address_space(4)))* ArgsP;

DI void tr_item(const float* W, int K, int N, bf16_t* WT, int k0, int n0, int drow0, LAS float* scr, int lane) {
#pragma unroll 8
    for (int i = 0; i < 32; ++i) { const int kk = 2 * i + (lane >> 5); scr[kk * 33 + (lane & 31)] = W[(size_t)(k0 + kk) * N + n0 + (lane & 31)]; }
    asm volatile("s_waitcnt lgkmcnt(0)" ::: "memory");
    const int c = lane & 7;
#pragma unroll
    for (int j = 0; j < 4; ++j) { const int n = (lane >> 3) + 8 * j; const LAS float* s = scr + (8 * c) * 33 + n;
        u32x4 o; o.x = cvt_pk_bf16(s[0 * 33], s[1 * 33]); o.y = cvt_pk_bf16(s[2 * 33], s[3 * 33]); o.z = cvt_pk_bf16(s[4 * 33], s[5 * 33]); o.w = cvt_pk_bf16(s[6 * 33], s[7 * 33]);
        *(u32x4*)(WT + (size_t)(drow0 + n) * K + k0 + 8 * c) = o; }
    asm volatile("s_waitcnt lgkmcnt(0)" ::: "memory");
}
DI void fold_item(const float* Pw  , const float* Sc  , const float* Wa  , bf16_t* WT  , int k0, int n0, LAS float* scr, int lane) {
    const int g = k0 >> 7, nn = lane & 31, hi = lane >> 5;
    for (int jc = 0; jc < 4; ++jc) {
        float w[32];
#pragma unroll
        for (int jj = 0; jj < 32; ++jj) { const int j = g * 128 + jc * 32 + jj; w[jj] = Sc[j] * Wa[(size_t)j * 1024 + n0 + nn]; }
#pragma unroll 1
        for (int i = 0; i < 32; ++i) { const float* pr = Pw + ((size_t)g * 128 + ((k0 & 127) + 2 * i + hi)) * 128 + jc * 32; float acc = 0.f;
#pragma unroll
            for (int j4 = 0; j4 < 8; ++j4) { const f32x4 p = *(const f32x4*)(pr + 4 * j4);
                acc += p[0] * w[4 * j4] + p[1] * w[4 * j4 + 1] + p[2] * w[4 * j4 + 2] + p[3] * w[4 * j4 + 3]; }
            LAS float* sp = scr + (2 * i + hi) * 33 + nn; if (jc == 0) *sp = acc; else *sp += acc; }
    }
    asm volatile("s_waitcnt lgkmcnt(0)" ::: "memory");
    const int c = lane & 7;
#pragma unroll
    for (int j = 0; j < 4; ++j) { const int n = (lane >> 3) + 8 * j; const LAS float* s = scr + (8 * c) * 33 + n;
        u32x4 o; o.x = cvt_pk_bf16(s[0 * 33], s[1 * 33]); o.y = cvt_pk_bf16(s[2 * 33], s[3 * 33]); o.z = cvt_pk_bf16(s[4 * 33], s[5 * 33]); o.w = cvt_pk_bf16(s[6 * 33], s[7 * 33]);
        *(u32x4*)(WT + (size_t)(n0 + n) * 512 + k0 + 8 * c) = o; }
    asm volatile("s_waitcnt lgkmcnt(0)" ::: "memory");
}
DI void sincos_frac(float f  , float& c, float& s) { s = __builtin_amdgcn_sinf(f); c = __builtin_amdgcn_cosf(f); }

DI void prologue(ArgsP a, LAS unsigned char* lds, int tid) {
    const int lane = tid & 63, wave = tid >> 6;
    const int gw = blockIdx.x * 8 + wave, NGW = gridDim.x * 8;
    const int gt = blockIdx.x * 512 + tid, NT = gridDim.x * 512;
    unsigned char* ws = a->ws;
    LAS float* scr = (LAS float*)(lds + wave * 16384);
    constexpr int I_IN = 16 * 152, I_GLU = 8 * 16, I_BR = 8 * 32, I_OUT = 16 * 32, I_FI = 16 * 176, I_FO = 44 * 32, I_ADA = 16 * 192, I_FOLD = 8 * 32;
    constexpr int PER_L = I_IN + I_GLU + 2 * I_BR + I_OUT + I_FI + I_FO + I_ADA + I_FOLD;
    for (int it = gw; it < PER_L * 4; it += NGW) {
        const int l = it & 3; int r = it >> 2;
        if (r < I_FOLD) { fold_item(a->in[14] + (size_t)l * 4 * 128 * 128, a->in[15] + l * 512, a->in[26] + (size_t)l * 512 * 1024, (bf16_t*)(ws + WS_WBR) + (size_t)l * 3072 * 512, (r >> 5) * 64, (r & 31) * 32, scr, lane); continue; } r -= I_FOLD;
        if (r < I_IN) { const int kb = r / 152, nb = r % 152; tr_item(a->in[13] + (size_t)l * 1024 * IN_COLS, 1024, IN_COLS, (bf16_t*)(ws + WS_WIN) + (size_t)l * IN_COLS * 1024, kb * 64, nb * 32, nb * 32, scr, lane); continue; } r -= I_IN;
        if (r < I_GLU) { const int kb = r / 16, nb = r % 16; tr_item(a->in[25] + (size_t)l * 512 * 512, 512, 512, (bf16_t*)(ws + WS_WGLU) + (size_t)l * 512 * 512, kb * 64, nb * 32, nb * 32, scr, lane); continue; } r -= I_GLU;
        if (r < I_BR) { const int kb = r / 32, nb = r % 32; tr_item(a->in[27] + (size_t)l * 512 * 1024, 512, 1024, (bf16_t*)(ws + WS_WBR) + (size_t)l * 3072 * 512, kb * 64, nb * 32, 1024 + nb * 32, scr, lane); continue; } r -= I_BR;
        if (r < I_BR) { const int kb = r / 32, nb = r % 32; tr_item(a->in[28] + (size_t)l * 512 * 1024, 512, 1024, (bf16_t*)(ws + WS_WBR) + (size_t)l * 3072 * 512, kb * 64, nb * 32, 2048 + nb * 32, scr, lane); continue; } r -= I_BR;
        if (r < I_OUT) { const int kb = r / 32, nb = r % 32; tr_item(a->in[29] + (size_t)l * 1024 * 1024, 1024, 1024, (bf16_t*)(ws + WS_WOUT) + (size_t)l * 1024 * 1024, kb * 64, nb * 32, nb * 32, scr, lane); continue; } r -= I_OUT;
        if (r < I_FI) { const int kb = r / 176, nb = r % 176; const int n0 = nb * 32, half = n0 / DFF, j = n0 - half * DFF;
            tr_item(a->in[30] + (size_t)l * 1024 * 2 * DFF, 1024, 2 * DFF, (bf16_t*)(ws + WS_WFI) + (size_t)l * 2 * DFF * 1024, kb * 64, n0, 256 * (j >> 7) + 128 * half + (j & 127), scr, lane); continue; } r -= I_FI;
        if (r < I_FO) { const int kb = r / 32, nb = r % 32; tr_item(a->in[31] + (size_t)l * DFF * 1024, DFF, 1024, (bf16_t*)(ws + WS_WFO) + (size_t)l * 1024 * DFF, kb * 64, nb * 32, nb * 32, scr, lane); continue; } r -= I_FO;
        { const int kb = r / 192, nb = r % 192; tr_item(a->in[11] + (size_t)l * 1024 * 6144, 1024, 6144, (bf16_t*)(ws + WS_GT), kb * 64, nb * 32, l * 6144 + nb * 32, scr, lane); }
    }
    { bf16_t* CA = (bf16_t*)(ws + WS_CA);
      for (int i = gt; i < 256 * 1024; i += NT) { const int r = i >> 10, c = i & 1023; float v = 0.f;
          if (r < 8) v = a->in[7][r * 1024 + c]; else if (r < NBAT) v = a->in[8][(r - 8) * 1024 + c];
          CA[i] = (bf16_t)f2bf(v * sigm(v)); } }
    { float* rc = (float*)(ws + WS_TAB + TB_ROPEC); float* rs = (float*)(ws + WS_TAB + TB_ROPES);
      for (int i = gt; i < 2052 * 8; i += NT) { const int ti = i >> 3, j = i & 7; const int pos = ti < 2048 ? ti : 8192 + (ti - 2048);
          const unsigned long long fx = (unsigned long long)pos * a->rfix[j];
          float c, s; sincos_frac((float)(unsigned)(fx >> 40) * 5.9604644775390625e-08f, c, s); rc[i] = c; rs[i] = s; } }
    { float* AB = (float*)(ws + WS_TAB + TB_ABAR); float* AB256 = (float*)(ws + WS_TAB + TB_ABAR256); bf16_t* BBF = (bf16_t*)(ws + WS_TAB + TB_BBF);
      for (int i = gt; i < 4 * 32 * 64; i += NT) { const int lg = i >> 6, p = i & 63;
          const float dt = expf(a->in[19][lg]); const float ar = a->in[17][i], ai = a->in[18][i];
          const float x = ar * dt; const float yt = ai * dt * 0.15915494309189535f;
          float c, s; sincos_frac(yt, c, s); float ch, sh; sincos_frac(0.5f * yt, ch, sh);
          const float em1 = x * (1.f + x * (0.5f + x * (0.16666667f + x * (0.041666668f + x * 0.0083333338f))));
          const float ex = 1.f + em1;
          const float abr = ex * c, abi = ex * s;
          const float nr = em1 * c - (sh + sh) * sh, ni = abi;
          const float den = 1.f / (ar * ar + ai * ai);
          const float cr = (nr * ar + ni * ai) * den, ci = (ni * ar - nr * ai) * den;
          AB[2 * i] = abr; AB[2 * i + 1] = abi;
          float pr = abr, pi = abi;
#pragma unroll
          for (int k = 0; k < 8; ++k) { const float t = pr * pr - pi * pi; pi = (pr + pr) * pi; pr = t; }
          AB256[2 * i] = pr; AB256[2 * i + 1] = pi;
          const float* br = a->in[20] + (size_t)i * 16; const float* bi = a->in[21] + (size_t)i * 16;
          const int st = p >> 5;
#pragma unroll
          for (int half = 0; half < 2; ++half) { u32x4 ore, oim; unsigned* pre = (unsigned*)&ore; unsigned* pim = (unsigned*)&oim; (void)pre; (void)pim;
              float vr[8], vi[8];
#pragma unroll
              for (int j = 0; j < 8; ++j) { const float b_r = br[half * 8 + j], b_i = bi[half * 8 + j]; vr[j] = cr * b_r - ci * b_i; vi[j] = cr * b_i + ci * b_r; }
              ore.x = cvt_pk_bf16(vr[0], vr[1]); ore.y = cvt_pk_bf16(vr[2], vr[3]); ore.z = cvt_pk_bf16(vr[4], vr[5]); ore.w = cvt_pk_bf16(vr[6], vr[7]);
              oim.x = cvt_pk_bf16(vi[0], vi[1]); oim.y = cvt_pk_bf16(vi[2], vi[3]); oim.z = cvt_pk_bf16(vi[4], vi[5]); oim.w = cvt_pk_bf16(vi[6], vi[7]);
              *(u32x4*)(BBF + (((size_t)lg * 4 + 0 + st) * 64 + half * 32 + (p & 31)) * 8) = ore;
              *(u32x4*)(BBF + (((size_t)lg * 4 + 2 + st) * 64 + half * 32 + (p & 31)) * 8) = oim; } } }
    { bf16_t* CF = (bf16_t*)(ws + WS_TAB + TB_CF);
      for (int i = gt; i < 4 * 32 * 4 * 64; i += NT) { const int ln = i & 63, ks = (i >> 6) & 3, lg = i >> 8; const int c = ln & 15, quad = ln >> 4;
          float v[8];
#pragma unroll
          for (int j = 0; j < 8; ++j) { const int k = ks * 32 + quad * 8 + j; v[j] = k < 64 ? a->in[22][((size_t)lg * 16 + c) * 64 + k] : -a->in[23][((size_t)lg * 16 + c) * 64 + (k - 64)]; }
          u32x4 o; o.x = cvt_pk_bf16(v[0], v[1]); o.y = cvt_pk_bf16(v[2], v[3]); o.z = cvt_pk_bf16(v[4], v[5]); o.w = cvt_pk_bf16(v[6], v[7]);
          *(u32x4*)(CF + (size_t)i * 8) = o; } }
}

DI void cache_shift(ArgsP a, int gt, int NT) {
    for (int i = gt; i < 4 * 128 * 124 * 32; i += NT) { const int c4 = i & 31, j = (i >> 5) % 124, lb = (i >> 5) / 124;
        *(f32x4*)(a->out + OFF_KS + ((size_t)lb * 128 + j) * 128 + c4 * 4) = *(const f32x4*)(a->in[2] + ((size_t)lb * 128 + j + 4) * 128 + c4 * 4);
        *(f32x4*)(a->out + OFF_VS + ((size_t)lb * 128 + j) * 128 + c4 * 4) = *(const f32x4*)(a->in[3] + ((size_t)lb * 128 + j + 4) * 128 + c4 * 4); }
    for (int i = gt; i < 4 * 128 * 11 * 128; i += NT) { const int c4 = i & 127, j = (i >> 7) % 11, lb = (i >> 7) / 11;
        *(f32x4*)(a->out + OFF_PS + ((size_t)lb * 15 + j) * 512 + c4 * 4) = *(const f32x4*)(a->in[4] + ((size_t)lb * 15 + j + 4) * 512 + c4 * 4); }
}

DI void norm_phase(const float* xp, const float* xs, const float* gvec, const float* MODL  , int sc_off, bf16_t* H, int tid,
                   const float* P, int nparts, const float* pgate, float* X) {
    const int lane = tid & 63, gw = blockIdx.x * 8 + (tid >> 6), NGW = gridDim.x * 8;
    for (int it = gw; it < M; it += NGW) {
        const int row = it < MS ? MP + it : it - MS;
        const int bi = batch_of(row);
        const float* xr = (row < MP ? xp : xs) + (size_t)row * 1024; const float* mr = MODL + (size_t)bi * NMOD;
        f32x4 v[4]; float ss = 0.f;
#pragma unroll
        for (int j = 0; j < 4; ++j) v[j] = *(const f32x4*)(xr + 4 * lane + 256 * j);
        if (row >= MP && nparts > 0) {
            f32x4 s[4];
#pragma unroll
            for (int j = 0; j < 4; ++j) s[j] = (f32x4){0.f, 0.f, 0.f, 0.f};
            for (int p = 0; p < nparts; ++p) { const float* pr = P + ((size_t)p * 512 + (row - MP)) * 1024 + 4 * lane;
#pragma unroll
                for (int j = 0; j < 4; ++j) s[j] += *(const f32x4*)(pr + 256 * j); }
#pragma unroll
            for (int j = 0; j < 4; ++j) { v[j] += *(const f32x4*)(pgate + (size_t)bi * NMOD + 4 * lane + 256 * j) * s[j]; *(f32x4*)(X + (size_t)row * 1024 + 4 * lane + 256 * j) = v[j]; }
        }
#pragma unroll
        for (int j = 0; j < 4; ++j) ss += v[j][0] * v[j][0] + v[j][1] * v[j][1] + v[j][2] * v[j][2] + v[j][3] * v[j][3];
        const float r = rsqrtf(wave_sum(ss, lane) * (1.f / 1024.f) + 1e-6f);
        if (H) {
#pragma unroll
            for (int j = 0; j < 4; ++j) { const int c = 4 * lane + 256 * j; const f32x4 g = *(const f32x4*)(gvec + c), sh = *(const f32x4*)(mr + c), sc = *(const f32x4*)(mr + sc_off + c);
                st_bf4(H + (size_t)row * 1024 + c, v[j] * r * g * (1.f + sc) + sh); }
        } else {
#pragma unroll
            for (int j = 0; j < 4; ++j) { const int c = 4 * lane + 256 * j; *(f32x4*)(X + (size_t)row * 1024 + c) = v[j] * r * *(const f32x4*)(gvec + c); }
        }
    }
}

template <int W>
DI void pool_run(const float* XA, bf16_t* Dm, float* out, int l, int row0, int c4) {
    const int t0 = row0 & 2047;
    f32x4 x[W + 7];
#pragma unroll
    for (int i = 0; i < W + 7; ++i) { const int dt = i - (W - 1); x[i] = (t0 + dt >= 0) ? *(const f32x4*)(XA + (size_t)(row0 + dt) * 512 + c4) : (f32x4){0.f, 0.f, 0.f, 0.f}; }
    f32x4 s = x[0];
#pragma unroll
    for (int i = 1; i < W - 1; ++i) s += x[i];
#pragma unroll
    for (int k = 0; k < 8; ++k) { s += x[W - 1 + k]; const int t = t0 + k; const float cnt = (float)((t + 1 < W) ? t + 1 : W);
        st_bf4(Dm + (size_t)(row0 + k) * 512 + c4, s * (1.f / cnt) - x[W - 1 + k]);
        if (t >= 2033) *(f32x4*)(out + OFF_PP + ((size_t)(l * 8 + (row0 >> 11)) * 15 + (t - 2033)) * 512 + c4) = x[W - 1 + k];
        s -= x[k]; }
}
DI void pool_phase(ArgsP a, int l, const float* XA, bf16_t* Dm, int gt  , int NT  , int lo, int hi  , bool do_sample) {
    constexpr int NRUN = MP / 8;
    for (int item = lo + gt; item < hi; item += NT) {
        const int c4l = item & 31, gr = item >> 5, g = gr / NRUN, run = gr - g * NRUN; const int c4 = g * 128 + c4l * 4, row0 = run * 8;
        if (g == 0) pool_run<2>(XA, Dm, a->out, l, row0, c4); else if (g == 1) pool_run<4>(XA, Dm, a->out, l, row0, c4);
        else if (g == 2) pool_run<8>(XA, Dm, a->out, l, row0, c4); else pool_run<16>(XA, Dm, a->out, l, row0, c4);
    }
    if (do_sample) for (int idx = gt; idx < MS * 128; idx += NT) {
        const int row = MP + (idx >> 7), c4 = (idx & 127) * 4, w = 2 << (c4 >> 7);
        const f32x4 x = *(const f32x4*)(XA + (size_t)row * 512 + c4); f32x4 sum = x;
        const int rs = row - MP, bs = rs >> 2, t = rs & 3;
        for (int s = 1; s < w; ++s) { const int pos = t - s;
            sum += pos >= 0 ? *(const f32x4*)(XA + (size_t)(row - s) * 512 + c4) : *(const f32x4*)(a->in[4] + ((size_t)(l * 128 + bs) * 15 + 15 + pos) * 512 + c4); }
        *(f32x4*)(a->out + OFF_PS + ((size_t)(l * 128 + bs) * 15 + 11 + t) * 512 + c4) = x;
        st_bf4(Dm + (size_t)row * 512 + c4, sum * (1.f / (float)w) - x);
    }
}

DI void attn_prompt_unit(LAS unsigned char* lds, int unit, const bf16_t* Q, const bf16_t* KB, const bf16_t* VB, bf16_t* YB, const float* sinks, int tid) {
    const int b = unit >> 5, g = (unit >> 4) & 1, nb = unit & 15;
    LAS bf16_t* Ks = (LAS bf16_t*)lds;
    LAS bf16_t* Vt = (LAS bf16_t*)(lds + 36864);
    const int krow0 = b * 2048 + (nb - 1) * 128;
#pragma unroll
    for (int it = 0; it < 4; ++it) {
        const int chunk = tid + 512 * it, j = chunk >> 3, c8 = chunk & 7;
        u32x4 kv = {0u, 0u, 0u, 0u}, vv = {0u, 0u, 0u, 0u};
        if (nb > 0 || j >= 128) { const size_t off = (size_t)(krow0 + j) * 128 + g * 64 + c8 * 8; kv = *(const u32x4*)(KB + off); vv = *(const u32x4*)(VB + off); }
        *(LAS u32x4*)(Ks + j * 72 + c8 * 8) = kv;
        LAS bf16_t* vp = Vt + (c8 * 8) * 264 + j;
        vp[0 * 264] = (bf16_t)(vv.x & 0xffffu); vp[1 * 264] = (bf16_t)(vv.x >> 16); vp[2 * 264] = (bf16_t)(vv.y & 0xffffu); vp[3 * 264] = (bf16_t)(vv.y >> 16);
        vp[4 * 264] = (bf16_t)(vv.z & 0xffffu); vp[5 * 264] = (bf16_t)(vv.z >> 16); vp[6 * 264] = (bf16_t)(vv.w & 0xffffu); vp[7 * 264] = (bf16_t)(vv.w >> 16);
    }
    __syncthreads();
    const int wave = tid >> 6, lane = tid & 63, l15 = lane & 15, quad = lane >> 4;
    const int r = wave >> 1, hq = g * 4 + r;
    const float sc2 = 0.125f * 1.4426950408889634f;
    const float sk2 = sinks[hq] * 1.4426950408889634f;
    const int kt0 = wave & 1;
#pragma unroll 1
    for (int qh = 0; qh < 2; ++qh) {
        const int q0 = (wave & 1) * 64 + qh * 32;
        const int qrow0 = b * 2048 + nb * 128 + q0;
        bf16x8 qf[2][2];
#pragma unroll
        for (int qt = 0; qt < 2; ++qt)
#pragma unroll
            for (int ds = 0; ds < 2; ++ds) qf[qt][ds] = *(const bf16x8*)(Q + (size_t)(qrow0 + qt * 16 + l15) * 512 + hq * 64 + ds * 32 + quad * 8);
        float m2[2], ls[2]; f32x4 o[4][2];
#pragma unroll
        for (int qt = 0; qt < 2; ++qt) { m2[qt] = sk2; ls[qt] = quad == 0 ? 1.f : 0.f;
#pragma unroll
            for (int dt = 0; dt < 4; ++dt) o[dt][qt] = (f32x4){0.f, 0.f, 0.f, 0.f}; }
#pragma unroll 1
        for (int kk = 0; kk < 3; ++kk) {
            const int kt = kt0 + kk;
            if (nb == 0 && kt < 2) continue;
            f32x4 s[4][2];
#pragma unroll
            for (int sub = 0; sub < 4; ++sub) { const LAS bf16_t* kp = Ks + (kt * 64 + sub * 16 + l15) * 72 + quad * 8;
                const bf16x8 k0 = *(const LAS bf16x8*)kp, k1 = *(const LAS bf16x8*)(kp + 32);
#pragma unroll
                for (int qt = 0; qt < 2; ++qt) { s[sub][qt] = MFMA16(k0, qf[qt][0], ((f32x4){0.f, 0.f, 0.f, 0.f})); s[sub][qt] = MFMA16(k1, qf[qt][1], s[sub][qt]); } }
#pragma unroll
            for (int qt = 0; qt < 2; ++qt) { const int i = q0 + qt * 16 + l15; float mx = -INFINITY;
#pragma unroll
                for (int sub = 0; sub < 4; ++sub)
#pragma unroll
                    for (int jj = 0; jj < 4; ++jj) { const int j = kt * 64 + sub * 16 + quad * 4 + jj; const bool valid = (j > i) && (j <= i + 128) && (nb > 0 || j >= 128);
                        const float v = valid ? s[sub][qt][jj] * sc2 : -INFINITY; s[sub][qt][jj] = v; mx = fmaxf(mx, v); }
                mx = fmaxf(mx, shx16(mx, quad & 1)); mx = fmaxf(mx, shx32(mx, quad >> 1));
                const float mn = fmaxf(m2[qt], mx), alpha = __builtin_amdgcn_exp2f(m2[qt] - mn); m2[qt] = mn; float sum = 0.f;
#pragma unroll
                for (int sub = 0; sub < 4; ++sub)
#pragma unroll
                    for (int jj = 0; jj < 4; ++jj) { const float p = __builtin_amdgcn_exp2f(s[sub][qt][jj] - mn); s[sub][qt][jj] = p; sum += p; }
                ls[qt] = ls[qt] * alpha + sum;
#pragma unroll
                for (int dt = 0; dt < 4; ++dt) o[dt][qt] *= alpha; }
#pragma unroll
            for (int s2 = 0; s2 < 2; ++s2) { bf16x8 pf[2];
#pragma unroll
                for (int qt = 0; qt < 2; ++qt) pf[qt] = pack8(s[2 * s2][qt], s[2 * s2 + 1][qt]);
#pragma unroll
                for (int dt = 0; dt < 4; ++dt) { const LAS bf16_t* vp = Vt + (dt * 16 + l15) * 264 + kt * 64 + s2 * 32 + quad * 4;
                    const s16x4 v0 = *(const LAS s16x4*)vp, v1 = *(const LAS s16x4*)(vp + 16);
                    const bf16x8 vf = __builtin_shufflevector(v0, v1, 0, 1, 2, 3, 4, 5, 6, 7);
#pragma unroll
                    for (int qt = 0; qt < 2; ++qt) o[dt][qt] = MFMA16(vf, pf[qt], o[dt][qt]); } }
        }
#pragma unroll
        for (int qt = 0; qt < 2; ++qt) { float lt = ls[qt]; lt += shx16(lt, quad & 1); lt += shx32(lt, quad >> 1); const float inv = 1.f / lt;
            bf16_t* yp = YB + (size_t)(qrow0 + qt * 16 + l15) * 512 + hq * 64 + quad * 4;
#pragma unroll
            for (int dt = 0; dt < 4; ++dt) st_bf4(yp + dt * 16, o[dt][qt] * inv); }
    }
    __syncthreads();
}

DI void attn_sample_task(LAS unsigned char* wl, int task, int l, ArgsP a, const bf16_t* Q, bf16_t* YB, int lane) {
    const int b = task >> 3, h = task & 7, g = h >> 2;
    LAS float* qs = (LAS float*)wl;
    LAS float* ps = qs + 256;
#pragma unroll
    for (int t = 0; t < 4; ++t) qs[t * 64 + lane] = bf2f(Q[(size_t)(MP + b * 4 + t) * 512 + h * 64 + lane]);
    const float* ck = a->in[2] + (size_t)(l * 128 + b) * 128 * 128 + g * 64;
    const float* cv = a->in[3] + (size_t)(l * 128 + b) * 128 * 128 + g * 64;
    const float* nk = a->out + OFF_KS + ((size_t)(l * 128 + b) * 128 + 124) * 128 + g * 64;
    const float* nv = a->out + OFF_VS + ((size_t)(l * 128 + b) * 128 + 124) * 128 + g * 64;
    const float sink = a->in[16][l * 8 + h];
    float mx[4] = {sink, sink, sink, sink};
    for (int rr = 0; rr < 3; ++rr) { const int j = rr * 64 + lane; float s[4] = {0.f, 0.f, 0.f, 0.f};
        if (j < 132) { const float* kp = j < 128 ? ck + (size_t)j * 128 : nk + (size_t)(j - 128) * 128;
#pragma unroll 4
            for (int d4 = 0; d4 < 16; ++d4) { const f32x4 k4 = *(const f32x4*)(kp + 4 * d4);
#pragma unroll
                for (int t = 0; t < 4; ++t) { const f32x4 q4 = *(const LAS f32x4*)(qs + t * 64 + 4 * d4); s[t] += k4[0] * q4[0] + k4[1] * q4[1] + k4[2] * q4[2] + k4[3] * q4[3]; } } }
#pragma unroll
        for (int t = 0; t < 4; ++t) { const bool valid = (j < 132) && (j >= t + 1) && (j <= t + 128); const float v = valid ? s[t] * 0.125f : -INFINITY;
            if (j < 136) ps[t * 136 + j] = v; mx[t] = fmaxf(mx[t], v); } }
    float den[4];
#pragma unroll
    for (int t = 0; t < 4; ++t) { mx[t] = wave_max(mx[t], lane); float sum = 0.f;
        for (int rr = 0; rr < 3; ++rr) { const int j = rr * 64 + lane; if (j < 132) { const float p = __expf(ps[t * 136 + j] - mx[t]); ps[t * 136 + j] = p; sum += p; } }
        den[t] = wave_sum(sum, lane) + __expf(sink - mx[t]); }
    float o[4] = {0.f, 0.f, 0.f, 0.f};
    for (int j = 0; j < 132; ++j) { const float v = (j < 128 ? cv + (size_t)j * 128 : nv + (size_t)(j - 128) * 128)[lane];
#pragma unroll
        for (int t = 0; t < 4; ++t) o[t] += ps[t * 136 + j] * v; }
#pragma unroll
    for (int t = 0; t < 4; ++t) YB[(size_t)(MP + b * 4 + t) * 512 + h * 64 + lane] = (bf16_t)f2bf(o[t] / den[t]);
}

struct S5C { bf16x8 bbf[4]; bf16x8 cf[4]; float are[2], aim[2]; };
DI float gelu_tanh(float y) { const float z = 1.5957691216057308f * (y + 0.044715f * y * y * y); return y * sigm(z); }
template <bool OUT>
DI void s5_tile(const S5C& K, const float* U, int row0, int g, int nruns, int nvalid, float (&hre)[2], float (&him)[2], LAS bf16_t* Hs, const float* dvec, bf16_t* YC0, int lane) {
    const int tok = lane & 31, half = lane >> 5;
    bf16x8 af = {0, 0, 0, 0, 0, 0, 0, 0};
    if (tok < nvalid) { const float* up = U + (size_t)(row0 + tok) * 512 + g * 16 + half * 8; af = pack8(*(const f32x4*)up, *(const f32x4*)(up + 4)); }
    f32x16 z16;
#pragma unroll
    for (int i = 0; i < 16; ++i) z16[i] = 0.f;
    f32x16 dre[2], dim[2];
#pragma unroll
    for (int st = 0; st < 2; ++st) { dre[st] = MFMA32(af, K.bbf[st], z16); dim[st] = MFMA32(af, K.bbf[2 + st], z16); }
#pragma unroll
    for (int r = 0; r < 8; ++r) {
        if (r < nruns) {
            const int hf = r & 1, i0 = 4 * (r >> 1);
            if (half == hf) {
#pragma unroll
                for (int k = 0; k < 4; ++k)
#pragma unroll
                    for (int st = 0; st < 2; ++st) { const float nr = K.are[st] * hre[st] - K.aim[st] * him[st] + dre[st][i0 + k]; const float ni = K.are[st] * him[st] + K.aim[st] * hre[st] + dim[st][i0 + k];
                        hre[st] = nr; him[st] = ni; dre[st][i0 + k] = nr; dim[st][i0 + k] = ni; }
            }
#pragma unroll
            for (int st = 0; st < 2; ++st) { const float pr = __shfl_xor(hre[st], 32), pi = __shfl_xor(him[st], 32); if (half != hf) { hre[st] = pr; him[st] = pi; } }
        }
    }
    if (OUT) {
#pragma unroll
        for (int i = 0; i < 16; ++i) { const int tr = (i & 3) + 8 * (i >> 2) + 4 * half; LAS bf16_t* hp = Hs + tr * 136 + tok;
#pragma unroll
            for (int st = 0; st < 2; ++st) { hp[st * 32] = (bf16_t)f2bf(dre[st][i]); hp[64 + st * 32] = (bf16_t)f2bf(dim[st][i]); } }
        const int l15 = lane & 15, quad = lane >> 4;
#pragma unroll
        for (int tt = 0; tt < 2; ++tt) {
            if (tt * 16 < nvalid) {
                f32x4 acc = {0.f, 0.f, 0.f, 0.f};
#pragma unroll
                for (int ks = 0; ks < 4; ++ks) { const bf16x8 hf8 = *(const LAS bf16x8*)(Hs + (tt * 16 + l15) * 136 + ks * 32 + quad * 8); acc = MFMA16(K.cf[ks], hf8, acc); }
                const int tk = tt * 16 + l15;
                if (tk < nvalid) { const size_t ro = (size_t)(row0 + tk) * 512 + g * 16 + quad * 4;
                    const f32x4 u4 = *(const f32x4*)(U + ro), d4 = *(const f32x4*)(dvec + quad * 4); f32x4 y = acc + d4 * u4;
                    y[0] = gelu_tanh(y[0]); y[1] = gelu_tanh(y[1]); y[2] = gelu_tanh(y[2]); y[3] = gelu_tanh(y[3]);
                    st_bf4(YC0 + ro, y); }
            }
        }
    }
}
DI void s5_load_consts(S5C& K, const unsigned char* ws, int lg, int lane) {
    const bf16_t* BBF = (const bf16_t*)(ws + WS_TAB + TB_BBF); const bf16_t* CF = (const bf16_t*)(ws + WS_TAB + TB_CF); const float* AB = (const float*)(ws + WS_TAB + TB_ABAR);
#pragma unroll
    for (int t = 0; t < 4; ++t) { K.bbf[t] = *(const bf16x8*)(BBF + (((size_t)lg * 4 + t) * 64 + lane) * 8); K.cf[t] = *(const bf16x8*)(CF + (((size_t)lg * 4 + t) * 64 + lane) * 8); }
#pragma unroll
    for (int st = 0; st < 2; ++st) { const int p = st * 32 + (lane & 31); K.are[st] = AB[((size_t)lg * 64 + p) * 2]; K.aim[st] = AB[((size_t)lg * 64 + p) * 2 + 1]; }
}
DI void s5_prompt_task(LAS unsigned char* lds, int task, int l, ArgsP a, const float* U, bf16_t* YC0, int tid) {
    const int b = task >> 5, g = task & 31, lg = l * 32 + g, wave = tid >> 6, lane = tid & 63;
    LAS bf16_t* Hs = (LAS bf16_t*)(lds + wave * 8704);
    LAS float* Es = (LAS float*)(lds + 8 * 8704);
    S5C K; s5_load_consts(K, a->ws, lg, lane);
    const float* dvec = a->in[24] + l * 512 + g * 16;
    const int rowb = b * 2048 + wave * 256;
    float hre[2] = {0.f, 0.f}, him[2] = {0.f, 0.f};
    for (int tl = 0; tl < 8; ++tl) s5_tile<false>(K, U, rowb + tl * 32, g, 8, 32, hre, him, Hs, dvec, YC0, lane);
    if (lane < 32) { Es[(wave * 4 + 0) * 32 + lane] = hre[0]; Es[(wave * 4 + 1) * 32 + lane] = hre[1]; Es[(wave * 4 + 2) * 32 + lane] = him[0]; Es[(wave * 4 + 3) * 32 + lane] = him[1]; }
    __syncthreads();
    { const float* A256 = (const float*)(a->ws + WS_TAB + TB_ABAR256); float pr[2], pi[2];
#pragma unroll
      for (int st = 0; st < 2; ++st) { const int p = st * 32 + (lane & 31); pr[st] = A256[((size_t)lg * 64 + p) * 2]; pi[st] = A256[((size_t)lg * 64 + p) * 2 + 1]; hre[st] = 0.f; him[st] = 0.f; }
      for (int w = 0; w < wave; ++w) {
#pragma unroll
          for (int st = 0; st < 2; ++st) { const float er = Es[(w * 4 + st) * 32 + (lane & 31)], ei = Es[(w * 4 + 2 + st) * 32 + (lane & 31)];
              const float nr = pr[st] * hre[st] - pi[st] * him[st] + er, ni = pr[st] * him[st] + pi[st] * hre[st] + ei; hre[st] = nr; him[st] = ni; } } }
    for (int tl = 0; tl < 8; ++tl) s5_tile<true>(K, U, rowb + tl * 32, g, 8, 32, hre, him, Hs, dvec, YC0, lane);
    if (wave == 7 && lane < 32) {
#pragma unroll
        for (int st = 0; st < 2; ++st) { a->out[OFF_SRP + ((size_t)(l * 8 + b) * 32 + g) * 64 + st * 32 + lane] = hre[st]; a->out[OFF_SIP + ((size_t)(l * 8 + b) * 32 + g) * 64 + st * 32 + lane] = him[st]; } }
    __syncthreads();
}
DI void s5_sample_task(LAS unsigned char* lds, int task, int l, ArgsP a, const float* U, bf16_t* YC0, int tid) {
    const int bs = task >> 5, g = task & 31, lg = l * 32 + g, wave = tid >> 6, lane = tid & 63;
    LAS bf16_t* Hs = (LAS bf16_t*)(lds + wave * 8704);
    S5C K; s5_load_consts(K, a->ws, lg, lane);
    const size_t so = ((size_t)(l * 128 + bs) * 32 + g) * 64;
    float hre[2], him[2];
#pragma unroll
    for (int st = 0; st < 2; ++st) { hre[st] = a->in[5][so + st * 32 + (lane & 31)]; him[st] = a->in[6][so + st * 32 + (lane & 31)]; }
    s5_tile<true>(K, U, MP + bs * 4, g, 1, 4, hre, him, Hs, a->in[24] + l * 512 + g * 16, YC0, lane);
    if (lane < 32) {
#pragma unroll
        for (int st = 0; st < 2; ++st) { a->out[OFF_SRS + so + st * 32 + lane] = hre[st]; a->out[OFF_SIS + so + st * 32 + lane] = him[st]; } }
}

DI void mixers_phase(ArgsP a, LAS unsigned char* lds, int l, int tid) {
    unsigned char* ws = a->ws;
    const float* XA = (const float*)(ws + WS_XA); const float* U = (const float*)(ws + WS_U);
    const bf16_t* Q = (const bf16_t*)(ws + WS_Q); const bf16_t* KB = (const bf16_t*)(ws + WS_K); const bf16_t* VB = (const bf16_t*)(ws + WS_V);
    bf16_t* Dm = (bf16_t*)(ws + WS_DYY); bf16_t* YB = Dm + (size_t)M * 512; bf16_t* YC0 = (bf16_t*)(ws + WS_YC0);
    const int wave = tid >> 6, lane = tid & 63, gw = blockIdx.x * 8 + wave, NGW = gridDim.x * 8;
    const int vcb = (gridDim.x % 8 == 0) ? (blockIdx.x % 8) * (gridDim.x / 8) + blockIdx.x / 8 : blockIdx.x;
    for (int rp = 0; rp < 1 + ((MIXM >> 0) & 1); ++rp) for (int u = vcb; u < 256; u += gridDim.x) attn_prompt_unit(lds, u, Q, KB, VB, YB, a->in[16] + l * 8, tid);
    for (int rp = 0; rp < 1 + ((MIXM >> 1) & 1); ++rp) for (int t = vcb; t < 256; t += gridDim.x) s5_prompt_task(lds, t, l, a, U, YC0, tid);
    for (int rp = 0; rp < 1 + ((MIXM >> 2) & 1); ++rp) for (int t = gw; t < 4096; t += NGW) s5_sample_task(lds, t, l, a, U, YC0, tid);
    __syncthreads();
    for (int rp = 0; rp < 1 + ((MIXM >> 3) & 1); ++rp) for (int t = gw; t < 1024; t += NGW) attn_sample_task(lds + wave * 4096, t, l, a, Q, YB, lane);
}

__global__ void __launch_bounds__(512, 2) mega(Args a_unused) {
    extern __shared__ __attribute__((aligned(16))) unsigned char lds_raw[];
    LAS unsigned char* lds = (LAS unsigned char*)lds_raw;
    cg::grid_group grid = cg::this_grid();
    const int wave_s = __builtin_amdgcn_readfirstlane((int)threadIdx.x >> 6);
    volatile LAS unsigned* bst = (volatile LAS unsigned*)(lds + 135168);
    if (threadIdx.x < 2) bst[threadIdx.x] = 0u;
    __syncthreads();
    XcdBarrier xbar = xcd_barrier_post((unsigned*)(((ArgsP)__builtin_amdgcn_kernarg_segment_ptr())->ws), bst);
    const int ph_lo = ((ArgsP)__builtin_amdgcn_kernarg_segment_ptr())->ph_lo, ph_hi = ((ArgsP)__builtin_amdgcn_kernarg_segment_ptr())->ph_hi;
    for (int ph = ph_lo; ph < ph_hi; ++ph) {
        const int kk9 = (ph - 2) % 9;
        const int cls = ph == 0 ? 0 : ph == 1 ? 1 : ph == NPHASE - 1 ? 10 : (kk9 == 0 || kk9 == 6) ? 2 : kk9 == 1 ? 3 : kk9 == 2 ? 4 : kk9 == 3 ? 5 : kk9 == 4 ? 6 : kk9 == 5 ? 7 : kk9 == 7 ? 8 : 9;
        const int nrep = 1 + ((REPM >> cls) & 1);
        for (int rep = 0; rep < nrep; ++rep) {
        ArgsP a = (ArgsP)__builtin_amdgcn_kernarg_segment_ptr(); asm volatile("" : "+s"(a));
        int G = gridDim.x, c = blockIdx.x; asm volatile("" : "+s"(G), "+s"(c));
        int tid = wave_s * 64 + lane_id_v(); asm volatile("" : "+v"(tid));
        unsigned char* ws = a->ws;
        float* X = a->out;
        float* MOD = (float*)(ws + WS_MOD);
        bf16_t* H = (bf16_t*)(ws + WS_H);
        if (ph == 0) { if (PHM & 1) prologue(a, lds, tid); }
        else if (ph == 1) { if (PHM & 4) {
            pg8::Gemm g{(const bf16_t*)(ws + WS_CA), (const bf16_t*)(ws + WS_GT), 256, NMOD, 1024}; pg8::StaticOrder S; S.init(256, NMOD, G, c);
            pg8::EpiMod E{MOD, a->in[12]};
            pg8::gemm_phase<pg8::EpiMod, pg8::StaticOrder, true, true>(lds, g, S, E, wave_s * 64 + lane_id_v());
            { const int t_ = wave_s * 64 + lane_id_v(); if (G > 96) { if (c >= 96) cache_shift(a, (c - 96) * 512 + t_, (G - 96) * 512); } else cache_shift(a, c * 512 + t_, G * 512); } }
        } else if (ph == NPHASE - 1) norm_phase(X, X, a->in[32], MOD, 0, nullptr, tid, (const float*)(ws + WS_DYY), 22, MOD + 3 * 6144 + 5120, X);
        else {
            const int l = (ph - 2) / 9, k = (ph - 2) % 9;
            const float* xp = l == 0 ? a->in[0] : X; const float* xs = l == 0 ? a->in[1] - (size_t)MP * 1024 : X;
            if (k == 0) norm_phase(xp, xs, a->in[9] + l * 1024, MOD + l * 6144, 1024, H, tid, (const float*)(ws + WS_DYY), l == 0 ? 0 : 22, MOD + (l - 1) * 6144 + 5120, X);
            else if (k == 1) { if (GM & 1) {
                pg8::Gemm g{H, (const bf16_t*)(ws + WS_WIN) + (size_t)l * IN_COLS * 1024, M, IN_COLS, 1024}; pg8::StaticOrder S; S.init(M, IN_COLS, G, c);
                pg8::EpiIn E{(float*)(ws + WS_XA), (float*)(ws + WS_U), (bf16_t*)(ws + WS_Q), (bf16_t*)(ws + WS_K), (bf16_t*)(ws + WS_V), (bf16_t*)(ws + WS_GT),
                             (const float*)(ws + WS_TAB + TB_ROPEC), (const float*)(ws + WS_TAB + TB_ROPES), a->out, l};
                pg8::gemm_phase<pg8::EpiIn, pg8::StaticOrder, true, true>(lds, g, S, E, wave_s * 64 + lane_id_v()); }
            } else if (k == 2) { if (PHM & 2) mixers_phase(a, lds, l, tid); }
            else if (k == 3) { if (GM & 2) {
                pg8::Gemm g{(const bf16_t*)(ws + WS_YC0), (const bf16_t*)(ws + WS_WGLU) + (size_t)l * 512 * 512, M, 512, 512}; pg8::StaticOrder S; S.init(M, 512, G, c);
                pg8::EpiGlu E{(const bf16_t*)(ws + WS_YC0), (bf16_t*)(ws + WS_DYY) + (size_t)2 * M * 512};
                pg8::gemm_phase<pg8::EpiGlu, pg8::StaticOrder, true, true>(lds, g, S, E, wave_s * 64 + lane_id_v());
                {
                  constexpr int NI = 4 * (MP / 8) * 32; const float* XAp = (const float*)(ws + WS_XA); bf16_t* Dp = (bf16_t*)(ws + WS_DYY); const int t_ = wave_s * 64 + lane_id_v();
                  if (G > 132) { constexpr int SPLIT = (NI / 6 * 5) & ~63;
                      if (c >= 132) pool_phase(a, l, XAp, Dp, (c - 132) * 512 + t_, (G - 132) * 512, 0, SPLIT, true);
                      else pool_phase(a, l, XAp, Dp, c * 512 + t_, 132 * 512, SPLIT, NI, false); }
                  else pool_phase(a, l, XAp, Dp, c * 512 + t_, G * 512, 0, NI, true); } }
            } else if (k == 4) { if (GM & 4) {
                { pg8::Gemm g{(const bf16_t*)(ws + WS_DYY), (const bf16_t*)(ws + WS_WBR) + (size_t)l * 3072 * 512, 3 * M, 3072, 512, 0, 0}; pg8::BranchOrder S{G, c};
                  pg8::EpiMerge E{(const bf16_t*)(ws + WS_GT), (float*)(ws + WS_XA), H};
                  pg8::gemm_phase<pg8::EpiMerge, pg8::BranchOrder, true, true>(lds, g, S, E, wave_s * 64 + lane_id_v()); }
                { pg8::Gemm g{(const bf16_t*)(ws + WS_DYY), (const bf16_t*)(ws + WS_WBR) + (size_t)l * 3072 * 512, 3 * M, 3072, 128, 512, 512}; pg8::SplitOrder S{G, c, 4, 3};
                  pg8::EpiPart E{(float*)(ws + WS_Q), (const bf16_t*)(ws + WS_GT), 4};
                  pg8::gemm_phase<pg8::EpiPart, pg8::SplitOrder, true, true>(lds, g, S, E, wave_s * 64 + lane_id_v()); } }
            } else if (k == 5) { if (GM & 8) {
                { pg8::Gemm g{H, (const bf16_t*)(ws + WS_WOUT) + (size_t)l * 1024 * 1024, MP, 1024, 1024, 0, 0}; pg8::StaticOrder S; S.init(MP, 1024, G, c);
                  pg8::EpiRes E{xp, rep ? (float*)(ws + WS_XA) : X, MOD + l * 6144 + 2048};
                  pg8::gemm_phase<pg8::EpiRes, pg8::StaticOrder, true, true>(lds, g, S, E, wave_s * 64 + lane_id_v()); }
                for (int j = c; j < 64; j += G) { const int ks = j & 7, pmr = j >> 5; const float* Pm = (const float*)(ws + WS_Q);
                    for (int e2 = wave_s * 64 + lane_id_v(); e2 < 256 * 32; e2 += 512) { const int rs = pmr * 256 + (e2 >> 5), c4 = ks * 128 + (e2 & 31) * 4; f32x4 s = {0.f, 0.f, 0.f, 0.f};
#pragma unroll
                        for (int p = 0; p < 12; ++p) s += *(const f32x4*)(Pm + ((size_t)p * 512 + rs) * 1024 + c4);
                        st_bf4(H + (size_t)(MP + rs) * 1024 + c4, s); } }
                asm volatile("s_waitcnt vmcnt(0)" ::: "memory"); __syncthreads();
                { pg8::Gemm g{H, (const bf16_t*)(ws + WS_WOUT) + (size_t)l * 1024 * 1024, M, 1024, 128, 1024, 1024}; pg8::SplitOrder S{G, c, 8, 1};
                  pg8::EpiPart E{(float*)(ws + WS_YC0), nullptr, 8};
                  pg8::gemm_phase<pg8::EpiPart, pg8::SplitOrder, true, true>(lds, g, S, E, wave_s * 64 + lane_id_v()); } }
            } else if (k == 6) norm_phase(X, xs, a->in[10] + l * 1024, MOD + l * 6144 + 3072, 1024, H, tid, (const float*)(ws + WS_YC0), 8, MOD + l * 6144 + 2048, X);
            else if (k == 7) { if (GM & 16) {
                pg8::Gemm g{H, (const bf16_t*)(ws + WS_WFI) + (size_t)l * 2 * DFF * 1024, M, 2 * DFF, 1024}; pg8::StaticOrder S; S.init(M, 2 * DFF, G, c);
                pg8::EpiFfn E{(bf16_t*)(ws + WS_GT)};
                pg8::gemm_phase<pg8::EpiFfn, pg8::StaticOrder, true, true>(lds, g, S, E, wave_s * 64 + lane_id_v()); }
            } else if (GM & 32) {
                { pg8::Gemm g{(const bf16_t*)(ws + WS_GT), (const bf16_t*)(ws + WS_WFO) + (size_t)l * 1024 * DFF, MP, 1024, DFF, 0, 0}; pg8::StaticOrder S; S.init(MP, 1024, G, c);
                  pg8::EpiRes E{X, rep ? (float*)(ws + WS_XA) : X, MOD + l * 6144 + 5120};
                  pg8::gemm_phase<pg8::EpiRes, pg8::StaticOrder, true, true>(lds, g, S, E, wave_s * 64 + lane_id_v()); }
                { pg8::Gemm g{(const bf16_t*)(ws + WS_GT), (const bf16_t*)(ws + WS_WFO) + (size_t)l * 1024 * DFF, M, 1024, 128, DFF, DFF}; pg8::SplitOrder S{G, c, 22, 1};
                  pg8::EpiPart E{(float*)(ws + WS_DYY), nullptr, 22};
                  pg8::gemm_phase<pg8::EpiPart, pg8::SplitOrder, true, true>(lds, g, S, E, wave_s * 64 + lane_id_v()); }
            }
        }
        if (REPM && rep + 1 < nrep) __syncthreads();
        }
        if (ph + 1 < ph_hi) { if (SYNC2 == 1 || ph_hi > 1000) grid.sync(); else { XcdBarrier xb = xbar; asm volatile("" : "+s"(xb.x), "+s"(xb.bar));
            xcd_barrier(xb); if (SYNC2 == 2) xcd_barrier(xb); } }
    }
}

extern "C" void kernel_launch(void* const* d_in, const int* in_sizes, int n_in, void* d_out, int out_size, void* d_ws, size_t ws_size, hipStream_t stream) {
    static int grid = 0;
    if (grid == 0) {
        if (n_in != 33 || (size_t)out_size != OUT_TOTAL || ws_size < WS_END) { fprintf(stderr, "kernel_launch: unexpected shapes: n_in %d out %d ws %zu (need %zu)\n", n_in, out_size, ws_size, (size_t)WS_END); grid = -1; return; }
        int dev = 0, cus = 0, per_cu = 0;
        (void)hipGetDevice(&dev); (void)hipDeviceGetAttribute(&cus, hipDeviceAttributeMultiprocessorCount, dev);
        if (hipFuncSetAttribute((const void*)mega, hipFuncAttributeMaxDynamicSharedMemorySize, LDS_BYTES) != hipSuccess) { fprintf(stderr, "kernel_launch: hipFuncSetAttribute failed\n"); grid = -1; return; }
        if (hipOccupancyMaxActiveBlocksPerMultiprocessor(&per_cu, (const void*)mega, 512, LDS_BYTES) != hipSuccess || per_cu < 1) { fprintf(stderr, "kernel_launch: occupancy query says %d\n", per_cu); per_cu = 1; }
        (void)hipGetLastError();
        grid = cus * 1;
        if (grid <= 0) grid = 256;
    }
    if (grid < 0) return;
    Args a{};
    for (int i = 0; i < 33; ++i) a.in[i] = (const float*)d_in[i];
    a.out = (float*)d_out; a.ws = (unsigned char*)d_ws;
    for (int j = 0; j < 8; ++j) a.rfix[j] = (unsigned long long)ldexpl(powl(500000.0L, -(long double)j / 8.0L) / (2.0L * 3.14159265358979323846264338327950288L), 64);
#if MK_MULTI
    for (int ph = 0; ph < NPHASE; ++ph) { a.ph_lo = ph; a.ph_hi = ph + 1; hipLaunchKernelGGL(mega, dim3(grid), dim3(512), LDS_BYTES, stream, a); }
#else
    a.ph_lo = 0; a.ph_hi = NPHASE;
    if (hipMemsetAsync(d_ws, 0, 16384, stream) != hipSuccess) { fprintf(stderr, "kernel_launch: memset failed\n"); return; }
    void* args[] = {&a};
    hipError_t e = hipLaunchCooperativeKernel((const void*)mega, dim3(grid), dim3(512), args, LDS_BYTES, stream);
    if (e != hipSuccess) fprintf(stderr, "kernel_launch: cooperative launch failed: %s (grid %d)\n", hipGetErrorString(e), grid);
#endif
}
```

```cpp
#include <hip/hip_runtime.h>
#include <hip/hip_cooperative_groups.h>
#include <cstdio>
#include <cstdint>
#include <cmath>
namespace cg = cooperative_groups;

#ifndef MK_MULTI
#define MK_MULTI 0
#endif

__device__ __forceinline__ int lane_id_v() { int l; asm volatile("v_mbcnt_lo_u32_b32 %0, -1, 0\n\tv_mbcnt_hi_u32_b32 %0, -1, %0" : "=v"(l)); return l; }
__device__ __forceinline__ float shx(float v, int mask, int lane) { return __builtin_bit_cast(float, __builtin_amdgcn_ds_bpermute((lane ^ mask) << 2, __builtin_bit_cast(int, v))); }

__device__ __forceinline__ float shx32(float v, int upper  ) { const unsigned x = __builtin_bit_cast(unsigned, v); auto r = __builtin_amdgcn_permlane32_swap(x, x, false, false); return __builtin_bit_cast(float, upper ? r[0] : r[1]); }
__device__ __forceinline__ float shx16(float v, int odd  ) { const unsigned x = __builtin_bit_cast(unsigned, v); auto r = __builtin_amdgcn_permlane16_swap(x, x, false, false); return __builtin_bit_cast(float, odd ? r[0] : r[1]); }

namespace cfg {
constexpr int D = 1024, MP = 16384, MS = 512, M = MP + MS, SEQ = 2048, NBAT = 136, DEPTH = 4;
constexpr int IN_COLS = 4864, DFF = 2816, NMOD = 6 * D * DEPTH;
constexpr size_t OFF_Y = 0;
constexpr size_t OFF_KP = (size_t)M * D;
constexpr size_t OFF_VP = OFF_KP + (size_t)4 * 8 * 128 * 128;
constexpr size_t OFF_PP = OFF_VP + (size_t)4 * 8 * 128 * 128;
constexpr size_t OFF_SRP = OFF_PP + (size_t)4 * 8 * 15 * 512;
constexpr size_t OFF_SIP = OFF_SRP + (size_t)4 * 8 * 32 * 64;
constexpr size_t OFF_KS = OFF_SIP + (size_t)4 * 8 * 32 * 64;
constexpr size_t OFF_VS = OFF_KS + (size_t)4 * 128 * 128 * 128;
constexpr size_t OFF_PS = OFF_VS + (size_t)4 * 128 * 128 * 128;
constexpr size_t OFF_SRS = OFF_PS + (size_t)4 * 128 * 15 * 512;
constexpr size_t OFF_SIS = OFF_SRS + (size_t)4 * 128 * 32 * 64;
constexpr size_t OUT_TOTAL = OFF_SIS + (size_t)4 * 128 * 32 * 64;
static_assert(OUT_TOTAL == 41533440, "output size");
constexpr size_t MiB = 1u << 20;
constexpr size_t WS_WIN = 1 * MiB;
constexpr size_t WS_WGLU = WS_WIN + 38 * MiB;
constexpr size_t WS_WBR = WS_WGLU + 2 * MiB;
constexpr size_t WS_WOUT = WS_WBR + 12 * MiB;
constexpr size_t WS_WFI = WS_WOUT + 8 * MiB;
constexpr size_t WS_WFO = WS_WFI + 44 * MiB;
constexpr size_t WS_MOD = WS_WFO + 22 * MiB;
constexpr size_t WS_CA = WS_MOD + 13 * MiB;
constexpr size_t WS_TAB = WS_CA + 1 * MiB;
constexpr size_t WS_H = WS_TAB + 2 * MiB;
constexpr size_t WS_XA = WS_H + 33 * MiB;
constexpr size_t WS_U = WS_XA + 33 * MiB;
constexpr size_t WS_Q = WS_U + 33 * MiB;
constexpr size_t WS_K = WS_Q + 17 * MiB;
constexpr size_t WS_V = WS_K + 5 * MiB;
constexpr size_t WS_DYY = WS_V + 5 * MiB;
constexpr size_t WS_YC0 = WS_DYY + 50 * MiB;
constexpr size_t WS_GT = WS_YC0 + 17 * MiB;
constexpr size_t WS_END = WS_GT + 99 * MiB;
static_assert((size_t)M * 512 * 2 * 3 <= 50 * MiB && (size_t)M * 3072 * 2 <= 99 * MiB && (size_t)M * 1024 * 2 <= 33 * MiB, "ws map");
constexpr size_t TB_ROPEC = 0;
constexpr size_t TB_ROPES = 65664;
constexpr size_t TB_ABAR = 131328;
constexpr size_t TB_ABAR256 = TB_ABAR + 65536;
constexpr size_t TB_BBF = 262400;
constexpr size_t TB_CF = TB_BBF + 524288;
static_assert(TB_CF + 524288 <= 2 * MiB, "tables");
constexpr int LDS_BYTES = 147456;
constexpr int NPHASE = 2 + 9 * DEPTH + 1;
}

namespace pg8 {
#define PG8_LAS __attribute__((address_space(3)))
typedef unsigned short bf16_t;
typedef short bf16x8 __attribute__((ext_vector_type(8)));
typedef float f32x4 __attribute__((ext_vector_type(4)));
typedef unsigned u32x4 __attribute__((ext_vector_type(4)));
constexpr int BM = 256, BK = 64, HALF = 128, HTB = HALF * BK * 2  , STAGE_BYTES = 8 * HTB, NXCD = 8, WGM = 4;

__host__ __device__ __forceinline__ int lds_byte(int r, int c) { const int st = (r >> 4) * 2 + (c >> 5), rr = r & 15, cc = c & 31, ob = rr * 64 + cc * 2; return st * 1024 + (ob ^ (((ob >> 9) & 1) << 5)); }
__host__ __device__ __forceinline__ void stage_rc(int b, int& R, int& C) { const int st = b / 1024, sb = b % 1024, swz = sb ^ (((sb >> 9) & 1) << 5); R = (st >> 1) * 16 + swz / 64; C = (st & 1) * 32 + (swz % 64) / 2; }
__host__ __device__ __forceinline__ int perm32(int rho) { const int n = rho >> 4, i = rho & 15; return 8 * (i >> 2) + 4 * n + (i & 3); }

struct Unit { int pm, pn, k0; };
struct Gemm { const bf16_t* A; const bf16_t* Bt; int M, N, K, lda, ldb; };

struct StaticOrder {
    int nM, nN, nwg, G, c;
    __host__ __device__ void init(int M, int N, int G_, int c_) { nM = M / BM; nN = N / BM; nwg = nM * nN; G = G_; c = c_; }
    __host__ __device__ bool next(int i, Unit& u) const {
        const long L = (long)i * G + c; if (L >= nwg) return false;
        int wgid = (int)L; { const int q = nwg / NXCD, r = nwg % NXCD, xcd = wgid % NXCD, off = wgid / NXCD; wgid = (xcd < r ? xcd * (q + 1) : r * (q + 1) + (xcd - r) * q) + off; }
        const int nig = WGM * nN, gid = wgid / nig, fm = gid * WGM, gsz = (nM - fm) < WGM ? (nM - fm) : WGM;
        u.pm = fm + ((wgid % nig) % gsz); u.pn = (wgid % nig) / gsz; u.k0 = 0; return true;
    }
    __device__ __forceinline__ void a_ready(const Unit&) const {}
    __device__ __forceinline__ void done(const Unit&) const {}
};

__device__ __forceinline__ unsigned cvt_pk_bf16(float lo, float hi) { unsigned r; asm volatile("v_cvt_pk_bf16_f32 %0, %1, %2" : "=v"(r) : "v"(lo), "v"(hi)); return r; }
typedef unsigned u32x2 __attribute__((ext_vector_type(2)));
__device__ __forceinline__ float sigm(float x) { return __builtin_amdgcn_rcpf(1.f + __expf(-x)); }
__device__ __forceinline__ f32x4 ld_bf4(const bf16_t* p) { const u32x2 w = *(const u32x2*)p; f32x4 r; r[0] = __uint_as_float(w.x << 16); r[1] = __uint_as_float(w.x & 0xffff0000u); r[2] = __uint_as_float(w.y << 16); r[3] = __uint_as_float(w.y & 0xffff0000u); return r; }
__device__ __forceinline__ void st_bf4(bf16_t* p, const f32x4 v) { u32x2 w; w.x = cvt_pk_bf16(v[0], v[1]); w.y = cvt_pk_bf16(v[2], v[3]); *(u32x2*)p = w; }
__device__ __forceinline__ int batch_of(int row) { return row < cfg::MP ? (row >> 11) : 8 + ((row - cfg::MP) >> 2); }

struct EpiMod {
    static constexpr bool PERM = true, AFTER_DRAIN = false;
    float* MOD; const float* bada;
    __device__ __forceinline__ void operator()(const f32x4 (&acc)[2][2][4][2], const Unit& u, int wr, int wc, int fr, int fq) const {
#pragma unroll
        for (int ai = 0; ai < 2; ++ai)
#pragma unroll
            for (int m = 0; m < 4; ++m) { const int row = u.pm * 256 + ai * 128 + wr * 64 + m * 16 + fr;
                if (row < cfg::NBAT) {
#pragma unroll
                    for (int bj = 0; bj < 2; ++bj)
#pragma unroll
                        for (int n = 0; n < 2; ++n) { const int col = u.pn * 256 + bj * 128 + wc * 32 + 8 * fq + 4 * n;
                            *(f32x4*)(MOD + (size_t)row * cfg::NMOD + col) = acc[ai][bj][m][n] + *(const f32x4*)(bada + col); } } }
    }
};

struct EpiIn {
    static constexpr bool PERM = true, AFTER_DRAIN = false;
    float* XA; float* U; bf16_t* Q; bf16_t* KB; bf16_t* VB; bf16_t* GT; const float* ropec; const float* ropes; float* out; int layer;
    __device__ __forceinline__ void operator()(const f32x4 (&acc)[2][2][4][2], const Unit& u, int wr, int wc, int fr, int fq) const {
        const int pn = u.pn;
#pragma unroll
        for (int ai = 0; ai < 2; ++ai)
#pragma unroll
            for (int m = 0; m < 4; ++m) { const int row = u.pm * 256 + ai * 128 + wr * 64 + m * 16 + fr;
#pragma unroll
                for (int bj = 0; bj < 2; ++bj)
#pragma unroll
                    for (int n = 0; n < 2; ++n) { const int tc = bj * 128 + wc * 32 + 8 * fq + 4 * n; f32x4 v = acc[ai][bj][m][n];
                        if (pn < 2) { *(f32x4*)(XA + (size_t)row * 512 + pn * 256 + tc) = v; }
                        else if (pn <= 4) {
                            const bool isv = (pn == 4 && bj == 1);
                            if (!isv && (wc & 1) == 0) {
                                const int tix = row < cfg::MP ? (row & 2047) : 2048 + (row & 3);
                                const f32x4 cs = *(const f32x4*)(ropec + tix * 8 + 4 * n), sn = *(const f32x4*)(ropes + tix * 8 + 4 * n);
#pragma unroll
                                for (int i = 0; i < 4; ++i) { const float p = shx16(v[i], fq & 1); const float rv = v[i] * cs[i] + (fq == 0 ? -p : p) * sn[i]; v[i] = fq < 2 ? rv : v[i]; }
                            }
                            if (pn < 4) st_bf4(Q + (size_t)row * 512 + (pn - 2) * 256 + tc, v);
                            else { st_bf4((bj == 0 ? KB : VB) + (size_t)row * 128 + (tc & 127), v);
                                bool w = false; size_t o = 0;
                                if (row < cfg::MP) { const int t = row & 2047; if (t >= 1920) { w = true; o = (bj == 0 ? cfg::OFF_KP : cfg::OFF_VP) + ((size_t)(layer * 8 + (row >> 11)) * 128 + (t - 1920)) * 128 + (tc & 127); } }
                                else { const int rs = row - cfg::MP; w = true; o = (bj == 0 ? cfg::OFF_KS : cfg::OFF_VS) + ((size_t)(layer * 128 + (rs >> 2)) * 128 + 124 + (rs & 3)) * 128 + (tc & 127); }
                                if (w) *(f32x4*)(out + o) = v; }
                        }
                        else if (pn < 7) { *(f32x4*)(U + (size_t)row * 512 + (pn - 5) * 256 + tc) = v; }
                        else { f32x4 s; s[0] = sigm(v[0]); s[1] = sigm(v[1]); s[2] = sigm(v[2]); s[3] = sigm(v[3]); st_bf4(GT + (size_t)row * 3072 + (pn - 7) * 256 + tc, s); }
                    } }
    }
};

struct EpiGlu {
    static constexpr bool PERM = true, AFTER_DRAIN = false;
    const bf16_t* YC0; bf16_t* YC;
    __device__ __forceinline__ void operator()(const f32x4 (&acc)[2][2][4][2], const Unit& u, int wr, int wc, int fr, int fq) const {
#pragma unroll
        for (int ai = 0; ai < 2; ++ai)
#pragma unroll
            for (int m = 0; m < 4; ++m) { const int row = u.pm * 256 + ai * 128 + wr * 64 + m * 16 + fr;
#pragma unroll
                for (int bj = 0; bj < 2; ++bj)
#pragma unroll
                    for (int n = 0; n < 2; ++n) { const int col = u.pn * 256 + bj * 128 + wc * 32 + 8 * fq + 4 * n; const f32x4 v = acc[ai][bj][m][n];
                        const f32x4 y0 = ld_bf4(YC0 + (size_t)row * 512 + col); f32x4 o;
#pragma unroll
                        for (int i = 0; i < 4; ++i) o[i] = y0[i] * sigm(v[i]);
                        st_bf4(YC + (size_t)row * 512 + col, o); } }
    }
};

struct EpiMerge {
    static constexpr bool PERM = true, AFTER_DRAIN = false;
    const bf16_t* GT; float* M32; bf16_t* M16;
    __device__ __forceinline__ void operator()(const f32x4 (&acc)[2][2][4][2], const Unit& u, int wr, int wc, int fr, int fq) const {
        const int br = u.pm / 66, pm = u.pm - br * 66, pn = u.pn & 3;
        if (br > 0) asm volatile("s_waitcnt vmcnt(0)" ::: "memory");
#pragma unroll
        for (int ai = 0; ai < 2; ++ai)
#pragma unroll
            for (int m = 0; m < 4; ++m) { const int row = pm * 256 + ai * 128 + wr * 64 + m * 16 + fr;
#pragma unroll
                for (int bj = 0; bj < 2; ++bj)
#pragma unroll
                    for (int n = 0; n < 2; ++n) { const int col = pn * 256 + bj * 128 + wc * 32 + 8 * fq + 4 * n; const f32x4 v = acc[ai][bj][m][n];
                        const f32x4 g = ld_bf4(GT + (size_t)row * 3072 + br * 1024 + col);
                        bf16_t* mp = M16 + (size_t)row * 1024 + col;
                        if (br == 0) st_bf4(mp, g * v); else st_bf4(mp, ld_bf4(mp) + g * v); } }
    }
};

struct EpiRes {
    static constexpr bool PERM = true, AFTER_DRAIN = false;
    const float* xin; float* X; const float* MODG;
    __device__ __forceinline__ void operator()(const f32x4 (&acc)[2][2][4][2], const Unit& u, int wr, int wc, int fr, int fq) const {
        const float* gp = MODG + (size_t)(u.pm >> 3) * cfg::NMOD + u.pn * 256 + wc * 32 + 8 * fq;
        f32x4 g[2][2];
#pragma unroll
        for (int bj = 0; bj < 2; ++bj)
#pragma unroll
            for (int n = 0; n < 2; ++n) g[bj][n] = *(const f32x4*)(gp + bj * 128 + n * 4);
#pragma unroll
        for (int ai = 0; ai < 2; ++ai)
#pragma unroll
            for (int m = 0; m < 4; ++m) { const int row = u.pm * 256 + ai * 128 + wr * 64 + m * 16 + fr;
#pragma unroll
                for (int bj = 0; bj < 2; ++bj)
#pragma unroll
                    for (int n = 0; n < 2; ++n) { const size_t o = (size_t)row * 1024 + u.pn * 256 + bj * 128 + wc * 32 + 8 * fq + 4 * n;
                        *(f32x4*)(X + o) = *(const f32x4*)(xin + o) + g[bj][n] * acc[ai][bj][m][n]; } }
    }
};

struct EpiPart {
    static constexpr bool PERM = true, AFTER_DRAIN = false;
    float* P; const bf16_t* GT; int nks;
    __device__ __forceinline__ void operator()(const f32x4 (&acc)[2][2][4][2], const Unit& u, int wr, int wc, int fr, int fq) const {
        const int br = u.pm / 66, pmr = u.pm - br * 66 - 64, pn = u.pn & 3, slice = br * nks + (u.k0 >> 7);
#pragma unroll
        for (int ai = 0; ai < 2; ++ai)
#pragma unroll
            for (int m = 0; m < 4; ++m) { const int rs = pmr * 256 + ai * 128 + wr * 64 + m * 16 + fr;
#pragma unroll
                for (int bj = 0; bj < 2; ++bj)
#pragma unroll
                    for (int n = 0; n < 2; ++n) { const int col = pn * 256 + bj * 128 + wc * 32 + 8 * fq + 4 * n; f32x4 v = acc[ai][bj][m][n];
                        if (GT) v = v * ld_bf4(GT + (size_t)(cfg::MP + rs) * 3072 + br * 1024 + col);
                        *(f32x4*)(P + ((size_t)slice * 512 + rs) * 1024 + col) = v; } }
    }
};

struct EpiFfn {
    static constexpr bool PERM = true, AFTER_DRAIN = false;
    bf16_t* ACT;
    __device__ __forceinline__ void operator()(const f32x4 (&acc)[2][2][4][2], const Unit& u, int wr, int wc, int fr, int fq) const {
#pragma unroll
        for (int ai = 0; ai < 2; ++ai)
#pragma unroll
            for (int m = 0; m < 4; ++m) { const int row = u.pm * 256 + ai * 128 + wr * 64 + m * 16 + fr;
#pragma unroll
                for (int n = 0; n < 2; ++n) { const int col = u.pn * 128 + wc * 32 + 8 * fq + 4 * n; const f32x4 a = acc[ai][0][m][n], b = acc[ai][1][m][n]; f32x4 o;
#pragma unroll
                    for (int i = 0; i < 4; ++i) o[i] = a[i] * sigm(a[i]) * b[i];
                    st_bf4(ACT + (size_t)row * cfg::DFF + col, o); } }
    }
};

struct BranchOrder {
    int G, c;
    __host__ __device__ bool next(int i, Unit& u) const { const int vc = (G % 8 == 0) ? (c % 8) * (G / 8) + c / 8 : c;
        const int tile = vc + (i / 3) * G; if (tile >= 256) return false; const int br = i % 3; u.pm = br * 66 + (tile >> 2); u.pn = br * 4 + (tile & 3); u.k0 = 0; return true; }
    __device__ __forceinline__ void a_ready(const Unit&) const {}
    __device__ __forceinline__ void done(const Unit&) const {}
};
struct SplitOrder {
    int G, c, nks, nbr;
    __host__ __device__ bool next(int i, Unit& u) const { const int j = c + i * G; if (j >= 8 * nbr * nks) return false; const int ks = j % nks, t = j / nks, br = t % nbr, tile = t / nbr;
        u.pm = br * 66 + 64 + (tile >> 2); u.pn = br * 4 + (tile & 3); u.k0 = ks * 128; return true; }
    __device__ __forceinline__ void a_ready(const Unit&) const {}
    __device__ __forceinline__ void done(const Unit&) const {}
};

template <class Epi, class Sched, bool ALIGN_EPI = false, bool SP2 = false>
__device__ __forceinline__ void gemm_phase(PG8_LAS unsigned char* lds, const Gemm g, const Sched& S, const Epi& E, const int tid_in) {
    int tid_l = tid_in; asm volatile("" : "+v"(tid_l));
    const int tid = tid_l, wid = __builtin_amdgcn_readfirstlane(tid >> 6), lane = tid & 63, wr = wid >> 2, wc = wid & 3, fr = lane & 15, fq = lane >> 4;
    const int K = g.K, nt = K / BK, lda = g.lda ? g.lda : K, ldb = lda;
    unsigned voffA[2], voffB[2];
#pragma unroll
    for (int i = 0; i < 2; ++i) { int R, C; stage_rc(tid * 16 + i * 8192, R, C); const int Rb = Epi::PERM ? ((R & ~31) + perm32(R & 31)) : R;
        voffA[i] = (unsigned)(R * lda + C) * 2u; voffB[i] = (unsigned)(Rb * ldb + C) * 2u; }
    const size_t kstep = (size_t)(BK * 2);
    const size_t hstepA = (size_t)HALF * lda * 2, hstepB = (size_t)HALF * ldb * 2;
    const size_t tstepA = 2 * hstepA, tstepB = 2 * hstepB;
    const unsigned ldsw = (unsigned)wid * 1024u;
    const int aoff = lds_byte(wr * 64 + fr, fq * 8), boff = lds_byte(wc * 32 + fr, fq * 8);
#define PG8_SA(b, h) (((b) * 2 + (h)) * HTB)
#define PG8_SB(b, h) ((4 + (b) * 2 + (h)) * HTB)
#define PG8_STAGE(bufoff, gbase, voff) do { _Pragma("unroll") for (int _i = 0; _i < 2; ++_i) \
        __builtin_amdgcn_global_load_lds((const unsigned*)((const char*)(gbase) + (voff)[_i]), (PG8_LAS unsigned*)(lds + (bufoff) + ldsw + _i * 8192), 16, 0, 0); } while (0)
#define PG8_LDA(dst, b, h) do { _Pragma("unroll") for (int m = 0; m < 4; ++m) _Pragma("unroll") for (int k = 0; k < 2; ++k) dst[m][k] = *(const PG8_LAS bf16x8*)(lds + PG8_SA(b, h) + aoff + m * 2048 + k * 1024); } while (0)
#define PG8_LDB(dst, b, h) do { _Pragma("unroll") for (int n = 0; n < 2; ++n) _Pragma("unroll") for (int k = 0; k < 2; ++k) dst[n][k] = *(const PG8_LAS bf16x8*)(lds + PG8_SB(b, h) + boff + n * 2048 + k * 1024); } while (0)
#define PG8_MMA(ai, bj, At, Bt) do { __builtin_amdgcn_s_setprio(1); _Pragma("unroll") for (int m = 0; m < 4; ++m) _Pragma("unroll") for (int n = 0; n < 2; ++n) _Pragma("unroll") for (int k = 0; k < 2; ++k) \
        acc[ai][bj][m][n] = __builtin_amdgcn_mfma_f32_16x16x32_bf16(Bt[n][k], At[m][k], acc[ai][bj][m][n], 0, 0, 0); __builtin_amdgcn_s_setprio(0); } while (0)
#define PG8_WAIT_V(n) asm volatile("s_waitcnt vmcnt(" #n ")" ::: "memory")
#define PG8_WAIT_L(n) asm volatile("s_waitcnt lgkmcnt(" #n ")" ::: "memory")
#define PG8_BAR __builtin_amdgcn_s_barrier()
#define PG8_SCHED __builtin_amdgcn_sched_barrier(0)
    Unit cur, nxt; int ui = 0;
    if (!S.next(0, cur)) return;
    f32x4 acc[2][2][4][2];
#pragma unroll
    for (int a = 0; a < 2; ++a)
#pragma unroll
        for (int b = 0; b < 2; ++b)
#pragma unroll
            for (int m = 0; m < 4; ++m)
#pragma unroll
                for (int n = 0; n < 2; ++n) acc[a][b][m][n] = (f32x4){0.f, 0.f, 0.f, 0.f};
    bf16x8 At[4][2], B0[2][2], B1[2][2];
    const char* cA = (const char*)g.A + (size_t)cur.pm * tstepA + (size_t)cur.k0 * 2; const char* cB = (const char*)g.Bt + (size_t)cur.pn * tstepB + (size_t)cur.k0 * 2;
    S.a_ready(cur);
    if constexpr (SP2) {
        PG8_STAGE(PG8_SB(0, 0), cB, voffB); PG8_STAGE(PG8_SB(0, 1), cB + hstepB, voffB); PG8_STAGE(PG8_SA(0, 0), cA, voffA); PG8_STAGE(PG8_SA(0, 1), cA + hstepA, voffA);
        if (wr == 1) PG8_BAR;
        PG8_WAIT_V(2); PG8_BAR;
        PG8_STAGE(PG8_SB(1, 0), cB + kstep, voffB); PG8_STAGE(PG8_SA(1, 0), cA + kstep, voffA); PG8_STAGE(PG8_SB(1, 1), cB + hstepB + kstep, voffB);
        PG8_WAIT_V(6); PG8_BAR;
    } else {
        PG8_STAGE(PG8_SB(0, 0), cB, voffB); PG8_STAGE(PG8_SA(0, 0), cA, voffA); PG8_STAGE(PG8_SB(0, 1), cB + hstepB, voffB); PG8_STAGE(PG8_SA(0, 1), cA + hstepA, voffA);
        if (wr == 1) PG8_BAR;
        PG8_WAIT_V(4); PG8_BAR;
        PG8_STAGE(PG8_SB(1, 0), cB + kstep, voffB); PG8_STAGE(PG8_SA(1, 0), cA + kstep, voffA); PG8_STAGE(PG8_SB(1, 1), cB + hstepB + kstep, voffB);
        PG8_WAIT_V(6); PG8_BAR;
    }
    for (;;) {
        const bool has_next = S.next(ui + 1, nxt);
        const char* nA = has_next ? (const char*)g.A + (size_t)nxt.pm * tstepA + (size_t)nxt.k0 * 2 : cA; const char* nB = has_next ? (const char*)g.Bt + (size_t)nxt.pn * tstepB + (size_t)nxt.k0 * 2 : cB;
        for (int t = 0; t < nt; t += 2) {
            const bool last = (t == nt - 2);
            const char* a1 = cA + (size_t)(t + 1) * kstep;
            const char* a2 = last ? nA : cA + (size_t)(t + 2) * kstep; const char* b2 = last ? nB : cB + (size_t)(t + 2) * kstep;
            const char* a3 = a2 + kstep; const char* b3 = b2 + kstep;
            if (last && has_next) S.a_ready(nxt);
            if constexpr (SP2) {
            PG8_LDB(B0, 0, 0); PG8_LDB(B1, 0, 1); PG8_SCHED; PG8_LDA(At, 0, 0); PG8_STAGE(PG8_SA(1, 1), a1 + hstepA, voffA);
            PG8_WAIT_V(8); PG8_WAIT_L(0); PG8_BAR; PG8_MMA(0, 0, At, B0); PG8_MMA(0, 1, At, B1); PG8_BAR; PG8_SCHED;
            PG8_LDA(At, 0, 1); PG8_STAGE(PG8_SB(0, 0), b2, voffB); PG8_STAGE(PG8_SB(0, 1), b2 + hstepB, voffB); PG8_STAGE(PG8_SA(0, 0), a2, voffA);
            PG8_WAIT_V(8); PG8_WAIT_L(0); PG8_BAR; PG8_MMA(1, 0, At, B0); PG8_MMA(1, 1, At, B1); PG8_BAR; PG8_SCHED;
            PG8_LDB(B0, 1, 0); PG8_LDB(B1, 1, 1); PG8_SCHED; PG8_LDA(At, 1, 0); PG8_STAGE(PG8_SA(0, 1), a2 + hstepA, voffA);
            PG8_WAIT_V(8); PG8_WAIT_L(0); PG8_BAR; PG8_MMA(0, 0, At, B0); PG8_MMA(0, 1, At, B1); PG8_BAR; PG8_SCHED;
            PG8_LDA(At, 1, 1); PG8_STAGE(PG8_SB(1, 0), b3, voffB); PG8_STAGE(PG8_SB(1, 1), b3 + hstepB, voffB); PG8_STAGE(PG8_SA(1, 0), a3, voffA);
            PG8_WAIT_V(8); PG8_WAIT_L(0); PG8_BAR; PG8_MMA(1, 0, At, B0); PG8_MMA(1, 1, At, B1); PG8_BAR; PG8_SCHED;
            } else {
            PG8_LDB(B0, 0, 0); PG8_SCHED; PG8_LDA(At, 0, 0); PG8_STAGE(PG8_SA(1, 1), a1 + hstepA, voffA);
            PG8_WAIT_L(8); PG8_BAR; PG8_WAIT_L(0); PG8_MMA(0, 0, At, B0); PG8_BAR; PG8_SCHED;
            PG8_LDB(B1, 0, 1); PG8_STAGE(PG8_SB(0, 0), b2, voffB);
            PG8_BAR; PG8_WAIT_L(0); PG8_MMA(0, 1, At, B1); PG8_BAR;
            PG8_LDA(At, 0, 1); PG8_STAGE(PG8_SA(0, 0), a2, voffA);
            PG8_BAR; PG8_WAIT_L(0); PG8_MMA(1, 0, At, B0); PG8_BAR; PG8_SCHED;
            PG8_STAGE(PG8_SB(0, 1), b2 + hstepB, voffB);
            PG8_WAIT_V(6); PG8_BAR; PG8_MMA(1, 1, At, B1); PG8_BAR;
            PG8_LDB(B0, 1, 0); PG8_SCHED; PG8_LDA(At, 1, 0); PG8_STAGE(PG8_SA(0, 1), a2 + hstepA, voffA);
            PG8_WAIT_L(8); PG8_BAR; PG8_WAIT_L(0); PG8_MMA(0, 0, At, B0); PG8_BAR; PG8_SCHED;
            PG8_LDB(B1, 1, 1); PG8_STAGE(PG8_SB(1, 0), b3, voffB);
            PG8_BAR; PG8_WAIT_L(0); PG8_MMA(0, 1, At, B1); PG8_BAR;
            PG8_LDA(At, 1, 1); PG8_STAGE(PG8_SA(1, 0), a3, voffA);
            PG8_BAR; PG8_WAIT_L(0); PG8_MMA(1, 0, At, B0); PG8_BAR; PG8_SCHED;
            PG8_STAGE(PG8_SB(1, 1), b3 + hstepB, voffB);
            PG8_WAIT_V(6); PG8_BAR; PG8_MMA(1, 1, At, B1); PG8_BAR;
            }
        }
        if constexpr (ALIGN_EPI) { if (wr == 0) PG8_BAR; }
        if constexpr (!Epi::AFTER_DRAIN) { E(acc, cur, wr, wc, fr, fq); S.done(cur); }
        if (!has_next) break;
#pragma unroll
        for (int a = 0; a < 2; ++a)
#pragma unroll
            for (int b = 0; b < 2; ++b)
#pragma unroll
                for (int m = 0; m < 4; ++m)
#pragma unroll
                    for (int n = 0; n < 2; ++n) acc[a][b][m][n] = (f32x4){0.f, 0.f, 0.f, 0.f};
        cur = nxt; cA = nA; cB = nB; ++ui;
        if constexpr (ALIGN_EPI) { if (wr == 1) PG8_BAR; }
    }
    PG8_WAIT_V(0);
    if constexpr (!ALIGN_EPI) { if (wr == 0) PG8_BAR; }
    PG8_BAR;
    if constexpr (Epi::AFTER_DRAIN) { E.fused(acc, cur, wr, wc, fr, fq, lds, wid, lane); S.done(cur); }
#undef PG8_SA
#undef PG8_SB
#undef PG8_STAGE
#undef PG8_LDA
#undef PG8_LDB
#undef PG8_MMA
#undef PG8_WAIT_V
#undef PG8_WAIT_L
#undef PG8_BAR
#undef PG8_SCHED
}
}

#define LAS __attribute__((address_space(3)))
#define DI __device__ __forceinline__
typedef unsigned short bf16_t;
typedef short bf16x8 __attribute__((ext_vector_type(8)));
typedef short s16x4 __attribute__((ext_vector_type(4)));
typedef float f32x4 __attribute__((ext_vector_type(4)));
typedef float f32x16 __attribute__((ext_vector_type(16)));
typedef unsigned u32x4 __attribute__((ext_vector_type(4)));
typedef unsigned u32x2 __attribute__((ext_vector_type(2)));
using pg8::cvt_pk_bf16; using pg8::sigm; using pg8::ld_bf4; using pg8::st_bf4; using pg8::batch_of;
using namespace cfg;

DI float bf2f(bf16_t b) { return __uint_as_float((unsigned)b << 16); }
DI unsigned f2bf(float f) { unsigned u = __float_as_uint(f); return (u + 0x7fffu + ((u >> 16) & 1u)) >> 16; }
DI float wave_sum(float v, int lane) {
#pragma unroll
    for (int o = 1; o < 64; o <<= 1) v += shx(v, o, lane);
    return v;
}
DI float wave_max(float v, int lane) {
#pragma unroll
    for (int o = 1; o < 64; o <<= 1) v = fmaxf(v, shx(v, o, lane));
    return v;
}
DI bf16x8 pack8(const f32x4 a, const f32x4 b) { u32x4 p; p.x = cvt_pk_bf16(a[0], a[1]); p.y = cvt_pk_bf16(a[2], a[3]); p.z = cvt_pk_bf16(b[0], b[1]); p.w = cvt_pk_bf16(b[2], b[3]); return __builtin_bit_cast(bf16x8, p); }
#define MFMA16(a, b, c) __builtin_amdgcn_mfma_f32_16x16x32_bf16((a), (b), (c), 0, 0, 0)
#define MFMA32(a, b, c) __builtin_amdgcn_mfma_f32_32x32x16_bf16((a), (b), (c), 0, 0, 0)

#define XB_TMO      128
#define XB_XCNT(j)  (256  + 64 * (j))
#define XB_XSUB(j)  (1280 + 64 * (j))
#define XB_XGEN(j)  (2304 + 64 * (j))
#define XB_TOP      3328
#define XB_TOPGEN   3392
#define XCD_BAR_WORDS 3456
#define XB_SPIN_CAP (1u << 18)

__device__ __forceinline__ unsigned xb_ld(unsigned* p)              { return __hip_atomic_load(p, __ATOMIC_RELAXED, __HIP_MEMORY_SCOPE_AGENT); }
__device__ __forceinline__ unsigned xb_add(unsigned* p, unsigned v) { return __hip_atomic_fetch_add(p, v, __ATOMIC_RELAXED, __HIP_MEMORY_SCOPE_AGENT); }
__device__ __forceinline__ unsigned xb_xcc_id() { return (unsigned)__builtin_amdgcn_s_getreg((3 << 11) | 20) & 0xFu; }
#define XB_SPIN(cond, bar) do { unsigned _sp = 0; while (cond) { __builtin_amdgcn_s_sleep(1); \
    if ((++_sp & 255u) == 0u) { if (xb_ld(&(bar)[XB_TMO])) break; if (_sp > XB_SPIN_CAP) { atomicAdd(&(bar)[XB_TMO], 1u); break; } } } } while (0)

struct XcdBarrier {
    unsigned* bar; unsigned x;
    volatile LAS unsigned* st;
};

__device__ __forceinline__ XcdBarrier xcd_barrier_post(unsigned* bar, volatile LAS unsigned* st) {
    XcdBarrier b; b.bar = bar; b.x = xb_xcc_id(); b.st = st;
    if (threadIdx.x == 0) (void)xb_add(&bar[XB_XCNT(b.x)], 1u);
    return b;
}
__device__ __forceinline__ void xcd_barrier_complete(unsigned* bar, unsigned x, unsigned& nloc, unsigned& nx) {
    const unsigned G = gridDim.x * gridDim.y * gridDim.z;
    unsigned sum, cnt, mine, sp = 0u;
    for (;;) {
        sum = 0u; cnt = 0u; mine = 0u;
#pragma unroll
        for (unsigned j = 0; j < 16; ++j) { const unsigned c = xb_ld(&bar[XB_XCNT(j)]); sum += c; cnt += (c > 0u) ? 1u : 0u; mine = (j == x) ? c : mine; }
        if (sum == G) break;
        __builtin_amdgcn_s_sleep(1);
        if ((++sp & 255u) == 0u) { if (xb_ld(&bar[XB_TMO])) break; if (sp > XB_SPIN_CAP) { atomicAdd(&bar[XB_TMO], 1u); break; } }
    }
    nloc = mine > 0u ? mine : 1u; nx = cnt > 0u ? cnt : 1u;
}

__device__ __forceinline__ void xcd_barrier(const XcdBarrier& b) {
    asm volatile("s_waitcnt vmcnt(0)" ::: "memory");
    __syncthreads();
    if (threadIdx.x == 0) {
        unsigned* bar = b.bar;
        __builtin_amdgcn_s_waitcnt(0);
        unsigned nloc = b.st[0], nx = b.st[1];
        if (nloc == 0u) { xcd_barrier_complete(bar, b.x, nloc, nx); b.st[0] = nloc; b.st[1] = nx; }
        const unsigned old = xb_add(&bar[XB_XSUB(b.x)], 1u);
        const unsigned gen = old / nloc;
        if (old + 1u == (gen + 1u) * nloc) {
            __builtin_amdgcn_fence(__ATOMIC_RELEASE, "agent");
            asm volatile("s_waitcnt vmcnt(0)" ::: "memory");
            const unsigned og = xb_add(&bar[XB_TOP], 1u);
            const unsigned tg = og / nx;
            if (og + 1u == (tg + 1u) * nx) xb_add(&bar[XB_TOPGEN], 1u);
            else XB_SPIN(xb_ld(&bar[XB_TOPGEN]) == tg, bar);
            __builtin_amdgcn_fence(__ATOMIC_ACQUIRE, "agent");
            xb_add(&bar[XB_XGEN(b.x)], 1u);
            asm volatile("s_waitcnt vmcnt(0)" ::: "memory");
        } else {
            XB_SPIN(xb_ld(&bar[XB_XGEN(b.x)]) == gen, bar);
            __builtin_amdgcn_fence(__ATOMIC_ACQUIRE, "agent");
            asm volatile("s_waitcnt vmcnt(0)" ::: "memory");
        }
    }
    __syncthreads();
}

#ifndef MIXM
#define MIXM 0
#endif
#ifndef SYNC2
#define SYNC2 0
#endif
#ifndef REPM
#define REPM 0
#endif
#ifndef GM
#define GM 0xff
#endif
#ifndef PHM
#define PHM 0xff
#endif
struct Args { const float* in[33]; float* out; unsigned char* ws; unsigned long long rfix[8]; int ph_lo, ph_hi; };
typedef const Args __attribute__((address_space(4)))* ArgsP;

DI void tr_item(const float* W, int K, int N, bf16_t* WT, int k0, int n0, int drow0, LAS float* scr, int lane) {
#pragma unroll 8
    for (int i = 0; i < 32; ++i) { const int kk = 2 * i + (lane >> 5); scr[kk * 33 + (lane & 31)] = W[(size_t)(k0 + kk) * N + n0 + (lane & 31)]; }
    asm volatile("s_waitcnt lgkmcnt(0)" ::: "memory");
    const int c = lane & 7;
#pragma unroll
    for (int j = 0; j < 4; ++j) { const int n = (lane >> 3) + 8 * j; const LAS float* s = scr + (8 * c) * 33 + n;
        u32x4 o; o.x = cvt_pk_bf16(s[0 * 33], s[1 * 33]); o.y = cvt_pk_bf16(s[2 * 33], s[3 * 33]); o.z = cvt_pk_bf16(s[4 * 33], s[5 * 33]); o.w = cvt_pk_bf16(s[6 * 33], s[7 * 33]);
        *(u32x4*)(WT + (size_t)(drow0 + n) * K + k0 + 8 * c) = o; }
    asm volatile("s_waitcnt lgkmcnt(0)" ::: "memory");
}
DI void fold_item(const float* Pw  , const float* Sc  , const float* Wa  , bf16_t* WT  , int k0, int n0, LAS float* scr, int lane) {
    const int g = k0 >> 7, nn = lane & 31, hi = lane >> 5;
    for (int jc = 0; jc < 4; ++jc) {
        float w[32];
#pragma unroll
        for (int jj = 0; jj < 32; ++jj) { const int j = g * 128 + jc * 32 + jj; w[jj] = Sc[j] * Wa[(size_t)j * 1024 + n0 + nn]; }
#pragma unroll 1
        for (int i = 0; i < 32; ++i) { const float* pr = Pw + ((size_t)g * 128 + ((k0 & 127) + 2 * i + hi)) * 128 + jc * 32; float acc = 0.f;
#pragma unroll
            for (int j4 = 0; j4 < 8; ++j4) { const f32x4 p = *(const f32x4*)(pr + 4 * j4);
                acc += p[0] * w[4 * j4] + p[1] * w[4 * j4 + 1] + p[2] * w[4 * j4 + 2] + p[3] * w[4 * j4 + 3]; }
            LAS float* sp = scr + (2 * i + hi) * 33 + nn; if (jc == 0) *sp = acc; else *sp += acc; }
    }
    asm volatile("s_waitcnt lgkmcnt(0)" ::: "memory");
    const int c = lane & 7;
#pragma unroll
    for (int j = 0; j < 4; ++j) { const int n = (lane >> 3) + 8 * j; const LAS float* s = scr + (8 * c) * 33 + n;
        u32x4 o; o.x = cvt_pk_bf16(s[0 * 33], s[1 * 33]); o.y = cvt_pk_bf16(s[2 * 33], s[3 * 33]); o.z = cvt_pk_bf16(s[4 * 33], s[5 * 33]); o.w = cvt_pk_bf16(s[6 * 33], s[7 * 33]);
        *(u32x4*)(WT + (size_t)(n0 + n) * 512 + k0 + 8 * c) = o; }
    asm volatile("s_waitcnt lgkmcnt(0)" ::: "memory");
}
DI void sincos_frac(float f  , float& c, float& s) { s = __builtin_amdgcn_sinf(f); c = __builtin_amdgcn_cosf(f); }

DI void prologue(ArgsP a, LAS unsigned char* lds, int tid) {
    const int lane = tid & 63, wave = tid >> 6;
    const int gw = blockIdx.x * 8 + wave, NGW = gridDim.x * 8;
    const int gt = blockIdx.x * 512 + tid, NT = gridDim.x * 512;
    unsigned char* ws = a->ws;
    LAS float* scr = (LAS float*)(lds + wave * 16384);
    constexpr int I_IN = 16 * 152, I_GLU = 8 * 16, I_BR = 8 * 32, I_OUT = 16 * 32, I_FI = 16 * 176, I_FO = 44 * 32, I_ADA = 16 * 192, I_FOLD = 8 * 32;
    constexpr int PER_L = I_IN + I_GLU + 2 * I_BR + I_OUT + I_FI + I_FO + I_ADA + I_FOLD;
    for (int it = gw; it < PER_L * 4; it += NGW) {
        const int l = it & 3; int r = it >> 2;
        if (r < I_FOLD) { fold_item(a->in[14] + (size_t)l * 4 * 128 * 128, a->in[15] + l * 512, a->in[26] + (size_t)l * 512 * 1024, (bf16_t*)(ws + WS_WBR) + (size_t)l * 3072 * 512, (r >> 5) * 64, (r & 31) * 32, scr, lane); continue; } r -= I_FOLD;
        if (r < I_IN) { const int kb = r / 152, nb = r % 152; tr_item(a->in[13] + (size_t)l * 1024 * IN_COLS, 1024, IN_COLS, (bf16_t*)(ws + WS_WIN) + (size_t)l * IN_COLS * 1024, kb * 64, nb * 32, nb * 32, scr, lane); continue; } r -= I_IN;
        if (r < I_GLU) { const int kb = r / 16, nb = r % 16; tr_item(a->in[25] + (size_t)l * 512 * 512, 512, 512, (bf16_t*)(ws + WS_WGLU) + (size_t)l * 512 * 512, kb * 64, nb * 32, nb * 32, scr, lane); continue; } r -= I_GLU;
        if (r < I_BR) { const int kb = r / 32, nb = r % 32; tr_item(a->in[27] + (size_t)l * 512 * 1024, 512, 1024, (bf16_t*)(ws + WS_WBR) + (size_t)l * 3072 * 512, kb * 64, nb * 32, 1024 + nb * 32, scr, lane); continue; } r -= I_BR;
        if (r < I_BR) { const int kb = r / 32, nb = r % 32; tr_item(a->in[28] + (size_t)l * 512 * 1024, 512, 1024, (bf16_t*)(ws + WS_WBR) + (size_t)l * 3072 * 512, kb * 64, nb * 32, 2048 + nb * 32, scr, lane); continue; } r -= I_BR;
        if (r < I_OUT) { const int kb = r / 32, nb = r % 32; tr_item(a->in[29] + (size_t)l * 1024 * 1024, 1024, 1024, (bf16_t*)(ws + WS_WOUT) + (size_t)l * 1024 * 1024, kb * 64, nb * 32, nb * 32, scr, lane); continue; } r -= I_OUT;
        if (r < I_FI) { const int kb = r / 176, nb = r % 176; const int n0 = nb * 32, half = n0 / DFF, j = n0 - half * DFF;
            tr_item(a->in[30] + (size_t)l * 1024 * 2 * DFF, 1024, 2 * DFF, (bf16_t*)(ws + WS_WFI) + (size_t)l * 2 * DFF * 1024, kb * 64, n0, 256 * (j >> 7) + 128 * half + (j & 127), scr, lane); continue; } r -= I_FI;
        if (r < I_FO) { const int kb = r / 32, nb = r % 32; tr_item(a->in[31] + (size_t)l * DFF * 1024, DFF, 1024, (bf16_t*)(ws + WS_WFO) + (size_t)l * 1024 * DFF, kb * 64, nb * 32, nb * 32, scr, lane); continue; } r -= I_FO;
        { const int kb = r / 192, nb = r % 192; tr_item(a->in[11] + (size_t)l * 1024 * 6144, 1024, 6144, (bf16_t*)(ws + WS_GT), kb * 64, nb * 32, l * 6144 + nb * 32, scr, lane); }
    }
    { bf16_t* CA = (bf16_t*)(ws + WS_CA);
      for (int i = gt; i < 256 * 1024; i += NT) { const int r = i >> 10, c = i & 1023; float v = 0.f;
          if (r < 8) v = a->in[7][r * 1024 + c]; else if (r < NBAT) v = a->in[8][(r - 8) * 1024 + c];
          CA[i] = (bf16_t)f2bf(v * sigm(v)); } }
    { float* rc = (float*)(ws + WS_TAB + TB_ROPEC); float* rs = (float*)(ws + WS_TAB + TB_ROPES);
      for (int i = gt; i < 2052 * 8; i += NT) { const int ti = i >> 3, j = i & 7; const int pos = ti < 2048 ? ti : 8192 + (ti - 2048);
          const unsigned long long fx = (unsigned long long)pos * a->rfix[j];
          float c, s; sincos_frac((float)(unsigned)(fx >> 40) * 5.9604644775390625e-08f, c, s); rc[i] = c; rs[i] = s; } }
    { float* AB = (float*)(ws + WS_TAB + TB_ABAR); float* AB256 = (float*)(ws + WS_TAB + TB_ABAR256); bf16_t* BBF = (bf16_t*)(ws + WS_TAB + TB_BBF);
      for (int i = gt; i < 4 * 32 * 64; i += NT) { const int lg = i >> 6, p = i & 63;
          const float dt = expf(a->in[19][lg]); const float ar = a->in[17][i], ai = a->in[18][i];
          const float x = ar * dt; const float yt = ai * dt * 0.15915494309189535f;
          float c, s; sincos_frac(yt, c, s); float ch, sh; sincos_frac(0.5f * yt, ch, sh);
          const float em1 = x * (1.f + x * (0.5f + x * (0.16666667f + x * (0.041666668f + x * 0.0083333338f))));
          const float ex = 1.f + em1;
          const float abr = ex * c, abi = ex * s;
          const float nr = em1 * c - (sh + sh) * sh, ni = abi;
          const float den = 1.f / (ar * ar + ai * ai);
          const float cr = (nr * ar + ni * ai) * den, ci = (ni * ar - nr * ai) * den;
          AB[2 * i] = abr; AB[2 * i + 1] = abi;
          float pr = abr, pi = abi;
#pragma unroll
          for (int k = 0; k < 8; ++k) { const float t = pr * pr - pi * pi; pi = (pr + pr) * pi; pr = t; }
          AB256[2 * i] = pr; AB256[2 * i + 1] = pi;
          const float* br = a->in[20] + (size_t)i * 16; const float* bi = a->in[21] + (size_t)i * 16;
          const int st = p >> 5;
#pragma unroll
          for (int half = 0; half < 2; ++half) { u32x4 ore, oim; unsigned* pre = (unsigned*)&ore; unsigned* pim = (unsigned*)&oim; (void)pre; (void)pim;
              float vr[8], vi[8];
#pragma unroll
              for (int j = 0; j < 8; ++j) { const float b_r = br[half * 8 + j], b_i = bi[half * 8 + j]; vr[j] = cr * b_r - ci * b_i; vi[j] = cr * b_i + ci * b_r; }
              ore.x = cvt_pk_bf16(vr[0], vr[1]); ore.y = cvt_pk_bf16(vr[2], vr[3]); ore.z = cvt_pk_bf16(vr[4], vr[5]); ore.w = cvt_pk_bf16(vr[6], vr[7]);
              oim.x = cvt_pk_bf16(vi[0], vi[1]); oim.y = cvt_pk_bf16(vi[2], vi[3]); oim.z = cvt_pk_bf16(vi[4], vi[5]); oim.w = cvt_pk_bf16(vi[6], vi[7]);
              *(u32x4*)(BBF + (((size_t)lg * 4 + 0 + st) * 64 + half * 32 + (p & 31)) * 8) = ore;
              *(u32x4*)(BBF + (((size_t)lg * 4 + 2 + st) * 64 + half * 32 + (p & 31)) * 8) = oim; } } }
    { bf16_t* CF = (bf16_t*)(ws + WS_TAB + TB_CF);
      for (int i = gt; i < 4 * 32 * 4 * 64; i += NT) { const int ln = i & 63, ks = (i >> 6) & 3, lg = i >> 8; const int c = ln & 15, quad = ln >> 4;
          float v[8];
#pragma unroll
          for (int j = 0; j < 8; ++j) { const int k = ks * 32 + quad * 8 + j; v[j] = k < 64 ? a->in[22][((size_t)lg * 16 + c) * 64 + k] : -a->in[23][((size_t)lg * 16 + c) * 64 + (k - 64)]; }
          u32x4 o; o.x = cvt_pk_bf16(v[0], v[1]); o.y = cvt_pk_bf16(v[2], v[3]); o.z = cvt_pk_bf16(v[4], v[5]); o.w = cvt_pk_bf16(v[6], v[7]);
          *(u32x4*)(CF + (size_t)i * 8) = o; } }
}

DI void cache_shift(ArgsP a, int gt, int NT) {
    for (int i = gt; i < 4 * 128 * 124 * 32; i += NT) { const int c4 = i & 31, j = (i >> 5) % 124, lb = (i >> 5) / 124;
        *(f32x4*)(a->out + OFF_KS + ((size_t)lb * 128 + j) * 128 + c4 * 4) = *(const f32x4*)(a->in[2] + ((size_t)lb * 128 + j + 4) * 128 + c4 * 4);
        *(f32x4*)(a->out + OFF_VS + ((size_t)lb * 128 + j) * 128 + c4 * 4) = *(const f32x4*)(a->in[3] + ((size_t)lb * 128 + j + 4) * 128 + c4 * 4); }
    for (int i = gt; i < 4 * 128 * 11 * 128; i += NT) { const int c4 = i & 127, j = (i >> 7) % 11, lb = (i >> 7) / 11;
        *(f32x4*)(a->out + OFF_PS + ((size_t)lb * 15 + j) * 512 + c4 * 4) = *(const f32x4*)(a->in[4] + ((size_t)lb * 15 + j + 4) * 512 + c4 * 4); }
}

DI void norm_phase(const float* xp, const float* xs, const float* gvec, const float* MODL  , int sc_off, bf16_t* H, int tid,
                   const float* P, int nparts, const float* pgate, float* X) {
    const int lane = tid & 63, gw = blockIdx.x * 8 + (tid >> 6), NGW = gridDim.x * 8;
    for (int it = gw; it < M; it += NGW) {
        const int row = it < MS ? MP + it : it - MS;
        const int bi = batch_of(row);
        const float* xr = (row < MP ? xp : xs) + (size_t)row * 1024; const float* mr = MODL + (size_t)bi * NMOD;
        f32x4 v[4]; float ss = 0.f;
#pragma unroll
        for (int j = 0; j < 4; ++j) v[j] = *(const f32x4*)(xr + 4 * lane + 256 * j);
        if (row >= MP && nparts > 0) {
            f32x4 s[4];
#pragma unroll
            for (int j = 0; j < 4; ++j) s[j] = (f32x4){0.f, 0.f, 0.f, 0.f};
            for (int p = 0; p < nparts; ++p) { const float* pr = P + ((size_t)p * 512 + (row - MP)) * 1024 + 4 * lane;
#pragma unroll
                for (int j = 0; j < 4; ++j) s[j] += *(const f32x4*)(pr + 256 * j); }
#pragma unroll
            for (int j = 0; j < 4; ++j) { v[j] += *(const f32x4*)(pgate + (size_t)bi * NMOD + 4 * lane + 256 * j) * s[j]; *(f32x4*)(X + (size_t)row * 1024 + 4 * lane + 256 * j) = v[j]; }
        }
#pragma unroll
        for (int j = 0; j < 4; ++j) ss += v[j][0] * v[j][0] + v[j][1] * v[j][1] + v[j][2] * v[j][2] + v[j][3] * v[j][3];
        const float r = rsqrtf(wave_sum(ss, lane) * (1.f / 1024.f) + 1e-6f);
        if (H) {
#pragma unroll
            for (int j = 0; j < 4; ++j) { const int c = 4 * lane + 256 * j; const f32x4 g = *(const f32x4*)(gvec + c), sh = *(const f32x4*)(mr + c), sc = *(const f32x4*)(mr + sc_off + c);
                st_bf4(H + (size_t)row * 1024 + c, v[j] * r * g * (1.f + sc) + sh); }
        } else {
#pragma unroll
            for (int j = 0; j < 4; ++j) { const int c = 4 * lane + 256 * j; *(f32x4*)(X + (size_t)row * 1024 + c) = v[j] * r * *(const f32x4*)(gvec + c); }
        }
    }
}

template <int W>
DI void pool_run(const float* XA, bf16_t* Dm, float* out, int l, int row0, int c4) {
    const int t0 = row0 & 2047;
    f32x4 x[W + 7];
#pragma unroll
    for (int i = 0; i < W + 7; ++i) { const int dt = i - (W - 1); x[i] = (t0 + dt >= 0) ? *(const f32x4*)(XA + (size_t)(row0 + dt) * 512 + c4) : (f32x4){0.f, 0.f, 0.f, 0.f}; }
    f32x4 s = x[0];
#pragma unroll
    for (int i = 1; i < W - 1; ++i) s += x[i];
#pragma unroll
    for (int k = 0; k < 8; ++k) { s += x[W - 1 + k]; const int t = t0 + k; const float cnt = (float)((t + 1 < W) ? t + 1 : W);
        st_bf4(Dm + (size_t)(row0 + k) * 512 + c4, s * (1.f / cnt) - x[W - 1 + k]);
        if (t >= 2033) *(f32x4*)(out + OFF_PP + ((size_t)(l * 8 + (row0 >> 11)) * 15 + (t - 2033)) * 512 + c4) = x[W - 1 + k];
        s -= x[k]; }
}
DI void pool_phase(ArgsP a, int l, const float* XA, bf16_t* Dm, int gt  , int NT  , int lo, int hi  , bool do_sample) {
    constexpr int NRUN = MP / 8;
    for (int item = lo + gt; item < hi; item += NT) {
        const int c4l = item & 31, gr = item >> 5, g = gr / NRUN, run = gr - g * NRUN; const int c4 = g * 128 + c4l * 4, row0 = run * 8;
        if (g == 0) pool_run<2>(XA, Dm, a->out, l, row0, c4); else if (g == 1) pool_run<4>(XA, Dm, a->out, l, row0, c4);
        else if (g == 2) pool_run<8>(XA, Dm, a->out, l, row0, c4); else pool_run<16>(XA, Dm, a->out, l, row0, c4);
    }
    if (do_sample) for (int idx = gt; idx < MS * 128; idx += NT) {
        const int row = MP + (idx >> 7), c4 = (idx & 127) * 4, w = 2 << (c4 >> 7);
        const f32x4 x = *(const f32x4*)(XA + (size_t)row * 512 + c4); f32x4 sum = x;
        const int rs = row - MP, bs = rs >> 2, t = rs & 3;
        for (int s = 1; s < w; ++s) { const int pos = t - s;
            sum += pos >= 0 ? *(const f32x4*)(XA + (size_t)(row - s) * 512 + c4) : *(const f32x4*)(a->in[4] + ((size_t)(l * 128 + bs) * 15 + 15 + pos) * 512 + c4); }
        *(f32x4*)(a->out + OFF_PS + ((size_t)(l * 128 + bs) * 15 + 11 + t) * 512 + c4) = x;
        st_bf4(Dm + (size_t)row * 512 + c4, sum * (1.f / (float)w) - x);
    }
}

DI void attn_prompt_unit(LAS unsigned char* lds, int unit, const bf16_t* Q, const bf16_t* KB, const bf16_t* VB, bf16_t* YB, const float* sinks, int tid) {
    const int b = unit >> 5, g = (unit >> 4) & 1, nb = unit & 15;
    LAS bf16_t* Ks = (LAS bf16_t*)lds;
    LAS bf16_t* Vt = (LAS bf16_t*)(lds + 36864);
    const int krow0 = b * 2048 + (nb - 1) * 128;
#pragma unroll
    for (int it = 0; it < 4; ++it) {
        const int chunk = tid + 512 * it, j = chunk >> 3, c8 = chunk & 7;
        u32x4 kv = {0u, 0u, 0u, 0u}, vv = {0u, 0u, 0u, 0u};
        if (nb > 0 || j >= 128) { const size_t off = (size_t)(krow0 + j) * 128 + g * 64 + c8 * 8; kv = *(const u32x4*)(KB + off); vv = *(const u32x4*)(VB + off); }
        *(LAS u32x4*)(Ks + j * 72 + c8 * 8) = kv;
        LAS bf16_t* vp = Vt + (c8 * 8) * 268 + j;
        vp[0 * 268] = (bf16_t)(vv.x & 0xffffu); vp[1 * 268] = (bf16_t)(vv.x >> 16); vp[2 * 268] = (bf16_t)(vv.y & 0xffffu); vp[3 * 268] = (bf16_t)(vv.y >> 16);
        vp[4 * 268] = (bf16_t)(vv.z & 0xffffu); vp[5 * 268] = (bf16_t)(vv.z >> 16); vp[6 * 268] = (bf16_t)(vv.w & 0xffffu); vp[7 * 268] = (bf16_t)(vv.w >> 16);
    }
    __syncthreads();
    const int wave = tid >> 6, lane = tid & 63, l15 = lane & 15, quad = lane >> 4;
    const int r = wave >> 1, hq = g * 4 + r;
    const float sc2 = 0.125f * 1.4426950408889634f;
    const float sk2 = sinks[hq] * 1.4426950408889634f;
    const int kt0 = wave & 1;
#pragma unroll 1
    for (int qh = 0; qh < 2; ++qh) {
        const int q0 = (wave & 1) * 64 + qh * 32;
        const int qrow0 = b * 2048 + nb * 128 + q0;
        bf16x8 qf[2][2];
#pragma unroll
        for (int qt = 0; qt < 2; ++qt)
#pragma unroll
            for (int ds = 0; ds < 2; ++ds) qf[qt][ds] = *(const bf16x8*)(Q + (size_t)(qrow0 + qt * 16 + l15) * 512 + hq * 64 + ds * 32 + quad * 8);
        float m2[2], ls[2]; f32x4 o[4][2];
#pragma unroll
        for (int qt = 0; qt < 2; ++qt) { m2[qt] = sk2; ls[qt] = quad == 0 ? 1.f : 0.f;
#pragma unroll
            for (int dt = 0; dt < 4; ++dt) o[dt][qt] = (f32x4){0.f, 0.f, 0.f, 0.f}; }
#pragma unroll 1
        for (int kk = 0; kk < 3; ++kk) {
            const int kt = kt0 + kk;
            if (nb == 0 && kt < 2) continue;
            f32x4 s[4][2];
#pragma unroll
            for (int sub = 0; sub < 4; ++sub) { const LAS bf16_t* kp = Ks + (kt * 64 + sub * 16 + l15) * 72 + quad * 8;
                const bf16x8 k0 = *(const LAS bf16x8*)kp, k1 = *(const LAS bf16x8*)(kp + 32);
#pragma unroll
                for (int qt = 0; qt < 2; ++qt) { s[sub][qt] = MFMA16(k0, qf[qt][0], ((f32x4){0.f, 0.f, 0.f, 0.f})); s[sub][qt] = MFMA16(k1, qf[qt][1], s[sub][qt]); } }
#pragma unroll
            for (int qt = 0; qt < 2; ++qt) { const int i = q0 + qt * 16 + l15; float mx = -INFINITY;
#pragma unroll
                for (int sub = 0; sub < 4; ++sub)
#pragma unroll
                    for (int jj = 0; jj < 4; ++jj) { const int j = kt * 64 + sub * 16 + quad * 4 + jj; const bool valid = (j > i) && (j <= i + 128) && (nb > 0 || j >= 128);
                        const float v = valid ? s[sub][qt][jj] * sc2 : -INFINITY; s[sub][qt][jj] = v; mx = fmaxf(mx, v); }
                mx = fmaxf(mx, shx16(mx, quad & 1)); mx = fmaxf(mx, shx32(mx, quad >> 1));
                const float mn = fmaxf(m2[qt], mx), alpha = __builtin_amdgcn_exp2f(m2[qt] - mn); m2[qt] = mn; float sum = 0.f;
#pragma unroll
                for (int sub = 0; sub < 4; ++sub)
#pragma unroll
                    for (int jj = 0; jj < 4; ++jj) { const float p = __builtin_amdgcn_exp2f(s[sub][qt][jj] - mn); s[sub][qt][jj] = p; sum += p; }
                ls[qt] = ls[qt] * alpha + sum;
#pragma unroll
                for (int dt = 0; dt < 4; ++dt) o[dt][qt] *= alpha; }
#pragma unroll
            for (int s2 = 0; s2 < 2; ++s2) { bf16x8 pf[2];
#pragma unroll
                for (int qt = 0; qt < 2; ++qt) pf[qt] = pack8(s[2 * s2][qt], s[2 * s2 + 1][qt]);
#pragma unroll
                for (int dt = 0; dt < 4; ++dt) { const LAS bf16_t* vp = Vt + (dt * 16 + l15) * 268 + kt * 64 + s2 * 32 + quad * 4;
                    const s16x4 v0 = *(const LAS s16x4*)vp, v1 = *(const LAS s16x4*)(vp + 16);
                    const bf16x8 vf = __builtin_shufflevector(v0, v1, 0, 1, 2, 3, 4, 5, 6, 7);
#pragma unroll
                    for (int qt = 0; qt < 2; ++qt) o[dt][qt] = MFMA16(vf, pf[qt], o[dt][qt]); } }
        }
#pragma unroll
        for (int qt = 0; qt < 2; ++qt) { float lt = ls[qt]; lt += shx16(lt, quad & 1); lt += shx32(lt, quad >> 1); const float inv = 1.f / lt;
            bf16_t* yp = YB + (size_t)(qrow0 + qt * 16 + l15) * 512 + hq * 64 + quad * 4;
#pragma unroll
            for (int dt = 0; dt < 4; ++dt) st_bf4(yp + dt * 16, o[dt][qt] * inv); }
    }
    __syncthreads();
}

DI void attn_sample_task(LAS unsigned char* wl, int task, int l, ArgsP a, const bf16_t* Q, bf16_t* YB, int lane) {
    const int b = task >> 3, h = task & 7, g = h >> 2;
    LAS float* qs = (LAS float*)wl;
    LAS float* ps = qs + 256;
#pragma unroll
    for (int t = 0; t < 4; ++t) qs[t * 64 + lane] = bf2f(Q[(size_t)(MP + b * 4 + t) * 512 + h * 64 + lane]);
    const float* ck = a->in[2] + (size_t)(l * 128 + b) * 128 * 128 + g * 64;
    const float* cv = a->in[3] + (size_t)(l * 128 + b) * 128 * 128 + g * 64;
    const float* nk = a->out + OFF_KS + ((size_t)(l * 128 + b) * 128 + 124) * 128 + g * 64;
    const float* nv = a->out + OFF_VS + ((size_t)(l * 128 + b) * 128 + 124) * 128 + g * 64;
    const float sink = a->in[16][l * 8 + h];
    float mx[4] = {sink, sink, sink, sink};
    for (int rr = 0; rr < 3; ++rr) { const int j = rr * 64 + lane; float s[4] = {0.f, 0.f, 0.f, 0.f};
        if (j < 132) { const float* kp = j < 128 ? ck + (size_t)j * 128 : nk + (size_t)(j - 128) * 128;
#pragma unroll 4
            for (int d4 = 0; d4 < 16; ++d4) { const f32x4 k4 = *(const f32x4*)(kp + 4 * d4);
#pragma unroll
                for (int t = 0; t < 4; ++t) { const f32x4 q4 = *(const LAS f32x4*)(qs + t * 64 + 4 * d4); s[t] += k4[0] * q4[0] + k4[1] * q4[1] + k4[2] * q4[2] + k4[3] * q4[3]; } } }
#pragma unroll
        for (int t = 0; t < 4; ++t) { const bool valid = (j < 132) && (j >= t + 1) && (j <= t + 128); const float v = valid ? s[t] * 0.125f : -INFINITY;
            if (j < 136) ps[t * 136 + j] = v; mx[t] = fmaxf(mx[t], v); } }
    float den[4];
#pragma unroll
    for (int t = 0; t < 4; ++t) { mx[t] = wave_max(mx[t], lane); float sum = 0.f;
        for (int rr = 0; rr < 3; ++rr) { const int j = rr * 64 + lane; if (j < 132) { const float p = __expf(ps[t * 136 + j] - mx[t]); ps[t * 136 + j] = p; sum += p; } }
        den[t] = wave_sum(sum, lane) + __expf(sink - mx[t]); }
    float o[4] = {0.f, 0.f, 0.f, 0.f};
    for (int j = 0; j < 132; ++j) { const float v = (j < 128 ? cv + (size_t)j * 128 : nv + (size_t)(j - 128) * 128)[lane];
#pragma unroll
        for (int t = 0; t < 4; ++t) o[t] += ps[t * 136 + j] * v; }
#pragma unroll
    for (int t = 0; t < 4; ++t) YB[(size_t)(MP + b * 4 + t) * 512 + h * 64 + lane] = (bf16_t)f2bf(o[t] / den[t]);
}

struct S5C { bf16x8 bbf[4]; bf16x8 cf[4]; float are[2], aim[2]; };
DI float gelu_tanh(float y) { const float z = 1.5957691216057308f * (y + 0.044715f * y * y * y); return y * sigm(z); }
template <bool OUT>
DI void s5_tile(const S5C& K, const float* U, int row0, int g, int nruns, int nvalid, float (&hre)[2], float (&him)[2], LAS bf16_t* Hs, const float* dvec, bf16_t* YC0, int lane) {
    const int tok = lane & 31, half = lane >> 5;
    bf16x8 af = {0, 0, 0, 0, 0, 0, 0, 0};
    if (tok < nvalid) { const float* up = U + (size_t)(row0 + tok) * 512 + g * 16 + half * 8; af = pack8(*(const f32x4*)up, *(const f32x4*)(up + 4)); }
    f32x16 z16;
#pragma unroll
    for (int i = 0; i < 16; ++i) z16[i] = 0.f;
    f32x16 dre[2], dim[2];
#pragma unroll
    for (int st = 0; st < 2; ++st) { dre[st] = MFMA32(af, K.bbf[st], z16); dim[st] = MFMA32(af, K.bbf[2 + st], z16); }
#pragma unroll
    for (int r = 0; r < 8; ++r) {
        if (r < nruns) {
            const int hf = r & 1, i0 = 4 * (r >> 1);
            if (half == hf) {
#pragma unroll
                for (int k = 0; k < 4; ++k)
#pragma unroll
                    for (int st = 0; st < 2; ++st) { const float nr = K.are[st] * hre[st] - K.aim[st] * him[st] + dre[st][i0 + k]; const float ni = K.are[st] * him[st] + K.aim[st] * hre[st] + dim[st][i0 + k];
                        hre[st] = nr; him[st] = ni; dre[st][i0 + k] = nr; dim[st][i0 + k] = ni; }
            }
#pragma unroll
            for (int st = 0; st < 2; ++st) { const float pr = __shfl_xor(hre[st], 32), pi = __shfl_xor(him[st], 32); if (half != hf) { hre[st] = pr; him[st] = pi; } }
        }
    }
    if (OUT) {
#pragma unroll
        for (int i = 0; i < 16; ++i) { const int tr = (i & 3) + 8 * (i >> 2) + 4 * half; LAS bf16_t* hp = Hs + tr * 136 + tok;
#pragma unroll
            for (int st = 0; st < 2; ++st) { hp[st * 32] = (bf16_t)f2bf(dre[st][i]); hp[64 + st * 32] = (bf16_t)f2bf(dim[st][i]); } }
        const int l15 = lane & 15, quad = lane >> 4;
#pragma unroll
        for (int tt = 0; tt < 2; ++tt) {
            if (tt * 16 < nvalid) {
                f32x4 acc = {0.f, 0.f, 0.f, 0.f};
#pragma unroll
                for (int ks = 0; ks < 4; ++ks) { const bf16x8 hf8 = *(const LAS bf16x8*)(Hs + (tt * 16 + l15) * 136 + ks * 32 + quad * 8); acc = MFMA16(K.cf[ks], hf8, acc); }
                const int tk = tt * 16 + l15;
                if (tk < nvalid) { const size_t ro = (size_t)(row0 + tk) * 512 + g * 16 + quad * 4;
                    const f32x4 u4 = *(const f32x4*)(U + ro), d4 = *(const f32x4*)(dvec + quad * 4); f32x4 y = acc + d4 * u4;
                    y[0] = gelu_tanh(y[0]); y[1] = gelu_tanh(y[1]); y[2] = gelu_tanh(y[2]); y[3] = gelu_tanh(y[3]);
                    st_bf4(YC0 + ro, y); }
            }
        }
    }
}
DI void s5_load_consts(S5C& K, const unsigned char* ws, int lg, int lane) {
    const bf16_t* BBF = (const bf16_t*)(ws + WS_TAB + TB_BBF); const bf16_t* CF = (const bf16_t*)(ws + WS_TAB + TB_CF); const float* AB = (const float*)(ws + WS_TAB + TB_ABAR);
#pragma unroll
    for (int t = 0; t < 4; ++t) { K.bbf[t] = *(const bf16x8*)(BBF + (((size_t)lg * 4 + t) * 64 + lane) * 8); K.cf[t] = *(const bf16x8*)(CF + (((size_t)lg * 4 + t) * 64 + lane) * 8); }
#pragma unroll
    for (int st = 0; st < 2; ++st) { const int p = st * 32 + (lane & 31); K.are[st] = AB[((size_t)lg * 64 + p) * 2]; K.aim[st] = AB[((size_t)lg * 64 + p) * 2 + 1]; }
}
DI void s5_prompt_task(LAS unsigned char* lds, int task, int l, ArgsP a, const float* U, bf16_t* YC0, int tid) {
    const int b = task >> 5, g = task & 31, lg = l * 32 + g, wave = tid >> 6, lane = tid & 63;
    LAS bf16_t* Hs = (LAS bf16_t*)(lds + wave * 8704);
    LAS float* Es = (LAS float*)(lds + 8 * 8704);
    S5C K; s5_load_consts(K, a->ws, lg, lane);
    const float* dvec = a->in[24] + l * 512 + g * 16;
    const int rowb = b * 2048 + wave * 256;
    float hre[2] = {0.f, 0.f}, him[2] = {0.f, 0.f};
    for (int tl = 0; tl < 8; ++tl) s5_tile<false>(K, U, rowb + tl * 32, g, 8, 32, hre, him, Hs, dvec, YC0, lane);
    if (lane < 32) { Es[(wave * 4 + 0) * 32 + lane] = hre[0]; Es[(wave * 4 + 1) * 32 + lane] = hre[1]; Es[(wave * 4 + 2) * 32 + lane] = him[0]; Es[(wave * 4 + 3) * 32 + lane] = him[1]; }
    __syncthreads();
    { const float* A256 = (const float*)(a->ws + WS_TAB + TB_ABAR256); float pr[2], pi[2];
#pragma unroll
      for (int st = 0; st < 2; ++st) { const int p = st * 32 + (lane & 31); pr[st] = A256[((size_t)lg * 64 + p) * 2]; pi[st] = A256[((size_t)lg * 64 + p) * 2 + 1]; hre[st] = 0.f; him[st] = 0.f; }
      for (int w = 0; w < wave; ++w) {
#pragma unroll
          for (int st = 0; st < 2; ++st) { const float er = Es[(w * 4 + st) * 32 + (lane & 31)], ei = Es[(w * 4 + 2 + st) * 32 + (lane & 31)];
              const float nr = pr[st] * hre[st] - pi[st] * him[st] + er, ni = pr[st] * him[st] + pi[st] * hre[st] + ei; hre[st] = nr; him[st] = ni; } } }
    for (int tl = 0; tl < 8; ++tl) s5_tile<true>(K, U, rowb + tl * 32, g, 8, 32, hre, him, Hs, dvec, YC0, lane);
    if (wave == 7 && lane < 32) {
#pragma unroll
        for (int st = 0; st < 2; ++st) { a->out[OFF_SRP + ((size_t)(l * 8 + b) * 32 + g) * 64 + st * 32 + lane] = hre[st]; a->out[OFF_SIP + ((size_t)(l * 8 + b) * 32 + g) * 64 + st * 32 + lane] = him[st]; } }
    __syncthreads();
}
DI void s5_sample_task(LAS unsigned char* lds, int task, int l, ArgsP a, const float* U, bf16_t* YC0, int tid) {
    const int bs = task >> 5, g = task & 31, lg = l * 32 + g, wave = tid >> 6, lane = tid & 63;
    LAS bf16_t* Hs = (LAS bf16_t*)(lds + wave * 8704);
    S5C K; s5_load_consts(K, a->ws, lg, lane);
    const size_t so = ((size_t)(l * 128 + bs) * 32 + g) * 64;
    float hre[2], him[2];
#pragma unroll
    for (int st = 0; st < 2; ++st) { hre[st] = a->in[5][so + st * 32 + (lane & 31)]; him[st] = a->in[6][so + st * 32 + (lane & 31)]; }
    s5_tile<true>(K, U, MP + bs * 4, g, 1, 4, hre, him, Hs, a->in[24] + l * 512 + g * 16, YC0, lane);
    if (lane < 32) {
#pragma unroll
        for (int st = 0; st < 2; ++st) { a->out[OFF_SRS + so + st * 32 + lane] = hre[st]; a->out[OFF_SIS + so + st * 32 + lane] = him[st]; } }
}

DI void mixers_phase(ArgsP a, LAS unsigned char* lds, int l, int tid) {
    unsigned char* ws = a->ws;
    const float* XA = (const float*)(ws + WS_XA); const float* U = (const float*)(ws + WS_U);
    const bf16_t* Q = (const bf16_t*)(ws + WS_Q); const bf16_t* KB = (const bf16_t*)(ws + WS_K); const bf16_t* VB = (const bf16_t*)(ws + WS_V);
    bf16_t* Dm = (bf16_t*)(ws + WS_DYY); bf16_t* YB = Dm + (size_t)M * 512; bf16_t* YC0 = (bf16_t*)(ws + WS_YC0);
    const int wave = tid >> 6, lane = tid & 63, gw = blockIdx.x * 8 + wave, NGW = gridDim.x * 8;
    const int vcb = (gridDim.x % 8 == 0) ? (blockIdx.x % 8) * (gridDim.x / 8) + blockIdx.x / 8 : blockIdx.x;
    for (int rp = 0; rp < 1 + ((MIXM >> 0) & 1); ++rp) for (int u = vcb; u < 256; u += gridDim.x) attn_prompt_unit(lds, u, Q, KB, VB, YB, a->in[16] + l * 8, tid);
    for (int rp = 0; rp < 1 + ((MIXM >> 1) & 1); ++rp) for (int t = vcb; t < 256; t += gridDim.x) s5_prompt_task(lds, t, l, a, U, YC0, tid);
    for (int rp = 0; rp < 1 + ((MIXM >> 2) & 1); ++rp) for (int t = gw; t < 4096; t += NGW) s5_sample_task(lds, t, l, a, U, YC0, tid);
    __syncthreads();
    for (int rp = 0; rp < 1 + ((MIXM >> 3) & 1); ++rp) for (int t = gw; t < 1024; t += NGW) attn_sample_task(lds + wave * 4096, t, l, a, Q, YB, lane);
}

__global__ void __launch_bounds__(512, 2) mega(Args a_unused) {
    extern __shared__ __attribute__((aligned(16))) unsigned char lds_raw[];
    LAS unsigned char* lds = (LAS unsigned char*)lds_raw;
    cg::grid_group grid = cg::this_grid();
    const int wave_s = __builtin_amdgcn_readfirstlane((int)threadIdx.x >> 6);
    volatile LAS unsigned* bst = (volatile LAS unsigned*)(lds + 135168);
    if (threadIdx.x < 2) bst[threadIdx.x] = 0u;
    __syncthreads();
    XcdBarrier xbar = xcd_barrier_post((unsigned*)(((ArgsP)__builtin_amdgcn_kernarg_segment_ptr())->ws), bst);
    const int ph_lo = ((ArgsP)__builtin_amdgcn_kernarg_segment_ptr())->ph_lo, ph_hi = ((ArgsP)__builtin_amdgcn_kernarg_segment_ptr())->ph_hi;
    for (int ph = ph_lo; ph < ph_hi; ++ph) {
        const int kk9 = (ph - 2) % 9;
        const int cls = ph == 0 ? 0 : ph == 1 ? 1 : ph == NPHASE - 1 ? 10 : (kk9 == 0 || kk9 == 6) ? 2 : kk9 == 1 ? 3 : kk9 == 2 ? 4 : kk9 == 3 ? 5 : kk9 == 4 ? 6 : kk9 == 5 ? 7 : kk9 == 7 ? 8 : 9;
        const int nrep = 1 + ((REPM >> cls) & 1);
        for (int rep = 0; rep < nrep; ++rep) {
        ArgsP a = (ArgsP)__builtin_amdgcn_kernarg_segment_ptr(); asm volatile("" : "+s"(a));
        int G = gridDim.x, c = blockIdx.x; asm volatile("" : "+s"(G), "+s"(c));
        int tid = wave_s * 64 + lane_id_v(); asm volatile("" : "+v"(tid));
        unsigned char* ws = a->ws;
        float* X = a->out;
        float* MOD = (float*)(ws + WS_MOD);
        bf16_t* H = (bf16_t*)(ws + WS_H);
        if (ph == 0) { if (PHM & 1) prologue(a, lds, tid); }
        else if (ph == 1) { if (PHM & 4) {
            pg8::Gemm g{(const bf16_t*)(ws + WS_CA), (const bf16_t*)(ws + WS_GT), 256, NMOD, 1024}; pg8::StaticOrder S; S.init(256, NMOD, G, c);
            pg8::EpiMod E{MOD, a->in[12]};
            pg8::gemm_phase<pg8::EpiMod, pg8::StaticOrder, true, true>(lds, g, S, E, wave_s * 64 + lane_id_v());
            { const int t_ = wave_s * 64 + lane_id_v(); if (G > 96) { if (c >= 96) cache_shift(a, (c - 96) * 512 + t_, (G - 96) * 512); } else cache_shift(a, c * 512 + t_, G * 512); } }
        } else if (ph == NPHASE - 1) norm_phase(X, X, a->in[32], MOD, 0, nullptr, tid, (const float*)(ws + WS_DYY), 22, MOD + 3 * 6144 + 5120, X);
        else {
            const int l = (ph - 2) / 9, k = (ph - 2) % 9;
            const float* xp = l == 0 ? a->in[0] : X; const float* xs = l == 0 ? a->in[1] - (size_t)MP * 1024 : X;
            if (k == 0) norm_phase(xp, xs, a->in[9] + l * 1024, MOD + l * 6144, 1024, H, tid, (const float*)(ws + WS_DYY), l == 0 ? 0 : 22, MOD + (l - 1) * 6144 + 5120, X);
            else if (k == 1) { if (GM & 1) {
                pg8::Gemm g{H, (const bf16_t*)(ws + WS_WIN) + (size_t)l * IN_COLS * 1024, M, IN_COLS, 1024}; pg8::StaticOrder S; S.init(M, IN_COLS, G, c);
                pg8::EpiIn E{(float*)(ws + WS_XA), (float*)(ws + WS_U), (bf16_t*)(ws + WS_Q), (bf16_t*)(ws + WS_K), (bf16_t*)(ws + WS_V), (bf16_t*)(ws + WS_GT),
                             (const float*)(ws + WS_TAB + TB_ROPEC), (const float*)(ws + WS_TAB + TB_ROPES), a->out, l};
                pg8::gemm_phase<pg8::EpiIn, pg8::StaticOrder, true, true>(lds, g, S, E, wave_s * 64 + lane_id_v()); }
            } else if (k == 2) { if (PHM & 2) mixers_phase(a, lds, l, tid); }
            else if (k == 3) { if (GM & 2) {
                pg8::Gemm g{(const bf16_t*)(ws + WS_YC0), (const bf16_t*)(ws + WS_WGLU) + (size_t)l * 512 * 512, M, 512, 512}; pg8::StaticOrder S; S.init(M, 512, G, c);
                pg8::EpiGlu E{(const bf16_t*)(ws + WS_YC0), (bf16_t*)(ws + WS_DYY) + (size_t)2 * M * 512};
                pg8::gemm_phase<pg8::EpiGlu, pg8::StaticOrder, true, true>(lds, g, S, E, wave_s * 64 + lane_id_v());
                {
                  constexpr int NI = 4 * (MP / 8) * 32; const float* XAp = (const float*)(ws + WS_XA); bf16_t* Dp = (bf16_t*)(ws + WS_DYY); const int t_ = wave_s * 64 + lane_id_v();
                  if (G > 132) { constexpr int SPLIT = (NI / 6 * 5) & ~63;
                      if (c >= 132) pool_phase(a, l, XAp, Dp, (c - 132) * 512 + t_, (G - 132) * 512, 0, SPLIT, true);
                      else pool_phase(a, l, XAp, Dp, c * 512 + t_, 132 * 512, SPLIT, NI, false); }
                  else pool_phase(a, l, XAp, Dp, c * 512 + t_, G * 512, 0, NI, true); } }
            } else if (k == 4) { if (GM & 4) {
                { pg8::Gemm g{(const bf16_t*)(ws + WS_DYY), (const bf16_t*)(ws + WS_WBR) + (size_t)l * 3072 * 512, 3 * M, 3072, 512, 0, 0}; pg8::BranchOrder S{G, c};
                  pg8::EpiMerge E{(const bf16_t*)(ws + WS_GT), (float*)(ws + WS_XA), H};
                  pg8::gemm_phase<pg8::EpiMerge, pg8::BranchOrder, true, true>(lds, g, S, E, wave_s * 64 + lane_id_v()); }
                { pg8::Gemm g{(const bf16_t*)(ws + WS_DYY), (const bf16_t*)(ws + WS_WBR) + (size_t)l * 3072 * 512, 3 * M, 3072, 128, 512, 512}; pg8::SplitOrder S{G, c, 4, 3};
                  pg8::EpiPart E{(float*)(ws + WS_Q), (const bf16_t*)(ws + WS_GT), 4};
                  pg8::gemm_phase<pg8::EpiPart, pg8::SplitOrder, true, true>(lds, g, S, E, wave_s * 64 + lane_id_v()); } }
            } else if (k == 5) { if (GM & 8) {
                { pg8::Gemm g{H, (const bf16_t*)(ws + WS_WOUT) + (size_t)l * 1024 * 1024, MP, 1024, 1024, 0, 0}; pg8::StaticOrder S; S.init(MP, 1024, G, c);
                  pg8::EpiRes E{xp, rep ? (float*)(ws + WS_XA) : X, MOD + l * 6144 + 2048};
                  pg8::gemm_phase<pg8::EpiRes, pg8::StaticOrder, true, true>(lds, g, S, E, wave_s * 64 + lane_id_v()); }
                for (int j = c; j < 64; j += G) { const int ks = j & 7, pmr = j >> 5; const float* Pm = (const float*)(ws + WS_Q);
                    for (int e2 = wave_s * 64 + lane_id_v(); e2 < 256 * 32; e2 += 512) { const int rs = pmr * 256 + (e2 >> 5), c4 = ks * 128 + (e2 & 31) * 4; f32x4 s = {0.f, 0.f, 0.f, 0.f};
#pragma unroll
                        for (int p = 0; p < 12; ++p) s += *(const f32x4*)(Pm + ((size_t)p * 512 + rs) * 1024 + c4);
                        st_bf4(H + (size_t)(MP + rs) * 1024 + c4, s); } }
                asm volatile("s_waitcnt vmcnt(0)" ::: "memory"); __syncthreads();
                { pg8::Gemm g{H, (const bf16_t*)(ws + WS_WOUT) + (size_t)l * 1024 * 1024, M, 1024, 128, 1024, 1024}; pg8::SplitOrder S{G, c, 8, 1};
                  pg8::EpiPart E{(float*)(ws + WS_YC0), nullptr, 8};
                  pg8::gemm_phase<pg8::EpiPart, pg8::SplitOrder, true, true>(lds, g, S, E, wave_s * 64 + lane_id_v()); } }
            } else if (k == 6) norm_phase(X, xs, a->in[10] + l * 1024, MOD + l * 6144 + 3072, 1024, H, tid, (const float*)(ws + WS_YC0), 8, MOD + l * 6144 + 2048, X);
            else if (k == 7) { if (GM & 16) {
                pg8::Gemm g{H, (const bf16_t*)(ws + WS_WFI) + (size_t)l * 2 * DFF * 1024, M, 2 * DFF, 1024}; pg8::StaticOrder S; S.init(M, 2 * DFF, G, c);
                pg8::EpiFfn E{(bf16_t*)(ws + WS_GT)};
                pg8::gemm_phase<pg8::EpiFfn, pg8::StaticOrder, true, true>(lds, g, S, E, wave_s * 64 + lane_id_v()); }
            } else if (GM & 32) {
                { pg8::Gemm g{(const bf16_t*)(ws + WS_GT), (const bf16_t*)(ws + WS_WFO) + (size_t)l * 1024 * DFF, MP, 1024, DFF, 0, 0}; pg8::StaticOrder S; S.init(MP, 1024, G, c);
                  pg8::EpiRes E{X, rep ? (float*)(ws + WS_XA) : X, MOD + l * 6144 + 5120};
                  pg8::gemm_phase<pg8::EpiRes, pg8::StaticOrder, true, true>(lds, g, S, E, wave_s * 64 + lane_id_v()); }
                { pg8::Gemm g{(const bf16_t*)(ws + WS_GT), (const bf16_t*)(ws + WS_WFO) + (size_t)l * 1024 * DFF, M, 1024, 128, DFF, DFF}; pg8::SplitOrder S{G, c, 22, 1};
                  pg8::EpiPart E{(float*)(ws + WS_DYY), nullptr, 22};
                  pg8::gemm_phase<pg8::EpiPart, pg8::SplitOrder, true, true>(lds, g, S, E, wave_s * 64 + lane_id_v()); }
            }
        }
        if (REPM && rep + 1 < nrep) __syncthreads();
        }
        if (ph + 1 < ph_hi) { if (SYNC2 == 1 || ph_hi > 1000) grid.sync(); else { XcdBarrier xb = xbar; asm volatile("" : "+s"(xb.x), "+s"(xb.bar));
            xcd_barrier(xb); if (SYNC2 == 2) xcd_barrier(xb); } }
    }
}

extern "C" void kernel_launch(void* const* d_in, const int* in_sizes, int n_in, void* d_out, int out_size, void* d_ws, size_t ws_size, hipStream_t stream) {
    static int grid = 0;
    if (grid == 0) {
        if (n_in != 33 || (size_t)out_size != OUT_TOTAL || ws_size < WS_END) { fprintf(stderr, "kernel_launch: unexpected shapes: n_in %d out %d ws %zu (need %zu)\n", n_in, out_size, ws_size, (size_t)WS_END); grid = -1; return; }
        int dev = 0, cus = 0, per_cu = 0;
        (void)hipGetDevice(&dev); (void)hipDeviceGetAttribute(&cus, hipDeviceAttributeMultiprocessorCount, dev);
        if (hipFuncSetAttribute((const void*)mega, hipFuncAttributeMaxDynamicSharedMemorySize, LDS_BYTES) != hipSuccess) { fprintf(stderr, "kernel_launch: hipFuncSetAttribute failed\n"); grid = -1; return; }
        if (hipOccupancyMaxActiveBlocksPerMultiprocessor(&per_cu, (const void*)mega, 512, LDS_BYTES) != hipSuccess || per_cu < 1) { fprintf(stderr, "kernel_launch: occupancy query says %d\n", per_cu); per_cu = 1; }
        (void)hipGetLastError();
        grid = cus * 1;
        if (grid <= 0) grid = 256;
    }
    if (grid < 0) return;
    Args a{};
    for (int i = 0; i < 33; ++i) a.in[i] = (const float*)d_in[i];
    a.out = (float*)d_out; a.ws = (unsigned char*)d_ws;
    for (int j = 0; j < 8; ++j) a.rfix[j] = (unsigned long long)ldexpl(powl(500000.0L, -(long double)j / 8.0L) / (2.0L * 3.14159265358979323846264338327950288L), 64);
#if MK_MULTI
    for (int ph = 0; ph < NPHASE; ++ph) { a.ph_lo = ph; a.ph_hi = ph + 1; hipLaunchKernelGGL(mega, dim3(grid), dim3(512), LDS_BYTES, stream, a); }
#else
    a.ph_lo = 0; a.ph_hi = NPHASE;
    if (hipMemsetAsync(d_ws, 0, 16384, stream) != hipSuccess) { fprintf(stderr, "kernel_launch: memset failed\n"); return; }
    void* args[] = {&a};
    hipError_t e = hipLaunchCooperativeKernel((const void*)mega, dim3(grid), dim3(512), args, LDS_BYTES, stream);
    if (e != hipSuccess) fprintf(stderr, "kernel_launch: cooperative launch failed: %s (grid %d)\n", hipGetErrorString(e), grid);
#endif
}
```
